# Optimizing an MI355X kernel written in HIP

```python
import jax, jax.numpy as jnp
from jax import lax
import numpy as np

D_MODEL = 1024
BATCH = 8
SEQ = 2048
DEPTH = 1
DEC_BATCH = 32
DEC_SEQ = 8
PAST_LEN = 8192
PAGE_SIZE = 128

HEAD_DIM = 64
D_MIX = D_MODEL
SB_HEADS = (D_MIX // 2) // HEAD_DIM
NSA_HEADS = (D_MIX // 2) // HEAD_DIM
NSA_KV_HEADS = 2
NSA_GROUP = NSA_HEADS // NSA_KV_HEADS
CMP_BLOCK = 32
CMP_HIDDEN = 256
SEL_BLOCK = 64
N_SEL = 16
WINDOW = 512
PLE_DIM = 256
SB_Q_BLOCK = 128
NSA_Q_BLOCK = 64
EPS = 1e-6
FORCED_SCORE = 1e3
NEG_INF = -1e30
SB_W = SB_HEADS * HEAD_DIM
NSA_W = NSA_HEADS * HEAD_DIM
KV_W = NSA_KV_HEADS * HEAD_DIM
SPLITS = (SB_W, SB_W, SB_W, SB_W, NSA_W, KV_W, KV_W, KV_W, KV_W, KV_W, KV_W, 3 * NSA_HEADS, NSA_W)
N_IN = sum(SPLITS)

kernel_name = "hymba_stickbreak_nsa_decode_step"


def rms_norm(x, g):
    xf = x.astype(jnp.float32)
    y = xf * lax.rsqrt(jnp.mean(xf * xf, axis=-1, keepdims=True) + EPS)
    return (y * g.astype(jnp.float32)).astype(x.dtype)


def alibi_slopes():
    h = np.arange(1, NSA_HEADS + 1, dtype=np.float32)
    slopes = np.power(np.float32(2.0), -8.0 * h / NSA_HEADS).astype(np.float32)
    return jnp.asarray(slopes, dtype=jnp.float32).reshape(NSA_KV_HEADS, NSA_GROUP)


def masked_softmax(s, mask):
    s = jnp.where(mask, s, NEG_INF)
    m = jnp.max(s, axis=-1, keepdims=True)
    e = jnp.where(mask, jnp.exp(s - m), 0.0)
    den = jnp.sum(e, axis=-1, keepdims=True)
    return e / jnp.where(den > 0, den, 1.0)


def sweep_query_blocks(fn, qs, q_pos, block):
    T = q_pos.shape[0]
    if T <= block or T % block:
        return fn(*qs, q_pos)
    nb = T // block

    def split(a):
        return a.reshape(a.shape[0], nb, block, *a.shape[2:]).swapaxes(0, 1)

    xs = (tuple(split(a) for a in qs), q_pos.reshape(nb, block))
    out = lax.map(lambda z: fn(*z[0], z[1]), xs)
    return out.swapaxes(0, 1).reshape(out.shape[1], T, *out.shape[3:])


def gather_pages(pool, page_table):
    rows = pool[page_table]
    return rows.reshape(rows.shape[0], rows.shape[1] * rows.shape[2], *rows.shape[3:])


def stick_breaking(q, q_pos, k, v, k_pos):
    z = jnp.einsum('bqhd,bkhd->bhqk', q, k).astype(jnp.float32) * (HEAD_DIM ** -0.5)
    before = (k_pos[None, :] < q_pos[:, None])[None, None]
    log_beta = jnp.where(before, jax.nn.log_sigmoid(z), -jnp.inf)
    log_keep = jnp.where(before, jax.nn.log_sigmoid(-z), 0.0)
    log_keep_after = lax.cumsum(log_keep, axis=3, reverse=True) - log_keep
    a = jnp.exp(log_beta + log_keep_after)
    return jnp.einsum('bhqk,bkhd->bqhd', a, v.astype(jnp.float32)).astype(q.dtype)


def compress(rows, pe, w1, w2):
    B, L, G, D = rows.shape
    blocks = rows.reshape(B, L // CMP_BLOCK, CMP_BLOCK, G, D) + pe[:, None, :]
    flat = blocks.transpose(0, 1, 3, 2, 4).reshape(B, L // CMP_BLOCK, G, CMP_BLOCK * D)
    return jax.nn.silu(flat @ w1) @ w2


def nsa_attend(q, gates, q_pos, kc, vc, k_sel, v_sel, k_win, v_win, kw_start):
    f32 = jnp.float32
    B, Tq = q.shape[:2]
    G, R, D = NSA_KV_HEADS, NSA_GROUP, HEAD_DIM
    scale = D ** -0.5
    slopes = alibi_slopes()
    qg = q.reshape(B, Tq, G, R, D)
    t = q_pos[:, None]

    n_cmp = kc.shape[1]
    c_end = jnp.arange(n_cmp, dtype=jnp.int32) * CMP_BLOCK + (CMP_BLOCK - 1)
    s = jnp.einsum('bqgrd,bcgd->bqgrc', qg, kc).astype(f32) * scale
    s = s - slopes[None, None, :, :, None] * (t - c_end[None, :]).astype(f32)[None, :, None, None, :]
    p_c = masked_softmax(s, (c_end[None, :] <= t)[None, :, None, None, :])
    o_c = jnp.einsum('bqgrc,bcgd->bqgrd', p_c, vc.astype(f32))

    n_blk = k_sel.shape[1] // SEL_BLOCK
    imp = p_c.sum(axis=3).reshape(B, Tq, G, n_blk, SEL_BLOCK // CMP_BLOCK).sum(-1)
    blk = jnp.arange(n_blk, dtype=jnp.int32)[None, :]
    cur = (q_pos // SEL_BLOCK)[:, None]
    forced = ((blk == 0) | (blk == cur) | (blk == cur - 1))[None, :, None, :]
    future = (blk > cur)[None, :, None, :]
    score = jnp.where(forced, FORCED_SCORE, jnp.where(future, -1.0, imp))
    n_top = min(N_SEL, n_blk)
    _, idx = lax.top_k(score, n_top)
    idx = idx.transpose(0, 2, 1, 3)
    kb = k_sel.reshape(B, n_blk, SEL_BLOCK, G, D).transpose(0, 3, 1, 2, 4)
    vb = v_sel.reshape(B, n_blk, SEL_BLOCK, G, D).transpose(0, 3, 1, 2, 4)
    take = jax.vmap(jax.vmap(lambda a, i: a[i]))
    gk = take(kb, idx)
    gv = take(vb, idx)
    kpos = (idx[..., None] * SEL_BLOCK + jnp.arange(SEL_BLOCK, dtype=jnp.int32))[:, :, :, None]
    tq = q_pos[None, None, :, None, None, None]
    qt = qg.transpose(0, 2, 1, 3, 4)
    s = jnp.einsum('bgqrd,bgqnld->bgqrnl', qt, gk).astype(f32) * scale
    s = s - slopes[None, :, None, :, None, None] * (tq - kpos).astype(f32)
    s = s.reshape(B, G, Tq, R, n_top * SEL_BLOCK)
    p_s = masked_softmax(s, (kpos <= tq).reshape(B, G, Tq, 1, n_top * SEL_BLOCK))
    o_s = jnp.einsum('bgqrk,bgqkd->bgqrd', p_s,
                     gv.reshape(B, G, Tq, n_top * SEL_BLOCK, D).astype(f32)).transpose(0, 2, 1, 3, 4)

    n_band = WINDOW + Tq
    start = q_pos[0] - WINDOW - kw_start
    kwb = lax.dynamic_slice_in_dim(k_win, start, n_band, axis=1)
    vwb = lax.dynamic_slice_in_dim(v_win, start, n_band, axis=1)
    wpos = q_pos[0] - WINDOW + jnp.arange(n_band, dtype=jnp.int32)
    s = jnp.einsum('bqgrd,bkgd->bqgrk', qg, kwb).astype(f32) * scale
    s = s - slopes[None, None, :, :, None] * (t - wpos[None, :]).astype(f32)[None, :, None, None, :]
    wmask = (wpos[None, :] <= t) & (wpos[None, :] > t - WINDOW) & (wpos[None, :] >= 0)
    p_w = masked_softmax(s, wmask[None, :, None, None, :])
    o_w = jnp.einsum('bqgrk,bkgd->bqgrd', p_w, vwb.astype(f32))

    g = gates.reshape(B, Tq, G, R, 3).astype(f32)
    o = g[..., 0:1] * o_c + g[..., 1:2] * o_s + g[..., 2:3] * o_w
    return o.reshape(B, Tq, NSA_HEADS, D).astype(q.dtype)


def project(x, norm_g, w_in, q_g, ks_g, kw_g):
    B, T, _ = x.shape
    h = rms_norm(x, norm_g)
    z = h @ w_in
    split_at = [int(c) for c in np.cumsum(SPLITS)[:-1]]
    (q_a, k_a, v_a, gate_a, q_b, kc, vc, ks, vs, kw, vw, br, gate_b) = jnp.split(z, split_at, axis=-1)

    def heads(a, n):
        return a.reshape(B, T, n, HEAD_DIM)

    G = NSA_KV_HEADS
    sb_rows = jnp.stack([heads(k_a, SB_HEADS), heads(v_a, SB_HEADS)], axis=2)
    nsa_rows = jnp.stack([heads(kc, G), heads(vc, G), rms_norm(heads(ks, G), ks_g), heads(vs, G)], axis=2)
    win_rows = jnp.stack([rms_norm(heads(kw, G), kw_g), heads(vw, G)], axis=2)
    q_b = rms_norm(heads(q_b, NSA_HEADS), q_g)
    br = jax.nn.sigmoid(br.reshape(B, T, NSA_HEADS, 3))
    return heads(q_a, SB_HEADS), gate_a, q_b, br, gate_b, sb_rows, nsa_rows, win_rows


def decoder_layer(x, p, start_pos, past_sb, past_nsa, past_win, win_keep, lw):
    (norm_g, w_in, q_g, kc_g, ks_g, kw_g, pe_k, w1_k, w2_k, pe_v, w1_v, w2_v, w_out, w_ple, w_ple_gate) = lw
    B, T, _ = x.shape
    q_a, gate_a, q_b, br, gate_b, sb_rows, nsa_rows, win_rows = project(x, norm_g, w_in, q_g, ks_g, kw_g)
    q_pos = start_pos + jnp.arange(T, dtype=jnp.int32)

    sb = jnp.concatenate([past_sb, sb_rows], axis=1)
    sb_k, sb_v = sb[:, :, 0], sb[:, :, 1]
    k_pos = jnp.arange(sb.shape[1], dtype=jnp.int32)
    o_sb = sweep_query_blocks(lambda qb, pb: stick_breaking(qb, pb, sb_k, sb_v, k_pos), (q_a,), q_pos, SB_Q_BLOCK)

    nsa = jnp.concatenate([past_nsa, nsa_rows], axis=1)
    L = nsa.shape[1]
    l_pad = -(-L // SEL_BLOCK) * SEL_BLOCK
    nsa = jnp.pad(nsa, ((0, 0), (0, l_pad - L), (0, 0), (0, 0), (0, 0)))
    kc = rms_norm(compress(nsa[:, :, 0], pe_k, w1_k, w2_k), kc_g)
    vc = compress(nsa[:, :, 1], pe_v, w1_v, w2_v)
    k_sel, v_sel = nsa[:, :, 2], nsa[:, :, 3]
    win = jnp.concatenate([past_win, win_rows], axis=1)
    win_p = jnp.pad(win, ((0, 0), (WINDOW - past_win.shape[1], 0), (0, 0), (0, 0), (0, 0)))
    k_win, v_win = win_p[:, :, 0], win_p[:, :, 1]
    kw_start = start_pos - WINDOW
    o_nsa = sweep_query_blocks(
        lambda qb, gb, pb: nsa_attend(qb, gb, pb, kc, vc, k_sel, v_sel, k_win, v_win, kw_start),
        (q_b, br), q_pos, NSA_Q_BLOCK)

    u = jnp.concatenate([o_sb.reshape(B, T, SB_W) * jax.nn.silu(gate_a),
                         o_nsa.reshape(B, T, NSA_W) * jax.nn.silu(gate_b)], axis=-1)
    h = x + u @ w_out
    y = h + jax.nn.sigmoid(h @ w_ple_gate) * (p @ w_ple)
    return y, sb_rows, nsa_rows, win[:, win.shape[1] - win_keep:]


def setup_inputs(seed: int = 0) -> dict:
    key = jax.random.key(seed)
    ks = jax.random.split(key, 23)
    n_pages = PAST_LEN // PAGE_SIZE
    n_used = DEC_BATCH * n_pages
    n_pool = n_used + n_used // 4
    w_buf = min(WINDOW, PAST_LEN)
    f32 = jnp.float32

    def nrm(k, shape, s=1.0):
        return jax.random.normal(k, shape, f32) * s

    def gain(k, shape):
        return 1.0 + 0.01 * jax.random.normal(k, shape, f32)

    page_table = jax.random.permutation(ks[7], n_pool)[:n_used].reshape(DEC_BATCH, n_pages).astype(jnp.int32)
    return {
        "x_prompt": nrm(ks[0], (BATCH, SEQ, D_MODEL)),
        "x_sample": nrm(ks[1], (DEC_BATCH, DEC_SEQ, D_MODEL)),
        "p_prompt": nrm(ks[2], (DEPTH, BATCH, SEQ, PLE_DIM)),
        "p_sample": nrm(ks[3], (DEPTH, DEC_BATCH, DEC_SEQ, PLE_DIM)),
        "cache_sb": nrm(ks[4], (DEPTH, n_pool, PAGE_SIZE, 2, SB_HEADS, HEAD_DIM)),
        "cache_nsa": nrm(ks[5], (DEPTH, n_pool, PAGE_SIZE, 4, NSA_KV_HEADS, HEAD_DIM)),
        "state_win": nrm(ks[6], (DEPTH, DEC_BATCH, w_buf, 2, NSA_KV_HEADS, HEAD_DIM)),
        "page_table": page_table,
        "norm_g": gain(ks[8], (DEPTH, D_MODEL)),
        "w_in": nrm(ks[9], (DEPTH, D_MODEL, N_IN), D_MODEL ** -0.5),
        "q_norm_g": gain(ks[10], (DEPTH, HEAD_DIM)),
        "kcmp_norm_g": gain(ks[11], (DEPTH, HEAD_DIM)),
        "ksel_norm_g": gain(ks[12], (DEPTH, HEAD_DIM)),
        "kwin_norm_g": gain(ks[13], (DEPTH, HEAD_DIM)),
        "cmp_pos_k": nrm(ks[14], (DEPTH, CMP_BLOCK, HEAD_DIM), 0.1),
        "cmp_w1_k": nrm(ks[15], (DEPTH, CMP_BLOCK * HEAD_DIM, CMP_HIDDEN), (CMP_BLOCK * HEAD_DIM) ** -0.5),
        "cmp_w2_k": nrm(ks[16], (DEPTH, CMP_HIDDEN, HEAD_DIM), CMP_HIDDEN ** -0.5),
        "cmp_pos_v": nrm(ks[17], (DEPTH, CMP_BLOCK, HEAD_DIM), 0.1),
        "cmp_w1_v": nrm(ks[18], (DEPTH, CMP_BLOCK * HEAD_DIM, CMP_HIDDEN), (CMP_BLOCK * HEAD_DIM) ** -0.5),
        "cmp_w2_v": nrm(ks[19], (DEPTH, CMP_HIDDEN, HEAD_DIM), CMP_HIDDEN ** -0.5),
        "w_out": nrm(ks[20], (DEPTH, D_MIX, D_MODEL), D_MIX ** -0.5),
        "w_ple": nrm(ks[21], (DEPTH, PLE_DIM, D_MODEL), PLE_DIM ** -0.5),
        "w_ple_gate": nrm(ks[22], (DEPTH, D_MODEL, D_MODEL), D_MODEL ** -0.5),
    }


def reference(x_prompt, x_sample, p_prompt, p_sample, cache_sb, cache_nsa, state_win, page_table,
              norm_g, w_in, q_norm_g, kcmp_norm_g, ksel_norm_g, kwin_norm_g,
              cmp_pos_k, cmp_w1_k, cmp_w2_k, cmp_pos_v, cmp_w1_v, cmp_w2_v,
              w_out, w_ple, w_ple_gate):
    B, T = x_prompt.shape[0], x_prompt.shape[1]
    dt = x_prompt.dtype
    empty_sb = jnp.zeros((B, 0, 2, SB_HEADS, HEAD_DIM), dt)
    empty_nsa = jnp.zeros((B, 0, 4, NSA_KV_HEADS, HEAD_DIM), dt)
    empty_win = jnp.zeros((B, 0, 2, NSA_KV_HEADS, HEAD_DIM), dt)
    y_p, y_s = x_prompt, x_sample
    sb_p, sb_s, nsa_p, nsa_s, win_p, win_s = [], [], [], [], [], []
    for i in range(DEPTH):
        lw = (norm_g[i], w_in[i], q_norm_g[i], kcmp_norm_g[i], ksel_norm_g[i], kwin_norm_g[i],
              cmp_pos_k[i], cmp_w1_k[i], cmp_w2_k[i], cmp_pos_v[i], cmp_w1_v[i], cmp_w2_v[i],
              w_out[i], w_ple[i], w_ple_gate[i])
        y_p, a, b, c = decoder_layer(y_p, p_prompt[i], 0, empty_sb, empty_nsa, empty_win, min(WINDOW, T), lw)
        sb_p.append(a); nsa_p.append(b); win_p.append(c)
        y_s, a, b, c = decoder_layer(y_s, p_sample[i], PAST_LEN,
                                     gather_pages(cache_sb[i], page_table),
                                     gather_pages(cache_nsa[i], page_table),
                                     state_win[i], state_win.shape[2], lw)
        sb_s.append(a); nsa_s.append(b); win_s.append(c)
    return (y_p, y_s, jnp.stack(sb_p), jnp.stack(sb_s), jnp.stack(nsa_p), jnp.stack(nsa_s), jnp.stack(win_p), jnp.stack(win_s))
```

```cpp
#include <hip/hip_runtime.h>
#include <cstdio>
#include <cstdint>
#define MK_N_LAUNCHES 6
namespace pg8 {
#define PG8_LAS __attribute__((address_space(3)))
typedef unsigned short bf16_t;
typedef short bf16x8 __attribute__((ext_vector_type(8)));
typedef float f32x4 __attribute__((ext_vector_type(4)));
typedef unsigned u32x4 __attribute__((ext_vector_type(4)));
constexpr int BM = 256, BK = 64, HALF = 128, HTB = HALF * BK * 2  , STAGE_BYTES = 8 * HTB, NXCD = 8, WGM = 8;

__host__ __device__ __forceinline__ int lds_byte(int r, int c) { const int st = (r >> 4) * 2 + (c >> 5), rr = r & 15, cc = c & 31, ob = rr * 64 + cc * 2; return st * 1024 + (ob ^ (((ob >> 9) & 1) << 5)); }
__host__ __device__ __forceinline__ void stage_rc(int b, int& R, int& C) { const int st = b / 1024, sb = b % 1024, swz = sb ^ (((sb >> 9) & 1) << 5); R = (st >> 1) * 16 + swz / 64; C = (st & 1) * 32 + (swz % 64) / 2; }
__host__ __device__ __forceinline__ int perm32(int rho) { const int n = rho >> 4, i = rho & 15; return 8 * (i >> 2) + 4 * n + (i & 3); }

struct Unit { int pm, pn; };
struct Gemm { const bf16_t* A; const bf16_t* Bt; int M, N, K; };

struct StaticOrder {
    int nM, nN, nwg, G, c;
    __host__ __device__ void init(int M, int N, int G_, int c_) { nM = M / BM; nN = N / BM; nwg = nM * nN; G = G_; c = c_; }
    __host__ __device__ bool next(int i, Unit& u) const {
        const long L = (long)i * G + c; if (L >= nwg) return false;
        int wgid = (int)L; { const int q = nwg / NXCD, r = nwg % NXCD, xcd = wgid % NXCD, off = wgid / NXCD; wgid = (xcd < r ? xcd * (q + 1) : r * (q + 1) + (xcd - r) * q) + off; }
        const int nig = WGM * nN, gid = wgid / nig, fm = gid * WGM, gsz = (nM - fm) < WGM ? (nM - fm) : WGM;
        u.pm = fm + ((wgid % nig) % gsz); u.pn = (wgid % nig) / gsz; return true;
    }
    __device__ __forceinline__ void a_ready(const Unit&) const {}
    __device__ __forceinline__ void done(const Unit&) const {}
};

__device__ __forceinline__ unsigned cvt_pk_bf16(float lo, float hi) { unsigned r; asm volatile("v_cvt_pk_bf16_f32 %0, %1, %2" : "=v"(r) : "v"(lo), "v"(hi)); return r; }
typedef float f32x2 __attribute__((ext_vector_type(2)));
__device__ __forceinline__ f32x2 gelu_pk(f32x2 v) {
    const f32x2 av = __builtin_elementwise_abs(v), d = av * 0.2316418882f + 1.0f;
    f32x2 t; t.x = __builtin_amdgcn_rcpf(d.x); t.y = __builtin_amdgcn_rcpf(d.y);
    f32x2 q = t * 0.5307027145f + (-0.7265760135f); q = q * t + 0.7107068705f; q = q * t + (-0.142248368f); q = q * t + 0.127414796f; q = q * t;
    const f32x2 s = (v * v) * (-0.72134752044f);
    f32x2 e; e.x = __builtin_amdgcn_exp2f(s.x); e.y = __builtin_amdgcn_exp2f(s.y);
    const f32x2 m = v * (q * e), r = v - m;
    f32x2 o; o.x = v.x < 0.f ? m.x : r.x; o.y = v.y < 0.f ? m.y : r.y; return o;
}

template <int ACT  > struct EpiBf16 {
    static constexpr bool PERM = true, AFTER_DRAIN = false; static_assert(ACT == 0 || ACT == 1, "EpiBf16: ACT is 0 (none) or 1 (gelu_pk)");
    bf16_t* O; int ldc; const float* bias; int split_cols; size_t split_stride; float scale0;
    __device__ __forceinline__ void operator()(const f32x4 (&acc)[2][2][4][2], const Unit& u, int wr, int wc, int fr, int fq) const {
        const int row0 = u.pm * BM + wr * 64 + fr; int colt = u.pn * BM; bf16_t* base = O;
        float sc = 1.f; if (split_cols) { const int t = colt / split_cols; base += (size_t)t * split_stride; colt -= t * split_cols; if (t == 0) sc = scale0; }
        const int col0 = colt + wc * 32 + 8 * fq, bcol0 = u.pn * BM + wc * 32 + 8 * fq;
        f32x4 bv[2][2];
#pragma unroll
        for (int bj = 0; bj < 2; ++bj)
#pragma unroll
            for (int n = 0; n < 2; ++n) bv[bj][n] = bias ? *(const f32x4*)(bias + bcol0 + bj * HALF + 4 * n) : (f32x4){0.f, 0.f, 0.f, 0.f};
#pragma unroll
        for (int ai = 0; ai < 2; ++ai)
#pragma unroll
            for (int m = 0; m < 4; ++m) { bf16_t* rowp = base + (size_t)(row0 + ai * HALF + m * 16) * ldc + col0;
#pragma unroll
                for (int bj = 0; bj < 2; ++bj) { f32x4 v0 = acc[ai][bj][m][0] + bv[bj][0], v1 = acc[ai][bj][m][1] + bv[bj][1];
                    if (ACT == 1) { f32x2 a = gelu_pk((f32x2){v0[0], v0[1]}), b = gelu_pk((f32x2){v0[2], v0[3]}), c = gelu_pk((f32x2){v1[0], v1[1]}), d = gelu_pk((f32x2){v1[2], v1[3]});
                        v0 = (f32x4){a.x, a.y, b.x, b.y}; v1 = (f32x4){c.x, c.y, d.x, d.y}; }
                    v0 = v0 * sc; v1 = v1 * sc; u32x4 w; w.x = cvt_pk_bf16(v0[0], v0[1]); w.y = cvt_pk_bf16(v0[2], v0[3]); w.z = cvt_pk_bf16(v1[0], v1[1]); w.w = cvt_pk_bf16(v1[2], v1[3]);
                    *(u32x4*)(rowp + bj * HALF) = w; } }
    }
};

template <class Epi, class Sched, bool ALIGN_EPI = false, bool SP2 = false>
__device__ __forceinline__ void gemm_phase(PG8_LAS unsigned char* lds, const Gemm g, const Sched& S, const Epi& E) {
    int tid_ = threadIdx.x; asm volatile("" : "+v"(tid_));
    const int tid = tid_, wid = __builtin_amdgcn_readfirstlane(tid >> 6), lane = tid & 63, wr = wid >> 2, wc = wid & 3, fr = lane & 15, fq = lane >> 4;
    const int K = g.K, nt = K / BK;
    unsigned voffA[2], voffB[2];
#pragma unroll
    for (int i = 0; i < 2; ++i) { int R, C; stage_rc(tid * 16 + i * 8192, R, C); const int Rb = Epi::PERM ? ((R & ~31) + perm32(R & 31)) : R;
        voffA[i] = (unsigned)(R * K + C) * 2u; voffB[i] = (unsigned)(Rb * K + C) * 2u; }
    const size_t kstep = (size_t)(BK * 2);
    const size_t hstep = (size_t)HALF * K * 2;
    const size_t tstep = 2 * hstep;
    const unsigned ldsw = (unsigned)wid * 1024u;
    const int aoff = lds_byte(wr * 64 + fr, fq * 8), boff = lds_byte(wc * 32 + fr, fq * 8);
#define PG8_SA(b, h) (((b) * 2 + (h)) * HTB)
#define PG8_SB(b, h) ((4 + (b) * 2 + (h)) * HTB)
#define PG8_STAGE(bufoff, gbase, voff) do { _Pragma("unroll") for (int _i = 0; _i < 2; ++_i) \
        __builtin_amdgcn_global_load_lds((const unsigned*)((const char*)(gbase) + (voff)[_i]), (PG8_LAS unsigned*)(lds + (bufoff) + ldsw + _i * 8192), 16, 0, 0); } while (0)
#define PG8_LDA(dst, b, h) do { _Pragma("unroll") for (int m = 0; m < 4; ++m) _Pragma("unroll") for (int k = 0; k < 2; ++k) dst[m][k] = *(const PG8_LAS bf16x8*)(lds + PG8_SA(b, h) + aoff + m * 2048 + k * 1024); } while (0)
#define PG8_LDB(dst, b, h) do { _Pragma("unroll") for (int n = 0; n < 2; ++n) _Pragma("unroll") for (int k = 0; k < 2; ++k) dst[n][k] = *(const PG8_LAS bf16x8*)(lds + PG8_SB(b, h) + boff + n * 2048 + k * 1024); } while (0)
#define PG8_MMA(ai, bj, At, Bt) do { __builtin_amdgcn_s_setprio(1); _Pragma("unroll") for (int m = 0; m < 4; ++m) _Pragma("unroll") for (int n = 0; n < 2; ++n) _Pragma("unroll") for (int k = 0; k < 2; ++k) \
        acc[ai][bj][m][n] = __builtin_amdgcn_mfma_f32_16x16x32_bf16(Bt[n][k], At[m][k], acc[ai][bj][m][n], 0, 0, 0); __builtin_amdgcn_s_setprio(0); } while (0)
#define PG8_WAIT_V(n) asm volatile("s_waitcnt vmcnt(" #n ")" ::: "memory")
#define PG8_WAIT_L(n) asm volatile("s_waitcnt lgkmcnt(" #n ")" ::: "memory")
#define PG8_BAR __builtin_amdgcn_s_barrier()
#define PG8_SCHED __builtin_amdgcn_sched_barrier(0)
    Unit cur, nxt; int ui = 0;
    if (!S.next(0, cur)) return;
    f32x4 acc[2][2][4][2];
#pragma unroll
    for (int a = 0; a < 2; ++a)
#pragma unroll
        for (int b = 0; b < 2; ++b)
#pragma unroll
            for (int m = 0; m < 4; ++m)
#pragma unroll
                for (int n = 0; n < 2; ++n) acc[a][b][m][n] = (f32x4){0.f, 0.f, 0.f, 0.f};
    bf16x8 At[4][2], B0[2][2], B1[2][2];
    const char* cA = (const char*)g.A + (size_t)cur.pm * tstep; const char* cB = (const char*)g.Bt + (size_t)cur.pn * tstep;
    S.a_ready(cur);
    if constexpr (SP2) {
        PG8_STAGE(PG8_SB(0, 0), cB, voffB); PG8_STAGE(PG8_SB(0, 1), cB + hstep, voffB); PG8_STAGE(PG8_SA(0, 0), cA, voffA); PG8_STAGE(PG8_SA(0, 1), cA + hstep, voffA);
        if (wr == 1) PG8_BAR;
        PG8_WAIT_V(2); PG8_BAR;
        PG8_STAGE(PG8_SB(1, 0), cB + kstep, voffB); PG8_STAGE(PG8_SA(1, 0), cA + kstep, voffA); PG8_STAGE(PG8_SB(1, 1), cB + hstep + kstep, voffB);
        PG8_WAIT_V(6); PG8_BAR;
    } else {
        PG8_STAGE(PG8_SB(0, 0), cB, voffB); PG8_STAGE(PG8_SA(0, 0), cA, voffA); PG8_STAGE(PG8_SB(0, 1), cB + hstep, voffB); PG8_STAGE(PG8_SA(0, 1), cA + hstep, voffA);
        if (wr == 1) PG8_BAR;
        PG8_WAIT_V(4); PG8_BAR;
        PG8_STAGE(PG8_SB(1, 0), cB + kstep, voffB); PG8_STAGE(PG8_SA(1, 0), cA + kstep, voffA); PG8_STAGE(PG8_SB(1, 1), cB + hstep + kstep, voffB);
        PG8_WAIT_V(6); PG8_BAR;
    }
    for (;;) {
        const bool has_next = S.next(ui + 1, nxt);
        const char* nA = has_next ? (const char*)g.A + (size_t)nxt.pm * tstep : cA; const char* nB = has_next ? (const char*)g.Bt + (size_t)nxt.pn * tstep : cB;
        for (int t = 0; t < nt; t += 2) {
            const bool last = (t == nt - 2);
            const char* a1 = cA + (size_t)(t + 1) * kstep;
            const char* a2 = last ? nA : cA + (size_t)(t + 2) * kstep; const char* b2 = last ? nB : cB + (size_t)(t + 2) * kstep;
            const char* a3 = a2 + kstep; const char* b3 = b2 + kstep;
            if (last && has_next) S.a_ready(nxt);
            if constexpr (SP2) {
            PG8_LDB(B0, 0, 0); PG8_LDB(B1, 0, 1); PG8_SCHED; PG8_LDA(At, 0, 0); PG8_STAGE(PG8_SA(1, 1), a1 + hstep, voffA);
            PG8_WAIT_V(8); PG8_WAIT_L(0); PG8_BAR; PG8_MMA(0, 0, At, B0); PG8_MMA(0, 1, At, B1); PG8_BAR; PG8_SCHED;
            PG8_LDA(At, 0, 1); PG8_STAGE(PG8_SB(0, 0), b2, voffB); PG8_STAGE(PG8_SB(0, 1), b2 + hstep, voffB); PG8_STAGE(PG8_SA(0, 0), a2, voffA);
            PG8_WAIT_V(8); PG8_WAIT_L(0); PG8_BAR; PG8_MMA(1, 0, At, B0); PG8_MMA(1, 1, At, B1); PG8_BAR; PG8_SCHED;
            PG8_LDB(B0, 1, 0); PG8_LDB(B1, 1, 1); PG8_SCHED; PG8_LDA(At, 1, 0); PG8_STAGE(PG8_SA(0, 1), a2 + hstep, voffA);
            PG8_WAIT_V(8); PG8_WAIT_L(0); PG8_BAR; PG8_MMA(0, 0, At, B0); PG8_MMA(0, 1, At, B1); PG8_BAR; PG8_SCHED;
            PG8_LDA(At, 1, 1); PG8_STAGE(PG8_SB(1, 0), b3, voffB); PG8_STAGE(PG8_SB(1, 1), b3 + hstep, voffB); PG8_STAGE(PG8_SA(1, 0), a3, voffA);
            PG8_WAIT_V(8); PG8_WAIT_L(0); PG8_BAR; PG8_MMA(1, 0, At, B0); PG8_MMA(1, 1, At, B1); PG8_BAR; PG8_SCHED;
            } else {
            PG8_LDB(B0, 0, 0); PG8_SCHED; PG8_LDA(At, 0, 0); PG8_STAGE(PG8_SA(1, 1), a1 + hstep, voffA);
            PG8_WAIT_L(8); PG8_BAR; PG8_WAIT_L(0); PG8_MMA(0, 0, At, B0); PG8_BAR; PG8_SCHED;
            PG8_LDB(B1, 0, 1); PG8_STAGE(PG8_SB(0, 0), b2, voffB);
            PG8_BAR; PG8_WAIT_L(0); PG8_MMA(0, 1, At, B1); PG8_BAR;
            PG8_LDA(At, 0, 1); PG8_STAGE(PG8_SA(0, 0), a2, voffA);
            PG8_BAR; PG8_WAIT_L(0); PG8_MMA(1, 0, At, B0); PG8_BAR; PG8_SCHED;
            PG8_STAGE(PG8_SB(0, 1), b2 + hstep, voffB);
            PG8_WAIT_V(6); PG8_BAR; PG8_MMA(1, 1, At, B1); PG8_BAR;
            PG8_LDB(B0, 1, 0); PG8_SCHED; PG8_LDA(At, 1, 0); PG8_STAGE(PG8_SA(0, 1), a2 + hstep, voffA);
            PG8_WAIT_L(8); PG8_BAR; PG8_WAIT_L(0); PG8_MMA(0, 0, At, B0); PG8_BAR; PG8_SCHED;
            PG8_LDB(B1, 1, 1); PG8_STAGE(PG8_SB(1, 0), b3, voffB);
            PG8_BAR; PG8_WAIT_L(0); PG8_MMA(0, 1, At, B1); PG8_BAR;
            PG8_LDA(At, 1, 1); PG8_STAGE(PG8_SA(1, 0), a3, voffA);
            PG8_BAR; PG8_WAIT_L(0); PG8_MMA(1, 0, At, B0); PG8_BAR; PG8_SCHED;
            PG8_STAGE(PG8_SB(1, 1), b3 + hstep, voffB);
            PG8_WAIT_V(6); PG8_BAR; PG8_MMA(1, 1, At, B1); PG8_BAR;
            }
        }
        if constexpr (ALIGN_EPI) { if (wr == 0) PG8_BAR; }
        if constexpr (!Epi::AFTER_DRAIN) { E(acc, cur, wr, wc, fr, fq); S.done(cur); }
        if (!has_next) break;
#pragma unroll
        for (int a = 0; a < 2; ++a)
#pragma unroll
            for (int b = 0; b < 2; ++b)
#pragma unroll
                for (int m = 0; m < 4; ++m)
#pragma unroll
                    for (int n = 0; n < 2; ++n) acc[a][b][m][n] = (f32x4){0.f, 0.f, 0.f, 0.f};
        cur = nxt; cA = nA; cB = nB; ++ui;
        if constexpr (ALIGN_EPI) { if (wr == 1) PG8_BAR; }
    }
    PG8_WAIT_V(0);
    if constexpr (!ALIGN_EPI) { if (wr == 0) PG8_BAR; }
    PG8_BAR;
    if constexpr (Epi::AFTER_DRAIN) { E.fused(acc, cur, wr, wc, fr, fq, lds, wid, lane); S.done(cur); }
#undef PG8_SA
#undef PG8_SB
#undef PG8_STAGE
#undef PG8_LDA
#undef PG8_LDB
#undef PG8_MMA
#undef PG8_WAIT_V
#undef PG8_WAIT_L
#undef PG8_BAR
#undef PG8_SCHED
}
}


#ifndef PG8_SP2
#define PG8_SP2 true
#endif
#ifndef PG8_ALIGN
#define PG8_ALIGN true
#endif
#define GAS __attribute__((address_space(1)))
#define LAS __attribute__((address_space(3)))
typedef unsigned short bf16;
typedef unsigned v4u __attribute__((ext_vector_type(4)));
typedef float f32x4 __attribute__((ext_vector_type(4)));
typedef short bf16x8 __attribute__((ext_vector_type(8)));
typedef GAS unsigned gu32;
typedef GAS unsigned long long gu64;
#define RLX_AGENT __ATOMIC_RELAXED, __HIP_MEMORY_SCOPE_AGENT
#define LDS_WAIT() asm volatile("s_waitcnt lgkmcnt(0)" ::: "memory")
#define VM_WAIT() asm volatile("s_waitcnt vmcnt(0)" ::: "memory")
__device__ __forceinline__ unsigned long long rt() { return __builtin_amdgcn_s_memrealtime(); }
__device__ __forceinline__ unsigned f2bf(float f) { unsigned u = __builtin_bit_cast(unsigned, f); return (u + 0x7fffu + ((u >> 16) & 1u)) >> 16; }
__device__ __forceinline__ unsigned pk2(float lo, float hi) { return f2bf(lo) | (f2bf(hi) << 16); }

#define XB_TMO      128
#define XB_XCNT(j)  (256  + 64 * (j))
#define XB_XSUB(j)  (1280 + 64 * (j))
#define XB_XGEN(j)  (2304 + 64 * (j))
#define XB_TOP      3328
#define XB_TOPGEN   3392
#define XCD_BAR_WORDS 3456
#define XB_SPIN_CAP (1u << 18)

__device__ __forceinline__ unsigned xb_ld(unsigned* p)              { return __hip_atomic_load(p, __ATOMIC_RELAXED, __HIP_MEMORY_SCOPE_AGENT); }
__device__ __forceinline__ unsigned xb_add(unsigned* p, unsigned v) { return __hip_atomic_fetch_add(p, v, __ATOMIC_RELAXED, __HIP_MEMORY_SCOPE_AGENT); }
__device__ __forceinline__ unsigned xb_xcc_id() { return (unsigned)__builtin_amdgcn_s_getreg((3 << 11) | 20) & 0xFu; }
#define XB_SPIN(cond, bar) do { unsigned _sp = 0; while (cond) { __builtin_amdgcn_s_sleep(1); \
    if ((++_sp & 255u) == 0u) { if (xb_ld(&(bar)[XB_TMO])) break; if (_sp > XB_SPIN_CAP) { atomicAdd(&(bar)[XB_TMO], 1u); break; } } } } while (0)

struct XcdBarrier {
    unsigned* bar; unsigned x;
    volatile LAS unsigned* st;
};

__device__ __forceinline__ XcdBarrier xcd_barrier_post(unsigned* bar, volatile LAS unsigned* st) {
    XcdBarrier b; b.bar = bar; b.x = xb_xcc_id(); b.st = st;
    if (threadIdx.x == 0) (void)xb_add(&bar[XB_XCNT(b.x)], 1u);
    return b;
}
__device__ __forceinline__ void xcd_barrier_complete(unsigned* bar, unsigned x, unsigned& nloc, unsigned& nx) {
    const unsigned G = gridDim.x * gridDim.y * gridDim.z;
    unsigned sum, cnt, mine, sp = 0u;
    for (;;) {
        sum = 0u; cnt = 0u; mine = 0u;
#pragma unroll
        for (unsigned j = 0; j < 16; ++j) { const unsigned c = xb_ld(&bar[XB_XCNT(j)]); sum += c; cnt += (c > 0u) ? 1u : 0u; mine = (j == x) ? c : mine; }
        if (sum == G) break;
        __builtin_amdgcn_s_sleep(1);
        if ((++sp & 255u) == 0u) { if (xb_ld(&bar[XB_TMO])) break; if (sp > XB_SPIN_CAP) { atomicAdd(&bar[XB_TMO], 1u); break; } }
    }
    nloc = mine > 0u ? mine : 1u; nx = cnt > 0u ? cnt : 1u;
}

__device__ __forceinline__ void xcd_barrier(const XcdBarrier& b) {
    asm volatile("s_waitcnt vmcnt(0)" ::: "memory");
    __syncthreads();
    if (threadIdx.x == 0) {
        unsigned* bar = b.bar;
        __builtin_amdgcn_s_waitcnt(0);
        unsigned nloc = b.st[0], nx = b.st[1];
        if (nloc == 0u) { xcd_barrier_complete(bar, b.x, nloc, nx); b.st[0] = nloc; b.st[1] = nx; }
        const unsigned old = xb_add(&bar[XB_XSUB(b.x)], 1u);
        const unsigned gen = old / nloc;
        if (old + 1u == (gen + 1u) * nloc) {
            __builtin_amdgcn_fence(__ATOMIC_RELEASE, "agent");
            asm volatile("s_waitcnt vmcnt(0)" ::: "memory");
            const unsigned og = xb_add(&bar[XB_TOP], 1u);
            const unsigned tg = og / nx;
            if (og + 1u == (tg + 1u) * nx) xb_add(&bar[XB_TOPGEN], 1u);
            else XB_SPIN(xb_ld(&bar[XB_TOPGEN]) == tg, bar);
            __builtin_amdgcn_fence(__ATOMIC_ACQUIRE, "agent");
            xb_add(&bar[XB_XGEN(b.x)], 1u);
            asm volatile("s_waitcnt vmcnt(0)" ::: "memory");
        } else {
            XB_SPIN(xb_ld(&bar[XB_XGEN(b.x)]) == gen, bar);
            __builtin_amdgcn_fence(__ATOMIC_ACQUIRE, "agent");
            asm volatile("s_waitcnt vmcnt(0)" ::: "memory");
        }
    }
    __syncthreads();
}


constexpr int NWAVES = 8, NTHR = 512;
constexpr int MP = 16384, MS = 256, MT = 16640, DM = 1024, TP = 2048;
constexpr int NG1 = 3840, NIN = 3864;
constexpr float EPS = 1e-6f, LOG2E = 1.4426950408889634f, LN2 = 0.6931471805599453f;
constexpr size_t OFF_SB = 17039360, OFF_NSA = 34078720, OFF_WINP = 42598400, OFF_WINS = 43646976, OUT_TOTAL = 47841280;
enum { IN_XP = 0, IN_XS, IN_PP, IN_PS, IN_CSB, IN_CNSA, IN_SWIN, IN_PT, IN_NORMG, IN_WIN, IN_QG, IN_KCG, IN_KSG, IN_KWG, IN_PEK, IN_W1K, IN_W2K, IN_PEV, IN_W1V, IN_W2V, IN_WOUT, IN_WPLE, IN_WG, N_INPUTS };

constexpr size_t MiB = 1u << 20;
constexpr size_t WS_CTL = 0, CTL_ZERO_BYTES = 1 * MiB;
constexpr size_t WS_WIN_T = 2 * MiB, WS_W1T = 11 * MiB, WS_W2T = 13 * MiB, WS_WOUT_T = 14 * MiB, WS_WG_T = 16 * MiB, WS_WPLE_T = 18 * MiB;
constexpr size_t WS_RSTD = 19 * MiB, WS_BR = 20 * MiB, WS_HBF = 24 * MiB, WS_PBF = 58 * MiB;
constexpr size_t WS_QA = 68 * MiB, WS_KA = 86 * MiB, WS_VA = 104 * MiB, WS_GA = 122 * MiB, WS_QB = 140 * MiB, WS_GB = 158 * MiB;
constexpr size_t WS_KSEL = 176 * MiB, WS_VSEL = 182 * MiB, WS_KWIN = 188 * MiB, WS_VWIN = 194 * MiB;
constexpr size_t WS_ACMP_P = 200 * MiB, WS_HIDP = 208 * MiB, WS_HIDS = 210 * MiB, WS_KCS = 226 * MiB, WS_VCS = 228 * MiB;
constexpr size_t WS_OW = 232 * MiB, WS_U = 248 * MiB, WS_T1 = 282 * MiB, WS_HB2 = 316 * MiB, WS_ACMP_S = 352 * MiB, WS_END = 480 * MiB;
constexpr int CW_BAR = 4096;
constexpr int CW_Q = 16384;

constexpr int RING_BYTES = 131072, LDSCTL_OFF = RING_BYTES, MISC_OFF = LDSCTL_OFF + 320, LDS_BYTES = 147456;

typedef float f32x16 __attribute__((ext_vector_type(16)));
typedef short s16x4 __attribute__((ext_vector_type(4)));
typedef float f32x2_t __attribute__((ext_vector_type(2)));
typedef __bf16 bf16x2_t __attribute__((ext_vector_type(2)));
typedef unsigned v2u __attribute__((ext_vector_type(2)));
__device__ __forceinline__ unsigned cvtpk(float lo, float hi) { f32x2_t v = {lo, hi}; bf16x2_t b = __builtin_convertvector(v, bf16x2_t); return __builtin_bit_cast(unsigned, b); }
__device__ __forceinline__ float bf_lo(unsigned w) { return __builtin_bit_cast(float, w << 16); }
__device__ __forceinline__ float bf_hi(unsigned w) { return __builtin_bit_cast(float, w & 0xffff0000u); }
__device__ __forceinline__ float fexp2(float x) { return __builtin_amdgcn_exp2f(x); }
__device__ __forceinline__ float flog2(float x) { return __builtin_amdgcn_logf(x); }
__device__ __forceinline__ float frcp(float x) { return __builtin_amdgcn_rcpf(x); }
__device__ __forceinline__ float sigmoidf_(float x) { return frcp(1.f + fexp2(-x * LOG2E)); }
__device__ __forceinline__ float siluf_(float x) { return x * sigmoidf_(x); }
__device__ __forceinline__ float wave_sum(float v) {
#pragma unroll
    for (int o = 1; o < 64; o <<= 1) v += __shfl_xor(v, o);
    return v;
}
__device__ __forceinline__ float wave_max(float v) {
#pragma unroll
    for (int o = 1; o < 64; o <<= 1) v = fmaxf(v, __shfl_xor(v, o));
    return v;
}

struct Args { const void* in[N_INPUTS]; float* out; unsigned char* ws; int ph_lo, ph_hi; };

__device__ __forceinline__ void p0_transpose_item(const float* __restrict__ W, int ldw, int col0, const float* __restrict__ gsc, bf16* WT, int K, int drow0, int k0, LAS float* scr, int lane) {
#pragma unroll 8
    for (int i = 0; i < 32; ++i) { const int kk = 2 * i + (lane >> 5); float v = W[(size_t)(k0 + kk) * ldw + col0 + (lane & 31)]; if (gsc) v *= gsc[k0 + kk]; scr[kk * 33 + (lane & 31)] = v; }
    LDS_WAIT(); asm volatile("" ::: "memory");
    const int c = lane & 7;
#pragma unroll
    for (int j = 0; j < 4; ++j) { const int n = (lane >> 3) + 8 * j; const LAS float* s = scr + (8 * c) * 33 + n;
        v4u o; o.x = pk2(s[0 * 33], s[1 * 33]); o.y = pk2(s[2 * 33], s[3 * 33]); o.z = pk2(s[4 * 33], s[5 * 33]); o.w = pk2(s[6 * 33], s[7 * 33]);
        *(GAS v4u*)(WT + (size_t)(drow0 + n) * K + k0 + 8 * c) = o; }
    LDS_WAIT(); asm volatile("" ::: "memory");
}
__device__ __forceinline__ int g1_src_col(int n) { const int t = n >> 8, gm = n & 255, lam = 64 * ((gm >> 5) & 3) + 32 * (gm >> 7) + (gm & 31); return (t < 13 ? t * 256 : 3352 + (t - 13) * 256) + lam; }

constexpr int WBR_OFF = 69632, WBR_PITCH = 2064;

__device__ __forceinline__ void p0_prologue(const Args& a, LAS unsigned char* lds, int tid, int lane, int wave, int vcu, int G) {
    const int gw = vcu * NWAVES + wave, NGW = G * NWAVES;
    unsigned char* ws = a.ws;
    const float* w_in = (const float*)a.in[IN_WIN]; const float* norm_g = (const float*)a.in[IN_NORMG];
    { LAS unsigned char* wbr = lds + WBR_OFF;
      for (int i = tid; i < (8 * WBR_PITCH) / 4; i += NTHR) ((LAS unsigned*)(wbr + 24 * WBR_PITCH))[i] = 0u;
      for (int idx = tid; idx < 1024 * 24; idx += NTHR) { const int k = idx / 24, c = idx - 24 * k; const float v = w_in[(size_t)k * NIN + 3328 + c] * norm_g[k];
          *(LAS unsigned short*)(wbr + c * WBR_PITCH + k * 2) = (unsigned short)f2bf(v); } }
    { LAS float* scr = (LAS float*)(lds + wave * 8448);
      constexpr int I0 = 16 * 120, I1 = 32 * 8, I3 = 4 * 2, I5 = 16 * 32, I7 = 4 * 32, NITEMS = I0 + 2 * I1 + 2 * I3 + 2 * I5 + I7;
      for (int it = gw; it < NITEMS; it += NGW) {
          int r = it;
          if (r < I0) { const int kb = r / 120, nb = r % 120; p0_transpose_item(w_in, NIN, g1_src_col(32 * nb), norm_g, (bf16*)(ws + WS_WIN_T), 1024, 32 * nb, 64 * kb, scr, lane); continue; } r -= I0;
          if (r < I1) { const int kb = r / 8, nb = r % 8; p0_transpose_item((const float*)a.in[IN_W1K], 256, 32 * nb, nullptr, (bf16*)(ws + WS_W1T), 2048, 32 * nb, 64 * kb, scr, lane); continue; } r -= I1;
          if (r < I1) { const int kb = r / 8, nb = r % 8; p0_transpose_item((const float*)a.in[IN_W1V], 256, 32 * nb, nullptr, (bf16*)(ws + WS_W1T), 2048, 256 + 32 * nb, 64 * kb, scr, lane); continue; } r -= I1;
          if (r < I3) { const int kb = r / 2, nb = r % 2; p0_transpose_item((const float*)a.in[IN_W2K], 64, 32 * nb, nullptr, (bf16*)(ws + WS_W2T), 256, 32 * nb, 64 * kb, scr, lane); continue; } r -= I3;
          if (r < I3) { const int kb = r / 2, nb = r % 2; p0_transpose_item((const float*)a.in[IN_W2V], 64, 32 * nb, nullptr, (bf16*)(ws + WS_W2T), 256, 64 + 32 * nb, 64 * kb, scr, lane); continue; } r -= I3;
          if (r < I5) { const int kb = r / 32, nb = r % 32; p0_transpose_item((const float*)a.in[IN_WOUT], 1024, 32 * nb, nullptr, (bf16*)(ws + WS_WOUT_T), 1024, 32 * nb, 64 * kb, scr, lane); continue; } r -= I5;
          if (r < I5) { const int kb = r / 32, nb = r % 32; p0_transpose_item((const float*)a.in[IN_WG], 1024, 32 * nb, nullptr, (bf16*)(ws + WS_WG_T), 1024, 32 * nb, 64 * kb, scr, lane); continue; } r -= I5;
          { const int kb = r / 32, nb = r % 32; p0_transpose_item((const float*)a.in[IN_WPLE], 1024, 32 * nb, nullptr, (bf16*)(ws + WS_WPLE_T), 256, 32 * nb, 64 * kb, scr, lane); }
      } }
    __syncthreads();
    { const float* xp = (const float*)a.in[IN_XP]; const float* xs = (const float*)a.in[IN_XS];
      bf16* hbf = (bf16*)(ws + WS_HBF); float* rstd = (float*)(ws + WS_RSTD); float* BR = (float*)(ws + WS_BR);
      const LAS unsigned char* wbr = lds + WBR_OFF;
      for (int rg = gw; rg < MT / 16; rg += NGW) {
          const int m = rg * 16 + (lane & 15), kq = lane >> 4;
          const float* xr = (m < MP) ? xp + (size_t)m * DM : xs + (size_t)(m - MP) * DM;
          f32x4 c0 = {0.f, 0.f, 0.f, 0.f}, c1 = {0.f, 0.f, 0.f, 0.f}; float ssq = 0.f;
#pragma unroll 4
          for (int s = 0; s < 32; ++s) {
              const f32x4 v0 = *(const GAS f32x4*)(xr + 32 * s + 8 * kq), v1 = *(const GAS f32x4*)(xr + 32 * s + 8 * kq + 4);
              ssq += (v0.x * v0.x + v0.y * v0.y) + (v0.z * v0.z + v0.w * v0.w) + (v1.x * v1.x + v1.y * v1.y) + (v1.z * v1.z + v1.w * v1.w);
              v4u pa; pa.x = pk2(v0.x, v0.y); pa.y = pk2(v0.z, v0.w); pa.z = pk2(v1.x, v1.y); pa.w = pk2(v1.z, v1.w);
              *(GAS v4u*)(hbf + (size_t)m * DM + 32 * s + 8 * kq) = pa;
              const bf16x8 af = __builtin_bit_cast(bf16x8, pa);
              const bf16x8 b0 = *(const LAS bf16x8*)(wbr + (lane & 15) * WBR_PITCH + (32 * s + 8 * kq) * 2);
              const bf16x8 b1 = *(const LAS bf16x8*)(wbr + (16 + (lane & 15)) * WBR_PITCH + (32 * s + 8 * kq) * 2);
              c0 = __builtin_amdgcn_mfma_f32_16x16x32_bf16(af, b0, c0, 0, 0, 0);
              c1 = __builtin_amdgcn_mfma_f32_16x16x32_bf16(af, b1, c1, 0, 0, 0);
          }
          ssq += __shfl_xor(ssq, 16); ssq += __shfl_xor(ssq, 32);
          const float rs = 1.f / sqrtf(ssq * (1.f / DM) + EPS);
          if (kq == 0) rstd[m] = rs;
#pragma unroll
          for (int r = 0; r < 4; ++r) { const int R = 4 * kq + r; const float rsR = __shfl(rs, R); const size_t row = (size_t)rg * 16 + R;
              BR[row * 24 + (lane & 15)] = sigmoidf_(c0[r] * rsR);
              if ((lane & 15) < 8) BR[row * 24 + 16 + (lane & 15)] = sigmoidf_(c1[r] * rsR); }
      } }
    { const float* pp = (const float*)a.in[IN_PP]; const float* ps = (const float*)a.in[IN_PS]; bf16* pbf = (bf16*)(ws + WS_PBF);
      for (int idx = (vcu * NTHR + tid); idx < MT * 32; idx += G * NTHR) { const int row = idx >> 5, c8 = (idx & 31) * 8;
          const float* src = (row < MP) ? pp + (size_t)row * 256 + c8 : ps + (size_t)(row - MP) * 256 + c8;
          const f32x4 v0 = *(const GAS f32x4*)src, v1 = *(const GAS f32x4*)(src + 4);
          v4u o; o.x = pk2(v0.x, v0.y); o.y = pk2(v0.z, v0.w); o.z = pk2(v1.x, v1.y); o.w = pk2(v1.z, v1.w);
          *(GAS v4u*)(pbf + (size_t)row * 256 + c8) = o; } }
    { const float* sw = (const float*)a.in[IN_SWIN]; float* dst = a.out + OFF_WINS;
      for (int idx = (vcu * NTHR + tid); idx < 32 * 504 * 64; idx += G * NTHR) { const int q = idx & 63, i = (idx >> 6) % 504, b = (idx >> 6) / 504;
          *(GAS f32x4*)(dst + ((size_t)(b * 512 + i) * 256) + q * 4) = *(const GAS f32x4*)(sw + ((size_t)(b * 512 + i + 8) * 256) + q * 4); } }
    { const float* cn = (const float*)a.in[IN_CNSA]; const int* pt = (const int*)a.in[IN_PT]; const float* pek = (const float*)a.in[IN_PEK]; const float* pev = (const float*)a.in[IN_PEV];
      bf16* ac = (bf16*)(ws + WS_ACMP_S);
      const int slot = lane >> 5, g = (lane >> 4) & 1, d = 4 * (lane & 15);
      for (int tk = gw; tk < 32 * 8192; tk += NGW) { const int b = tk >> 13, pos = tk & 8191, c = pos >> 5, p = pos & 31;
          const int page = pt[b * 64 + (pos >> 7)];
          const f32x4 v = *(const GAS f32x4*)(cn + ((size_t)page * 128 + (pos & 127)) * 512 + lane * 4);
          const f32x4 e = *(const GAS f32x4*)((slot ? pev : pek) + p * 64 + d);
          v2u o; o.x = pk2(v.x + e.x, v.y + e.y); o.y = pk2(v.z + e.z, v.w + e.w);
          *(GAS v2u*)(ac + ((size_t)slot * 16384 + (size_t)(b * 256 + c) * 2 + g) * 2048 + p * 64 + d) = o; } }
}

namespace pg8 {
__device__ __forceinline__ void st8_bf16(bf16_t* p, f32x4 a, f32x4 b) { u32x4 w; w.x = cvtpk(a[0], a[1]); w.y = cvtpk(a[2], a[3]); w.z = cvtpk(b[0], b[1]); w.w = cvtpk(b[2], b[3]); *(u32x4*)p = w; }
__device__ __forceinline__ void st8_f32(float* p, f32x4 a, f32x4 b) { *(f32x4*)p = a; *(f32x4*)(p + 4) = b; }
__device__ __forceinline__ f32x4 silu4(f32x4 v) { f32x4 r; for (int i = 0; i < 4; ++i) r[i] = siluf_(v[i]); return r; }

struct EpiG1 {
    static constexpr bool PERM = true, AFTER_DRAIN = false;
    float* out; const float* rstd; bf16_t *QA, *KA, *VA, *GA, *QB, *GB, *KSEL, *VSEL, *KWIN, *VWIN, *ACMP; const float *q_g, *ks_g, *kw_g, *pe_k, *pe_v;
    __device__ __forceinline__ void operator()(const f32x4 (&acc)[2][2][4][2], const Unit& u, int wr, int wc, int fr, int fq) const {
        const int pn = u.pn;
#pragma unroll
        for (int ai = 0; ai < 2; ++ai)
#pragma unroll
            for (int m = 0; m < 4; ++m) {
                asm volatile("" ::: "memory");
                const int row = u.pm * BM + ai * HALF + wr * 64 + m * 16 + fr; const float rs = rstd[row];
                f32x4 v[2][2];
#pragma unroll
                for (int bj = 0; bj < 2; ++bj) { v[bj][0] = acc[ai][bj][m][0] * rs; v[bj][1] = acc[ai][bj][m][1] * rs; }
                const int lam0 = 64 * wc + 8 * fq;
                if (pn < 2) {
#pragma unroll
                    for (int bj = 0; bj < 2; ++bj) st8_bf16(QA + (size_t)row * 512 + pn * 256 + lam0 + 32 * bj, v[bj][0] * 0.125f, v[bj][1] * 0.125f);
                } else if (pn < 6) {
                    const int sl = (pn >= 4) ? 1 : 0, col = (pn & 1) * 256 + lam0; bf16_t* B = KA + (size_t)sl * ((WS_VA - WS_KA) / 2);
#pragma unroll
                    for (int bj = 0; bj < 2; ++bj) { st8_f32(out + OFF_SB + (size_t)row * 1024 + sl * 512 + col + 32 * bj, v[bj][0], v[bj][1]); st8_bf16(B + (size_t)row * 512 + col + 32 * bj, v[bj][0], v[bj][1]); }
                } else if (pn < 8) {
#pragma unroll
                    for (int bj = 0; bj < 2; ++bj) st8_bf16(GA + (size_t)row * 512 + (pn - 6) * 256 + lam0 + 32 * bj, silu4(v[bj][0]), silu4(v[bj][1]));
                } else if (pn >= 13) {
#pragma unroll
                    for (int bj = 0; bj < 2; ++bj) st8_bf16(GB + (size_t)row * 512 + (pn - 13) * 256 + lam0 + 32 * bj, silu4(v[bj][0]), silu4(v[bj][1]));
                } else {
                    float ssq = 0.f;
#pragma unroll
                    for (int bj = 0; bj < 2; ++bj)
#pragma unroll
                        for (int n = 0; n < 2; ++n) ssq += (v[bj][n][0] * v[bj][n][0] + v[bj][n][1] * v[bj][n][1]) + (v[bj][n][2] * v[bj][n][2] + v[bj][n][3] * v[bj][n][3]);
                    ssq += __shfl_xor(ssq, 16); ssq += __shfl_xor(ssq, 32);
                    const float hr = 1.f / sqrtf(ssq * (1.f / 64.f) + EPS);
                    if (pn < 10) {
#pragma unroll
                        for (int bj = 0; bj < 2; ++bj) { const int d0 = 32 * bj + 8 * fq; const f32x4 g0 = *(const f32x4*)(q_g + d0), g1 = *(const f32x4*)(q_g + d0 + 4);
                            st8_bf16(QB + (size_t)row * 512 + (pn - 8) * 256 + lam0 + 32 * bj, v[bj][0] * g0 * (hr * 0.125f * LOG2E), v[bj][1] * g1 * (hr * 0.125f * LOG2E)); }
                    } else if (pn == 10) {
                        const int t = row & 2047, b = row >> 11, c = t >> 5, p = t & 31, slot = wc >> 1, g = wc & 1; const float* pe = pe_k + (ptrdiff_t)slot * (pe_v - pe_k);
#pragma unroll
                        for (int bj = 0; bj < 2; ++bj) { const int lam = lam0 + 32 * bj, d0 = 32 * bj + 8 * fq;
                            st8_f32(out + OFF_NSA + (size_t)row * 512 + lam, v[bj][0], v[bj][1]);
                            if (row < MP) { const f32x4 e0 = *(const f32x4*)(pe + p * 64 + d0), e1 = *(const f32x4*)(pe + p * 64 + d0 + 4);
                                st8_bf16(ACMP + ((size_t)slot * 1024 + (size_t)(b * 64 + c) * 2 + g) * 2048 + p * 64 + d0, v[bj][0] + e0, v[bj][1] + e1); } }
                    } else if (pn == 11) {
#pragma unroll
                        for (int bj = 0; bj < 2; ++bj) { const int lam = lam0 + 32 * bj, d0 = 32 * bj + 8 * fq; f32x4 x0 = v[bj][0], x1 = v[bj][1];
                            if (wc < 2) { const f32x4 g0 = *(const f32x4*)(ks_g + d0), g1 = *(const f32x4*)(ks_g + d0 + 4); x0 = x0 * g0 * hr; x1 = x1 * g1 * hr; }
                            st8_f32(out + OFF_NSA + (size_t)row * 512 + 256 + lam, x0, x1);
                            st8_bf16(KSEL + (size_t)(wc >> 1) * ((WS_VSEL - WS_KSEL) / 2) + (size_t)row * 128 + (lam & 127), x0, x1); }
                    } else {
                        float* wdst = nullptr;
                        if (row >= MP) { const int si = row - MP; wdst = out + OFF_WINS + ((size_t)((si >> 3) * 512 + 504 + (si & 7))) * 256; }
                        else if ((row & 2047) >= 1536) wdst = out + OFF_WINP + ((size_t)((row >> 11) * 512 + (row & 2047) - 1536)) * 256;
#pragma unroll
                        for (int bj = 0; bj < 2; ++bj) { const int lam = lam0 + 32 * bj, d0 = 32 * bj + 8 * fq; f32x4 x0 = v[bj][0], x1 = v[bj][1];
                            if (wc < 2) { const f32x4 g0 = *(const f32x4*)(kw_g + d0), g1 = *(const f32x4*)(kw_g + d0 + 4); x0 = x0 * g0 * hr; x1 = x1 * g1 * hr; }
                            if (wdst) st8_f32(wdst + lam, x0, x1);
                            st8_bf16(KWIN + (size_t)(wc >> 1) * ((WS_VWIN - WS_KWIN) / 2) + (size_t)row * 128 + (lam & 127), x0, x1); }
                    }
                }
            }
    }
};
struct EpiHid {
    static constexpr bool PERM = true, AFTER_DRAIN = false;
    bf16_t* O;
    __device__ __forceinline__ void operator()(const f32x4 (&acc)[2][2][4][2], const Unit& u, int wr, int wc, int fr, int fq) const {
#pragma unroll
        for (int ai = 0; ai < 2; ++ai)
#pragma unroll
            for (int m = 0; m < 4; ++m) { const int row = u.pm * BM + ai * HALF + wr * 64 + m * 16 + fr;
#pragma unroll
                for (int bj = 0; bj < 2; ++bj) st8_bf16(O + (size_t)row * 256 + bj * HALF + wc * 32 + 8 * fq, silu4(acc[ai][bj][m][0]), silu4(acc[ai][bj][m][1])); }
    }
};
struct EpiOut {
    static constexpr bool PERM = true, AFTER_DRAIN = false;
    const float* xp; const float* xs; float* Y; bf16_t* HB;
    __device__ __forceinline__ void operator()(const f32x4 (&acc)[2][2][4][2], const Unit& u, int wr, int wc, int fr, int fq) const {
#pragma unroll
        for (int ai = 0; ai < 2; ++ai)
#pragma unroll
            for (int m = 0; m < 4; ++m) { const int row = u.pm * BM + ai * HALF + wr * 64 + m * 16 + fr; const float* xr = (row < MP) ? xp + (size_t)row * DM : xs + (size_t)(row - MP) * DM;
#pragma unroll
                for (int bj = 0; bj < 2; ++bj) { const int col = u.pn * BM + bj * HALF + wc * 32 + 8 * fq;
                    const f32x4 h0 = *(const f32x4*)(xr + col) + acc[ai][bj][m][0], h1 = *(const f32x4*)(xr + col + 4) + acc[ai][bj][m][1];
                    st8_f32(Y + (size_t)row * DM + col, h0, h1); st8_bf16(HB + (size_t)row * DM + col, h0, h1); } }
    }
};
struct EpiFinal {
    static constexpr bool PERM = true, AFTER_DRAIN = false;
    float* Y; const bf16_t* T1;
    __device__ __forceinline__ void operator()(const f32x4 (&acc)[2][2][4][2], const Unit& u, int wr, int wc, int fr, int fq) const {
#pragma unroll
        for (int ai = 0; ai < 2; ++ai)
#pragma unroll
            for (int m = 0; m < 4; ++m) { const int row = u.pm * BM + ai * HALF + wr * 64 + m * 16 + fr;
#pragma unroll
                for (int bj = 0; bj < 2; ++bj) { const int col = u.pn * BM + bj * HALF + wc * 32 + 8 * fq; float* yp = Y + (size_t)row * DM + col;
                    const u32x4 t = *(const u32x4*)(T1 + (size_t)row * DM + col); const f32x4 h0 = *(const f32x4*)yp, h1 = *(const f32x4*)(yp + 4);
                    const f32x4 a0 = acc[ai][bj][m][0], a1 = acc[ai][bj][m][1];
                    f32x4 y0, y1;
                    y0[0] = h0[0] + sigmoidf_(a0[0]) * bf_lo(t.x); y0[1] = h0[1] + sigmoidf_(a0[1]) * bf_hi(t.x); y0[2] = h0[2] + sigmoidf_(a0[2]) * bf_lo(t.y); y0[3] = h0[3] + sigmoidf_(a0[3]) * bf_hi(t.y);
                    y1[0] = h1[0] + sigmoidf_(a1[0]) * bf_lo(t.z); y1[1] = h1[1] + sigmoidf_(a1[1]) * bf_hi(t.z); y1[2] = h1[2] + sigmoidf_(a1[2]) * bf_lo(t.w); y1[3] = h1[3] + sigmoidf_(a1[3]) * bf_hi(t.w);
                    st8_f32(yp, y0, y1); } }
    }
};
struct DiagOrder {
    int n, per, G, c;
    __device__ __forceinline__ bool next(int i, Unit& u) const { const int L = i * G + c; if (L >= n) return false; u.pm = L; u.pn = L / per; return true; }
    __device__ __forceinline__ void a_ready(const Unit&) const {}
    __device__ __forceinline__ void done(const Unit&) const {}
};
}

#define MFMA32(a, b, c) __builtin_amdgcn_mfma_f32_32x32x16_bf16((a), (b), (c), 0, 0, 0)
constexpr int KP = 144, VP = 192;
constexpr int KT_BYTES = 64 * KP, VT_BYTES = 64 * VP;
typedef short v4i16_t __attribute__((ext_vector_type(4)));
__device__ __forceinline__ int kidx_of(int kh, int v, int h) { return 32 * kh + (v & 3) + 8 * (v >> 2) + 4 * h; }
__device__ __forceinline__ s16x4 vtr(const LAS unsigned char* p) { return __builtin_bit_cast(s16x4, __builtin_amdgcn_ds_read_tr16_b64_v4i16((LAS v4i16_t*)p)); }

__device__ __forceinline__ void qk64(f32x16 (&s)[2], const LAS unsigned char* Ks, const bf16x8 (&qf)[4], int lane) {
    const LAS unsigned char* kb = Ks + (lane & 31) * KP + (lane >> 5) * 16;
#pragma unroll
    for (int kh = 0; kh < 2; ++kh) { f32x16 acc; for (int i = 0; i < 16; ++i) acc[i] = 0.f;
#pragma unroll
        for (int ks = 0; ks < 4; ++ks) acc = MFMA32(*(const LAS bf16x8*)(kb + kh * 32 * KP + ks * 32), qf[ks], acc);
        s[kh] = acc; }
}
__device__ __forceinline__ void qk64_g(f32x16 (&s)[2], const bf16* Kg, int kpitch, const bf16x8 (&qf)[4], int lane) {
    const bf16* kb = Kg + (size_t)(lane & 31) * kpitch + (lane >> 5) * 8;
    bf16x8 kf[2][4];
#pragma unroll
    for (int kh = 0; kh < 2; ++kh)
#pragma unroll
        for (int ks = 0; ks < 4; ++ks) kf[kh][ks] = *(const GAS bf16x8*)(kb + (size_t)kh * 32 * kpitch + ks * 16);
#pragma unroll
    for (int kh = 0; kh < 2; ++kh) { f32x16 acc; for (int i = 0; i < 16; ++i) acc[i] = 0.f;
#pragma unroll
        for (int ks = 0; ks < 4; ++ks) acc = MFMA32(kf[kh][ks], qf[ks], acc);
        s[kh] = acc; }
}
__device__ __forceinline__ void pv64(f32x16 (&o)[2], const LAS unsigned char* Vs, const f32x16 (&e)[2], int lane) {
    const int G = lane >> 4, i = lane & 15, q = i >> 2, p = i & 3, h = G >> 1;
    const LAS unsigned char* vb = Vs + (4 * h + q) * VP + (16 * (G & 1) + 4 * p) * 2;
#pragma unroll
    for (int kh = 0; kh < 2; ++kh)
#pragma unroll
        for (int s = 0; s < 2; ++s) {
            v4u pw; pw.x = cvtpk(e[kh][8 * s + 0], e[kh][8 * s + 1]); pw.y = cvtpk(e[kh][8 * s + 2], e[kh][8 * s + 3]); pw.z = cvtpk(e[kh][8 * s + 4], e[kh][8 * s + 5]); pw.w = cvtpk(e[kh][8 * s + 6], e[kh][8 * s + 7]);
            const bf16x8 pf = __builtin_bit_cast(bf16x8, pw);
#pragma unroll
            for (int dh = 0; dh < 2; ++dh) {
                const s16x4 lo = vtr(vb + (32 * kh + 16 * s) * VP + 64 * dh), hi = vtr(vb + (32 * kh + 16 * s + 8) * VP + 64 * dh);
                const bf16x8 vf = {lo[0], lo[1], lo[2], lo[3], hi[0], hi[1], hi[2], hi[3]};
                o[dh] = MFMA32(vf, pf, o[dh]);
            }
        }
}
__device__ __forceinline__ void load_qf(bf16x8 (&qf)[4], const bf16* qrow, int lane) {
#pragma unroll
    for (int ks = 0; ks < 4; ++ks) qf[ks] = *(const GAS bf16x8*)(qrow + 16 * ks + 8 * (lane >> 5));
}
__device__ __forceinline__ v4u tile_ld(const bf16* g, int rpitch, int tid) { return *(const GAS v4u*)(g + (size_t)(tid >> 3) * rpitch + (tid & 7) * 8); }
__device__ __forceinline__ void tile_st(LAS unsigned char* t, int P, int tid, v4u v) { *(LAS v4u*)(t + (tid >> 3) * P + (tid & 7) * 16) = v; }

template <class F> __device__ __forceinline__ void softmax_tile(f32x16 (&s)[2], float& m, float& l, f32x16 (&o)[2], int h, F&& biasf) {
    float mx = -1e30f;
#pragma unroll
    for (int kh = 0; kh < 2; ++kh)
#pragma unroll
        for (int v = 0; v < 16; ++v) { const float x = s[kh][v] + biasf(kidx_of(kh, v, h)); s[kh][v] = x; mx = fmaxf(mx, x); }
    mx = fmaxf(mx, __shfl_xor(mx, 32));
    const float mn = fmaxf(m, mx), al = fexp2(m - mn); m = mn;
    float sum = 0.f;
#pragma unroll
    for (int kh = 0; kh < 2; ++kh)
#pragma unroll
        for (int v = 0; v < 16; ++v) { const float e = fexp2(s[kh][v] - mn); s[kh][v] = e; sum += e; }
    l = l * al + sum;
#pragma unroll
    for (int dh = 0; dh < 2; ++dh)
#pragma unroll
        for (int v = 0; v < 16; ++v) o[dh][v] *= al;
}
__device__ __forceinline__ void store_ot(bf16* dst, const f32x16 (&o)[2], float sc, int h) {
#pragma unroll
    for (int dh = 0; dh < 2; ++dh)
#pragma unroll
        for (int a = 0; a < 4; ++a) { v2u w; w.x = cvtpk(o[dh][4 * a] * sc, o[dh][4 * a + 1] * sc); w.y = cvtpk(o[dh][4 * a + 2] * sc, o[dh][4 * a + 3] * sc);
            *(GAS v2u*)(dst + 32 * dh + 8 * a + 4 * h) = w; }
}
__device__ __forceinline__ void zero_o(f32x16 (&o)[2]) { for (int dh = 0; dh < 2; ++dh) for (int v = 0; v < 16; ++v) o[dh][v] = 0.f; }

template <bool TO_LDS> __device__ __forceinline__ void l2_wave(const bf16* w2t  , const bf16* hid0, int hstride, const float* kcg  , unsigned char* dst, int dpitch_bytes, int lane) {
    const int r = lane & 31, h = lane >> 5;
    f32x16 acc[2]; zero_o(acc);
    const bf16* hp = hid0 + (size_t)r * hstride + 8 * h;
#pragma unroll 4
    for (int ks = 0; ks < 16; ++ks) {
        const bf16x8 bfr = *(const GAS bf16x8*)(hp + 16 * ks);
#pragma unroll
        for (int dh = 0; dh < 2; ++dh) { const bf16x8 af = *(const GAS bf16x8*)(w2t + (size_t)(32 * dh + r) * 256 + 16 * ks + 8 * h); acc[dh] = MFMA32(af, bfr, acc[dh]); }
    }
    float sc = 1.f;
    if (kcg) { float ssq = 0.f;
#pragma unroll
        for (int dh = 0; dh < 2; ++dh)
#pragma unroll
            for (int v = 0; v < 16; ++v) ssq += acc[dh][v] * acc[dh][v];
        ssq += __shfl_xor(ssq, 32); sc = 1.f / sqrtf(ssq * (1.f / 64.f) + EPS); }
#pragma unroll
    for (int dh = 0; dh < 2; ++dh)
#pragma unroll
        for (int a = 0; a < 4; ++a) { const int d0 = 32 * dh + 8 * a + 4 * h; f32x4 x = {acc[dh][4 * a], acc[dh][4 * a + 1], acc[dh][4 * a + 2], acc[dh][4 * a + 3]};
            if (kcg) x = x * *(const f32x4*)(kcg + d0) * sc;
            v2u w; w.x = cvtpk(x[0], x[1]); w.y = cvtpk(x[2], x[3]);
            if (TO_LDS) *(LAS v2u*)((LAS unsigned char*)(uintptr_t)dst + r * dpitch_bytes + d0 * 2) = w;
            else *(GAS v2u*)(dst + (size_t)r * dpitch_bytes + d0 * 2) = w; }
}

__device__ __forceinline__ int next_item(gu32* ctr, volatile LAS int* slot) {
    __syncthreads();
    if (threadIdx.x == 0) *slot = (int)__hip_atomic_fetch_add(ctr, 1u, RLX_AGENT);
    __syncthreads();
    return *slot;
}

__device__ __forceinline__ void item_l2_sample(const Args& a, int it, int lane, int wave) {
    unsigned char* ws = a.ws; const int sb = it >> 1, g = it & 1, slot = wave & 1;
    const bf16* w2t = (const bf16*)(ws + WS_W2T) + slot * 64 * 256;
    const float* kcg = slot ? nullptr : (const float*)a.in[IN_KCG];
    for (int j = 0; j < 2; ++j) { const int ch = (wave >> 1) + 4 * j;
        const bf16* hid0 = (const bf16*)(ws + WS_HIDS) + ((size_t)slot * 16384 + (size_t)(sb * 256 + 32 * ch) * 2 + g) * 256;
        unsigned char* dst = ws + (slot ? WS_VCS : WS_KCS) + ((size_t)((sb * 2 + g) * 256 + 32 * ch)) * 128;
        l2_wave<false>(w2t, hid0, 512, kcg, dst, 128, lane); }
}
__device__ __forceinline__ void item_sb_prompt(const Args& a, LAS unsigned char* lds, int it, int lane, int wave) {
    unsigned char* ws = a.ws;
    const int qb = 7 - (it >> 6), bh = it & 63, b = bh >> 3, hd = bh & 7;
    const int r = lane & 31, h = lane >> 5, tw = 256 * qb + 32 * wave, tpos = tw + r; const size_t mrow = (size_t)b * TP + tpos;
    const bf16* QA = (const bf16*)(ws + WS_QA); const bf16* KA = (const bf16*)(ws + WS_KA) + hd * 64; const bf16* VA = (const bf16*)(ws + WS_VA) + hd * 64;
    bf16x8 qf[4]; load_qf(qf, QA + mrow * 512 + hd * 64, lane);
    LAS unsigned char* Vs = lds + wave * VT_BYTES;
    f32x16 o[2]; zero_o(o);
    float C = 0.f;
    for (int kb = (tw >> 6) << 6; kb >= 0; kb -= 64) {
        const size_t krow0 = (size_t)b * TP + kb;
        v4u vr[8];
#pragma unroll
        for (int i = 0; i < 8; ++i) vr[i] = *(const GAS v4u*)(VA + (krow0 + 8 * i + (lane >> 3)) * 512 + (lane & 7) * 8);
        f32x16 s[2]; qk64_g(s, KA + krow0 * 512, 512, qf, lane);
#pragma unroll
        for (int i = 0; i < 8; ++i) *(LAS v4u*)(Vs + (8 * i + (lane >> 3)) * VP + (lane & 7) * 16) = vr[i];
        float gs[8];
#pragma unroll
        for (int kh = 0; kh < 2; ++kh)
#pragma unroll
            for (int aa = 0; aa < 4; ++aa) { float gsum = 0.f;
#pragma unroll
                for (int j = 3; j >= 0; --j) { const int v = 4 * aa + j; const float z = s[kh][v]; const bool ok = (kb + kidx_of(kh, v, h)) < tpos;
                    const float lb = fminf(z, 0.f) - LN2 * flog2(1.f + fexp2(-fabsf(z) * LOG2E));
                    const float lk = ok ? (lb - z) : 0.f;
                    s[kh][v] = ok ? (lb + gsum) : -INFINITY;
                    gsum += lk; }
                gs[4 * kh + aa] = gsum; }
        float tot = 0.f, off[8];
#pragma unroll
        for (int ap = 7; ap >= 0; --ap) { const float mine = gs[ap], oth = __shfl_xor(mine, 32);
            off[ap] = tot + (h == 0 ? oth : 0.f); tot += mine + oth; }
#pragma unroll
        for (int kh = 0; kh < 2; ++kh)
#pragma unroll
            for (int v = 0; v < 16; ++v) s[kh][v] = fexp2((s[kh][v] + C + off[4 * kh + (v >> 2)]) * LOG2E);
        C += tot;
        asm volatile("" ::: "memory");
        pv64(o, Vs, s, lane);
        asm volatile("" ::: "memory");
        if (__all(C < -60.f)) break;
    }
    const bf16* GA = (const bf16*)(ws + WS_GA) + mrow * 512 + hd * 64; bf16* U = (bf16*)(ws + WS_U) + mrow * 1024 + hd * 64;
#pragma unroll
    for (int dh = 0; dh < 2; ++dh)
#pragma unroll
        for (int aa = 0; aa < 4; ++aa) { const int d0 = 32 * dh + 8 * aa + 4 * h; const v2u gw = *(const GAS v2u*)(GA + d0);
            v2u w; w.x = cvtpk(o[dh][4 * aa] * bf_lo(gw.x), o[dh][4 * aa + 1] * bf_hi(gw.x)); w.y = cvtpk(o[dh][4 * aa + 2] * bf_lo(gw.y), o[dh][4 * aa + 3] * bf_hi(gw.y));
            *(GAS v2u*)(U + d0) = w; }
}
__device__ __forceinline__ void item_win_prompt(const Args& a, LAS unsigned char* lds, int it, int tid, int lane, int wave) {
    unsigned char* ws = a.ws;
    const int qblk = 31 - (it >> 4), bg = it & 15, b = bg >> 1, g = bg & 1;
    const int r = lane & 31, h = lane >> 5, hq = 4 * g + (wave & 3), tpos = 64 * qblk + 32 * (wave >> 2) + r; const size_t mrow = (size_t)b * TP + tpos;
    const float slope2 = fexp2(-(float)(hq + 1)) * LOG2E;
    bf16x8 qf[4]; load_qf(qf, (const bf16*)(ws + WS_QB) + mrow * 512 + hq * 64, lane);
    const bf16* KW = (const bf16*)(ws + WS_KWIN) + (size_t)b * TP * 128 + g * 64; const bf16* VW = (const bf16*)(ws + WS_VWIN) + (size_t)b * TP * 128 + g * 64;
    LAS unsigned char* Ks = lds; LAS unsigned char* Vs = lds + KT_BYTES;
    f32x16 o[2]; zero_o(o); float m = -1e30f, l = 0.f;
    const int kt_lo = qblk >= 8 ? qblk - 8 : 0;
    v4u kr = tile_ld(KW + (size_t)(64 * qblk) * 128, 128, tid), vr = tile_ld(VW + (size_t)(64 * qblk) * 128, 128, tid);
    for (int kt = qblk; kt >= kt_lo; --kt) {
        __syncthreads();
        tile_st(Ks, KP, tid, kr); tile_st(Vs, VP, tid, vr);
        if (kt > kt_lo) { kr = tile_ld(KW + (size_t)(64 * (kt - 1)) * 128, 128, tid); vr = tile_ld(VW + (size_t)(64 * (kt - 1)) * 128, 128, tid); }
        __syncthreads();
        f32x16 s[2]; qk64(s, Ks, qf, lane);
        const int kb = 64 * kt;
        softmax_tile(s, m, l, o, h, [&](int ki) { const int kpos = kb + ki, dist = tpos - kpos; return (dist >= 0 && dist < 512) ? -slope2 * (float)dist : -INFINITY; });
        pv64(o, Vs, s, lane);
    }
    l += __shfl_xor(l, 32);
    const float g2 = ((const float*)(ws + WS_BR))[mrow * 24 + hq * 3 + 2];
    store_ot((bf16*)(ws + WS_OW) + mrow * 512 + hq * 64, o, g2 / l, h);
}

__device__ __forceinline__ void item_sb_sample(const Args& a, LAS unsigned char* lds, int it, int lane, int wave) {
    unsigned char* ws = a.ws; const int sb = it >> 3, hd = it & 7, st = wave, t = 8192 + st; const size_t mrow = (size_t)MP + sb * 8 + st;
    const float* csb = (const float*)a.in[IN_CSB]; const int* pt = (const int*)a.in[IN_PT]; const float* newrows = a.out + OFF_SB + (size_t)(MP + sb * 8) * 1024;
    LAS float* qs = (LAS float*)(lds + wave * 256);
    { const unsigned short qv = ((const bf16*)(ws + WS_QA))[mrow * 512 + hd * 64 + lane]; qs[lane] = __builtin_bit_cast(float, (unsigned)qv << 16); }
    asm volatile("s_waitcnt lgkmcnt(0)" ::: "memory");
    float C = 0.f, o = 0.f;
    for (int c0 = t - 1; c0 >= 0; c0 -= 64) {
        const int kp = c0 - lane; const bool ok = kp >= 0; const int kpc = ok ? kp : 0;
        const float* rowp = (kpc >= 8192) ? newrows + (size_t)(kpc - 8192) * 1024 : csb + ((size_t)pt[sb * 64 + (kpc >> 7)] * 128 + (kpc & 127)) * 1024;
        const float* kptr = rowp + hd * 64; const float* vptr = rowp + 512 + hd * 64;
        float z = 0.f;
#pragma unroll
        for (int j = 0; j < 16; ++j) { const f32x4 kv = *(const GAS f32x4*)(kptr + 4 * j); const f32x4 qv = *(const LAS f32x4*)(qs + 4 * j); z += kv.x * qv.x + kv.y * qv.y + kv.z * qv.z + kv.w * qv.w; }
        const float lb = fminf(z, 0.f) - LN2 * flog2(1.f + fexp2(-fabsf(z) * LOG2E));
        const float lk = ok ? (lb - z) : 0.f;
        float inc = lk;
#pragma unroll
        for (int d = 1; d < 64; d <<= 1) { const float up = __shfl_up(inc, d); if (lane >= d) inc += up; }
        const float w = ok ? fexp2((lb + C + (inc - lk)) * LOG2E) : 0.f;
        C += __shfl(inc, 63);
        const unsigned long long vp = (unsigned long long)(uintptr_t)vptr; const unsigned vlo = (unsigned)vp, vhi = (unsigned)(vp >> 32);
#pragma unroll 16
        for (int i = 0; i < 64; ++i) { const float wi = __builtin_bit_cast(float, __builtin_amdgcn_readlane(__builtin_bit_cast(int, w), i));
            const unsigned long long p = ((unsigned long long)(unsigned)__builtin_amdgcn_readlane((int)vhi, i) << 32) | (unsigned)__builtin_amdgcn_readlane((int)vlo, i);
            o += wi * ((const GAS float*)(uintptr_t)p)[lane]; }
        if (C < -60.f) break;
    }
    const unsigned short gv = ((const bf16*)(ws + WS_GA))[mrow * 512 + hd * 64 + lane];
    ((bf16*)(ws + WS_U))[mrow * 1024 + hd * 64 + lane] = (unsigned short)f2bf(o * __builtin_bit_cast(float, (unsigned)gv << 16));
}

constexpr int P3_KC = 0, P3_VC = KT_BYTES, P3_KS = KT_BYTES + VT_BYTES, P3_VS = P3_KS + KT_BYTES, P3_IMPW = P3_VS + VT_BYTES  , P3_IMP = P3_IMPW + 8 * 32 * 33 * 4  ,
              P3_SEL = P3_IMP + 64 * 33 * 4  , P3_UM = P3_SEL + 256;
__device__ __forceinline__ void item_nsa_prompt(const Args& a, LAS unsigned char* lds, int it, int tid, int lane, int wave) {
    unsigned char* ws = a.ws;
    const int qblk = 31 - (it >> 4), bg = it & 15, b = bg >> 1, g = bg & 1, cur = qblk;
    const int r = lane & 31, h = lane >> 5, hq = 4 * g + (wave & 3), th = wave >> 2, tpos = 64 * qblk + 32 * th + r; const size_t mrow = (size_t)b * TP + tpos;
    const float slope2 = fexp2(-(float)(hq + 1)) * LOG2E;
    if (wave < 4) { const int slot = wave & 1, chf = wave >> 1;
        const bf16* hid0 = (const bf16*)(ws + WS_HIDP) + ((size_t)slot * 1024 + (size_t)(b * 64 + 32 * chf) * 2 + g) * 256;
        if (slot == 0) l2_wave<true>((const bf16*)(ws + WS_W2T), hid0, 512, (const float*)a.in[IN_KCG], (unsigned char*)(uintptr_t)(lds + P3_KC + 32 * chf * KP), KP, lane);
        else           l2_wave<true>((const bf16*)(ws + WS_W2T) + 64 * 256, hid0, 512, nullptr, (unsigned char*)(uintptr_t)(lds + P3_VC + 32 * chf * VP), VP, lane); }
    bf16x8 qf[4]; load_qf(qf, (const bf16*)(ws + WS_QB) + mrow * 512 + hq * 64, lane);
    __syncthreads();
    f32x16 oc[2]; zero_o(oc);
    { f32x16 s[2]; qk64(s, lds + P3_KC, qf, lane);
      float mx = -1e30f;
#pragma unroll
      for (int kh = 0; kh < 2; ++kh)
#pragma unroll
          for (int v = 0; v < 16; ++v) { const int ce = 32 * kidx_of(kh, v, h) + 31, dist = tpos - ce; const float x = dist >= 0 ? s[kh][v] - slope2 * (float)dist : -INFINITY; s[kh][v] = x; mx = fmaxf(mx, x); }
      mx = fmaxf(mx, __shfl_xor(mx, 32));
      float sum = 0.f;
#pragma unroll
      for (int kh = 0; kh < 2; ++kh)
#pragma unroll
          for (int v = 0; v < 16; ++v) { const float e = fexp2(s[kh][v] - mx); s[kh][v] = e; sum += e; }
      sum += __shfl_xor(sum, 32);
      const float inv = sum > 0.f ? 1.f / sum : 1.f;
#pragma unroll
      for (int kh = 0; kh < 2; ++kh)
#pragma unroll
          for (int v = 0; v < 16; ++v) s[kh][v] *= inv;
      LAS float* impw = (LAS float*)(lds + P3_IMPW) + (wave * 32 + r) * 33;
#pragma unroll
      for (int kh = 0; kh < 2; ++kh)
#pragma unroll
          for (int aa = 0; aa < 4; ++aa)
#pragma unroll
              for (int b2 = 0; b2 < 2; ++b2) impw[16 * kh + 4 * aa + 2 * h + b2] = s[kh][4 * aa + 2 * b2] + s[kh][4 * aa + 2 * b2 + 1];
      pv64(oc, lds + P3_VC, s, lane);
    }
    __syncthreads();
    { const int tk = tid >> 3, j8 = tid & 7; LAS float* imp = (LAS float*)(lds + P3_IMP) + tk * 33;
      const LAS float* iw = (const LAS float*)(lds + P3_IMPW) + (((tk >> 5) * 4) * 32 + (tk & 31)) * 33;
#pragma unroll
      for (int j = 0; j < 4; ++j) { const int blk = 4 * j8 + j; imp[blk] = (iw[blk] + iw[32 * 33 + blk]) + (iw[2 * 32 * 33 + blk] + iw[3 * 32 * 33 + blk]); }
      __syncthreads();
      unsigned bits = 0u;
      if (cur <= 15) bits = 0xffffffffu;
      else {
#pragma unroll
          for (int j = 0; j < 4; ++j) { const int blk = 4 * j8 + j;
              if (blk == 0 || blk == cur || blk == cur - 1) bits |= 1u << blk;
              else if (blk < cur - 1) { const float x = imp[blk]; int rank = 0;
                  for (int o2 = 1; o2 <= cur - 2; ++o2) { const float y = imp[o2]; rank += (y > x || (y == x && o2 < blk)) ? 1 : 0; }
                  if (rank < 13) bits |= 1u << blk; } } }
      bits |= __shfl_xor(bits, 1); bits |= __shfl_xor(bits, 2); bits |= __shfl_xor(bits, 4);
      if (j8 == 0) ((LAS unsigned*)(lds + P3_SEL))[tk] = bits;
      __syncthreads();
      if (wave == 0) { unsigned um = ((const LAS unsigned*)(lds + P3_SEL))[lane];
#pragma unroll
          for (int o2 = 1; o2 < 64; o2 <<= 1) um |= __shfl_xor(um, o2);
          if (lane == 0) *(LAS unsigned*)(lds + P3_UM) = um; }
      __syncthreads();
    }
    const unsigned selbits = ((const LAS unsigned*)(lds + P3_SEL))[32 * th + r], umask = *(const LAS unsigned*)(lds + P3_UM);
    f32x16 os[2]; zero_o(os); float m = -1e30f, l = 0.f;
    { const bf16* KS = (const bf16*)(ws + WS_KSEL) + (size_t)b * TP * 128 + g * 64; const bf16* VS = (const bf16*)(ws + WS_VSEL) + (size_t)b * TP * 128 + g * 64;
      LAS unsigned char* Ks = lds + P3_KS; LAS unsigned char* Vs = lds + P3_VS;
      unsigned todo = umask & (cur >= 31 ? 0xffffffffu : ((2u << cur) - 1u));
      int blk = __builtin_ctz(todo); todo &= todo - 1;
      v4u kr = tile_ld(KS + (size_t)(64 * blk) * 128, 128, tid), vr = tile_ld(VS + (size_t)(64 * blk) * 128, 128, tid);
      for (;;) {
          __syncthreads();
          tile_st(Ks, KP, tid, kr); tile_st(Vs, VP, tid, vr);
          const int nblk = todo ? __builtin_ctz(todo) : -1; todo &= todo - 1;
          if (nblk >= 0) { kr = tile_ld(KS + (size_t)(64 * nblk) * 128, 128, tid); vr = tile_ld(VS + (size_t)(64 * nblk) * 128, 128, tid); }
          __syncthreads();
          f32x16 s[2]; qk64(s, Ks, qf, lane);
          const int kb = 64 * blk; const bool mine = (selbits >> blk) & 1u;
          softmax_tile(s, m, l, os, h, [&](int ki) { const int dist = tpos - (kb + ki); return (mine && dist >= 0) ? -slope2 * (float)dist : -INFINITY; });
          pv64(os, Vs, s, lane);
          if (nblk < 0) break;
          blk = nblk;
      } }
    l += __shfl_xor(l, 32);
    { const float* br = (const float*)(ws + WS_BR) + mrow * 24 + hq * 3; const float g0 = br[0], g1 = br[1] / l;
      const bf16* OW = (const bf16*)(ws + WS_OW) + mrow * 512 + hq * 64; const bf16* GB = (const bf16*)(ws + WS_GB) + mrow * 512 + hq * 64; bf16* U = (bf16*)(ws + WS_U) + mrow * 1024 + 512 + hq * 64;
#pragma unroll
      for (int dh = 0; dh < 2; ++dh)
#pragma unroll
          for (int aa = 0; aa < 4; ++aa) { const int d0 = 32 * dh + 8 * aa + 4 * h; const v2u ow = *(const GAS v2u*)(OW + d0), gb = *(const GAS v2u*)(GB + d0);
              const float x0 = (g0 * oc[dh][4 * aa] + g1 * os[dh][4 * aa] + bf_lo(ow.x)) * bf_lo(gb.x), x1 = (g0 * oc[dh][4 * aa + 1] + g1 * os[dh][4 * aa + 1] + bf_hi(ow.x)) * bf_hi(gb.x);
              const float x2 = (g0 * oc[dh][4 * aa + 2] + g1 * os[dh][4 * aa + 2] + bf_lo(ow.y)) * bf_lo(gb.y), x3 = (g0 * oc[dh][4 * aa + 3] + g1 * os[dh][4 * aa + 3] + bf_hi(ow.y)) * bf_hi(gb.y);
              v2u w; w.x = cvtpk(x0, x1); w.y = cvtpk(x2, x3); *(GAS v2u*)(U + d0) = w; } }
}

constexpr int SN_Q = 0, SN_SC = 1024, SN_PART = 5120, SN_IMP = SN_PART + 3 * 8 * 4 * 66 * 4  , SN_LIST = SN_IMP + 132 * 4, SN_PS = SN_LIST + 64  , SN_END = SN_PS + 1024;
struct SnState { float m[4], l[4], o[4]; };
template <bool BF16ROWS> __device__ __forceinline__ void sn_chunk(SnState& S, const LAS float* q, const void* kptr, const void* vptr, bool ok, float dist, const float (&sl2)[4], int lane, LAS float* sc_out  ) {
    float s[4] = {0.f, 0.f, 0.f, 0.f};
    if (BF16ROWS) {
#pragma unroll 1
        for (int j = 0; j < 8; ++j) { const v4u kw = *(const GAS v4u*)((const bf16*)kptr + 8 * j); const float kf[8] = {bf_lo(kw.x), bf_hi(kw.x), bf_lo(kw.y), bf_hi(kw.y), bf_lo(kw.z), bf_hi(kw.z), bf_lo(kw.w), bf_hi(kw.w)};
#pragma unroll
            for (int hh = 0; hh < 4; ++hh) { const f32x4 q0 = *(const LAS f32x4*)(q + hh * 64 + 8 * j), q1 = *(const LAS f32x4*)(q + hh * 64 + 8 * j + 4);
                s[hh] += kf[0] * q0.x + kf[1] * q0.y + kf[2] * q0.z + kf[3] * q0.w + kf[4] * q1.x + kf[5] * q1.y + kf[6] * q1.z + kf[7] * q1.w; } }
    } else {
#pragma unroll 2
        for (int j = 0; j < 16; ++j) { const f32x4 kv = *(const GAS f32x4*)((const float*)kptr + 4 * j);
#pragma unroll
            for (int hh = 0; hh < 4; ++hh) { const f32x4 qv = *(const LAS f32x4*)(q + hh * 64 + 4 * j); s[hh] += kv.x * qv.x + kv.y * qv.y + kv.z * qv.z + kv.w * qv.w; } }
    }
    float e[4];
#pragma unroll
    for (int hh = 0; hh < 4; ++hh) { const float x = ok ? s[hh] - sl2[hh] * dist : -INFINITY;
        if (sc_out) sc_out[hh * 256] = x;
        const float mn = fmaxf(S.m[hh], wave_max(x)), al = fexp2(S.m[hh] - mn); S.m[hh] = mn;
        e[hh] = fexp2(x - mn); S.l[hh] = S.l[hh] * al + wave_sum(e[hh]); S.o[hh] *= al; }
    const unsigned long long vp = (unsigned long long)(uintptr_t)vptr; const unsigned vlo = (unsigned)vp, vhi = (unsigned)(vp >> 32);
#pragma unroll 8
    for (int i = 0; i < 64; ++i) {
        const unsigned long long p = ((unsigned long long)(unsigned)__builtin_amdgcn_readlane((int)vhi, i) << 32) | (unsigned)__builtin_amdgcn_readlane((int)vlo, i);
        float vv;
        if (BF16ROWS) { const unsigned short x = ((const GAS unsigned short*)(uintptr_t)p)[lane]; vv = __builtin_bit_cast(float, (unsigned)x << 16); }
        else vv = ((const GAS float*)(uintptr_t)p)[lane];
#pragma unroll
        for (int hh = 0; hh < 4; ++hh) S.o[hh] += __builtin_bit_cast(float, __builtin_amdgcn_readlane(__builtin_bit_cast(int, e[hh]), i)) * vv;
    }
}
__device__ __forceinline__ void sn_init(SnState& S) { for (int i = 0; i < 4; ++i) { S.m[i] = -1e30f; S.l[i] = 0.f; S.o[i] = 0.f; } }
__device__ __forceinline__ void sn_put(const SnState& S, LAS float* part, int lane) {
#pragma unroll
    for (int hh = 0; hh < 4; ++hh) { part[hh * 66 + lane] = S.o[hh]; if (lane == 0) { part[hh * 66 + 64] = S.m[hh]; part[hh * 66 + 65] = S.l[hh]; } }
}
__device__ __forceinline__ float sn_merge(const LAS float* part  , int hh, int lane, float* Mo, float* Lo) {
    float M = -1e30f;
#pragma unroll
    for (int w = 0; w < 8; ++w) M = fmaxf(M, part[(w * 4 + hh) * 66 + 64]);
    float L = 0.f, o = 0.f;
#pragma unroll
    for (int w = 0; w < 8; ++w) { const float f = fexp2(part[(w * 4 + hh) * 66 + 64] - M); L += part[(w * 4 + hh) * 66 + 65] * f; o += part[(w * 4 + hh) * 66 + lane] * f; }
    if (Mo) *Mo = M; if (Lo) *Lo = L;
    return L > 0.f ? o / L : 0.f;
}
__device__ __forceinline__ void item_nsa_sample(const Args& a, LAS unsigned char* lds, int it, int tid, int lane, int wave) {
    unsigned char* ws = a.ws; const int sb = it >> 4, g = (it >> 3) & 1, st = it & 7, t = 8192 + st; const size_t mrow = (size_t)MP + sb * 8 + st;
    const float* cn = (const float*)a.in[IN_CNSA]; const int* pt = (const int*)a.in[IN_PT] + sb * 64; const float* sw = (const float*)a.in[IN_SWIN];
    LAS float* q = (LAS float*)(lds + SN_Q); LAS float* sc = (LAS float*)(lds + SN_SC); LAS float* part = (LAS float*)(lds + SN_PART); LAS float* imp = (LAS float*)(lds + SN_IMP);
    LAS int* list = (LAS int*)(lds + SN_LIST); LAS float* psum = (LAS float*)(lds + SN_PS);
    float sl2[4];
#pragma unroll
    for (int hh = 0; hh < 4; ++hh) sl2[hh] = fexp2(-(float)(4 * g + hh + 1)) * LOG2E;
    if (tid < 256) { const unsigned short qv = ((const bf16*)(ws + WS_QB))[mrow * 512 + (4 * g) * 64 + tid]; q[tid] = __builtin_bit_cast(float, (unsigned)qv << 16); }
    __syncthreads();
    SnState S;
    sn_init(S);
    if (wave < 4) { const int c = 64 * wave + lane;
        const bf16* kp = (const bf16*)(ws + WS_KCS) + ((size_t)((sb * 2 + g) * 256 + c)) * 64; const bf16* vp = (const bf16*)(ws + WS_VCS) + ((size_t)((sb * 2 + g) * 256 + c)) * 64;
        sn_chunk<true>(S, q, kp, vp, true, (float)(t - (32 * c + 31)), sl2, lane, sc + c); }
    sn_put(S, part + (0 * 8 + wave) * 4 * 66, lane);
    sn_init(S);
    for (int ch = ((wave + 4) & 7); ch < 9; ch += 8) { const int i = 64 * ch + lane; const bool inr = i < 520; const int ic = inr ? i : 0; const int wpos = 7680 + ic;
        const float* rowp = (ic < 512) ? sw + ((size_t)(sb * 512 + ic)) * 256 : a.out + OFF_WINS + ((size_t)(sb * 512 + 504 + (ic - 512))) * 256;
        const bool ok = inr && wpos <= t && wpos > t - 512;
        sn_chunk<false>(S, q, rowp + g * 64, rowp + 128 + g * 64, ok, (float)(t - wpos), sl2, lane, nullptr); }
    sn_put(S, part + (2 * 8 + wave) * 4 * 66, lane);
    __syncthreads();
    if (tid < 256) { float ps = 0.f;
#pragma unroll
        for (int hh = 0; hh < 4; ++hh) { float M, L; (void)sn_merge(part, hh, 0, &M, &L); ps += fexp2(sc[hh * 256 + tid] - M) / L; }
        psum[tid] = ps; }
    __syncthreads();
    if (tid < 128) imp[tid] = psum[2 * tid] + psum[2 * tid + 1];
    __syncthreads();
    if (tid < 128) { bool selb = (tid == 0 || tid == 127);
        if (tid >= 1 && tid <= 126) { const float x = imp[tid]; int rank = 0; for (int o2 = 1; o2 <= 126; ++o2) { const float y = imp[o2]; rank += (y > x || (y == x && o2 < tid)) ? 1 : 0; } selb = rank < 13; }
        psum[tid] = selb ? 1.f : 0.f; }
    __syncthreads();
    if (tid == 0) { int n = 0; for (int b2 = 0; b2 < 128; ++b2) if (psum[b2] != 0.f && n < 15) list[n++] = b2; list[n++] = 128; for (; n < 16; ++n) list[n] = -1; }
    __syncthreads();
    sn_init(S);
    for (int j = 0; j < 2; ++j) { const int blk = list[2 * wave + j]; if (blk < 0) continue;
        const int kpos = 64 * blk + lane; const bool ok = kpos <= t; const int kc = ok ? kpos : 0;
        const float* rowp = (kc < 8192) ? cn + ((size_t)pt[kc >> 7] * 128 + (kc & 127)) * 512 : a.out + OFF_NSA + ((size_t)(MP + sb * 8 + (kc - 8192))) * 512;
        sn_chunk<false>(S, q, rowp + 256 + g * 64, rowp + 384 + g * 64, ok, (float)(t - kc), sl2, lane, nullptr); }
    sn_put(S, part + (1 * 8 + wave) * 4 * 66, lane);
    __syncthreads();
    if (wave < 4) { const int hh = wave, hq = 4 * g + hh; const float* br = (const float*)(ws + WS_BR) + mrow * 24 + hq * 3;
        const float oc = sn_merge(part, hh, lane, nullptr, nullptr), os = sn_merge(part + 8 * 4 * 66, hh, lane, nullptr, nullptr), ow = sn_merge(part + 2 * 8 * 4 * 66, hh, lane, nullptr, nullptr);
        const float o = br[0] * oc + br[1] * os + br[2] * ow;
        const unsigned short gv = ((const bf16*)(ws + WS_GB))[mrow * 512 + hq * 64 + lane];
        ((bf16*)(ws + WS_U))[mrow * 1024 + 512 + hq * 64 + lane] = (unsigned short)f2bf(o * __builtin_bit_cast(float, (unsigned)gv << 16)); }
}

#ifndef MK_N_LAUNCHES
#define MK_N_LAUNCHES 1
#endif
#ifndef DBG_STAGE
#define DBG_STAGE 0
#endif
constexpr int N_PHASES = 6;
constexpr int N_L2S = 64, N_SBS = 256, N_WINP = 512, N_SBP = 512, N_NP = 512, N_NS = 512;

__global__ void __launch_bounds__(NTHR, 2) mk_fwd(Args a) {
    extern __shared__ __attribute__((aligned(16))) unsigned char lds_raw[];
    LAS unsigned char* lds = (LAS unsigned char*)lds_raw;
    const int tid0 = threadIdx.x;
    const int G = gridDim.x, bx = blockIdx.x, vcu = (G % 8 == 0) ? (bx % 8) * (G / 8) + bx / 8 : bx;
    unsigned char* ws = a.ws; gu32* ctl = (gu32*)(ws + WS_CTL);
    for (int u = tid0; u < (LDS_BYTES - LDSCTL_OFF) / 4; u += NTHR) ((LAS unsigned*)(lds + LDSCTL_OFF))[u] = 0u;
    __syncthreads();
    volatile LAS unsigned* MISC = (volatile LAS unsigned*)(lds + MISC_OFF);
    volatile LAS int* qslot = (volatile LAS int*)(lds + LDSCTL_OFF + 64);
    const int lo = a.ph_lo, hi = a.ph_hi; const bool multi = (hi - lo) > 1;
    XcdBarrier bar; bar.bar = (unsigned*)(ctl + CW_BAR); bar.x = 0; bar.st = nullptr;
    if (multi) bar = xcd_barrier_post((unsigned*)(ctl + CW_BAR), MISC + 8);
#ifdef DBG_PHMASK
#define IN(k) (((DBG_PHMASK >> (k)) & 1) && lo <= (k) && (k) < hi)
#else
#define IN(k) (lo <= (k) && (k) < hi)
#endif
#define SEAM(k) do { if (IN(k) && IN((k) + 1)) xcd_barrier(bar); } while (0)

    if (IN(0)) { int tid = tid0; asm volatile("" : "+v"(tid)); p0_prologue(a, lds, tid, tid & 63, __builtin_amdgcn_readfirstlane(tid >> 6), vcu, G); SEAM(0); }

    if (IN(1)) {
#ifndef DBG_P1MASK
#define DBG_P1MASK 7
#endif
        if (DBG_P1MASK & 1) { pg8::Gemm g{(const bf16*)(ws + WS_ACMP_S), (const bf16*)(ws + WS_W1T), 32768, 512, 2048}; pg8::DiagOrder S{128, 64, G, bx};
          pg8::EpiHid E{(bf16*)(ws + WS_HIDS)};
          pg8::gemm_phase<pg8::EpiHid, pg8::DiagOrder, PG8_ALIGN, PG8_SP2>(lds, g, S, E); }
        if (DBG_P1MASK & 2) { pg8::Gemm g{(const bf16*)(ws + WS_PBF), (const bf16*)(ws + WS_WPLE_T), MT, 1024, 256}; pg8::StaticOrder S; S.init(MT, 1024, G, bx);
          pg8::EpiBf16<0> E{(bf16*)(ws + WS_T1), 1024, nullptr, 0, 0, 1.f};
          pg8::gemm_phase<pg8::EpiBf16<0>, pg8::StaticOrder, PG8_ALIGN, PG8_SP2>(lds, g, S, E); }
        if (DBG_P1MASK & 4) { pg8::Gemm g{(const bf16*)(ws + WS_HBF), (const bf16*)(ws + WS_WIN_T), MT, NG1, 1024}; pg8::StaticOrder S; S.init(MT, NG1, G, bx);
          pg8::EpiG1 E{a.out, (const float*)(ws + WS_RSTD), (bf16*)(ws + WS_QA), (bf16*)(ws + WS_KA), (bf16*)(ws + WS_VA), (bf16*)(ws + WS_GA), (bf16*)(ws + WS_QB), (bf16*)(ws + WS_GB),
                       (bf16*)(ws + WS_KSEL), (bf16*)(ws + WS_VSEL), (bf16*)(ws + WS_KWIN), (bf16*)(ws + WS_VWIN), (bf16*)(ws + WS_ACMP_P),
                       (const float*)a.in[IN_QG], (const float*)a.in[IN_KSG], (const float*)a.in[IN_KWG], (const float*)a.in[IN_PEK], (const float*)a.in[IN_PEV]};
          pg8::gemm_phase<pg8::EpiG1, pg8::StaticOrder, PG8_ALIGN, PG8_SP2>(lds, g, S, E); }
        SEAM(1);
    }

    if (IN(2)) {
#if DBG_STAGE == 1
        { v4u z = {0u, 0u, 0u, 0u}; for (size_t i = (size_t)bx * NTHR + tid0; i < (size_t)MT * 1024 / 8; i += (size_t)G * NTHR) *(GAS v4u*)((bf16*)(ws + WS_U) + i * 8) = z; }
#else
        { pg8::Gemm g{(const bf16*)(ws + WS_ACMP_P), (const bf16*)(ws + WS_W1T), 2048, 512, 2048}; pg8::DiagOrder S{8, 4, G, bx};
          pg8::EpiHid E{(bf16*)(ws + WS_HIDP)};
          pg8::gemm_phase<pg8::EpiHid, pg8::DiagOrder, PG8_ALIGN, PG8_SP2>(lds, g, S, E); }
        for (;;) {
            int it = next_item(ctl + CW_Q, qslot);
            int tid = tid0; asm volatile("" : "+v"(tid)); const int lane = tid & 63, wave = __builtin_amdgcn_readfirstlane(tid >> 6);
            if (it >= N_L2S + N_SBS + N_WINP + N_SBP) break;
#ifndef DBG_IM
#define DBG_IM 63
#endif
            if (it < N_L2S) { if (DBG_IM & 1) item_l2_sample(a, it, lane, wave); continue; } it -= N_L2S;
            if (it < N_SBS) { if (DBG_IM & 2) item_sb_sample(a, lds, it, lane, wave); continue; } it -= N_SBS;
            if (it < N_WINP) { if (DBG_IM & 4) item_win_prompt(a, lds, it, tid, lane, wave); continue; } it -= N_WINP;
            if (DBG_IM & 8) item_sb_prompt(a, lds, it, lane, wave);
        }
#endif
        SEAM(2);
    }

    if (IN(3)) {
#if DBG_STAGE != 1
        for (;;) {
            int it = next_item(ctl + CW_Q + 64, qslot);
            int tid = tid0; asm volatile("" : "+v"(tid)); const int lane = tid & 63, wave = __builtin_amdgcn_readfirstlane(tid >> 6);
            if (it >= N_NP + N_NS) break;
            if (it < N_NP) { if (DBG_IM & 16) item_nsa_prompt(a, lds, it, tid, lane, wave); continue; } it -= N_NP;
            if (DBG_IM & 32) item_nsa_sample(a, lds, it, tid, lane, wave);
        }
#endif
        SEAM(3);
    }

    if (IN(4)) {
        pg8::Gemm g{(const bf16*)(ws + WS_U), (const bf16*)(ws + WS_WOUT_T), MT, 1024, 1024}; pg8::StaticOrder S; S.init(MT, 1024, G, bx);
        pg8::EpiOut E{(const float*)a.in[IN_XP], (const float*)a.in[IN_XS], a.out, (bf16*)(ws + WS_HB2)};
        pg8::gemm_phase<pg8::EpiOut, pg8::StaticOrder, PG8_ALIGN, PG8_SP2>(lds, g, S, E);
        SEAM(4);
    }
    if (IN(5)) {
        pg8::Gemm g{(const bf16*)(ws + WS_HB2), (const bf16*)(ws + WS_WG_T), MT, 1024, 1024}; pg8::StaticOrder S; S.init(MT, 1024, G, bx);
        pg8::EpiFinal E{a.out, (const bf16*)(ws + WS_T1)};
        pg8::gemm_phase<pg8::EpiFinal, pg8::StaticOrder, PG8_ALIGN, PG8_SP2>(lds, g, S, E);
    }
#undef IN
#undef SEAM
}

extern "C" void kernel_launch(void* const* d_in, const int* in_sizes, int n_in, void* d_out, int out_size, void* d_ws, size_t ws_size, hipStream_t stream) {
    static int grid = 0;
    if (grid == 0) {
        if (n_in != N_INPUTS || (size_t)out_size != OUT_TOTAL || ws_size < WS_END) { fprintf(stderr, "kernel_launch: unexpected shapes (n_in %d, out %d, ws %zu); nothing launched\n", n_in, out_size, ws_size); grid = -1; return; }
        int dev = 0, cus = 0;
        if (hipGetDevice(&dev) != hipSuccess || hipDeviceGetAttribute(&cus, hipDeviceAttributeMultiprocessorCount, dev) != hipSuccess) { grid = -1; return; }
        if (hipFuncSetAttribute((const void*)mk_fwd, hipFuncAttributeMaxDynamicSharedMemorySize, LDS_BYTES) != hipSuccess) { fprintf(stderr, "kernel_launch: hipFuncSetAttribute failed\n"); grid = -1; return; }
        int per_cu = 0;
        if (hipOccupancyMaxActiveBlocksPerMultiprocessor(&per_cu, (const void*)mk_fwd, NTHR, LDS_BYTES) != hipSuccess || per_cu < 1) { fprintf(stderr, "kernel_launch: occupancy query says %d\n", per_cu); per_cu = 1; }
        (void)hipGetLastError();
        grid = cus;
    }
    if (grid < 0) return;
    if (hipMemsetAsync((char*)d_ws + WS_CTL, 0, CTL_ZERO_BYTES, stream) != hipSuccess) { fprintf(stderr, "kernel_launch: memset failed\n"); return; }
    Args a{};
    for (int i = 0; i < N_INPUTS; ++i) a.in[i] = d_in[i];
    a.out = (float*)d_out; a.ws = (unsigned char*)d_ws;
#if MK_N_LAUNCHES == 1
    a.ph_lo = 0; a.ph_hi = N_PHASES;
    hipLaunchKernelGGL(mk_fwd, dim3(grid), dim3(NTHR), LDS_BYTES, stream, a);
#else
    for (int p = 0; p < N_PHASES; ++p) { a.ph_lo = p; a.ph_hi = p + 1; hipLaunchKernelGGL(mk_fwd, dim3(grid), dim3(NTHR), LDS_BYTES, stream, a); }
#endif
    const hipError_t le = hipPeekAtLastError();
    if (le != hipSuccess) fprintf(stderr, "kernel_launch: launch failed: %s\n", hipGetErrorName(le));
}
```

```cpp
#include <hip/hip_runtime.h>
#include <cstdio>
#include <cstdint>
namespace pg8 {
#define PG8_LAS __attribute__((address_space(3)))
typedef unsigned short bf16_t;
typedef short bf16x8 __attribute__((ext_vector_type(8)));
typedef float f32x4 __attribute__((ext_vector_type(4)));
typedef unsigned u32x4 __attribute__((ext_vector_type(4)));
constexpr int BM = 256, BK = 64, HALF = 128, HTB = HALF * BK * 2  , STAGE_BYTES = 8 * HTB, NXCD = 8, WGM = 8;

__host__ __device__ __forceinline__ int lds_byte(int r, int c) { const int st = (r >> 4) * 2 + (c >> 5), rr = r & 15, cc = c & 31, ob = rr * 64 + cc * 2; return st * 1024 + (ob ^ (((ob >> 9) & 1) << 5)); }
__host__ __device__ __forceinline__ void stage_rc(int b, int& R, int& C) { const int st = b / 1024, sb = b % 1024, swz = sb ^ (((sb >> 9) & 1) << 5); R = (st >> 1) * 16 + swz / 64; C = (st & 1) * 32 + (swz % 64) / 2; }
__host__ __device__ __forceinline__ int perm32(int rho) { const int n = rho >> 4, i = rho & 15; return 8 * (i >> 2) + 4 * n + (i & 3); }

struct Unit { int pm, pn; };
struct Gemm { const bf16_t* A; const bf16_t* Bt; int M, N, K; };

struct StaticOrder {
    int nM, nN, nwg, G, c;
    __host__ __device__ void init(int M, int N, int G_, int c_) { nM = M / BM; nN = N / BM; nwg = nM * nN; G = G_; c = c_; }
    __host__ __device__ bool next(int i, Unit& u) const {
        const long L = (long)i * G + c; if (L >= nwg) return false;
        int wgid = (int)L; { const int q = nwg / NXCD, r = nwg % NXCD, xcd = wgid % NXCD, off = wgid / NXCD; wgid = (xcd < r ? xcd * (q + 1) : r * (q + 1) + (xcd - r) * q) + off; }
        const int nig = WGM * nN, gid = wgid / nig, fm = gid * WGM, gsz = (nM - fm) < WGM ? (nM - fm) : WGM;
        u.pm = fm + ((wgid % nig) % gsz); u.pn = (wgid % nig) / gsz; return true;
    }
    __device__ __forceinline__ void a_ready(const Unit&) const {}
    __device__ __forceinline__ void done(const Unit&) const {}
};

__device__ __forceinline__ unsigned cvt_pk_bf16(float lo, float hi) { unsigned r; asm volatile("v_cvt_pk_bf16_f32 %0, %1, %2" : "=v"(r) : "v"(lo), "v"(hi)); return r; }
typedef float f32x2 __attribute__((ext_vector_type(2)));
__device__ __forceinline__ f32x2 gelu_pk(f32x2 v) {
    const f32x2 av = __builtin_elementwise_abs(v), d = av * 0.2316418882f + 1.0f;
    f32x2 t; t.x = __builtin_amdgcn_rcpf(d.x); t.y = __builtin_amdgcn_rcpf(d.y);
    f32x2 q = t * 0.5307027145f + (-0.7265760135f); q = q * t + 0.7107068705f; q = q * t + (-0.142248368f); q = q * t + 0.127414796f; q = q * t;
    const f32x2 s = (v * v) * (-0.72134752044f);
    f32x2 e; e.x = __builtin_amdgcn_exp2f(s.x); e.y = __builtin_amdgcn_exp2f(s.y);
    const f32x2 m = v * (q * e), r = v - m;
    f32x2 o; o.x = v.x < 0.f ? m.x : r.x; o.y = v.y < 0.f ? m.y : r.y; return o;
}

template <int ACT  > struct EpiBf16 {
    static constexpr bool PERM = true, AFTER_DRAIN = false; static_assert(ACT == 0 || ACT == 1, "EpiBf16: ACT is 0 (none) or 1 (gelu_pk)");
    bf16_t* O; int ldc; const float* bias; int split_cols; size_t split_stride; float scale0;
    __device__ __forceinline__ void operator()(const f32x4 (&acc)[2][2][4][2], const Unit& u, int wr, int wc, int fr_, int fq_) const {
        int fr = fr_, fq = fq_; asm volatile("" : "+v"(fr), "+v"(fq));
        const int row0 = u.pm * BM + wr * 64 + fr; int colt = u.pn * BM; bf16_t* base = O;
        float sc = 1.f; if (split_cols) { const int t = colt / split_cols; base += (size_t)t * split_stride; colt -= t * split_cols; if (t == 0) sc = scale0; }
        const int col0 = colt + wc * 32 + 8 * fq, bcol0 = u.pn * BM + wc * 32 + 8 * fq;
        f32x4 bv[2][2];
#pragma unroll
        for (int bj = 0; bj < 2; ++bj)
#pragma unroll
            for (int n = 0; n < 2; ++n) bv[bj][n] = bias ? *(const f32x4*)(bias + bcol0 + bj * HALF + 4 * n) : (f32x4){0.f, 0.f, 0.f, 0.f};
#pragma unroll
        for (int ai = 0; ai < 2; ++ai)
#pragma unroll
            for (int m = 0; m < 4; ++m) { bf16_t* rowp = base + (size_t)(row0 + ai * HALF + m * 16) * ldc + col0;
#pragma unroll
                for (int bj = 0; bj < 2; ++bj) { f32x4 v0 = acc[ai][bj][m][0] + bv[bj][0], v1 = acc[ai][bj][m][1] + bv[bj][1];
                    if (ACT == 1) { f32x2 a = gelu_pk((f32x2){v0[0], v0[1]}), b = gelu_pk((f32x2){v0[2], v0[3]}), c = gelu_pk((f32x2){v1[0], v1[1]}), d = gelu_pk((f32x2){v1[2], v1[3]});
                        v0 = (f32x4){a.x, a.y, b.x, b.y}; v1 = (f32x4){c.x, c.y, d.x, d.y}; }
                    v0 = v0 * sc; v1 = v1 * sc; u32x4 w; w.x = cvt_pk_bf16(v0[0], v0[1]); w.y = cvt_pk_bf16(v0[2], v0[3]); w.z = cvt_pk_bf16(v1[0], v1[1]); w.w = cvt_pk_bf16(v1[2], v1[3]);
                    *(u32x4*)(rowp + bj * HALF) = w; } }
    }
};

template <class Epi, class Sched, bool ALIGN_EPI = false, bool SP2 = false, bool OPAQUE_K = false>
__device__ __forceinline__ void gemm_phase(PG8_LAS unsigned char* lds, const Gemm g, const Sched& S, const Epi& E) {
    int tid_ = threadIdx.x;
#ifndef PG8_NOLAUNDER
    asm volatile("" : "+v"(tid_));
#endif
    const int tid = tid_, wid = __builtin_amdgcn_readfirstlane(tid >> 6), lane = tid & 63, wr = wid >> 2, wc = wid & 3, fr = lane & 15, fq = lane >> 4;
    int K_ = g.K; if (OPAQUE_K) asm volatile("" : "+s"(K_));
    const int K = K_, nt = K / BK;
    unsigned voffA[2], voffB[2];
#pragma unroll
    for (int i = 0; i < 2; ++i) { int R, C; stage_rc(tid * 16 + i * 8192, R, C); const int Rb = Epi::PERM ? ((R & ~31) + perm32(R & 31)) : R;
        voffA[i] = (unsigned)(R * K + C) * 2u; voffB[i] = (unsigned)(Rb * K + C) * 2u; }
    const size_t kstep = (size_t)(BK * 2);
    const size_t hstep = (size_t)HALF * K * 2;
    const size_t tstep = 2 * hstep;
    const unsigned ldsw = (unsigned)wid * 1024u;
    const int aoff = lds_byte(wr * 64 + fr, fq * 8), boff = lds_byte(wc * 32 + fr, fq * 8);
#define PG8_SA(b, h) (((b) * 2 + (h)) * HTB)
#define PG8_SB(b, h) ((4 + (b) * 2 + (h)) * HTB)
#define PG8_STAGE(bufoff, gbase, voff) do { _Pragma("unroll") for (int _i = 0; _i < 2; ++_i) \
        __builtin_amdgcn_global_load_lds((const unsigned*)((const char*)(gbase) + (voff)[_i]), (PG8_LAS unsigned*)(lds + (bufoff) + ldsw + _i * 8192), 16, 0, 0); } while (0)
#define PG8_LDA(dst, b, h) do { _Pragma("unroll") for (int m = 0; m < 4; ++m) _Pragma("unroll") for (int k = 0; k < 2; ++k) dst[m][k] = *(const PG8_LAS bf16x8*)(lds + PG8_SA(b, h) + aoff + m * 2048 + k * 1024); } while (0)
#define PG8_LDB(dst, b, h) do { _Pragma("unroll") for (int n = 0; n < 2; ++n) _Pragma("unroll") for (int k = 0; k < 2; ++k) dst[n][k] = *(const PG8_LAS bf16x8*)(lds + PG8_SB(b, h) + boff + n * 2048 + k * 1024); } while (0)
#define PG8_MMA(ai, bj, At, Bt) do { __builtin_amdgcn_s_setprio(1); _Pragma("unroll") for (int m = 0; m < 4; ++m) _Pragma("unroll") for (int n = 0; n < 2; ++n) _Pragma("unroll") for (int k = 0; k < 2; ++k) \
        acc[ai][bj][m][n] = __builtin_amdgcn_mfma_f32_16x16x32_bf16(Bt[n][k], At[m][k], acc[ai][bj][m][n], 0, 0, 0); __builtin_amdgcn_s_setprio(0); } while (0)
#define PG8_WAIT_V(n) asm volatile("s_waitcnt vmcnt(" #n ")" ::: "memory")
#define PG8_WAIT_L(n) asm volatile("s_waitcnt lgkmcnt(" #n ")" ::: "memory")
#define PG8_BAR __builtin_amdgcn_s_barrier()
#define PG8_SCHED __builtin_amdgcn_sched_barrier(0)
    Unit cur, nxt; int ui = 0;
    if (!S.next(0, cur)) return;
    f32x4 acc[2][2][4][2];
#pragma unroll
    for (int a = 0; a < 2; ++a)
#pragma unroll
        for (int b = 0; b < 2; ++b)
#pragma unroll
            for (int m = 0; m < 4; ++m)
#pragma unroll
                for (int n = 0; n < 2; ++n) acc[a][b][m][n] = (f32x4){0.f, 0.f, 0.f, 0.f};
    bf16x8 At[4][2], B0[2][2], B1[2][2];
    const char* cA = (const char*)g.A + (size_t)cur.pm * tstep; const char* cB = (const char*)g.Bt + (size_t)cur.pn * tstep;
    S.a_ready(cur);
    if constexpr (SP2) {
        PG8_STAGE(PG8_SB(0, 0), cB, voffB); PG8_STAGE(PG8_SB(0, 1), cB + hstep, voffB); PG8_STAGE(PG8_SA(0, 0), cA, voffA); PG8_STAGE(PG8_SA(0, 1), cA + hstep, voffA);
        if (wr == 1) PG8_BAR;
        PG8_WAIT_V(2); PG8_BAR;
        PG8_STAGE(PG8_SB(1, 0), cB + kstep, voffB); PG8_STAGE(PG8_SA(1, 0), cA + kstep, voffA); PG8_STAGE(PG8_SB(1, 1), cB + hstep + kstep, voffB);
        PG8_WAIT_V(6); PG8_BAR;
    } else {
        PG8_STAGE(PG8_SB(0, 0), cB, voffB); PG8_STAGE(PG8_SA(0, 0), cA, voffA); PG8_STAGE(PG8_SB(0, 1), cB + hstep, voffB); PG8_STAGE(PG8_SA(0, 1), cA + hstep, voffA);
        if (wr == 1) PG8_BAR;
        PG8_WAIT_V(4); PG8_BAR;
        PG8_STAGE(PG8_SB(1, 0), cB + kstep, voffB); PG8_STAGE(PG8_SA(1, 0), cA + kstep, voffA); PG8_STAGE(PG8_SB(1, 1), cB + hstep + kstep, voffB);
        PG8_WAIT_V(6); PG8_BAR;
    }
    for (;;) {
        const bool has_next = S.next(ui + 1, nxt);
        const char* nA = has_next ? (const char*)g.A + (size_t)nxt.pm * tstep : cA; const char* nB = has_next ? (const char*)g.Bt + (size_t)nxt.pn * tstep : cB;
        for (int t = 0; t < nt; t += 2) {
            const bool last = (t == nt - 2);
            const char* a1 = cA + (size_t)(t + 1) * kstep;
            const char* a2 = last ? nA : cA + (size_t)(t + 2) * kstep; const char* b2 = last ? nB : cB + (size_t)(t + 2) * kstep;
            const char* a3 = a2 + kstep; const char* b3 = b2 + kstep;
            if (last && has_next) S.a_ready(nxt);
            if constexpr (SP2) {
            PG8_LDB(B0, 0, 0); PG8_LDB(B1, 0, 1); PG8_SCHED; PG8_LDA(At, 0, 0); PG8_STAGE(PG8_SA(1, 1), a1 + hstep, voffA);
            PG8_WAIT_V(8); PG8_WAIT_L(0); PG8_BAR; PG8_MMA(0, 0, At, B0); PG8_MMA(0, 1, At, B1); PG8_BAR; PG8_SCHED;
            PG8_LDA(At, 0, 1); PG8_STAGE(PG8_SB(0, 0), b2, voffB); PG8_STAGE(PG8_SB(0, 1), b2 + hstep, voffB); PG8_STAGE(PG8_SA(0, 0), a2, voffA);
            PG8_WAIT_V(8); PG8_WAIT_L(0); PG8_BAR; PG8_MMA(1, 0, At, B0); PG8_MMA(1, 1, At, B1); PG8_BAR; PG8_SCHED;
            PG8_LDB(B0, 1, 0); PG8_LDB(B1, 1, 1); PG8_SCHED; PG8_LDA(At, 1, 0); PG8_STAGE(PG8_SA(0, 1), a2 + hstep, voffA);
            PG8_WAIT_V(8); PG8_WAIT_L(0); PG8_BAR; PG8_MMA(0, 0, At, B0); PG8_MMA(0, 1, At, B1); PG8_BAR; PG8_SCHED;
            PG8_LDA(At, 1, 1); PG8_STAGE(PG8_SB(1, 0), b3, voffB); PG8_STAGE(PG8_SB(1, 1), b3 + hstep, voffB); PG8_STAGE(PG8_SA(1, 0), a3, voffA);
            PG8_WAIT_V(8); PG8_WAIT_L(0); PG8_BAR; PG8_MMA(1, 0, At, B0); PG8_MMA(1, 1, At, B1); PG8_BAR; PG8_SCHED;
            } else {
            PG8_LDB(B0, 0, 0); PG8_SCHED; PG8_LDA(At, 0, 0); PG8_STAGE(PG8_SA(1, 1), a1 + hstep, voffA);
            PG8_WAIT_L(8); PG8_BAR; PG8_WAIT_L(0); PG8_MMA(0, 0, At, B0); PG8_BAR; PG8_SCHED;
            PG8_LDB(B1, 0, 1); PG8_STAGE(PG8_SB(0, 0), b2, voffB);
            PG8_BAR; PG8_WAIT_L(0); PG8_MMA(0, 1, At, B1); PG8_BAR;
            PG8_LDA(At, 0, 1); PG8_STAGE(PG8_SA(0, 0), a2, voffA);
            PG8_BAR; PG8_WAIT_L(0); PG8_MMA(1, 0, At, B0); PG8_BAR; PG8_SCHED;
            PG8_STAGE(PG8_SB(0, 1), b2 + hstep, voffB);
            PG8_WAIT_V(6); PG8_BAR; PG8_MMA(1, 1, At, B1); PG8_BAR;
            PG8_LDB(B0, 1, 0); PG8_SCHED; PG8_LDA(At, 1, 0); PG8_STAGE(PG8_SA(0, 1), a2 + hstep, voffA);
            PG8_WAIT_L(8); PG8_BAR; PG8_WAIT_L(0); PG8_MMA(0, 0, At, B0); PG8_BAR; PG8_SCHED;
            PG8_LDB(B1, 1, 1); PG8_STAGE(PG8_SB(1, 0), b3, voffB);
            PG8_BAR; PG8_WAIT_L(0); PG8_MMA(0, 1, At, B1); PG8_BAR;
            PG8_LDA(At, 1, 1); PG8_STAGE(PG8_SA(1, 0), a3, voffA);
            PG8_BAR; PG8_WAIT_L(0); PG8_MMA(1, 0, At, B0); PG8_BAR; PG8_SCHED;
            PG8_STAGE(PG8_SB(1, 1), b3 + hstep, voffB);
            PG8_WAIT_V(6); PG8_BAR; PG8_MMA(1, 1, At, B1); PG8_BAR;
            }
        }
        if constexpr (ALIGN_EPI) { if (wr == 0) PG8_BAR; }
        if constexpr (!Epi::AFTER_DRAIN) { E(acc, cur, wr, wc, fr, fq);
#ifdef DBG_EPI2
            E(acc, cur, wr, wc, fr, fq);
#endif
            S.done(cur); }
        if (!has_next) break;
#pragma unroll
        for (int a = 0; a < 2; ++a)
#pragma unroll
            for (int b = 0; b < 2; ++b)
#pragma unroll
                for (int m = 0; m < 4; ++m)
#pragma unroll
                    for (int n = 0; n < 2; ++n) acc[a][b][m][n] = (f32x4){0.f, 0.f, 0.f, 0.f};
        cur = nxt; cA = nA; cB = nB; ++ui;
        if constexpr (ALIGN_EPI) { if (wr == 1) PG8_BAR; }
    }
    PG8_WAIT_V(0);
    if constexpr (!ALIGN_EPI) { if (wr == 0) PG8_BAR; }
    PG8_BAR;
    if constexpr (Epi::AFTER_DRAIN) { E.fused(acc, cur, wr, wc, fr, fq, lds, wid, lane); S.done(cur); }
#undef PG8_SA
#undef PG8_SB
#undef PG8_STAGE
#undef PG8_LDA
#undef PG8_LDB
#undef PG8_MMA
#undef PG8_WAIT_V
#undef PG8_WAIT_L
#undef PG8_BAR
#undef PG8_SCHED
}
}


#ifndef PG8_SP2
#define PG8_SP2 true
#endif
#ifndef PG8_ALIGN
#define PG8_ALIGN true
#endif
#define GAS __attribute__((address_space(1)))
#define LAS __attribute__((address_space(3)))
typedef unsigned short bf16;
typedef unsigned v4u __attribute__((ext_vector_type(4)));
typedef float f32x4 __attribute__((ext_vector_type(4)));
typedef short bf16x8 __attribute__((ext_vector_type(8)));
typedef GAS unsigned gu32;
typedef GAS unsigned long long gu64;
#define RLX_AGENT __ATOMIC_RELAXED, __HIP_MEMORY_SCOPE_AGENT
#define LDS_WAIT() asm volatile("s_waitcnt lgkmcnt(0)" ::: "memory")
#define VM_WAIT() asm volatile("s_waitcnt vmcnt(0)" ::: "memory")
__device__ __forceinline__ unsigned long long rt() { return __builtin_amdgcn_s_memrealtime(); }
__device__ __forceinline__ unsigned f2bf(float f) { unsigned u = __builtin_bit_cast(unsigned, f); return (u + 0x7fffu + ((u >> 16) & 1u)) >> 16; }
__device__ __forceinline__ unsigned pk2(float lo, float hi) { return f2bf(lo) | (f2bf(hi) << 16); }

#define XB_TMO      128
#define XB_XCNT(j)  (256  + 64 * (j))
#define XB_XSUB(j)  (1280 + 64 * (j))
#define XB_XGEN(j)  (2304 + 64 * (j))
#define XB_TOP      3328
#define XB_TOPGEN   3392
#define XCD_BAR_WORDS 3456
#define XB_SPIN_CAP (1u << 18)

__device__ __forceinline__ unsigned xb_ld(unsigned* p)              { return __hip_atomic_load(p, __ATOMIC_RELAXED, __HIP_MEMORY_SCOPE_AGENT); }
__device__ __forceinline__ unsigned xb_add(unsigned* p, unsigned v) { return __hip_atomic_fetch_add(p, v, __ATOMIC_RELAXED, __HIP_MEMORY_SCOPE_AGENT); }
__device__ __forceinline__ unsigned xb_xcc_id() { return (unsigned)__builtin_amdgcn_s_getreg((3 << 11) | 20) & 0xFu; }
#define XB_SPIN(cond, bar) do { unsigned _sp = 0; while (cond) { __builtin_amdgcn_s_sleep(1); \
    if ((++_sp & 255u) == 0u) { if (xb_ld(&(bar)[XB_TMO])) break; if (_sp > XB_SPIN_CAP) { atomicAdd(&(bar)[XB_TMO], 1u); break; } } } } while (0)

struct XcdBarrier {
    unsigned* bar; unsigned x;
    volatile LAS unsigned* st;
};

__device__ __forceinline__ XcdBarrier xcd_barrier_post(unsigned* bar, volatile LAS unsigned* st) {
    XcdBarrier b; b.bar = bar; b.x = xb_xcc_id(); b.st = st;
    if (threadIdx.x == 0) (void)xb_add(&bar[XB_XCNT(b.x)], 1u);
    return b;
}
__device__ __forceinline__ void xcd_barrier_complete(unsigned* bar, unsigned x, unsigned& nloc, unsigned& nx) {
    const unsigned G = gridDim.x * gridDim.y * gridDim.z;
    unsigned sum, cnt, mine, sp = 0u;
    for (;;) {
        sum = 0u; cnt = 0u; mine = 0u;
#pragma unroll
        for (unsigned j = 0; j < 16; ++j) { const unsigned c = xb_ld(&bar[XB_XCNT(j)]); sum += c; cnt += (c > 0u) ? 1u : 0u; mine = (j == x) ? c : mine; }
        if (sum == G) break;
        __builtin_amdgcn_s_sleep(1);
        if ((++sp & 255u) == 0u) { if (xb_ld(&bar[XB_TMO])) break; if (sp > XB_SPIN_CAP) { atomicAdd(&bar[XB_TMO], 1u); break; } }
    }
    nloc = mine > 0u ? mine : 1u; nx = cnt > 0u ? cnt : 1u;
}

__device__ __forceinline__ void xcd_barrier(const XcdBarrier& b) {
    asm volatile("s_waitcnt vmcnt(0)" ::: "memory");
    __syncthreads();
    if (threadIdx.x == 0) {
        unsigned* bar = b.bar;
        __builtin_amdgcn_s_waitcnt(0);
        unsigned nloc = b.st[0], nx = b.st[1];
        if (nloc == 0u) { xcd_barrier_complete(bar, b.x, nloc, nx); b.st[0] = nloc; b.st[1] = nx; }
        const unsigned old = xb_add(&bar[XB_XSUB(b.x)], 1u);
        const unsigned gen = old / nloc;
        if (old + 1u == (gen + 1u) * nloc) {
            __builtin_amdgcn_fence(__ATOMIC_RELEASE, "agent");
            asm volatile("s_waitcnt vmcnt(0)" ::: "memory");
            const unsigned og = xb_add(&bar[XB_TOP], 1u);
            const unsigned tg = og / nx;
            if (og + 1u == (tg + 1u) * nx) xb_add(&bar[XB_TOPGEN], 1u);
            else XB_SPIN(xb_ld(&bar[XB_TOPGEN]) == tg, bar);
            __builtin_amdgcn_fence(__ATOMIC_ACQUIRE, "agent");
            xb_add(&bar[XB_XGEN(b.x)], 1u);
            asm volatile("s_waitcnt vmcnt(0)" ::: "memory");
        } else {
            XB_SPIN(xb_ld(&bar[XB_XGEN(b.x)]) == gen, bar);
            __builtin_amdgcn_fence(__ATOMIC_ACQUIRE, "agent");
            asm volatile("s_waitcnt vmcnt(0)" ::: "memory");
        }
    }
    __syncthreads();
}


constexpr int NWAVES = 8, NTHR = 512;
constexpr int MP = 16384, MS = 256, MT = 16640, DM = 1024, TP = 2048;
constexpr int NG1 = 3840, NIN = 3864;
constexpr float EPS = 1e-6f, LOG2E = 1.4426950408889634f, LN2 = 0.6931471805599453f;
constexpr size_t OFF_SB = 17039360, OFF_NSA = 34078720, OFF_WINP = 42598400, OFF_WINS = 43646976, OUT_TOTAL = 47841280;
enum { IN_XP = 0, IN_XS, IN_PP, IN_PS, IN_CSB, IN_CNSA, IN_SWIN, IN_PT, IN_NORMG, IN_WIN, IN_QG, IN_KCG, IN_KSG, IN_KWG, IN_PEK, IN_W1K, IN_W2K, IN_PEV, IN_W1V, IN_W2V, IN_WOUT, IN_WPLE, IN_WG, N_INPUTS };

constexpr size_t MiB = 1u << 20;
constexpr size_t WS_CTL = 0, CTL_ZERO_BYTES = 1 * MiB;
constexpr size_t WS_WIN_T = 2 * MiB, WS_W1T = 11 * MiB, WS_W2T = 13 * MiB, WS_WOUT_T = 14 * MiB, WS_WG_T = 16 * MiB, WS_WPLE_T = 18 * MiB;
constexpr size_t WS_RSTD = 19 * MiB, WS_BR = 20 * MiB, WS_HBF = 24 * MiB, WS_PBF = 58 * MiB;
constexpr size_t WS_QA = 68 * MiB, WS_KA = 86 * MiB, WS_VA = 104 * MiB, WS_GA = 122 * MiB, WS_QB = 140 * MiB, WS_GB = 158 * MiB;
constexpr size_t WS_KSEL = 176 * MiB, WS_VSEL = 182 * MiB, WS_KWIN = 188 * MiB, WS_VWIN = 194 * MiB;
constexpr size_t WS_ACMP_P = 200 * MiB, WS_HIDP = 208 * MiB, WS_HIDS = 210 * MiB, WS_KCS = 226 * MiB, WS_VCS = 228 * MiB;
constexpr size_t WS_OW = 232 * MiB, WS_U = 248 * MiB, WS_T1 = 282 * MiB, WS_HB2 = 316 * MiB, WS_ACMP_S = 352 * MiB, WS_END = 480 * MiB;
constexpr int CW_BAR = 4096;
constexpr int CW_Q = 16384;
constexpr int CW_PANEL = 32768;
constexpr int CW_PANEL2 = 40960;
constexpr int CW_BIAS = 65536;

constexpr int RING_BYTES = 131072, LDSCTL_OFF = RING_BYTES, MISC_OFF = LDSCTL_OFF + 320, LDS_BYTES = 147456;

typedef float f32x16 __attribute__((ext_vector_type(16)));
typedef short s16x4 __attribute__((ext_vector_type(4)));
typedef float f32x2_t __attribute__((ext_vector_type(2)));
typedef __bf16 bf16x2_t __attribute__((ext_vector_type(2)));
typedef unsigned v2u __attribute__((ext_vector_type(2)));
__device__ __forceinline__ unsigned cvtpk(float lo, float hi) { f32x2_t v = {lo, hi}; bf16x2_t b = __builtin_convertvector(v, bf16x2_t); return __builtin_bit_cast(unsigned, b); }
__device__ __forceinline__ float bf_lo(unsigned w) { return __builtin_bit_cast(float, w << 16); }
__device__ __forceinline__ float bf_hi(unsigned w) { return __builtin_bit_cast(float, w & 0xffff0000u); }
__device__ __forceinline__ float fexp2(float x) { return __builtin_amdgcn_exp2f(x); }
__device__ __forceinline__ float flog2(float x) { return __builtin_amdgcn_logf(x); }
__device__ __forceinline__ float frcp(float x) { return __builtin_amdgcn_rcpf(x); }
__device__ __forceinline__ float sigmoidf_(float x) { return frcp(1.f + fexp2(-x * LOG2E)); }
__device__ __forceinline__ float siluf_(float x) { return x * sigmoidf_(x); }
__device__ __forceinline__ float wave_sum(float v) {
#pragma unroll
    for (int o = 1; o < 64; o <<= 1) v += __shfl_xor(v, o);
    return v;
}
__device__ __forceinline__ float wave_max(float v) {
#pragma unroll
    for (int o = 1; o < 64; o <<= 1) v = fmaxf(v, __shfl_xor(v, o));
    return v;
}

struct Args { const void* in[N_INPUTS]; float* out; unsigned char* ws; int ph_lo, ph_hi; };

__device__ __forceinline__ void p0_transpose_item(const float* __restrict__ W, int ldw, int col0, const float* __restrict__ gsc, bf16* WT, int K, int drow0, int k0, LAS float* scr, int lane) {
#pragma unroll 16
    for (int i = 0; i < 32; ++i) { const int kk = 2 * i + (lane >> 5); float v = W[(size_t)(k0 + kk) * ldw + col0 + (lane & 31)]; if (gsc) v *= gsc[k0 + kk]; scr[kk * 33 + (lane & 31)] = v; }
    LDS_WAIT(); asm volatile("" ::: "memory");
    const int c = lane & 7;
#pragma unroll
    for (int j = 0; j < 4; ++j) { const int n = (lane >> 3) + 8 * j; const LAS float* s = scr + (8 * c) * 33 + n;
        v4u o; o.x = pk2(s[0 * 33], s[1 * 33]); o.y = pk2(s[2 * 33], s[3 * 33]); o.z = pk2(s[4 * 33], s[5 * 33]); o.w = pk2(s[6 * 33], s[7 * 33]);
        *(GAS v4u*)(WT + (size_t)(drow0 + n) * K + k0 + 8 * c) = o; }
    LDS_WAIT(); asm volatile("" ::: "memory");
}
__host__ __device__ __forceinline__ int g1_role(int pn) { return (int)((0xec9b7a15d483620ull >> (4 * pn)) & 15); }
__device__ __forceinline__ int g1_src_col(int n) { const int t = g1_role(n >> 8), gm = n & 255, lam = 64 * ((gm >> 5) & 3) + 32 * (gm >> 7) + (gm & 31); return (t < 13 ? t * 256 : 3352 + (t - 13) * 256) + lam; }

constexpr int WBR_OFF = 67584, WBR_PITCH = 2064;

__device__ __forceinline__ void p0_prologue(const Args& a, LAS unsigned char* lds, int tid, int lane, int wave, int vcu, int G, int rep = 0) {
    const int gw = vcu * NWAVES + wave, NGW = G * NWAVES;
    unsigned char* ws = a.ws;
    const float* w_in = (const float*)a.in[IN_WIN]; const float* norm_g = (const float*)a.in[IN_NORMG];
    { LAS unsigned char* wbr = lds + WBR_OFF;
      for (int i0 = 0; i0 < 48; i0 += 24) { float v[24], gk[24];
#pragma unroll
          for (int i = 0; i < 24; ++i) { const int idx = tid + NTHR * (i0 + i), k = idx / 24, c = idx - 24 * k; v[i] = w_in[(size_t)k * NIN + 3328 + c]; gk[i] = norm_g[k]; }
#pragma unroll
          for (int i = 0; i < 24; ++i) { const int idx = tid + NTHR * (i0 + i), k = idx / 24, c = idx - 24 * k; *(LAS unsigned short*)(wbr + c * WBR_PITCH + k * 2) = (unsigned short)f2bf(v[i] * gk[i]); } } }
    { LAS float* scr = (LAS float*)(lds + wave * 8448);
      constexpr int I0 = 16 * 120, I1 = 32 * 8, I3 = 4 * 2, I5 = 16 * 32, I7 = 4 * 32, NITEMS = I0 + 2 * I1 + 2 * I3 + 2 * I5 + I7;
      for (int it = gw; it < NITEMS; it += NGW) {
          int r = it;
          if (r < I0) { const int kb = r / 120, nb = r % 120; p0_transpose_item(w_in, NIN, g1_src_col(32 * nb), norm_g, (bf16*)(ws + WS_WIN_T), 1024, 32 * nb, 64 * kb, scr, lane); continue; } r -= I0;
          if (r < I1) { const int kb = r / 8, nb = r % 8; p0_transpose_item((const float*)a.in[IN_W1K], 256, 32 * nb, nullptr, (bf16*)(ws + WS_W1T), 2048, 32 * nb, 64 * kb, scr, lane); continue; } r -= I1;
          if (r < I1) { const int kb = r / 8, nb = r % 8; p0_transpose_item((const float*)a.in[IN_W1V], 256, 32 * nb, nullptr, (bf16*)(ws + WS_W1T), 2048, 256 + 32 * nb, 64 * kb, scr, lane); continue; } r -= I1;
          if (r < I3) { const int kb = r / 2, nb = r % 2; p0_transpose_item((const float*)a.in[IN_W2K], 64, 32 * nb, nullptr, (bf16*)(ws + WS_W2T), 256, 32 * nb, 64 * kb, scr, lane); continue; } r -= I3;
          if (r < I3) { const int kb = r / 2, nb = r % 2; p0_transpose_item((const float*)a.in[IN_W2V], 64, 32 * nb, nullptr, (bf16*)(ws + WS_W2T), 256, 64 + 32 * nb, 64 * kb, scr, lane); continue; } r -= I3;
          if (r < I5) { const int kb = r / 32, nb = r % 32; p0_transpose_item((const float*)a.in[IN_WOUT], 1024, 32 * nb, nullptr, (bf16*)(ws + WS_WOUT_T), 1024, 32 * nb, 64 * kb, scr, lane); continue; } r -= I5;
          if (r < I5) { const int kb = r / 32, nb = r % 32; p0_transpose_item((const float*)a.in[IN_WG], 1024, 32 * nb, nullptr, (bf16*)(ws + WS_WG_T), 1024, 32 * nb, 64 * kb, scr, lane); continue; } r -= I5;
          { const int kb = r / 32, nb = r % 32; p0_transpose_item((const float*)a.in[IN_WPLE], 1024, 32 * nb, nullptr, (bf16*)(ws + WS_WPLE_T), 256, 32 * nb, 64 * kb, scr, lane); }
      } }
    __syncthreads();
    { const float* xp = (const float*)a.in[IN_XP]; const float* xs = (const float*)a.in[IN_XS];
      bf16* hbf = (bf16*)(ws + WS_HBF); float* rstd = (float*)(ws + WS_RSTD); float* BR = (float*)(ws + WS_BR);
      const LAS unsigned char* wbr = lds + WBR_OFF;
      for (int rg = gw; rg < MT / 16; rg += NGW) {
          const int m = rg * 16 + (lane & 15), kq = lane >> 4;
          const float* xr = (m < MP) ? xp + (size_t)m * DM : xs + (size_t)(m - MP) * DM;
          f32x4 c0 = {0.f, 0.f, 0.f, 0.f}, c1 = {0.f, 0.f, 0.f, 0.f}; float ssq = 0.f;
#pragma unroll 8
          for (int s = 0; s < 32; ++s) {
              const f32x4 v0 = *(const GAS f32x4*)(xr + 32 * s + 8 * kq), v1 = *(const GAS f32x4*)(xr + 32 * s + 8 * kq + 4);
              ssq += (v0.x * v0.x + v0.y * v0.y) + (v0.z * v0.z + v0.w * v0.w) + (v1.x * v1.x + v1.y * v1.y) + (v1.z * v1.z + v1.w * v1.w);
              v4u pa; pa.x = pk2(v0.x, v0.y); pa.y = pk2(v0.z, v0.w); pa.z = pk2(v1.x, v1.y); pa.w = pk2(v1.z, v1.w);
              *(GAS v4u*)(hbf + (size_t)m * DM + 32 * s + 8 * kq) = pa;
              const bf16x8 af = __builtin_bit_cast(bf16x8, pa);
              const bf16x8 b0 = *(const LAS bf16x8*)(wbr + (lane & 15) * WBR_PITCH + (32 * s + 8 * kq) * 2);
              const bf16x8 b1 = *(const LAS bf16x8*)(wbr + (16 + (lane & 7)) * WBR_PITCH + (32 * s + 8 * kq) * 2);
              c0 = __builtin_amdgcn_mfma_f32_16x16x32_bf16(af, b0, c0, 0, 0, 0);
              c1 = __builtin_amdgcn_mfma_f32_16x16x32_bf16(af, b1, c1, 0, 0, 0);
          }
          ssq += __shfl_xor(ssq, 16); ssq += __shfl_xor(ssq, 32);
          const float rs = 1.f / sqrtf(ssq * (1.f / DM) + EPS);
          if (kq == 0) rstd[m] = rs;
#pragma unroll
          for (int r = 0; r < 4; ++r) { const int R = 4 * kq + r; const float rsR = __shfl(rs, R); const size_t row = (size_t)rg * 16 + R;
              BR[row * 24 + (lane & 15)] = sigmoidf_(c0[r] * rsR);
              if ((lane & 15) < 8) BR[row * 24 + 16 + (lane & 15)] = sigmoidf_(c1[r] * rsR); }
      } }
    { const float* pp = (const float*)a.in[IN_PP]; const float* ps = (const float*)a.in[IN_PS]; bf16* pbf = (bf16*)(ws + WS_PBF);
      for (int base = (vcu * NTHR + tid); base < MT * 32; base += 8 * G * NTHR) { f32x4 v0[8], v1[8];
#pragma unroll
          for (int u = 0; u < 8; ++u) { const int idx = base + u * G * NTHR; if (idx < MT * 32) { const int row = idx >> 5, c8 = (idx & 31) * 8;
              const float* src = (row < MP) ? pp + (size_t)row * 256 + c8 : ps + (size_t)(row - MP) * 256 + c8; v0[u] = *(const GAS f32x4*)src; v1[u] = *(const GAS f32x4*)(src + 4); } }
#pragma unroll
          for (int u = 0; u < 8; ++u) { const int idx = base + u * G * NTHR; if (idx < MT * 32) { const int row = idx >> 5, c8 = (idx & 31) * 8;
              v4u o; o.x = pk2(v0[u].x, v0[u].y); o.y = pk2(v0[u].z, v0[u].w); o.z = pk2(v1[u].x, v1[u].y); o.w = pk2(v1[u].z, v1[u].w);
              *(GAS v4u*)(pbf + (size_t)row * 256 + c8) = o; } } } }
    { const float* sw = (const float*)a.in[IN_SWIN]; float* dst = a.out + OFF_WINS;
      for (int base = (vcu * NTHR + tid); base < 32 * 504 * 64; base += 8 * G * NTHR) { f32x4 v[8];
#pragma unroll
          for (int u = 0; u < 8; ++u) { const int idx = base + u * G * NTHR; if (idx < 32 * 504 * 64) { const int q = idx & 63, i = (idx >> 6) % 504, b = (idx >> 6) / 504; v[u] = *(const GAS f32x4*)(sw + ((size_t)(b * 512 + i + 8) * 256) + q * 4); } }
#pragma unroll
          for (int u = 0; u < 8; ++u) { const int idx = base + u * G * NTHR; if (idx < 32 * 504 * 64) { const int q = idx & 63, i = (idx >> 6) % 504, b = (idx >> 6) / 504; *(GAS f32x4*)(dst + ((size_t)(b * 512 + i) * 256) + q * 4) = v[u]; } } } }
    { float* bias = (float*)(ws + WS_CTL) + CW_BIAS;
      if (rep == 0) for (int job = gw; job < 256; job += NGW) { const int slot = job >> 7, jc = (job >> 4) & 7, kc = job & 15, j = jc * 32 + (lane & 31), k0 = kc * 128 + (lane >> 5) * 64;
          const float* W1 = (const float*)a.in[slot ? IN_W1V : IN_W1K]; const float* pe = (const float*)a.in[slot ? IN_PEV : IN_PEK];
          float acc = 0.f;
#pragma unroll 16
          for (int k = 0; k < 64; ++k) acc += pe[k0 + k] * W1[(size_t)(k0 + k) * 256 + j];
          acc += __shfl_xor(acc, 32);
          if (lane < 32) atomicAdd(bias + slot * 256 + j, acc); } }
}

namespace pg8 {
#ifdef EPI_NT_STORES
#define EPI_ST(ptr, val) __builtin_nontemporal_store((val), (ptr))
#else
#define EPI_ST(ptr, val) (*(ptr) = (val))
#endif
__device__ __forceinline__ void st8_bf16(bf16_t* p, f32x4 a, f32x4 b) { u32x4 w; w.x = cvtpk(a[0], a[1]); w.y = cvtpk(a[2], a[3]); w.z = cvtpk(b[0], b[1]); w.w = cvtpk(b[2], b[3]); EPI_ST((u32x4*)p, w); }
__device__ __forceinline__ void st8_f32(float* p, f32x4 a, f32x4 b) { EPI_ST((f32x4*)p, a); EPI_ST((f32x4*)(p + 4), b); }
__device__ __forceinline__ f32x4 silu4(f32x4 v) { f32x4 r; for (int i = 0; i < 4; ++i) r[i] = siluf_(v[i]); return r; }

struct EpiG1 {
    static constexpr bool PERM = true, AFTER_DRAIN = false;
    float* out; const float* rstd; bf16_t *QA, *KA, *VA, *GA, *QB, *GB, *KSEL, *VSEL, *KWIN, *VWIN, *ACMP; const float *q_g, *ks_g, *kw_g, *pe_k, *pe_v;
    __device__ __forceinline__ void operator()(const f32x4 (&acc)[2][2][4][2], const Unit& u, int wr, int wc, int fr_, int fq_) const {
        int fr = fr_, fq = fq_;
#ifndef G1_NOLAUNDER
        asm volatile("" : "+v"(fr), "+v"(fq));
#endif
#ifdef DBG_G1EPI2
        for (int dupe = 0; dupe < 2; ++dupe) {
#endif
        const int pn = g1_role(u.pn);
        float rsv[2][4];
#pragma unroll
        for (int ai = 0; ai < 2; ++ai)
#pragma unroll
            for (int m = 0; m < 4; ++m) rsv[ai][m] = rstd[u.pm * BM + ai * HALF + wr * 64 + m * 16 + fr];
#pragma unroll
        for (int ai = 0; ai < 2; ++ai)
#pragma unroll
            for (int m = 0; m < 4; ++m) {
#ifndef G1_NOROWCLOBBER
                asm volatile("" ::: "memory");
#endif
                const int row = u.pm * BM + ai * HALF + wr * 64 + m * 16 + fr; const float rs = rsv[ai][m];
#define A0(bj) (acc[ai][bj][m][0])
#define A1(bj) (acc[ai][bj][m][1])
                const int lam0 = 64 * wc + 8 * fq;
                if (pn < 2) {
                    const float sc = rs * 0.125f;
#pragma unroll
                    for (int bj = 0; bj < 2; ++bj) st8_bf16(QA + (size_t)row * 512 + pn * 256 + lam0 + 32 * bj, A0(bj) * sc, A1(bj) * sc);
                } else if (pn < 6) {
                    const int sl = (pn >= 4) ? 1 : 0, col = (pn & 1) * 256 + lam0; bf16_t* B = KA + (size_t)sl * ((WS_VA - WS_KA) / 2);
#pragma unroll
                    for (int bj = 0; bj < 2; ++bj) { const f32x4 x0 = A0(bj) * rs, x1 = A1(bj) * rs; st8_f32(out + OFF_SB + (size_t)row * 1024 + sl * 512 + col + 32 * bj, x0, x1); st8_bf16(B + (size_t)row * 512 + col + 32 * bj, x0, x1); }
                } else if (pn < 8) {
#pragma unroll
                    for (int bj = 0; bj < 2; ++bj) st8_bf16(GA + (size_t)row * 512 + (pn - 6) * 256 + lam0 + 32 * bj, silu4(A0(bj) * rs), silu4(A1(bj) * rs));
                } else if (pn >= 13) {
#pragma unroll
                    for (int bj = 0; bj < 2; ++bj) st8_bf16(GB + (size_t)row * 512 + (pn - 13) * 256 + lam0 + 32 * bj, silu4(A0(bj) * rs), silu4(A1(bj) * rs));
                } else {
                    float ssq = 0.f;
#pragma unroll
                    for (int bj = 0; bj < 2; ++bj) { const f32x4 a0 = A0(bj), a1 = A1(bj); ssq += (a0[0] * a0[0] + a0[1] * a0[1]) + (a0[2] * a0[2] + a0[3] * a0[3]) + (a1[0] * a1[0] + a1[1] * a1[1]) + (a1[2] * a1[2] + a1[3] * a1[3]); }
                    ssq += __shfl_xor(ssq, 16); ssq += __shfl_xor(ssq, 32);
                    const float hr = rs / sqrtf(ssq * rs * rs * (1.f / 64.f) + EPS);
                    if (pn < 10) {
                        const float sc = hr * (0.125f * LOG2E);
#pragma unroll
                        for (int bj = 0; bj < 2; ++bj) { const int d0 = 32 * bj + 8 * fq; const f32x4 g0 = *(const f32x4*)(q_g + d0), g1 = *(const f32x4*)(q_g + d0 + 4);
                            st8_bf16(QB + (size_t)row * 512 + (pn - 8) * 256 + lam0 + 32 * bj, A0(bj) * g0 * sc, A1(bj) * g1 * sc); }
                    } else if (pn == 10) {
                        const int t = row & 2047, b = row >> 11, c = t >> 5, p = t & 31, slot = wc >> 1, g = wc & 1; const float* pe = pe_k + (ptrdiff_t)slot * (pe_v - pe_k);
#pragma unroll
                        for (int bj = 0; bj < 2; ++bj) { const int lam = lam0 + 32 * bj, d0 = 32 * bj + 8 * fq; const f32x4 x0 = A0(bj) * rs, x1 = A1(bj) * rs;
                            st8_f32(out + OFF_NSA + (size_t)row * 512 + lam, x0, x1);
                            if (row < MP) { const f32x4 e0 = *(const f32x4*)(pe + p * 64 + d0), e1 = *(const f32x4*)(pe + p * 64 + d0 + 4);
                                st8_bf16(ACMP + ((size_t)slot * 1024 + (size_t)(b * 64 + c) * 2 + g) * 2048 + p * 64 + d0, x0 + e0, x1 + e1); } }
                    } else if (pn == 11) {
#pragma unroll
                        for (int bj = 0; bj < 2; ++bj) { const int lam = lam0 + 32 * bj, d0 = 32 * bj + 8 * fq; f32x4 x0, x1;
                            if (wc < 2) { const f32x4 g0 = *(const f32x4*)(ks_g + d0), g1 = *(const f32x4*)(ks_g + d0 + 4); x0 = A0(bj) * g0 * hr; x1 = A1(bj) * g1 * hr; } else { x0 = A0(bj) * rs; x1 = A1(bj) * rs; }
                            st8_f32(out + OFF_NSA + (size_t)row * 512 + 256 + lam, x0, x1);
                            st8_bf16(KSEL + (size_t)(wc >> 1) * ((WS_VSEL - WS_KSEL) / 2) + (size_t)row * 128 + (lam & 127), x0, x1); }
                    } else {
                        float* wdst = nullptr;
                        if (row >= MP) { const int si = row - MP; wdst = out + OFF_WINS + ((size_t)((si >> 3) * 512 + 504 + (si & 7))) * 256; }
                        else if ((row & 2047) >= 1536) wdst = out + OFF_WINP + ((size_t)((row >> 11) * 512 + (row & 2047) - 1536)) * 256;
#pragma unroll
                        for (int bj = 0; bj < 2; ++bj) { const int lam = lam0 + 32 * bj, d0 = 32 * bj + 8 * fq; f32x4 x0, x1;
                            if (wc < 2) { const f32x4 g0 = *(const f32x4*)(kw_g + d0), g1 = *(const f32x4*)(kw_g + d0 + 4); x0 = A0(bj) * g0 * hr; x1 = A1(bj) * g1 * hr; } else { x0 = A0(bj) * rs; x1 = A1(bj) * rs; }
                            if (wdst) st8_f32(wdst + lam, x0, x1);
                            st8_bf16(KWIN + (size_t)(wc >> 1) * ((WS_VWIN - WS_KWIN) / 2) + (size_t)row * 128 + (lam & 127), x0, x1); }
                    }
                }
#undef A0
#undef A1
            }
#ifdef DBG_G1EPI2
        }
#endif
    }
};
struct EpiNone { static constexpr bool PERM = true, AFTER_DRAIN = false;
    __device__ __forceinline__ void operator()(const f32x4 (&acc)[2][2][4][2], const Unit& u, int wr, int wc, int fr, int fq) const { if (acc[0][0][0][0][0] == 123456.789f) __builtin_trap(); } };
struct EpiHid {
    static constexpr bool PERM = true, AFTER_DRAIN = false;
    bf16_t* O;
    __device__ __forceinline__ void operator()(const f32x4 (&acc)[2][2][4][2], const Unit& u, int wr, int wc, int fr_, int fq_) const {
        int fr = fr_, fq = fq_; asm volatile("" : "+v"(fr), "+v"(fq));
#pragma unroll
        for (int ai = 0; ai < 2; ++ai)
#pragma unroll
            for (int m = 0; m < 4; ++m) { const int row = u.pm * BM + ai * HALF + wr * 64 + m * 16 + fr;
#pragma unroll
                for (int bj = 0; bj < 2; ++bj) st8_bf16(O + (size_t)row * 256 + bj * HALF + wc * 32 + 8 * fq, silu4(acc[ai][bj][m][0]), silu4(acc[ai][bj][m][1])); }
    }
};
struct EpiOut {
    static constexpr bool PERM = true, AFTER_DRAIN = false;
    const bf16_t* XB; bf16_t* HB;
    __device__ __forceinline__ void operator()(const f32x4 (&acc)[2][2][4][2], const Unit& u, int wr, int wc, int fr_, int fq_) const {
        int fr = fr_, fq = fq_; asm volatile("" : "+v"(fr), "+v"(fq));
#pragma unroll
        for (int ai = 0; ai < 2; ++ai) {
            u32x4 xv[4][2];
#pragma unroll
            for (int m = 0; m < 4; ++m) { const int row = u.pm * BM + ai * HALF + wr * 64 + m * 16 + fr;
#pragma unroll
                for (int bj = 0; bj < 2; ++bj) { const int col = u.pn * BM + bj * HALF + wc * 32 + 8 * fq; xv[m][bj] = *(const u32x4*)(XB + (size_t)row * DM + col); } }
#pragma unroll
            for (int m = 0; m < 4; ++m) { const int row = u.pm * BM + ai * HALF + wr * 64 + m * 16 + fr;
#pragma unroll
                for (int bj = 0; bj < 2; ++bj) { const int col = u.pn * BM + bj * HALF + wc * 32 + 8 * fq; const u32x4 x = xv[m][bj];
                    const f32x4 x0 = {bf_lo(x.x), bf_hi(x.x), bf_lo(x.y), bf_hi(x.y)}, x1 = {bf_lo(x.z), bf_hi(x.z), bf_lo(x.w), bf_hi(x.w)};
                    st8_bf16(HB + (size_t)row * DM + col, x0 + acc[ai][bj][m][0], x1 + acc[ai][bj][m][1]); } }
        }
    }
};
struct EpiFinal {
    static constexpr bool PERM = true, AFTER_DRAIN = false;
    float* Y; const bf16_t* T1; const bf16_t* HB;
    __device__ __forceinline__ void operator()(const f32x4 (&acc)[2][2][4][2], const Unit& u, int wr, int wc, int fr_, int fq_) const {
        int fr = fr_, fq = fq_; asm volatile("" : "+v"(fr), "+v"(fq));
#pragma unroll
        for (int ai = 0; ai < 2; ++ai) {
            u32x4 tv[4][2], hv[4][2];
#pragma unroll
            for (int m = 0; m < 4; ++m) { const int row = u.pm * BM + ai * HALF + wr * 64 + m * 16 + fr;
#pragma unroll
                for (int bj = 0; bj < 2; ++bj) { const int col = u.pn * BM + bj * HALF + wc * 32 + 8 * fq; tv[m][bj] = *(const u32x4*)(T1 + (size_t)row * DM + col); hv[m][bj] = *(const u32x4*)(HB + (size_t)row * DM + col); } }
#pragma unroll
            for (int m = 0; m < 4; ++m) { const int row = u.pm * BM + ai * HALF + wr * 64 + m * 16 + fr;
#pragma unroll
                for (int bj = 0; bj < 2; ++bj) { const int col = u.pn * BM + bj * HALF + wc * 32 + 8 * fq; float* yp = Y + (size_t)row * DM + col;
                    const u32x4 t = tv[m][bj], hb = hv[m][bj]; const f32x4 a0 = acc[ai][bj][m][0], a1 = acc[ai][bj][m][1];
                    f32x4 y0, y1;
                    y0[0] = bf_lo(hb.x) + sigmoidf_(a0[0]) * bf_lo(t.x); y0[1] = bf_hi(hb.x) + sigmoidf_(a0[1]) * bf_hi(t.x); y0[2] = bf_lo(hb.y) + sigmoidf_(a0[2]) * bf_lo(t.y); y0[3] = bf_hi(hb.y) + sigmoidf_(a0[3]) * bf_hi(t.y);
                    y1[0] = bf_lo(hb.z) + sigmoidf_(a1[0]) * bf_lo(t.z); y1[1] = bf_hi(hb.z) + sigmoidf_(a1[1]) * bf_hi(t.z); y1[2] = bf_lo(hb.w) + sigmoidf_(a1[2]) * bf_lo(t.w); y1[3] = bf_hi(hb.w) + sigmoidf_(a1[3]) * bf_hi(t.w);
#ifdef Y_NT_STORES
                    __builtin_nontemporal_store(y0, (f32x4*)yp); __builtin_nontemporal_store(y1, (f32x4*)(yp + 4));
#else
                    st8_f32(yp, y0, y1);
#endif
                    } }
        }
    }
};
struct DiagOrder {
    int n, per, G, c;
    __device__ __forceinline__ bool next(int i, Unit& u) const { const int L = i * G + c; if (L >= n) return false; u.pm = L; u.pn = L / per; return true; }
    __device__ __forceinline__ void a_ready(const Unit&) const {}
    __device__ __forceinline__ void done(const Unit&) const {}
};
struct EpiHidB {
    bf16_t* O; const float* bias;
    __device__ __forceinline__ void operator()(const f32x4 (&acc)[2][2][4][2], int pm, int wr, int wc, int fr_, int fq_) const {
        int fr = fr_, fq = fq_; asm volatile("" : "+v"(fr), "+v"(fq));
#pragma unroll
        for (int bj = 0; bj < 2; ++bj) { const int col = bj * HALF + wc * 32 + 8 * fq; const f32x4 b0 = *(const f32x4*)(bias + col), b1 = *(const f32x4*)(bias + col + 4);
#pragma unroll
            for (int ai = 0; ai < 2; ++ai)
#pragma unroll
                for (int m = 0; m < 4; ++m) { const int row = pm * BM + ai * HALF + wr * 64 + m * 16 + fr;
                    st8_bf16(O + (size_t)row * 256 + col, silu4(acc[ai][bj][m][0] + b0), silu4(acc[ai][bj][m][1] + b1)); } }
    }
};
__device__ __forceinline__ void gemm_unit_gather(PG8_LAS unsigned char* lds, const float* cn, const int* pt, const bf16_t* W1T  , int L  , const EpiHidB& E) {
    int tid_ = threadIdx.x; asm volatile("" : "+v"(tid_));
    const int tid = tid_, wid = __builtin_amdgcn_readfirstlane(tid >> 6), lane = tid & 63, wr = wid >> 2, wc = wid & 3, fr = lane & 15, fq = lane >> 4;
    const int slot = L >> 6, pmu = L & 63;
    const float* abase[4]; const bf16_t* bbase[4]; int aofs[4], bofs[4];
#pragma unroll
    for (int j = 0; j < 4; ++j) { const int q = tid + 512 * j, row = q >> 3, c8 = q & 7, R = pmu * 256 + row, b = R >> 9, c = (R >> 1) & 255, g = R & 1, pos0 = c * 32;
        abase[j] = cn + ((size_t)pt[b * 64 + (pos0 >> 7)] * 128 + (pos0 & 127)) * 512 + slot * 128 + g * 64 + c8 * 8;
        aofs[j] = (row >> 7) * HTB + lds_byte(row & 127, c8 * 8);
        const int nsrc = (row & ~31) + perm32(row & 31);
        bbase[j] = W1T + (size_t)(slot * 256 + nsrc) * 2048 + c8 * 8;
        bofs[j] = (4 + (row >> 7)) * HTB + lds_byte(row & 127, c8 * 8); }
    const int aoff = lds_byte(wr * 64 + fr, fq * 8), boff = lds_byte(wc * 32 + fr, fq * 8);
    f32x4 acc[2][2][4][2];
#pragma unroll
    for (int a = 0; a < 2; ++a)
#pragma unroll
        for (int b = 0; b < 2; ++b)
#pragma unroll
            for (int m = 0; m < 4; ++m)
#pragma unroll
                for (int n = 0; n < 2; ++n) acc[a][b][m][n] = (f32x4){0.f, 0.f, 0.f, 0.f};
    f32x4 ar[4][2]; u32x4 br[4];
#define GU_LOAD(kt) do { _Pragma("unroll") for (int j = 0; j < 4; ++j) { ar[j][0] = *(const f32x4*)(abase[j] + (size_t)(kt) * 512); ar[j][1] = *(const f32x4*)(abase[j] + (size_t)(kt) * 512 + 4); br[j] = *(const u32x4*)(bbase[j] + (kt) * 64); } } while (0)
#define GU_STORE(stg) do { _Pragma("unroll") for (int j = 0; j < 4; ++j) { u32x4 w; w.x = cvtpk(ar[j][0][0], ar[j][0][1]); w.y = cvtpk(ar[j][0][2], ar[j][0][3]); w.z = cvtpk(ar[j][1][0], ar[j][1][1]); w.w = cvtpk(ar[j][1][2], ar[j][1][3]); \
        *(PG8_LAS u32x4*)(lds + (stg) * 2 * HTB + aofs[j]) = w; *(PG8_LAS u32x4*)(lds + (stg) * 2 * HTB + bofs[j]) = br[j]; } } while (0)
    GU_LOAD(0); GU_STORE(0); GU_LOAD(1);
    for (int kt = 0; kt < 32; ++kt) {
        const int stg = kt & 1;
        __syncthreads();
        if (kt + 1 < 32) GU_STORE(stg ^ 1);
        if (kt + 2 < 32) GU_LOAD(kt + 2);
        bf16x8 At[4][2], Bf[2][2];
#pragma unroll
        for (int ai = 0; ai < 2; ++ai) {
#pragma unroll
            for (int m = 0; m < 4; ++m)
#pragma unroll
                for (int k = 0; k < 2; ++k) At[m][k] = *(const PG8_LAS bf16x8*)(lds + (stg * 2 + ai) * HTB + aoff + m * 2048 + k * 1024);
#pragma unroll
            for (int bj = 0; bj < 2; ++bj) {
#pragma unroll
                for (int n = 0; n < 2; ++n)
#pragma unroll
                    for (int k = 0; k < 2; ++k) Bf[n][k] = *(const PG8_LAS bf16x8*)(lds + (4 + stg * 2 + bj) * HTB + boff + n * 2048 + k * 1024);
#pragma unroll
                for (int m = 0; m < 4; ++m)
#pragma unroll
                    for (int n = 0; n < 2; ++n)
#pragma unroll
                        for (int k = 0; k < 2; ++k) acc[ai][bj][m][n] = __builtin_amdgcn_mfma_f32_16x16x32_bf16(Bf[n][k], At[m][k], acc[ai][bj][m][n], 0, 0, 0);
            } }
    }
#undef GU_LOAD
#undef GU_STORE
    E(acc, L, wr, wc, fr, fq);
    __syncthreads();
}
struct EpiHidB128 {
    bf16_t* O; const float* bias;
    __device__ __forceinline__ void operator()(const f32x4 (&acc)[2][4][2], int row0, int wr, int wc, int fr_, int fq_) const {
        int fr = fr_, fq = fq_; asm volatile("" : "+v"(fr), "+v"(fq));
#pragma unroll
        for (int bj = 0; bj < 2; ++bj) { const int col = bj * HALF + wc * 32 + 8 * fq; const f32x4 b0 = *(const f32x4*)(bias + col), b1 = *(const f32x4*)(bias + col + 4);
#pragma unroll
            for (int m = 0; m < 4; ++m) { const int row = row0 + wr * 64 + m * 16 + fr;
                st8_bf16(O + (size_t)row * 256 + col, silu4(acc[bj][m][0] + b0), silu4(acc[bj][m][1] + b1)); } }
    }
};
__device__ __forceinline__ void gemm_unit_gather128(PG8_LAS unsigned char* lds, const float* cn, const int* pt, const bf16_t* W1T  , int L  , const EpiHidB128& E) {
    int tid_ = threadIdx.x; asm volatile("" : "+v"(tid_));
    const int tid = tid_, wid = __builtin_amdgcn_readfirstlane(tid >> 6), lane = tid & 63, wr = wid >> 2, wc = wid & 3, fr = lane & 15, fq = lane >> 4;
    const int slot = L >> 7, pmu = L & 127;
    const float* abase[2]; const bf16_t* bbase[4]; int aofs[2], bofs[4];
#pragma unroll
    for (int j = 0; j < 2; ++j) { const int q = tid + 512 * j, row = q >> 3, c8 = q & 7, R = pmu * 128 + row, b = R >> 9, c = (R >> 1) & 255, g = R & 1, pos0 = c * 32;
        abase[j] = cn + ((size_t)pt[b * 64 + (pos0 >> 7)] * 128 + (pos0 & 127)) * 512 + slot * 128 + g * 64 + c8 * 8;
        aofs[j] = lds_byte(row, c8 * 8); }
#pragma unroll
    for (int j = 0; j < 4; ++j) { const int q = tid + 512 * j, n = q >> 3, c8 = q & 7, nsrc = (n & ~31) + perm32(n & 31);
        bbase[j] = W1T + (size_t)(slot * 256 + nsrc) * 2048 + c8 * 8;
        bofs[j] = (1 + (n >> 7)) * HTB + lds_byte(n & 127, c8 * 8); }
    const int aoff = lds_byte(wr * 64 + fr, fq * 8), boff = lds_byte(wc * 32 + fr, fq * 8);
    f32x4 acc[2][4][2];
#pragma unroll
    for (int b = 0; b < 2; ++b)
#pragma unroll
        for (int m = 0; m < 4; ++m)
#pragma unroll
            for (int n = 0; n < 2; ++n) acc[b][m][n] = (f32x4){0.f, 0.f, 0.f, 0.f};
    f32x4 ra0[2][2], ra1[2][2], ra2[2][2], ra3[2][2]; u32x4 br[4];
#define GU_LDA(ra, kt) do { _Pragma("unroll") for (int j = 0; j < 2; ++j) { ra[j][0] = *(const f32x4*)(abase[j] + (size_t)(kt) * 512); ra[j][1] = *(const f32x4*)(abase[j] + (size_t)(kt) * 512 + 4); } } while (0)
#define GU_LDB(kt) do { _Pragma("unroll") for (int j = 0; j < 4; ++j) br[j] = *(const u32x4*)(bbase[j] + (kt) * 64); } while (0)
#define GU_ST(stg, ra) do { _Pragma("unroll") for (int j = 0; j < 2; ++j) { u32x4 w; w.x = cvtpk(ra[j][0][0], ra[j][0][1]); w.y = cvtpk(ra[j][0][2], ra[j][0][3]); w.z = cvtpk(ra[j][1][0], ra[j][1][1]); w.w = cvtpk(ra[j][1][2], ra[j][1][3]); \
        *(PG8_LAS u32x4*)(lds + (stg) * 3 * HTB + aofs[j]) = w; } _Pragma("unroll") for (int j = 0; j < 4; ++j) *(PG8_LAS u32x4*)(lds + (stg) * 3 * HTB + bofs[j]) = br[j]; } while (0)
#define GU_MMA(stg) do { bf16x8 At[4][2], Bf[2][2]; \
        _Pragma("unroll") for (int m = 0; m < 4; ++m) _Pragma("unroll") for (int k = 0; k < 2; ++k) At[m][k] = *(const PG8_LAS bf16x8*)(lds + (stg) * 3 * HTB + aoff + m * 2048 + k * 1024); \
        _Pragma("unroll") for (int bj = 0; bj < 2; ++bj) { \
            _Pragma("unroll") for (int n = 0; n < 2; ++n) _Pragma("unroll") for (int k = 0; k < 2; ++k) Bf[n][k] = *(const PG8_LAS bf16x8*)(lds + ((stg) * 3 + 1 + bj) * HTB + boff + n * 2048 + k * 1024); \
            _Pragma("unroll") for (int m = 0; m < 4; ++m) _Pragma("unroll") for (int n = 0; n < 2; ++n) _Pragma("unroll") for (int k = 0; k < 2; ++k) \
                acc[bj][m][n] = __builtin_amdgcn_mfma_f32_16x16x32_bf16(Bf[n][k], At[m][k], acc[bj][m][n], 0, 0, 0); } } while (0)
#define GU_STEP(kt, stg, raN) do { __syncthreads(); if ((kt) + 1 < 32) GU_ST((stg) ^ 1, raN); if ((kt) + 5 < 32) GU_LDA(raN, (kt) + 5); GU_LDB((kt) + 2 < 32 ? (kt) + 2 : 31); GU_MMA(stg); } while (0)
    GU_LDA(ra0, 0); GU_LDB(0); GU_ST(0, ra0); GU_LDA(ra1, 1); GU_LDA(ra2, 2); GU_LDA(ra3, 3); GU_LDA(ra0, 4); GU_LDB(1);
    for (int kt = 0; kt < 32; kt += 4) { GU_STEP(kt, 0, ra1); GU_STEP(kt + 1, 1, ra2); GU_STEP(kt + 2, 0, ra3); GU_STEP(kt + 3, 1, ra0); }
#undef GU_LDA
#undef GU_LDB
#undef GU_ST
#undef GU_MMA
#undef GU_STEP
    E(acc, L * 128, wr, wc, fr, fq);
    __syncthreads();
}
__device__ __forceinline__ void gemm_unit_bf16_128(PG8_LAS unsigned char* lds, const bf16_t* A  , const bf16_t* W1T  , int slot, int row0, const EpiHidB128& E) {
    int tid_ = threadIdx.x; asm volatile("" : "+v"(tid_));
    const int tid = tid_, wid = __builtin_amdgcn_readfirstlane(tid >> 6), lane = tid & 63, wr = wid >> 2, wc = wid & 3, fr = lane & 15, fq = lane >> 4;
    const bf16_t* abase[2]; const bf16_t* bbase[4]; int aofs[2], bofs[4];
#pragma unroll
    for (int j = 0; j < 2; ++j) { const int q = tid + 512 * j, row = q >> 3, c8 = q & 7; abase[j] = A + (size_t)row * 2048 + c8 * 8; aofs[j] = lds_byte(row, c8 * 8); }
#pragma unroll
    for (int j = 0; j < 4; ++j) { const int q = tid + 512 * j, n = q >> 3, c8 = q & 7, nsrc = (n & ~31) + perm32(n & 31);
        bbase[j] = W1T + (size_t)(slot * 256 + nsrc) * 2048 + c8 * 8;
        bofs[j] = (1 + (n >> 7)) * HTB + lds_byte(n & 127, c8 * 8); }
    const int aoff = lds_byte(wr * 64 + fr, fq * 8), boff = lds_byte(wc * 32 + fr, fq * 8);
    f32x4 acc[2][4][2];
#pragma unroll
    for (int b = 0; b < 2; ++b)
#pragma unroll
        for (int m = 0; m < 4; ++m)
#pragma unroll
            for (int n = 0; n < 2; ++n) acc[b][m][n] = (f32x4){0.f, 0.f, 0.f, 0.f};
    u32x4 ra0[2], ra1[2], ra2[2], ra3[2], br[4];
#define GB_LDA(ra, kt) do { _Pragma("unroll") for (int j = 0; j < 2; ++j) ra[j] = *(const u32x4*)(abase[j] + (kt) * 64); } while (0)
#define GB_LDB(kt) do { _Pragma("unroll") for (int j = 0; j < 4; ++j) br[j] = *(const u32x4*)(bbase[j] + (kt) * 64); } while (0)
#define GB_ST(stg, ra) do { _Pragma("unroll") for (int j = 0; j < 2; ++j) *(PG8_LAS u32x4*)(lds + (stg) * 3 * HTB + aofs[j]) = ra[j]; \
        _Pragma("unroll") for (int j = 0; j < 4; ++j) *(PG8_LAS u32x4*)(lds + (stg) * 3 * HTB + bofs[j]) = br[j]; } while (0)
#define GB_MMA(stg) do { bf16x8 At[4][2], Bf[2][2]; \
        _Pragma("unroll") for (int m = 0; m < 4; ++m) _Pragma("unroll") for (int k = 0; k < 2; ++k) At[m][k] = *(const PG8_LAS bf16x8*)(lds + (stg) * 3 * HTB + aoff + m * 2048 + k * 1024); \
        _Pragma("unroll") for (int bj = 0; bj < 2; ++bj) { \
            _Pragma("unroll") for (int n = 0; n < 2; ++n) _Pragma("unroll") for (int k = 0; k < 2; ++k) Bf[n][k] = *(const PG8_LAS bf16x8*)(lds + ((stg) * 3 + 1 + bj) * HTB + boff + n * 2048 + k * 1024); \
            _Pragma("unroll") for (int m = 0; m < 4; ++m) _Pragma("unroll") for (int n = 0; n < 2; ++n) _Pragma("unroll") for (int k = 0; k < 2; ++k) \
                acc[bj][m][n] = __builtin_amdgcn_mfma_f32_16x16x32_bf16(Bf[n][k], At[m][k], acc[bj][m][n], 0, 0, 0); } } while (0)
#define GB_STEP(kt, stg, raN) do { __syncthreads(); if ((kt) + 1 < 32) GB_ST((stg) ^ 1, raN); if ((kt) + 5 < 32) GB_LDA(raN, (kt) + 5); GB_LDB((kt) + 2 < 32 ? (kt) + 2 : 31); GB_MMA(stg); } while (0)
    GB_LDA(ra0, 0); GB_LDB(0); GB_ST(0, ra0); GB_LDA(ra1, 1); GB_LDA(ra2, 2); GB_LDA(ra3, 3); GB_LDA(ra0, 4); GB_LDB(1);
    for (int kt = 0; kt < 32; kt += 4) { GB_STEP(kt, 0, ra1); GB_STEP(kt + 1, 1, ra2); GB_STEP(kt + 2, 0, ra3); GB_STEP(kt + 3, 1, ra0); }
#undef GB_LDA
#undef GB_LDB
#undef GB_ST
#undef GB_MMA
#undef GB_STEP
    E(acc, row0, wr, wc, fr, fq);
    __syncthreads();
}
struct XcdQueueOrder {
    unsigned* q; volatile PG8_LAS int* slot; int nM, nN, nwg, x;
    __device__ __forceinline__ void init(int M, int N, unsigned* q_, volatile PG8_LAS int* slot_, int xcc) { nM = M / BM; nN = N / BM; nwg = nM * nN; q = q_; slot = slot_; x = xcc & 7; }
    __device__ __forceinline__ bool next(int i, Unit& u) const {
        if (threadIdx.x == 0) { int res = -1; const int qq = nwg / NXCD, rr = nwg % NXCD;
#pragma unroll 1
            for (int k = 0; k < NXCD; ++k) { const int xx = (x + k) & 7, sz = qq + (xx < rr ? 1 : 0), st = xx < rr ? xx * (qq + 1) : rr * (qq + 1) + (xx - rr) * qq;
                if ((int)__hip_atomic_load(q + 64 * xx, __ATOMIC_RELAXED, __HIP_MEMORY_SCOPE_AGENT) >= sz) continue;
                const int t = (int)__hip_atomic_fetch_add(q + 64 * xx, 1u, __ATOMIC_RELAXED, __HIP_MEMORY_SCOPE_AGENT);
                if (t < sz) { res = st + t; break; } }
            slot[i & 1] = res; }
        asm volatile("s_waitcnt lgkmcnt(0)" ::: "memory"); __builtin_amdgcn_s_barrier(); asm volatile("" ::: "memory");
        const int wgid = slot[i & 1]; if (wgid < 0) return false;
        const int nig = WGM * nN, gid = wgid / nig, fm = gid * WGM, gsz = (nM - fm) < WGM ? (nM - fm) : WGM;
        u.pm = fm + ((wgid % nig) % gsz); u.pn = (wgid % nig) / gsz; return true;
    }
    __device__ __forceinline__ void a_ready(const Unit&) const {}
    __device__ __forceinline__ void done(const Unit&) const {}
};
struct HybridOrder {
    unsigned* q; volatile PG8_LAS int* slot; int nM, nN, nwg, ns, l0, lstride, dyn0;
    __device__ __forceinline__ bool decode(int L, Unit& u) const {
        int wgid = L; { const int qq = nwg / NXCD, r = nwg % NXCD, xcd = wgid % NXCD, off = wgid / NXCD; wgid = (xcd < r ? xcd * (qq + 1) : r * (qq + 1) + (xcd - r) * qq) + off; }
        const int nig = WGM * nN, gid = wgid / nig, fm = gid * WGM, gsz = (nM - fm) < WGM ? (nM - fm) : WGM;
        u.pm = fm + ((wgid % nig) % gsz); u.pn = (wgid % nig) / gsz; return true;
    }
    __device__ __forceinline__ bool next(int i, Unit& u) const {
        if (i < ns) return decode(l0 + i * lstride, u);
        if (threadIdx.x == 0) { int res = -1;
            if ((int)__hip_atomic_load(q, __ATOMIC_RELAXED, __HIP_MEMORY_SCOPE_AGENT) < nwg - dyn0) { const int t = (int)__hip_atomic_fetch_add(q, 1u, __ATOMIC_RELAXED, __HIP_MEMORY_SCOPE_AGENT); if (t < nwg - dyn0) res = dyn0 + t; }
            slot[i & 1] = res; }
        asm volatile("s_waitcnt lgkmcnt(0)" ::: "memory"); __builtin_amdgcn_s_barrier(); asm volatile("" ::: "memory");
        const int L = slot[i & 1]; if (L < 0) return false; return decode(L, u);
    }
    __device__ __forceinline__ void a_ready(const Unit&) const {}
    __device__ __forceinline__ void done(const Unit&) const {}
};
struct DiagQueueOrder {
    unsigned* q; volatile PG8_LAS int* slot; int n, per;
    __device__ __forceinline__ bool next(int i, Unit& u) const {
        if (threadIdx.x == 0) { int res = -1;
            if ((int)__hip_atomic_load(q, __ATOMIC_RELAXED, __HIP_MEMORY_SCOPE_AGENT) < n) { const int t = (int)__hip_atomic_fetch_add(q, 1u, __ATOMIC_RELAXED, __HIP_MEMORY_SCOPE_AGENT); if (t < n) res = t; }
            slot[i & 1] = res; }
        asm volatile("s_waitcnt lgkmcnt(0)" ::: "memory"); __builtin_amdgcn_s_barrier(); asm volatile("" ::: "memory");
        const int L = slot[i & 1]; if (L < 0) return false; u.pm = L; u.pn = L / per; return true;
    }
    __device__ __forceinline__ void a_ready(const Unit&) const {}
    __device__ __forceinline__ void done(const Unit&) const {}
};
struct OneUnit {
    int pm, pn;
    __device__ __forceinline__ bool next(int i, Unit& u) const { if (i > 0) return false; u.pm = pm; u.pn = pn; return true; }
    __device__ __forceinline__ void a_ready(const Unit&) const {}
    __device__ __forceinline__ void done(const Unit&) const {}
};
}

#ifndef DBG_DUP
#define DBG_DUP 0
#endif

#define MFMA32(a, b, c) __builtin_amdgcn_mfma_f32_32x32x16_bf16((a), (b), (c), 0, 0, 0)
constexpr int KP = 144, VP = 192;
constexpr int KT_BYTES = 64 * KP, VT_BYTES = 64 * VP;
typedef short v4i16_t __attribute__((ext_vector_type(4)));
__device__ __forceinline__ int kidx_of(int kh, int v, int h) { return 32 * kh + (v & 3) + 8 * (v >> 2) + 4 * h; }
__device__ __forceinline__ s16x4 vtr(const LAS unsigned char* p) { return __builtin_bit_cast(s16x4, __builtin_amdgcn_ds_read_tr16_b64_v4i16((LAS v4i16_t*)p)); }

__device__ __forceinline__ void qk64(f32x16 (&s)[2], const LAS unsigned char* Ks, const bf16x8 (&qf)[4], int lane) {
    const LAS unsigned char* kb = Ks + (lane & 31) * KP + (lane >> 5) * 16;
#pragma unroll
    for (int kh = 0; kh < 2; ++kh) { f32x16 acc; for (int i = 0; i < 16; ++i) acc[i] = 0.f;
#pragma unroll
        for (int ks = 0; ks < 4; ++ks) { const bf16x8 kf = *(const LAS bf16x8*)(kb + kh * 32 * KP + ks * 32); __builtin_amdgcn_s_setprio(1); acc = MFMA32(kf, qf[ks], acc); __builtin_amdgcn_s_setprio(0); }
        s[kh] = acc; }
}
__device__ __forceinline__ void qk64_g(f32x16 (&s)[2], const bf16* Kg, int kpitch, const bf16x8 (&qf)[4], int lane) {
    const bf16* kb = Kg + (size_t)(lane & 31) * kpitch + (lane >> 5) * 8;
    bf16x8 kf[2][4];
#pragma unroll
    for (int kh = 0; kh < 2; ++kh)
#pragma unroll
        for (int ks = 0; ks < 4; ++ks) kf[kh][ks] = *(const GAS bf16x8*)(kb + (size_t)kh * 32 * kpitch + ks * 16);
#pragma unroll
    for (int kh = 0; kh < 2; ++kh) { f32x16 acc; for (int i = 0; i < 16; ++i) acc[i] = 0.f;
        __builtin_amdgcn_s_setprio(1);
#pragma unroll
        for (int ks = 0; ks < 4; ++ks) acc = MFMA32(kf[kh][ks], qf[ks], acc);
        __builtin_amdgcn_s_setprio(0);
        s[kh] = acc; }
}
__device__ __forceinline__ void pv64(f32x16 (&o)[2], const LAS unsigned char* Vs, const f32x16 (&e)[2], int lane) {
    const int G = lane >> 4, i = lane & 15, q = i >> 2, p = i & 3, h = G >> 1;
    const LAS unsigned char* vb = Vs + (4 * h + q) * VP + (16 * (G & 1) + 4 * p) * 2;
#pragma unroll
    for (int kh = 0; kh < 2; ++kh)
#pragma unroll
        for (int s = 0; s < 2; ++s) {
            v4u pw; pw.x = cvtpk(e[kh][8 * s + 0], e[kh][8 * s + 1]); pw.y = cvtpk(e[kh][8 * s + 2], e[kh][8 * s + 3]); pw.z = cvtpk(e[kh][8 * s + 4], e[kh][8 * s + 5]); pw.w = cvtpk(e[kh][8 * s + 6], e[kh][8 * s + 7]);
            const bf16x8 pf = __builtin_bit_cast(bf16x8, pw);
#pragma unroll
            for (int dh = 0; dh < 2; ++dh) {
                const s16x4 lo = vtr(vb + (32 * kh + 16 * s) * VP + 64 * dh), hi = vtr(vb + (32 * kh + 16 * s + 8) * VP + 64 * dh);
                const bf16x8 vf = {lo[0], lo[1], lo[2], lo[3], hi[0], hi[1], hi[2], hi[3]};
                __builtin_amdgcn_s_setprio(1); o[dh] = MFMA32(vf, pf, o[dh]); __builtin_amdgcn_s_setprio(0);
            }
        }
}
__device__ __forceinline__ bf16x8 pack8(f32x4 a, f32x4 b) { v4u w; w.x = cvtpk(a[0], a[1]); w.y = cvtpk(a[2], a[3]); w.z = cvtpk(b[0], b[1]); w.w = cvtpk(b[2], b[3]); return __builtin_bit_cast(bf16x8, w); }
__device__ __forceinline__ float xhalf(float v, int h) {
    const unsigned u = __builtin_bit_cast(unsigned, v);
    auto r = __builtin_amdgcn_permlane32_swap(u, u, false, false);
    return __builtin_bit_cast(float, h ? r[0] : r[1]);
}
__device__ __forceinline__ float xmax_half(float v) {
    const unsigned u = __builtin_bit_cast(unsigned, v); auto r = __builtin_amdgcn_permlane32_swap(u, u, false, false);
    return fmaxf(__builtin_bit_cast(float, r[0]), __builtin_bit_cast(float, r[1]));
}
__device__ __forceinline__ void load_qf(bf16x8 (&qf)[4], const bf16* qrow, int lane) {
#pragma unroll
    for (int ks = 0; ks < 4; ++ks) qf[ks] = *(const GAS bf16x8*)(qrow + 16 * ks + 8 * (lane >> 5));
}
__device__ __forceinline__ v4u tile_ld(const bf16* g, int rpitch, int tid) { return *(const GAS v4u*)(g + (size_t)(tid >> 3) * rpitch + (tid & 7) * 8); }
__device__ __forceinline__ void tile_st(LAS unsigned char* t, int P, int tid, v4u v) { *(LAS v4u*)(t + (tid >> 3) * P + (tid & 7) * 16) = v; }

template <class F> __device__ __forceinline__ void softmax_tile(f32x16 (&s)[2], float& m, float& l, f32x16 (&o)[2], int h, F&& biasf) {
    float mx = -1e30f;
#pragma unroll
    for (int kh = 0; kh < 2; ++kh)
#pragma unroll
        for (int v = 0; v < 16; ++v) { const float x = s[kh][v] + biasf(kidx_of(kh, v, h)); s[kh][v] = x; mx = fmaxf(mx, x); }
    mx = xmax_half(mx);
    const float mn = fmaxf(m, mx), al = fexp2(m - mn); m = mn;
    float sum = 0.f;
#pragma unroll
    for (int kh = 0; kh < 2; ++kh)
#pragma unroll
        for (int v = 0; v < 16; ++v) { const float e = fexp2(s[kh][v] - mn); s[kh][v] = e; sum += e; }
    l = l * al + sum;
#pragma unroll
    for (int dh = 0; dh < 2; ++dh)
#pragma unroll
        for (int v = 0; v < 16; ++v) o[dh][v] *= al;
}
__device__ __forceinline__ void alibi_cinit(f32x16 (&c)[2], float slope2) {
#pragma unroll
    for (int kh = 0; kh < 2; ++kh)
#pragma unroll
        for (int v = 0; v < 16; ++v) c[kh][v] = slope2 * (float)(32 * kh + (v & 3) + 8 * (v >> 2));
}
__device__ __forceinline__ void qk64c(f32x16 (&s)[2], const LAS unsigned char* Ks, const bf16x8 (&qf)[4], const f32x16 (&cinit)[2], int lane) {
    const LAS unsigned char* kb = Ks + (lane & 31) * KP + (lane >> 5) * 16;
    bf16x8 kf[2][4];
#pragma unroll
    for (int ks = 0; ks < 4; ++ks)
#pragma unroll
        for (int kh = 0; kh < 2; ++kh) kf[kh][ks] = *(const LAS bf16x8*)(kb + kh * 32 * KP + ks * 32);
    __builtin_amdgcn_s_setprio(1);
    f32x16 a0 = MFMA32(kf[0][0], qf[0], cinit[0]), a1 = MFMA32(kf[1][0], qf[0], cinit[1]);
#pragma unroll
    for (int ks = 1; ks < 4; ++ks) { a0 = MFMA32(kf[0][ks], qf[ks], a0); a1 = MFMA32(kf[1][ks], qf[ks], a1); }
    __builtin_amdgcn_s_setprio(0);
    s[0] = a0; s[1] = a1;
}
template <bool MASKED> __device__ __forceinline__ void sm2_tile(f32x16 (&s)[2], float& m, float& l, f32x16 (&o)[2], float off, bool part, int lo, int hi) {
    float mxp = -INFINITY;
#pragma unroll
    for (int kh = 0; kh < 2; ++kh)
#pragma unroll
        for (int v = 0; v < 16; ++v) { const int Kc = 32 * kh + (v & 3) + 8 * (v >> 2); float xp = s[kh][v];
            if (MASKED) { xp = (Kc > lo && Kc <= hi) ? xp : -INFINITY; s[kh][v] = xp; }
            mxp = fmaxf(mxp, xp); }
    float mx = mxp + off; mx = xmax_half(mx);
    const float mn = part ? fmaxf(m, mx) : m, al = fexp2(m - mn); m = mn; l *= al;
#pragma unroll
    for (int dh = 0; dh < 2; ++dh)
#pragma unroll
        for (int v = 0; v < 16; ++v) o[dh][v] *= al;
    const float mb = part ? (mn - off) : INFINITY;
    float sum = 0.f;
#pragma unroll
    for (int kh = 0; kh < 2; ++kh)
#pragma unroll
        for (int v = 0; v < 16; ++v) { const float e = fexp2(s[kh][v] - mb); s[kh][v] = e; sum += e; }
    l += sum;
}
__device__ __forceinline__ void store_row_wide(bf16* rowp, v2u (&grp)[8], int h, bool pred = true) {
#pragma unroll
    for (int g = 0; g < 8; g += 2) { v2u a = grp[g], b = grp[g + 1];
        { auto r = __builtin_amdgcn_permlane32_swap(a.x, b.x, false, false); a.x = r[0]; b.x = r[1]; }
        { auto r = __builtin_amdgcn_permlane32_swap(a.y, b.y, false, false); a.y = r[0]; b.y = r[1]; }
        if (pred) { v4u w; w.x = a.x; w.y = a.y; w.z = b.x; w.w = b.y; *(GAS v4u*)(rowp + 8 * g + 8 * h) = w; } }
}
__device__ __forceinline__ void store_ot(bf16* dst, const f32x16 (&o)[2], float sc, int h) {
    v2u grp[8];
#pragma unroll
    for (int dh = 0; dh < 2; ++dh)
#pragma unroll
        for (int a = 0; a < 4; ++a) { grp[4 * dh + a].x = cvtpk(o[dh][4 * a] * sc, o[dh][4 * a + 1] * sc); grp[4 * dh + a].y = cvtpk(o[dh][4 * a + 2] * sc, o[dh][4 * a + 3] * sc); }
    store_row_wide(dst, grp, h);
}
__device__ __forceinline__ void zero_o(f32x16 (&o)[2]) { for (int dh = 0; dh < 2; ++dh) for (int v = 0; v < 16; ++v) o[dh][v] = 0.f; }

template <bool TO_LDS> __device__ __forceinline__ void l2_wave(const bf16* w2t  , const bf16* hid0, int hstride, const float* kcg  , unsigned char* dst, int dpitch_bytes, int lane) {
    const int r = lane & 31, h = lane >> 5;
    f32x16 acc[2]; zero_o(acc);
    const bf16* hp = hid0 + (size_t)r * hstride + 8 * h;
#pragma unroll
    for (int k0 = 0; k0 < 16; k0 += 8) {
        bf16x8 bfr[8], af[2][8];
#pragma unroll
        for (int k = 0; k < 8; ++k) { bfr[k] = *(const GAS bf16x8*)(hp + 16 * (k0 + k));
#pragma unroll
            for (int dh = 0; dh < 2; ++dh) af[dh][k] = *(const GAS bf16x8*)(w2t + (size_t)(32 * dh + r) * 256 + 16 * (k0 + k) + 8 * h); }
#pragma unroll
        for (int k = 0; k < 8; ++k)
#pragma unroll
            for (int dh = 0; dh < 2; ++dh) acc[dh] = MFMA32(af[dh][k], bfr[k], acc[dh]);
    }
    float sc = 1.f;
    if (kcg) { float ssq = 0.f;
#pragma unroll
        for (int dh = 0; dh < 2; ++dh)
#pragma unroll
            for (int v = 0; v < 16; ++v) ssq += acc[dh][v] * acc[dh][v];
        ssq += __shfl_xor(ssq, 32); sc = 1.f / sqrtf(ssq * (1.f / 64.f) + EPS); }
#pragma unroll
    for (int dh = 0; dh < 2; ++dh)
#pragma unroll
        for (int a = 0; a < 4; ++a) { const int d0 = 32 * dh + 8 * a + 4 * h; f32x4 x = {acc[dh][4 * a], acc[dh][4 * a + 1], acc[dh][4 * a + 2], acc[dh][4 * a + 3]};
            if (kcg) x = x * *(const f32x4*)(kcg + d0) * sc;
            v2u w; w.x = cvtpk(x[0], x[1]); w.y = cvtpk(x[2], x[3]);
            if (TO_LDS) *(LAS v2u*)((LAS unsigned char*)(uintptr_t)dst + r * dpitch_bytes + d0 * 2) = w;
            else *(GAS v2u*)(dst + (size_t)r * dpitch_bytes + d0 * 2) = w; }
}

__device__ __forceinline__ int next_item(gu32* ctr, volatile LAS int* slot) {
    __syncthreads();
    if (threadIdx.x == 0) *slot = (int)__hip_atomic_fetch_add(ctr, 1u, RLX_AGENT);
    __syncthreads();
    return *slot;
}

__device__ __forceinline__ void sb_weights(f32x16 (&s)[2], float& C, int kb, int tpos, int h) {
    float gs[8];
#pragma unroll
    for (int kh = 0; kh < 2; ++kh)
#pragma unroll
        for (int aa = 0; aa < 4; ++aa) { float gsum = 0.f;
#pragma unroll
            for (int j = 3; j >= 0; --j) { const int v = 4 * aa + j; const float z = s[kh][v]; const bool ok = (kb + kidx_of(kh, v, h)) < tpos;
                const float lb = fminf(z, 0.f) - LN2 * flog2(1.f + fexp2(-fabsf(z) * LOG2E));
                const float lk = ok ? (lb - z) : 0.f;
                s[kh][v] = ok ? (lb + gsum) : -INFINITY;
                gsum += lk; }
            gs[4 * kh + aa] = gsum; }
    float tot = 0.f, off[8];
#pragma unroll
    for (int ap = 7; ap >= 0; --ap) { const float mine = gs[ap], oth = xhalf(mine, h);
        off[ap] = tot + (h == 0 ? oth : 0.f); tot += mine + oth; }
#pragma unroll
    for (int kh = 0; kh < 2; ++kh)
#pragma unroll
        for (int v = 0; v < 16; ++v) s[kh][v] = fexp2((s[kh][v] + C + off[4 * kh + (v >> 2)]) * LOG2E);
    C += tot;
}
__device__ __forceinline__ void item_l2_sample(const Args& a, int it, int lane, int wave) {
    unsigned char* ws = a.ws; const int sb = it >> 1, g = it & 1, slot = wave & 1;
    const bf16* w2t = (const bf16*)(ws + WS_W2T) + slot * 64 * 256;
    const float* kcg = slot ? nullptr : (const float*)a.in[IN_KCG];
    for (int j = 0; j < 2; ++j) { const int ch = (wave >> 1) + 4 * j;
        const bf16* hid0 = (const bf16*)(ws + WS_HIDS) + ((size_t)slot * 16384 + (size_t)(sb * 256 + 32 * ch) * 2 + g) * 256;
        unsigned char* dst = ws + (slot ? WS_VCS : WS_KCS) + ((size_t)((sb * 2 + g) * 256 + 32 * ch)) * 128;
        l2_wave<false>(w2t, hid0, 512, kcg, dst, 128, lane); }
}
__device__ __forceinline__ void item_sb_prompt(const Args& a, LAS unsigned char* lds, int it, int lane, int wave) {
    unsigned char* ws = a.ws;
    const int qb = 7 - (it >> 6), bh = it & 63, b = bh >> 3, hd = bh & 7;
    const int r = lane & 31, h = lane >> 5, tw = 256 * qb + 32 * wave, tpos = tw + r; const size_t mrow = (size_t)b * TP + tpos;
    const bf16* QA = (const bf16*)(ws + WS_QA); const bf16* KA = (const bf16*)(ws + WS_KA) + hd * 64; const bf16* VA = (const bf16*)(ws + WS_VA) + hd * 64;
    bf16x8 qf[4]; load_qf(qf, QA + mrow * 512 + hd * 64, lane);
    LAS unsigned char* Vs = lds + wave * VT_BYTES;
    f32x16 o[2]; zero_o(o);
    float C = 0.f;
    for (int kb = (tw >> 6) << 6; kb >= 0; kb -= 64) {
        const size_t krow0 = (size_t)b * TP + kb;
        v4u vr[8];
#pragma unroll
        for (int i = 0; i < 8; ++i) vr[i] = *(const GAS v4u*)(VA + (krow0 + 8 * i + (lane >> 3)) * 512 + (lane & 7) * 8);
        f32x16 s[2]; qk64_g(s, KA + krow0 * 512, 512, qf, lane);
#pragma unroll
        for (int i = 0; i < 8; ++i) *(LAS v4u*)(Vs + (8 * i + (lane >> 3)) * VP + (lane & 7) * 16) = vr[i];
        sb_weights(s, C, kb, tpos, h);
        asm volatile("" ::: "memory");
        pv64(o, Vs, s, lane);
        asm volatile("" ::: "memory");
        if (__all(C < -60.f)) break;
    }
    const bf16* GA = (const bf16*)(ws + WS_GA) + mrow * 512 + hd * 64; bf16* U = (bf16*)(ws + WS_U) + mrow * 1024 + hd * 64;
    v2u grp[8];
#pragma unroll
    for (int dh = 0; dh < 2; ++dh)
#pragma unroll
        for (int aa = 0; aa < 4; ++aa) { const int d0 = 32 * dh + 8 * aa + 4 * h; const v2u gw = *(const GAS v2u*)(GA + d0);
            grp[4 * dh + aa].x = cvtpk(o[dh][4 * aa] * bf_lo(gw.x), o[dh][4 * aa + 1] * bf_hi(gw.x)); grp[4 * dh + aa].y = cvtpk(o[dh][4 * aa + 2] * bf_lo(gw.y), o[dh][4 * aa + 3] * bf_hi(gw.y)); }
    store_row_wide(U, grp, h);
}
__device__ __forceinline__ void item_win_prompt(const Args& a, LAS unsigned char* lds, int it, int tid, int lane, int wave) {
    unsigned char* ws = a.ws;
    const int qp = 15 - (it >> 4), bg = it & 15, b = bg >> 1, g = bg & 1, qA = 2 * qp + 1, qB = 2 * qp;
    const int r = lane & 31, h = lane >> 5, hq = 4 * g + (wave & 3), tA = 64 * qA + 32 * (wave >> 2) + r, tB = tA - 64; const size_t mA = (size_t)b * TP + tA, mB = mA - 64;
    const float slope2 = fexp2(-(float)(hq + 1)) * LOG2E;
    bf16x8 qfA[4], qfB[4]; load_qf(qfA, (const bf16*)(ws + WS_QB) + mA * 512 + hq * 64, lane); load_qf(qfB, (const bf16*)(ws + WS_QB) + mB * 512 + hq * 64, lane);
    const bf16* KW = (const bf16*)(ws + WS_KWIN) + (size_t)b * TP * 128 + g * 64; const bf16* VW = (const bf16*)(ws + WS_VWIN) + (size_t)b * TP * 128 + g * 64;
    f32x16 oA[2], oB[2]; zero_o(oA); zero_o(oB); float mAx = -1e30f, lA = 0.f, mBx = -1e30f, lB = 0.f;
    f32x16 cinit[2]; alibi_cinit(cinit, slope2);
    const int kt_lo = qB >= 8 ? qB - 8 : 0;
    { const v4u k0 = tile_ld(KW + (size_t)(64 * qA) * 128, 128, tid), v0 = tile_ld(VW + (size_t)(64 * qA) * 128, 128, tid);
      tile_st(lds, KP, tid, k0); tile_st(lds + KT_BYTES, VP, tid, v0); }
    v4u kr = {0u, 0u, 0u, 0u}, vr = {0u, 0u, 0u, 0u};
    if (qA - 1 >= kt_lo) { kr = tile_ld(KW + (size_t)(64 * (qA - 1)) * 128, 128, tid); vr = tile_ld(VW + (size_t)(64 * (qA - 1)) * 128, 128, tid); }
    int st = 0;
    for (int kt = qA; kt >= kt_lo; --kt, st ^= 1) {
        __syncthreads();
        LAS unsigned char* Ks = lds + st * (KT_BYTES + VT_BYTES); LAS unsigned char* Vs = Ks + KT_BYTES;
        if (kt - 1 >= kt_lo) { LAS unsigned char* Kn = lds + (st ^ 1) * (KT_BYTES + VT_BYTES); tile_st(Kn, KP, tid, kr); tile_st(Kn + KT_BYTES, VP, tid, vr); }
        if (kt - 2 >= kt_lo) { kr = tile_ld(KW + (size_t)(64 * (kt - 2)) * 128, 128, tid); vr = tile_ld(VW + (size_t)(64 * (kt - 2)) * 128, 128, tid); }
        const int kb = 64 * kt; const float off = slope2 * (float)(kb + 4 * h);
        if (kt >= qA - 8) { f32x16 s[2]; qk64c(s, Ks, qfA, cinit, lane);
            if (kt == qA || kt == qA - 8) sm2_tile<true>(s, mAx, lA, oA, off, true, tA - 512 - kb - 4 * h, tA - kb - 4 * h);
            else sm2_tile<false>(s, mAx, lA, oA, off, true, 0, 0);
            pv64(oA, Vs, s, lane); }
        if (kt <= qB) { f32x16 s[2]; qk64c(s, Ks, qfB, cinit, lane);
            if (kt == qB || kt == qB - 8) sm2_tile<true>(s, mBx, lB, oB, off, true, tB - 512 - kb - 4 * h, tB - kb - 4 * h);
            else sm2_tile<false>(s, mBx, lB, oB, off, true, 0, 0);
            pv64(oB, Vs, s, lane); }
    }
    lA += __shfl_xor(lA, 32); lB += __shfl_xor(lB, 32);
    const float gA = ((const float*)(ws + WS_BR))[mA * 24 + hq * 3 + 2], gB = ((const float*)(ws + WS_BR))[mB * 24 + hq * 3 + 2];
    store_ot((bf16*)(ws + WS_OW) + mA * 512 + hq * 64, oA, gA / lA, h);
    store_ot((bf16*)(ws + WS_OW) + mB * 512 + hq * 64, oB, gB / lB, h);
}

__device__ __forceinline__ void item_sb_sample(const Args& a, LAS unsigned char* lds, int it, int lane, int wave) {
    unsigned char* ws = a.ws; const int pair = it * 8 + wave, sb = pair >> 3, hd = pair & 7;
    const int r = lane & 31, h = lane >> 5, st = r & 7, tpos = 8192 + st; const size_t mrow = (size_t)MP + sb * 8 + st;
    const float* csb = (const float*)a.in[IN_CSB]; const int* pt = (const int*)a.in[IN_PT] + sb * 64;
    bf16x8 qf[4]; load_qf(qf, (const bf16*)(ws + WS_QA) + mrow * 512 + hd * 64, lane);
    LAS unsigned char* Vs = lds + wave * VT_BYTES;
    f32x16 o[2]; zero_o(o); float C = 0.f;
    for (int blk = 128; blk >= 0; --blk) {
        const float* rows = (blk == 128) ? a.out + OFF_SB + (size_t)(MP + sb * 8) * 1024 : csb + ((size_t)pt[blk >> 1] * 128 + (blk & 1) * 64) * 1024;
        const int maxrow = blk == 128 ? 7 : 63;
        const float* kbase = rows + hd * 64; const float* vbase = rows + 512 + hd * 64;
        f32x4 kt[2][4][2];
#pragma unroll
        for (int kh = 0; kh < 2; ++kh) { const float* kp = kbase + (size_t)min(32 * kh + r, maxrow) * 1024 + 8 * h;
#pragma unroll
            for (int ks = 0; ks < 4; ++ks) { kt[kh][ks][0] = *(const GAS f32x4*)(kp + 16 * ks); kt[kh][ks][1] = *(const GAS f32x4*)(kp + 16 * ks + 4); } }
        f32x4 va[4][2], vb[4][2];
#pragma unroll
        for (int i = 0; i < 4; ++i) { const float* vp = vbase + (size_t)min(8 * i + (lane >> 3), maxrow) * 1024 + (lane & 7) * 8; va[i][0] = *(const GAS f32x4*)vp; va[i][1] = *(const GAS f32x4*)(vp + 4); }
        f32x16 s[2];
#pragma unroll
        for (int kh = 0; kh < 2; ++kh) { f32x16 acc; for (int i = 0; i < 16; ++i) acc[i] = 0.f;
#pragma unroll
            for (int ks = 0; ks < 4; ++ks) { const bf16x8 kf8 = pack8(kt[kh][ks][0], kt[kh][ks][1]); __builtin_amdgcn_s_setprio(1); acc = MFMA32(kf8, qf[ks], acc); __builtin_amdgcn_s_setprio(0); }
            s[kh] = acc; }
#pragma unroll
        for (int i = 0; i < 4; ++i) { const float* vp = vbase + (size_t)min(8 * (i + 4) + (lane >> 3), maxrow) * 1024 + (lane & 7) * 8; vb[i][0] = *(const GAS f32x4*)vp; vb[i][1] = *(const GAS f32x4*)(vp + 4); }
#pragma unroll
        for (int i = 0; i < 4; ++i) *(LAS bf16x8*)(Vs + (8 * i + (lane >> 3)) * VP + (lane & 7) * 16) = pack8(va[i][0], va[i][1]);
        sb_weights(s, C, 64 * blk, tpos, h);
#pragma unroll
        for (int i = 0; i < 4; ++i) *(LAS bf16x8*)(Vs + (8 * (i + 4) + (lane >> 3)) * VP + (lane & 7) * 16) = pack8(vb[i][0], vb[i][1]);
        asm volatile("" ::: "memory");
        pv64(o, Vs, s, lane);
        asm volatile("" ::: "memory");
        if (__all(C < -60.f)) break;
    }
    { const bf16* GA = (const bf16*)(ws + WS_GA) + mrow * 512 + hd * 64; bf16* U = (bf16*)(ws + WS_U) + mrow * 1024 + hd * 64;
      v2u grp[8];
#pragma unroll
      for (int dh = 0; dh < 2; ++dh)
#pragma unroll
          for (int aa = 0; aa < 4; ++aa) { const int d0 = 32 * dh + 8 * aa + 4 * h; const v2u gw = *(const GAS v2u*)(GA + d0);
              grp[4 * dh + aa].x = cvtpk(o[dh][4 * aa] * bf_lo(gw.x), o[dh][4 * aa + 1] * bf_hi(gw.x)); grp[4 * dh + aa].y = cvtpk(o[dh][4 * aa + 2] * bf_lo(gw.y), o[dh][4 * aa + 3] * bf_hi(gw.y)); }
      store_row_wide(U, grp, h, r < 8); }
}

#ifndef DBG_DUP
#define DBG_DUP 0
#endif

constexpr size_t WS_KCP = 230 * MiB, WS_VCP = 231 * MiB;
constexpr int P3_KC = 0, P3_VC = KT_BYTES, P3_KS = KT_BYTES + VT_BYTES  , P3_IMPW = P3_KS + 2 * (KT_BYTES + VT_BYTES)  , P3_IMP = P3_IMPW + 8 * 32 * 33 * 4,
              P3_SEL = P3_IMP + 64 * 36 * 4, P3_UM = P3_SEL + 256;
__device__ __forceinline__ void item_nsa_prompt(const Args& a, LAS unsigned char* lds, int it, int tid, int lane, int wave) {
    unsigned char* ws = a.ws;
    const int qblk = 31 - (it >> 4), bg = it & 15, b = bg >> 1, g = bg & 1, cur = qblk;
    const int r = lane & 31, h = lane >> 5, hq = 4 * g + (wave & 3), th = wave >> 2, tpos = 64 * qblk + 32 * th + r; const size_t mrow = (size_t)b * TP + tpos;
    const float slope2 = fexp2(-(float)(hq + 1)) * LOG2E;
    { const bf16* KCP = (const bf16*)(ws + WS_KCP) + (size_t)(b * 2 + g) * 4096; const bf16* VCP = (const bf16*)(ws + WS_VCP) + (size_t)(b * 2 + g) * 4096;
      const v4u k0 = tile_ld(KCP, 64, tid), v0 = tile_ld(VCP, 64, tid); tile_st(lds + P3_KC, KP, tid, k0); tile_st(lds + P3_VC, VP, tid, v0); }
    bf16x8 qf[4]; load_qf(qf, (const bf16*)(ws + WS_QB) + mrow * 512 + hq * 64, lane);
    __syncthreads();
    f32x16 oc[2];
    for (int dupp = 0; dupp < ((DBG_DUP & 128) ? 2 : 1); ++dupp) { if (dupp) __syncthreads();
    zero_o(oc);
    { f32x16 s[2]; qk64(s, lds + P3_KC, qf, lane);
      float mx = -1e30f;
#pragma unroll
      for (int kh = 0; kh < 2; ++kh)
#pragma unroll
          for (int v = 0; v < 16; ++v) { const int ce = 32 * kidx_of(kh, v, h) + 31, dist = tpos - ce; const float x = dist >= 0 ? s[kh][v] - slope2 * (float)dist : -INFINITY; s[kh][v] = x; mx = fmaxf(mx, x); }
      mx = fmaxf(mx, __shfl_xor(mx, 32));
      float sum = 0.f;
#pragma unroll
      for (int kh = 0; kh < 2; ++kh)
#pragma unroll
          for (int v = 0; v < 16; ++v) { const float e = fexp2(s[kh][v] - mx); s[kh][v] = e; sum += e; }
      sum += __shfl_xor(sum, 32);
      const float inv = sum > 0.f ? 1.f / sum : 1.f;
#pragma unroll
      for (int kh = 0; kh < 2; ++kh)
#pragma unroll
          for (int v = 0; v < 16; ++v) s[kh][v] *= inv;
      LAS float* impw = (LAS float*)(lds + P3_IMPW) + (wave * 32 + r) * 33;
#pragma unroll
      for (int kh = 0; kh < 2; ++kh)
#pragma unroll
          for (int aa = 0; aa < 4; ++aa)
#pragma unroll
              for (int b2 = 0; b2 < 2; ++b2) impw[16 * kh + 4 * aa + 2 * h + b2] = s[kh][4 * aa + 2 * b2] + s[kh][4 * aa + 2 * b2 + 1];
      pv64(oc, lds + P3_VC, s, lane);
    }
    __syncthreads();
    { const int tk = tid >> 3, j8 = tid & 7; LAS float* imp = (LAS float*)(lds + P3_IMP) + tk * 36;
      const LAS float* iw = (const LAS float*)(lds + P3_IMPW) + (((tk >> 5) * 4) * 32 + (tk & 31)) * 33;
#pragma unroll
      for (int j = 0; j < 4; ++j) { const int blk = 4 * j8 + j; imp[blk] = (iw[blk] + iw[32 * 33 + blk]) + (iw[2 * 32 * 33 + blk] + iw[3 * 32 * 33 + blk]); }
      __syncthreads();
      unsigned bits = 0u;
      if (cur <= 15) bits = 0xffffffffu;
      else {
          float y[32];
#pragma unroll
          for (int q4 = 0; q4 < 8; ++q4) { const f32x4 v = *(const LAS f32x4*)(imp + 4 * q4); y[4 * q4] = v.x; y[4 * q4 + 1] = v.y; y[4 * q4 + 2] = v.z; y[4 * q4 + 3] = v.w; }
#pragma unroll
          for (int j = 0; j < 4; ++j) { const int blk = 4 * j8 + j;
              if (blk == 0 || blk == cur || blk == cur - 1) bits |= 1u << blk;
              else if (blk < cur - 1) { float x = 0.f;
#pragma unroll
                  for (int o2 = 0; o2 < 32; ++o2) x = (o2 == blk) ? y[o2] : x;
                  int rank = 0;
#pragma unroll
                  for (int o2 = 1; o2 < 30; ++o2) rank += (o2 <= cur - 2 && (y[o2] > x || (y[o2] == x && o2 < blk))) ? 1 : 0;
                  if (rank < 13) bits |= 1u << blk; } } }
      bits |= __shfl_xor(bits, 1); bits |= __shfl_xor(bits, 2); bits |= __shfl_xor(bits, 4);
      if (j8 == 0) ((LAS unsigned*)(lds + P3_SEL))[tk] = bits;
      __syncthreads();
      if (wave == 0) { unsigned um = ((const LAS unsigned*)(lds + P3_SEL))[lane];
#pragma unroll
          for (int o2 = 1; o2 < 64; o2 <<= 1) um |= __shfl_xor(um, o2);
          if (lane == 0) *(LAS unsigned*)(lds + P3_UM) = um; }
      __syncthreads();
    }
    }
    const unsigned selbits = ((const LAS unsigned*)(lds + P3_SEL))[32 * th + r], umask = *(const LAS unsigned*)(lds + P3_UM);
    f32x16 os[2]; zero_o(os); float m = -1e30f, l = 0.f;
    f32x16 cinit[2]; alibi_cinit(cinit, slope2);
    { const bf16* KS = (const bf16*)(ws + WS_KSEL) + (size_t)b * TP * 128 + g * 64; const bf16* VS = (const bf16*)(ws + WS_VSEL) + (size_t)b * TP * 128 + g * 64;
      unsigned todo = umask & (cur >= 31 ? 0xffffffffu : ((2u << cur) - 1u));
      int blk = 31 - __builtin_clz(todo); todo &= ~(1u << blk);
      int nb1 = todo ? 31 - __builtin_clz(todo) : -1; if (nb1 >= 0) todo &= ~(1u << nb1);
      { const v4u k0 = tile_ld(KS + (size_t)(64 * blk) * 128, 128, tid), v0 = tile_ld(VS + (size_t)(64 * blk) * 128, 128, tid);
        tile_st(lds + P3_KS, KP, tid, k0); tile_st(lds + P3_KS + KT_BYTES, VP, tid, v0); }
      v4u kr = {0u, 0u, 0u, 0u}, vr = {0u, 0u, 0u, 0u};
      if (nb1 >= 0) { kr = tile_ld(KS + (size_t)(64 * nb1) * 128, 128, tid); vr = tile_ld(VS + (size_t)(64 * nb1) * 128, 128, tid); }
      int st = 0;
      for (;;) {
          __syncthreads();
          LAS unsigned char* Ks = lds + P3_KS + st * (KT_BYTES + VT_BYTES); LAS unsigned char* Vs = Ks + KT_BYTES;
          if (nb1 >= 0) { LAS unsigned char* Kn = lds + P3_KS + (st ^ 1) * (KT_BYTES + VT_BYTES); tile_st(Kn, KP, tid, kr); tile_st(Kn + KT_BYTES, VP, tid, vr); }
          const int nb2 = todo ? 31 - __builtin_clz(todo) : -1; if (nb2 >= 0) todo &= ~(1u << nb2);
          if (nb2 >= 0) { kr = tile_ld(KS + (size_t)(64 * nb2) * 128, 128, tid); vr = tile_ld(VS + (size_t)(64 * nb2) * 128, 128, tid); }
          const int kb = 64 * blk; const bool mine = (selbits >> blk) & 1u;
          if (__any(mine)) {
              for (int dupc = 0; dupc < ((DBG_DUP & 32) ? 2 : 1); ++dupc) {
              f32x16 s[2]; qk64c(s, Ks, qf, cinit, lane);
              const float off = slope2 * (float)(kb + 4 * h);
              if (blk == cur) sm2_tile<true>(s, m, l, os, off, mine && dupc == 0, -(1 << 30), tpos - kb - 4 * h);
              else sm2_tile<false>(s, m, l, os, off, mine && dupc == 0, 0, 0);
              pv64(os, Vs, s, lane); } }
          if (nb1 < 0) break;
          blk = nb1; nb1 = nb2; st ^= 1;
      } }
    l += __shfl_xor(l, 32);
    { const float* br = (const float*)(ws + WS_BR) + mrow * 24 + hq * 3; const float g0 = br[0], g1 = br[1] / l;
      const bf16* OW = (const bf16*)(ws + WS_OW) + mrow * 512 + hq * 64; const bf16* GB = (const bf16*)(ws + WS_GB) + mrow * 512 + hq * 64; bf16* U = (bf16*)(ws + WS_U) + mrow * 1024 + 512 + hq * 64;
      v2u grp[8];
#pragma unroll
      for (int dh = 0; dh < 2; ++dh)
#pragma unroll
          for (int aa = 0; aa < 4; ++aa) { const int d0 = 32 * dh + 8 * aa + 4 * h; const v2u ow = *(const GAS v2u*)(OW + d0), gb = *(const GAS v2u*)(GB + d0);
              const float x0 = (g0 * oc[dh][4 * aa] + g1 * os[dh][4 * aa] + bf_lo(ow.x)) * bf_lo(gb.x), x1 = (g0 * oc[dh][4 * aa + 1] + g1 * os[dh][4 * aa + 1] + bf_hi(ow.x)) * bf_hi(gb.x);
              const float x2 = (g0 * oc[dh][4 * aa + 2] + g1 * os[dh][4 * aa + 2] + bf_lo(ow.y)) * bf_lo(gb.y), x3 = (g0 * oc[dh][4 * aa + 3] + g1 * os[dh][4 * aa + 3] + bf_hi(ow.y)) * bf_hi(gb.y);
              grp[4 * dh + aa].x = cvtpk(x0, x1); grp[4 * dh + aa].y = cvtpk(x2, x3); }
      store_row_wide(U, grp, h); }
}

constexpr int SM_V = 0, SM_ACC = 8 * VT_BYTES  , SM_ST = SM_ACC + 8192, SM_IMP = SM_ST + 3 * 8 * 32 * 2 * 4  , SM_SELW = SM_IMP + 8 * 128 * 4, SM_END = SM_SELW + 128;
static_assert(SM_END <= RING_BYTES, "sample NSA LDS map");
template <class F> __device__ __forceinline__ void sm_tile_f32(f32x16 (&o)[2], float& m, float& l, const float* kbase, const float* vbase, int stride, int maxrow, LAS unsigned char* Vs, const bf16x8 (&qf)[4], int lane, F&& biasf) {
    const int h = lane >> 5;
    f32x4 kt[2][4][2];
#pragma unroll
    for (int kh = 0; kh < 2; ++kh) { const int row = min(32 * kh + (lane & 31), maxrow); const float* kp = kbase + (size_t)row * stride + 8 * h;
#pragma unroll
        for (int ks = 0; ks < 4; ++ks) { kt[kh][ks][0] = *(const GAS f32x4*)(kp + 16 * ks); kt[kh][ks][1] = *(const GAS f32x4*)(kp + 16 * ks + 4); } }
    f32x4 va[4][2], vb[4][2];
#pragma unroll
    for (int i = 0; i < 4; ++i) { const float* vp = vbase + (size_t)min(8 * i + (lane >> 3), maxrow) * stride + (lane & 7) * 8; va[i][0] = *(const GAS f32x4*)vp; va[i][1] = *(const GAS f32x4*)(vp + 4); }
    f32x16 s[2];
#pragma unroll
    for (int kh = 0; kh < 2; ++kh) { f32x16 acc; for (int i = 0; i < 16; ++i) acc[i] = 0.f;
#pragma unroll
        for (int ks = 0; ks < 4; ++ks) { const bf16x8 kf8 = pack8(kt[kh][ks][0], kt[kh][ks][1]); __builtin_amdgcn_s_setprio(1); acc = MFMA32(kf8, qf[ks], acc); __builtin_amdgcn_s_setprio(0); }
        s[kh] = acc; }
#pragma unroll
    for (int i = 0; i < 4; ++i) { const float* vp = vbase + (size_t)min(8 * (i + 4) + (lane >> 3), maxrow) * stride + (lane & 7) * 8; vb[i][0] = *(const GAS f32x4*)vp; vb[i][1] = *(const GAS f32x4*)(vp + 4); }
#pragma unroll
    for (int i = 0; i < 4; ++i) *(LAS bf16x8*)(Vs + (8 * i + (lane >> 3)) * VP + (lane & 7) * 16) = pack8(va[i][0], va[i][1]);
    softmax_tile(s, m, l, o, h, biasf);
#pragma unroll
    for (int i = 0; i < 4; ++i) *(LAS bf16x8*)(Vs + (8 * (i + 4) + (lane >> 3)) * VP + (lane & 7) * 16) = pack8(vb[i][0], vb[i][1]);
    asm volatile("" ::: "memory");
    pv64(o, Vs, s, lane);
    asm volatile("" ::: "memory");
}
__device__ __forceinline__ void sm_put_stats(LAS float* st, int br, int wave, int lane, float m, float l) { if (lane < 32) { st[((br * 8 + wave) * 32 + lane) * 2] = m; st[((br * 8 + wave) * 32 + lane) * 2 + 1] = l; } }
__device__ __forceinline__ void sm_get_ML(const LAS float* st, int br, int r, float& M, float& L) {
    M = -1e30f;
#pragma unroll
    for (int w = 0; w < 8; ++w) M = fmaxf(M, st[((br * 8 + w) * 32 + r) * 2]);
    L = 0.f;
#pragma unroll
    for (int w = 0; w < 8; ++w) L += st[((br * 8 + w) * 32 + r) * 2 + 1] * fexp2(st[((br * 8 + w) * 32 + r) * 2] - M);
}
__device__ __forceinline__ void sm_put(LAS float* slice, const f32x16 (&o)[2], float f, int lane) {
    const int r = lane & 31, h = lane >> 5;
#pragma unroll
    for (int dh = 0; dh < 2; ++dh)
#pragma unroll
        for (int v = 0; v < 16; ++v) { const int d = 32 * dh + (v & 3) + 8 * (v >> 2) + 4 * h; slice[d * 32 + r] = o[dh][v] * f; }
}
__device__ __forceinline__ void item_nsa_sample(const Args& a, LAS unsigned char* lds, int it, int tid, int lane, int wave) {
    unsigned char* ws = a.ws; const int sb = it >> 1, g = it & 1;
    const int r = lane & 31, h = lane >> 5, st = r >> 2, hh = r & 3, hq = 4 * g + hh, t = 8192 + st; const size_t mrow = (size_t)MP + sb * 8 + st;
    const float* cn = (const float*)a.in[IN_CNSA]; const int* pt = (const int*)a.in[IN_PT] + sb * 64; const float* sw = (const float*)a.in[IN_SWIN];
    LAS unsigned char* Vs = lds + SM_V + wave * VT_BYTES; LAS float* acc = (LAS float*)(lds + SM_ACC); LAS float* stt = (LAS float*)(lds + SM_ST); LAS float* imp = (LAS float*)(lds + SM_IMP);
    LAS unsigned long long* selw = (LAS unsigned long long*)(lds + SM_SELW);
    const float slope2 = fexp2(-(float)(hq + 1)) * LOG2E;
    const float* br = (const float*)(ws + WS_BR) + mrow * 24 + hq * 3; const float g0 = br[0], g1 = br[1], g2 = br[2];
    bf16x8 qf[4]; load_qf(qf, (const bf16*)(ws + WS_QB) + mrow * 512 + hq * 64, lane);
    f32x16 ow[2]; zero_o(ow); float mw = -1e30f, lw = 0.f;
#pragma unroll 1
    for (int pass = 0; pass < 2; ++pass) { if (pass == 1 && wave != 4) break;
        const int j = pass == 0 ? wave : 8, i0 = 64 * j;
        const float* rows = (j < 8) ? sw + ((size_t)(sb * 512 + i0)) * 256 : a.out + OFF_WINS + ((size_t)(sb * 512 + 504)) * 256;
        sm_tile_f32(ow, mw, lw, rows + g * 64, rows + 128 + g * 64, 256, j < 8 ? 63 : 7, Vs, qf, lane, [&](int ki) { const int i = i0 + ki, dist = t - (7680 + i); return (i < 520 && dist >= 0 && dist < 512) ? -slope2 * (float)dist : -INFINITY; }); }
    if (DBG_DUP & 4) { f32x16 o2[2]; zero_o(o2); float m2 = -1e30f, l2 = 0.f;
#pragma unroll 1
        for (int pass = 0; pass < 2; ++pass) { if (pass == 1 && wave != 4) break;
            const int j = pass == 0 ? wave : 8, i0 = 64 * j;
            const float* rows = (j < 8) ? sw + ((size_t)(sb * 512 + i0)) * 256 : a.out + OFF_WINS + ((size_t)(sb * 512 + 504)) * 256;
            sm_tile_f32(o2, m2, l2, rows + g * 64, rows + 128 + g * 64, 256, j < 8 ? 63 : 7, Vs, qf, lane, [&](int ki) { const int i = i0 + ki, dist = t - (7680 + i); return (i < 520 && dist >= 0 && dist < 512) ? -slope2 * (float)dist : -INFINITY; }); }
        if (m2 == 12345.f) ow[0][0] += o2[0][0] + l2; }
    lw += __shfl_xor(lw, 32);
    sm_put_stats(stt, 2, wave, lane, mw, lw);
    f32x16 oc[2]; zero_o(oc); f32x16 ec[2]; float mc = -1e30f, lc = 0.f;
    if (wave < 4) {
        const bf16* KC = (const bf16*)(ws + WS_KCS) + ((size_t)((sb * 2 + g) * 256 + 64 * wave)) * 64; const bf16* VC = (const bf16*)(ws + WS_VCS) + ((size_t)((sb * 2 + g) * 256 + 64 * wave)) * 64;
        v4u vr[8];
#pragma unroll
        for (int i = 0; i < 8; ++i) vr[i] = *(const GAS v4u*)(VC + (size_t)(8 * i + (lane >> 3)) * 64 + (lane & 7) * 8);
        qk64_g(ec, KC, 64, qf, lane);
#pragma unroll
        for (int i = 0; i < 8; ++i) *(LAS v4u*)(Vs + (8 * i + (lane >> 3)) * VP + (lane & 7) * 16) = vr[i];
        const int c0 = 64 * wave;
        softmax_tile(ec, mc, lc, oc, h, [&](int ki) { return -slope2 * (float)(t - (32 * (c0 + ki) + 31)); });
        asm volatile("" ::: "memory");
        pv64(oc, Vs, ec, lane);
        asm volatile("" ::: "memory");
        lc += __shfl_xor(lc, 32);
    }
    sm_put_stats(stt, 0, wave, lane, mc, lc);
    __syncthreads();
    LAS float* mbuf = (LAS float*)(lds + SM_V);
    { float M, L; sm_get_ML(stt, 2, r, M, L); sm_put(mbuf + wave * 2048, ow, (L > 0.f) ? g2 * fexp2(mw - M) / L : 0.f, lane); }
    if (wave < 4) { float M, L; sm_get_ML(stt, 0, r, M, L); const float f = fexp2(mc - M) / L;
        sm_put(mbuf + (8 + wave) * 2048, oc, g0 * f, lane);
#pragma unroll
        for (int kh = 0; kh < 2; ++kh)
#pragma unroll
            for (int aa = 0; aa < 4; ++aa)
#pragma unroll
                for (int b2 = 0; b2 < 2; ++b2) { float v = (ec[kh][4 * aa + 2 * b2] + ec[kh][4 * aa + 2 * b2 + 1]) * f; v += __shfl_xor(v, 1); v += __shfl_xor(v, 2);
                    if (hh == 0) imp[st * 128 + 32 * wave + 16 * kh + 4 * aa + 2 * h + b2] = v; } }
    __syncthreads();
    { f32x4 sum = {0.f, 0.f, 0.f, 0.f};
#pragma unroll
      for (int w = 0; w < 12; ++w) sum += *(const LAS f32x4*)(mbuf + w * 2048 + tid * 4);
      *(LAS f32x4*)(acc + tid * 4) = sum; }
    for (int dup = 0; dup < ((DBG_DUP & 2) ? 2 : 1); ++dup)
    { const LAS float* im = imp + wave * 128; bool s0, s1;
      { const int blk = lane; if (blk == 0) s0 = true; else { const float x = im[blk]; int rank = 0; for (int o2 = 1; o2 <= 126; ++o2) { const float y = im[o2]; rank += (y > x || (y == x && o2 < blk)) ? 1 : 0; } s0 = rank < 13; } }
      { const int blk = lane + 64; if (blk == 127) s1 = true; else { const float x = im[blk]; int rank = 0; for (int o2 = 1; o2 <= 126; ++o2) { const float y = im[o2]; rank += (y > x || (y == x && o2 < blk)) ? 1 : 0; } s1 = rank < 13; } }
      const unsigned long long b0 = __ballot(s0), b1 = __ballot(s1);
      if (lane == 0) { selw[2 * wave] = b0; selw[2 * wave + 1] = b1; } }
    __syncthreads();
    f32x16 os[2]; zero_o(os); float ms = -1e30f, ls = 0.f;
    { unsigned long long u0 = 0ull, u1 = 0ull;
#pragma unroll
      for (int s8 = 0; s8 < 8; ++s8) { u0 |= selw[2 * s8]; u1 |= selw[2 * s8 + 1]; }
      const unsigned long long my0 = selw[2 * st], my1 = selw[2 * st + 1];
      int cnt = 0;
      for (int dup8 = 0; dup8 < ((DBG_DUP & 8) ? 2 : 1); ++dup8)
      for (int half = 0; half < 3; ++half) { unsigned long long bits = half == 0 ? u0 : (half == 1 ? u1 : 1ull);
          while (bits) { const int bi = __builtin_ctzll(bits); bits &= bits - 1; const int blk = 64 * half + bi;
              if ((cnt++ & 7) != wave) continue;
              const float* rows = (blk < 128) ? cn + ((size_t)pt[blk >> 1] * 128 + (blk & 1) * 64) * 512 : a.out + OFF_NSA + ((size_t)(MP + sb * 8)) * 512;
              const bool mine = (dup8 == 0) && (half == 0 ? ((my0 >> bi) & 1ull) : (half == 1 ? ((my1 >> bi) & 1ull) : true));
              const int kb = 64 * blk;
              sm_tile_f32(os, ms, ls, rows + 256 + g * 64, rows + 384 + g * 64, 512, blk < 128 ? 63 : 7, Vs, qf, lane, [&](int ki) { const int dist = t - (kb + ki); return (mine && dist >= 0) ? -slope2 * (float)dist : -INFINITY; }); } } }
    ls += __shfl_xor(ls, 32);
    sm_put_stats(stt, 1, wave, lane, ms, ls);
    __syncthreads();
    { float M, L; sm_get_ML(stt, 1, r, M, L); sm_put(mbuf + wave * 2048, os, (L > 0.f) ? g1 * fexp2(ms - M) / L : 0.f, lane); }
    __syncthreads();
    { f32x4 sum = *(const LAS f32x4*)(acc + tid * 4);
#pragma unroll
      for (int w = 0; w < 8; ++w) sum += *(const LAS f32x4*)(mbuf + w * 2048 + tid * 4);
      *(LAS f32x4*)(acc + tid * 4) = sum; }
    __syncthreads();
    { const int r2 = tid >> 4, d4 = (tid & 15) * 4; const size_t m2 = (size_t)MP + sb * 8 + (r2 >> 2); const int hq2 = 4 * g + (r2 & 3);
      const v2u gb = *(const GAS v2u*)((const bf16*)(ws + WS_GB) + m2 * 512 + hq2 * 64 + d4);
      v2u w; w.x = cvtpk(acc[(d4 + 0) * 32 + r2] * bf_lo(gb.x), acc[(d4 + 1) * 32 + r2] * bf_hi(gb.x)); w.y = cvtpk(acc[(d4 + 2) * 32 + r2] * bf_lo(gb.y), acc[(d4 + 3) * 32 + r2] * bf_hi(gb.y));
      *(GAS v2u*)((bf16*)(ws + WS_U) + m2 * 1024 + 512 + hq2 * 64 + d4) = w; }
}

#ifndef MK_N_LAUNCHES
#define MK_N_LAUNCHES 1
#endif
#ifndef DBG_STAGE
#define DBG_STAGE 0
#endif
constexpr int N_PHASES = 6;
constexpr int N_L2S = 64, N_SBS = 32, N_WINP = 256, N_SBP = 512, N_NP = 512, N_NS = 64;

__global__ void __launch_bounds__(NTHR, 2) mk_fwd(Args a) {
    extern __shared__ __attribute__((aligned(16))) unsigned char lds_raw[];
    LAS unsigned char* lds = (LAS unsigned char*)lds_raw;
    const int tid0 = threadIdx.x;
    const int G = gridDim.x, bx = blockIdx.x, vcu = (G % 8 == 0) ? (bx % 8) * (G / 8) + bx / 8 : bx;
    unsigned char* ws = a.ws; gu32* ctl = (gu32*)(ws + WS_CTL);
    for (int u = tid0; u < (LDS_BYTES - LDSCTL_OFF) / 4; u += NTHR) ((LAS unsigned*)(lds + LDSCTL_OFF))[u] = 0u;
    __syncthreads();
    volatile LAS unsigned* MISC = (volatile LAS unsigned*)(lds + MISC_OFF);
    volatile LAS int* qslot = (volatile LAS int*)(lds + LDSCTL_OFF + 64);
    const int lo = a.ph_lo, hi = a.ph_hi; const bool multi = (hi - lo) > 1;
    XcdBarrier bar; bar.bar = (unsigned*)(ctl + CW_BAR); bar.x = 0; bar.st = nullptr;
    if (multi) bar = xcd_barrier_post((unsigned*)(ctl + CW_BAR), MISC + 8);
#ifdef DBG_PHMASK
#define IN(k) (((DBG_PHMASK >> (k)) & 1) && lo <= (k) && (k) < hi)
#else
#define IN(k) (lo <= (k) && (k) < hi)
#endif
#define SEAM(k) do { if (IN(k) && IN((k) + 1)) xcd_barrier(bar); } while (0)
#ifndef DBG_REP
#define DBG_REP (-1)
#endif
#define NREP(k) ((DBG_REP == (k)) ? 2 : 1)
#define REPSEAM(k) do { if (rep + 1 < NREP(k)) xcd_barrier(bar); } while (0)

    if (IN(0)) _Pragma("unroll") for (int rep = 0; rep < NREP(0); ++rep) { int tid = tid0; asm volatile("" : "+v"(tid)); p0_prologue(a, lds, tid, tid & 63, __builtin_amdgcn_readfirstlane(tid >> 6), vcu, G, rep); REPSEAM(0); }
    SEAM(0);

    if (IN(1)) { _Pragma("unroll") for (int rep = 0; rep < NREP(1); ++rep) {
#ifndef DBG_P1MASK
#define DBG_P1MASK 7
#endif
        const int xcc = (int)xb_xcc_id(); volatile LAS int* gslot = (volatile LAS int*)(lds + LDSCTL_OFF + 128);
#ifndef DBG_P1REPM
#define DBG_P1REPM 7
#endif
#define P1ON(bit) ((DBG_P1MASK & (bit)) && (rep == 0 || (DBG_P1REPM & (bit))))
        const int ngb = G < 128 ? G : 128;
        if (P1ON(1) && bx < ngb) {
#pragma unroll 1
            for (int L = bx; L < 256; L += ngb) {
                pg8::EpiHidB128 E{(bf16*)(ws + WS_HIDS), (const float*)(ws + WS_CTL) + CW_BIAS + (L >> 7) * 256};
                pg8::gemm_unit_gather128(lds, (const float*)a.in[IN_CNSA], (const int*)a.in[IN_PT], (const bf16*)(ws + WS_W1T), L, E); } }
        if (P1ON(4)) { pg8::Gemm g{(const bf16*)(ws + WS_HBF), (const bf16*)(ws + WS_WIN_T), MT, NG1, 1024};
          pg8::HybridOrder S; S.q = (unsigned*)(ctl + CW_Q + 64 * 16 + 4096 * rep); S.slot = gslot; S.nM = MT / 256; S.nN = NG1 / 256; S.nwg = S.nM * S.nN; S.dyn0 = 640;
          if (G != 256) { S.ns = 0; S.l0 = 0; S.lstride = 0; S.dyn0 = 0; }
          else if (bx >= 128) { S.ns = 4; S.l0 = bx - 128; S.lstride = 128; } else { S.ns = 1; S.l0 = 512 + bx; S.lstride = 0; }
#ifdef DBG_G1STATIC
          if (rep == 1) { S.ns = 4; S.l0 = bx; S.lstride = 256; S.dyn0 = 975; if (bx + 768 >= 975) S.ns = 3; }
#endif
          pg8::EpiG1 E{a.out, (const float*)(ws + WS_RSTD), (bf16*)(ws + WS_QA), (bf16*)(ws + WS_KA), (bf16*)(ws + WS_VA), (bf16*)(ws + WS_GA), (bf16*)(ws + WS_QB), (bf16*)(ws + WS_GB),
                       (bf16*)(ws + WS_KSEL), (bf16*)(ws + WS_VSEL), (bf16*)(ws + WS_KWIN), (bf16*)(ws + WS_VWIN), (bf16*)(ws + WS_ACMP_P),
                       (const float*)a.in[IN_QG], (const float*)a.in[IN_KSG], (const float*)a.in[IN_KWG], (const float*)a.in[IN_PEK], (const float*)a.in[IN_PEV]};
#ifdef DBG_NOEPI
#if DBG_NOEPI == 2
#ifdef DBG_TILECONTIG
          if (rep == 1) { pg8::EpiBf16<0> E0{(bf16*)(ws + WS_ACMP_S), 256, nullptr, 256, (size_t)65 * 65536, 1.f};
#else
          if (rep == 1) { pg8::EpiBf16<0> E0{(bf16*)(ws + WS_ACMP_S), NG1, nullptr, 0, 0, 1.f};
#endif
          pg8::gemm_phase<pg8::EpiBf16<0>, pg8::HybridOrder, PG8_ALIGN, PG8_SP2>(lds, g, S, E0); } else
#else
          if (rep == 1) { pg8::EpiNone E0; pg8::gemm_phase<pg8::EpiNone, pg8::HybridOrder, PG8_ALIGN, PG8_SP2>(lds, g, S, E0); } else
#endif
#endif
          pg8::gemm_phase<pg8::EpiG1, pg8::HybridOrder, PG8_ALIGN, PG8_SP2>(lds, g, S, E); }
        if (P1ON(2)) { pg8::Gemm g{(const bf16*)(ws + WS_PBF), (const bf16*)(ws + WS_WPLE_T), MT, 1024, 256}; pg8::XcdQueueOrder S; S.init(MT, 1024, (unsigned*)(ctl + CW_Q + 64 * 24 + 4096 * rep), gslot, xcc);
          pg8::EpiBf16<0> E{(bf16*)(ws + WS_T1), 1024, nullptr, 0, 0, 1.f};
          pg8::gemm_phase<pg8::EpiBf16<0>, pg8::XcdQueueOrder, PG8_ALIGN, PG8_SP2, true>(lds, g, S, E); }
        REPSEAM(1); }
        SEAM(1);
    }

    if (IN(2)) { _Pragma("unroll") for (int rep = 0; rep < NREP(2); ++rep) {
#if DBG_STAGE == 1
        { v4u z = {0u, 0u, 0u, 0u}; for (size_t i = (size_t)bx * NTHR + tid0; i < (size_t)MT * 1024 / 8; i += (size_t)G * NTHR) *(GAS v4u*)((bf16*)(ws + WS_U) + i * 8) = z; }
#else
        if (bx < 16) {
            const int slot = bx >> 3, b = bx & 7;
            { pg8::EpiHidB128 E{(bf16*)(ws + WS_HIDP), (const float*)(ws + WS_CTL) + CW_BIAS + 1024  };
              pg8::gemm_unit_bf16_128(lds, (const bf16*)(ws + WS_ACMP_P) + (size_t)bx * 128 * 2048, (const bf16*)(ws + WS_W1T), slot, bx * 128, E); }
            VM_WAIT(); __syncthreads();
            int t2 = tid0; asm volatile("" : "+v"(t2)); const int ln = t2 & 63, wv = __builtin_amdgcn_readfirstlane(t2 >> 6);
            if (wv < 4) { const int g = wv >> 1, chf = wv & 1;
                const bf16* hid0 = (const bf16*)(ws + WS_HIDP) + ((size_t)slot * 1024 + (size_t)(b * 64 + 32 * chf) * 2 + g) * 256;
                unsigned char* dst = ws + (slot ? WS_VCP : WS_KCP) + ((size_t)((b * 2 + g) * 64 + 32 * chf)) * 128;
                l2_wave<false>((const bf16*)(ws + WS_W2T) + slot * 64 * 256, hid0, 512, slot ? nullptr : (const float*)a.in[IN_KCG], dst, 128, ln); } }
        for (;;) {
            int it = next_item(ctl + CW_Q + 128 * rep, qslot);
            int tid = tid0; asm volatile("" : "+v"(tid)); const int lane = tid & 63, wave = __builtin_amdgcn_readfirstlane(tid >> 6);
            if (it >= N_NS + N_SBS + N_WINP + N_SBP) break;
#ifndef DBG_IM
#define DBG_IM 63
#endif
#ifndef DBG_REPIM
#define DBG_REPIM 63
#endif
#define IMON(bit) ((DBG_IM & (bit)) && (rep == 0 || (DBG_REPIM & (bit))))
            if (it < N_NS) { if (IMON(32)) { item_l2_sample(a, it, lane, wave); if (DBG_DUP & 1) { VM_WAIT(); item_l2_sample(a, it, lane, wave); } VM_WAIT(); __syncthreads(); item_nsa_sample(a, lds, it, tid, lane, wave); if (DBG_DUP & 16) { __syncthreads(); item_nsa_sample(a, lds, it, tid, lane, wave); } } continue; } it -= N_NS;
            if (it < N_SBS) { if (IMON(2)) item_sb_sample(a, lds, it, lane, wave); continue; } it -= N_SBS;
            if (it < N_WINP) { if (IMON(4)) item_win_prompt(a, lds, it, tid, lane, wave); continue; } it -= N_WINP;
            if (IMON(8)) item_sb_prompt(a, lds, it, lane, wave);
        }
#endif
        REPSEAM(2); }
        SEAM(2);
    }

    if (IN(3)) { _Pragma("unroll") for (int rep = 0; rep < NREP(3); ++rep) {
#if DBG_STAGE != 1
        for (;;) {
            int it = next_item(ctl + CW_Q + 64 + 128 * rep, qslot);
            int tid = tid0; asm volatile("" : "+v"(tid)); const int lane = tid & 63, wave = __builtin_amdgcn_readfirstlane(tid >> 6);
            if (it >= N_NP + 8) break;
            gu32* dep1 = ctl + CW_Q + 64 * 41;
            if (it < 4 || (it >= 300 && it < 304)) {
                const bool second = it >= 300; const int pn = second ? it - 300 : it;
                if (rep == 0) {
                if (!second) { pg8::Gemm g{(const bf16*)(ws + WS_U), (const bf16*)(ws + WS_WOUT_T), MT, 1024, 1024}; pg8::OneUnit S{64, pn};
                    pg8::EpiOut E{(const bf16*)(ws + WS_HBF), (bf16*)(ws + WS_HB2)};
                    pg8::gemm_phase<pg8::EpiOut, pg8::OneUnit, PG8_ALIGN, PG8_SP2>(lds, g, S, E);
                    VM_WAIT(); __syncthreads();
                    if (tid == 0) { __builtin_amdgcn_fence(__ATOMIC_RELEASE, "agent"); VM_WAIT(); (void)__hip_atomic_fetch_add(dep1, 1u, RLX_AGENT); } }
                else {
                    if (tid == 0) { unsigned sp = 0; while (__hip_atomic_load(dep1, RLX_AGENT) < 4u) { __builtin_amdgcn_s_sleep(2); if (++sp > (1u << 22)) break; }
                        __builtin_amdgcn_fence(__ATOMIC_ACQUIRE, "agent"); VM_WAIT(); }
                    __syncthreads();
                    pg8::Gemm g{(const bf16*)(ws + WS_HB2), (const bf16*)(ws + WS_WG_T), MT, 1024, 1024}; pg8::OneUnit S{64, pn};
                    pg8::EpiFinal E{a.out, (const bf16*)(ws + WS_T1), (const bf16*)(ws + WS_HB2)};
                    pg8::gemm_phase<pg8::EpiFinal, pg8::OneUnit, PG8_ALIGN, PG8_SP2>(lds, g, S, E); }
                }
                continue; }
            it -= (it >= 304) ? 8 : 4;
            if (IMON(16)) item_nsa_prompt(a, lds, it, tid, lane, wave);
        }
#endif
        REPSEAM(3); }
        SEAM(3);
    }

    if (IN(4)) { _Pragma("unroll") for (int rep = 0; rep < NREP(4); ++rep) {
        pg8::Gemm g{(const bf16*)(ws + WS_U), (const bf16*)(ws + WS_WOUT_T), MP, 1024, 1024}; pg8::StaticOrder S; S.init(MP, 1024, G, bx);
        pg8::EpiOut E{(const bf16*)(ws + WS_HBF), (bf16*)(ws + WS_HB2)};
        pg8::gemm_phase<pg8::EpiOut, pg8::StaticOrder, PG8_ALIGN, PG8_SP2>(lds, g, S, E);
        REPSEAM(4); }
        SEAM(4);
    }
    if (IN(5)) {
        pg8::Gemm g{(const bf16*)(ws + WS_HB2), (const bf16*)(ws + WS_WG_T), MP, 1024, 1024}; pg8::StaticOrder S; S.init(MP, 1024, G, bx);
        pg8::EpiFinal E{a.out, (const bf16*)(ws + WS_T1), (const bf16*)(ws + WS_HB2)};
        pg8::gemm_phase<pg8::EpiFinal, pg8::StaticOrder, PG8_ALIGN, PG8_SP2>(lds, g, S, E);
    }
#undef IN
#undef SEAM
}

extern "C" void kernel_launch(void* const* d_in, const int* in_sizes, int n_in, void* d_out, int out_size, void* d_ws, size_t ws_size, hipStream_t stream) {
    static int grid = 0;
    if (grid == 0) {
        if (n_in != N_INPUTS || (size_t)out_size != OUT_TOTAL || ws_size < WS_END) { fprintf(stderr, "kernel_launch: unexpected shapes (n_in %d, out %d, ws %zu); nothing launched\n", n_in, out_size, ws_size); grid = -1; return; }
        int dev = 0, cus = 0;
        if (hipGetDevice(&dev) != hipSuccess || hipDeviceGetAttribute(&cus, hipDeviceAttributeMultiprocessorCount, dev) != hipSuccess) { grid = -1; return; }
        if (hipFuncSetAttribute((const void*)mk_fwd, hipFuncAttributeMaxDynamicSharedMemorySize, LDS_BYTES) != hipSuccess) { fprintf(stderr, "kernel_launch: hipFuncSetAttribute failed\n"); grid = -1; return; }
        int per_cu = 0;
        if (hipOccupancyMaxActiveBlocksPerMultiprocessor(&per_cu, (const void*)mk_fwd, NTHR, LDS_BYTES) != hipSuccess || per_cu < 1) { fprintf(stderr, "kernel_launch: occupancy query says %d\n", per_cu); per_cu = 1; }
        (void)hipGetLastError();
        grid = cus;
    }
    if (grid < 0) return;
    if (hipMemsetAsync((char*)d_ws + WS_CTL, 0, CTL_ZERO_BYTES, stream) != hipSuccess) { fprintf(stderr, "kernel_launch: memset failed\n"); return; }
    Args a{};
    for (int i = 0; i < N_INPUTS; ++i) a.in[i] = d_in[i];
    a.out = (float*)d_out; a.ws = (unsigned char*)d_ws;
#if MK_N_LAUNCHES == 1
    a.ph_lo = 0; a.ph_hi = N_PHASES;
    hipLaunchKernelGGL(mk_fwd, dim3(grid), dim3(NTHR), LDS_BYTES, stream, a);
#else
    for (int p = 0; p < N_PHASES; ++p) { a.ph_lo = p; a.ph_hi = p + 1; hipLaunchKernelGGL(mk_fwd, dim3(grid), dim3(NTHR), LDS_BYTES, stream, a); }
#endif
    const hipError_t le = hipPeekAtLastError();
    if (le != hipSuccess) fprintf(stderr, "kernel_launch: launch failed: %s\n", hipGetErrorName(le));
}
```

```cpp
#include <hip/hip_runtime.h>
#include <cstdio>
#include <cstdint>
namespace pg8 {
#define PG8_LAS __attribute__((address_space(3)))
typedef unsigned short bf16_t;
typedef short bf16x8 __attribute__((ext_vector_type(8)));
typedef float f32x4 __attribute__((ext_vector_type(4)));
typedef unsigned u32x4 __attribute__((ext_vector_type(4)));
constexpr int BM = 256, BK = 64, HALF = 128, HTB = HALF * BK * 2  , STAGE_BYTES = 8 * HTB, NXCD = 8, WGM = 8;

__host__ __device__ __forceinline__ int lds_byte(int r, int c) { const int st = (r >> 4) * 2 + (c >> 5), rr = r & 15, cc = c & 31, ob = rr * 64 + cc * 2; return st * 1024 + (ob ^ (((ob >> 9) & 1) << 5)); }
__host__ __device__ __forceinline__ void stage_rc(int b, int& R, int& C) { const int st = b / 1024, sb = b % 1024, swz = sb ^ (((sb >> 9) & 1) << 5); R = (st >> 1) * 16 + swz / 64; C = (st & 1) * 32 + (swz % 64) / 2; }
__host__ __device__ __forceinline__ int perm32(int rho) { const int n = rho >> 4, i = rho & 15; return 8 * (i >> 2) + 4 * n + (i & 3); }

struct Unit { int pm, pn; };
struct Gemm { const bf16_t* A; const bf16_t* Bt; int M, N, K; };

struct StaticOrder {
    int nM, nN, nwg, G, c;
    __host__ __device__ void init(int M, int N, int G_, int c_) { nM = M / BM; nN = N / BM; nwg = nM * nN; G = G_; c = c_; }
    __host__ __device__ bool next(int i, Unit& u) const {
        const long L = (long)i * G + c; if (L >= nwg) return false;
        int wgid = (int)L; { const int q = nwg / NXCD, r = nwg % NXCD, xcd = wgid % NXCD, off = wgid / NXCD; wgid = (xcd < r ? xcd * (q + 1) : r * (q + 1) + (xcd - r) * q) + off; }
        const int nig = WGM * nN, gid = wgid / nig, fm = gid * WGM, gsz = (nM - fm) < WGM ? (nM - fm) : WGM;
        u.pm = fm + ((wgid % nig) % gsz); u.pn = (wgid % nig) / gsz; return true;
    }
    __device__ __forceinline__ void a_ready(const Unit&) const {}
    __device__ __forceinline__ void done(const Unit&) const {}
};

__device__ __forceinline__ unsigned cvt_pk_bf16(float lo, float hi) { unsigned r; asm volatile("v_cvt_pk_bf16_f32 %0, %1, %2" : "=v"(r) : "v"(lo), "v"(hi)); return r; }
typedef float f32x2 __attribute__((ext_vector_type(2)));
__device__ __forceinline__ f32x2 gelu_pk(f32x2 v) {
    const f32x2 av = __builtin_elementwise_abs(v), d = av * 0.2316418882f + 1.0f;
    f32x2 t; t.x = __builtin_amdgcn_rcpf(d.x); t.y = __builtin_amdgcn_rcpf(d.y);
    f32x2 q = t * 0.5307027145f + (-0.7265760135f); q = q * t + 0.7107068705f; q = q * t + (-0.142248368f); q = q * t + 0.127414796f; q = q * t;
    const f32x2 s = (v * v) * (-0.72134752044f);
    f32x2 e; e.x = __builtin_amdgcn_exp2f(s.x); e.y = __builtin_amdgcn_exp2f(s.y);
    const f32x2 m = v * (q * e), r = v - m;
    f32x2 o; o.x = v.x < 0.f ? m.x : r.x; o.y = v.y < 0.f ? m.y : r.y; return o;
}

template <int ACT  > struct EpiBf16 {
    static constexpr bool PERM = true, AFTER_DRAIN = false; static_assert(ACT == 0 || ACT == 1, "EpiBf16: ACT is 0 (none) or 1 (gelu_pk)");
    bf16_t* O; int ldc; const float* bias; int split_cols; size_t split_stride; float scale0;
    __device__ __forceinline__ void operator()(const f32x4 (&acc)[2][2][4][2], const Unit& u, int wr, int wc, int fr_, int fq_) const {
        int fr = fr_, fq = fq_; asm volatile("" : "+v"(fr), "+v"(fq));
        const int row0 = u.pm * BM + wr * 64 + fr; int colt = u.pn * BM; bf16_t* base = O;
        float sc = 1.f; if (split_cols) { const int t = colt / split_cols; base += (size_t)t * split_stride; colt -= t * split_cols; if (t == 0) sc = scale0; }
        const int col0 = colt + wc * 32 + 8 * fq, bcol0 = u.pn * BM + wc * 32 + 8 * fq;
        f32x4 bv[2][2];
#pragma unroll
        for (int bj = 0; bj < 2; ++bj)
#pragma unroll
            for (int n = 0; n < 2; ++n) bv[bj][n] = bias ? *(const f32x4*)(bias + bcol0 + bj * HALF + 4 * n) : (f32x4){0.f, 0.f, 0.f, 0.f};
#pragma unroll
        for (int ai = 0; ai < 2; ++ai)
#pragma unroll
            for (int m = 0; m < 4; ++m) { bf16_t* rowp = base + (size_t)(row0 + ai * HALF + m * 16) * ldc + col0;
#pragma unroll
                for (int bj = 0; bj < 2; ++bj) { f32x4 v0 = acc[ai][bj][m][0] + bv[bj][0], v1 = acc[ai][bj][m][1] + bv[bj][1];
                    if (ACT == 1) { f32x2 a = gelu_pk((f32x2){v0[0], v0[1]}), b = gelu_pk((f32x2){v0[2], v0[3]}), c = gelu_pk((f32x2){v1[0], v1[1]}), d = gelu_pk((f32x2){v1[2], v1[3]});
                        v0 = (f32x4){a.x, a.y, b.x, b.y}; v1 = (f32x4){c.x, c.y, d.x, d.y}; }
                    v0 = v0 * sc; v1 = v1 * sc; u32x4 w; w.x = cvt_pk_bf16(v0[0], v0[1]); w.y = cvt_pk_bf16(v0[2], v0[3]); w.z = cvt_pk_bf16(v1[0], v1[1]); w.w = cvt_pk_bf16(v1[2], v1[3]);
                    *(u32x4*)(rowp + bj * HALF) = w; } }
    }
};

template <class Epi, class Sched, bool ALIGN_EPI = false, bool SP2 = false, bool OPAQUE_K = false>
__device__ __forceinline__ void gemm_phase(PG8_LAS unsigned char* lds, const Gemm g, const Sched& S, const Epi& E) {
    int tid_ = threadIdx.x;
#ifndef PG8_NOLAUNDER
    asm volatile("" : "+v"(tid_));
#endif
    const int tid = tid_, wid = __builtin_amdgcn_readfirstlane(tid >> 6), lane = tid & 63, wr = wid >> 2, wc = wid & 3, fr = lane & 15, fq = lane >> 4;
    int K_ = g.K; if (OPAQUE_K) asm volatile("" : "+s"(K_));
    const int K = K_, nt = K / BK;
    unsigned voffA[2], voffB[2];
#pragma unroll
    for (int i = 0; i < 2; ++i) { int R, C; stage_rc(tid * 16 + i * 8192, R, C); const int Rb = Epi::PERM ? ((R & ~31) + perm32(R & 31)) : R;
        voffA[i] = (unsigned)(R * K + C) * 2u; voffB[i] = (unsigned)(Rb * K + C) * 2u; }
    const size_t kstep = (size_t)(BK * 2);
    const size_t hstep = (size_t)HALF * K * 2;
    const size_t tstep = 2 * hstep;
    const unsigned ldsw = (unsigned)wid * 1024u;
    const int aoff = lds_byte(wr * 64 + fr, fq * 8), boff = lds_byte(wc * 32 + fr, fq * 8);
#define PG8_SA(b, h) (((b) * 2 + (h)) * HTB)
#define PG8_SB(b, h) ((4 + (b) * 2 + (h)) * HTB)
#define PG8_STAGE(bufoff, gbase, voff) do { _Pragma("unroll") for (int _i = 0; _i < 2; ++_i) \
        __builtin_amdgcn_global_load_lds((const unsigned*)((const char*)(gbase) + (voff)[_i]), (PG8_LAS unsigned*)(lds + (bufoff) + ldsw + _i * 8192), 16, 0, 0); } while (0)
#define PG8_LDA(dst, b, h) do { _Pragma("unroll") for (int m = 0; m < 4; ++m) _Pragma("unroll") for (int k = 0; k < 2; ++k) dst[m][k] = *(const PG8_LAS bf16x8*)(lds + PG8_SA(b, h) + aoff + m * 2048 + k * 1024); } while (0)
#define PG8_LDB(dst, b, h) do { _Pragma("unroll") for (int n = 0; n < 2; ++n) _Pragma("unroll") for (int k = 0; k < 2; ++k) dst[n][k] = *(const PG8_LAS bf16x8*)(lds + PG8_SB(b, h) + boff + n * 2048 + k * 1024); } while (0)
#define PG8_MMA(ai, bj, At, Bt) do { __builtin_amdgcn_s_setprio(1); _Pragma("unroll") for (int m = 0; m < 4; ++m) _Pragma("unroll") for (int n = 0; n < 2; ++n) _Pragma("unroll") for (int k = 0; k < 2; ++k) \
        acc[ai][bj][m][n] = __builtin_amdgcn_mfma_f32_16x16x32_bf16(Bt[n][k], At[m][k], acc[ai][bj][m][n], 0, 0, 0); __builtin_amdgcn_s_setprio(0); } while (0)
#define PG8_WAIT_V(n) asm volatile("s_waitcnt vmcnt(" #n ")" ::: "memory")
#define PG8_WAIT_L(n) asm volatile("s_waitcnt lgkmcnt(" #n ")" ::: "memory")
#define PG8_BAR __builtin_amdgcn_s_barrier()
#define PG8_SCHED __builtin_amdgcn_sched_barrier(0)
    Unit cur, nxt; int ui = 0;
    if (!S.next(0, cur)) return;
    f32x4 acc[2][2][4][2];
#pragma unroll
    for (int a = 0; a < 2; ++a)
#pragma unroll
        for (int b = 0; b < 2; ++b)
#pragma unroll
            for (int m = 0; m < 4; ++m)
#pragma unroll
                for (int n = 0; n < 2; ++n) acc[a][b][m][n] = (f32x4){0.f, 0.f, 0.f, 0.f};
    bf16x8 At[4][2], B0[2][2], B1[2][2];
    const char* cA = (const char*)g.A + (size_t)cur.pm * tstep; const char* cB = (const char*)g.Bt + (size_t)cur.pn * tstep;
    S.a_ready(cur);
    if constexpr (SP2) {
        PG8_STAGE(PG8_SB(0, 0), cB, voffB); PG8_STAGE(PG8_SB(0, 1), cB + hstep, voffB); PG8_STAGE(PG8_SA(0, 0), cA, voffA); PG8_STAGE(PG8_SA(0, 1), cA + hstep, voffA);
        if (wr == 1) PG8_BAR;
        PG8_WAIT_V(2); PG8_BAR;
        PG8_STAGE(PG8_SB(1, 0), cB + kstep, voffB); PG8_STAGE(PG8_SA(1, 0), cA + kstep, voffA); PG8_STAGE(PG8_SB(1, 1), cB + hstep + kstep, voffB);
        PG8_WAIT_V(6); PG8_BAR;
    } else {
        PG8_STAGE(PG8_SB(0, 0), cB, voffB); PG8_STAGE(PG8_SA(0, 0), cA, voffA); PG8_STAGE(PG8_SB(0, 1), cB + hstep, voffB); PG8_STAGE(PG8_SA(0, 1), cA + hstep, voffA);
        if (wr == 1) PG8_BAR;
        PG8_WAIT_V(4); PG8_BAR;
        PG8_STAGE(PG8_SB(1, 0), cB + kstep, voffB); PG8_STAGE(PG8_SA(1, 0), cA + kstep, voffA); PG8_STAGE(PG8_SB(1, 1), cB + hstep + kstep, voffB);
        PG8_WAIT_V(6); PG8_BAR;
    }
    for (;;) {
        const bool has_next = S.next(ui + 1, nxt);
        const char* nA = has_next ? (const char*)g.A + (size_t)nxt.pm * tstep : cA; const char* nB = has_next ? (const char*)g.Bt + (size_t)nxt.pn * tstep : cB;
        for (int t = 0; t < nt; t += 2) {
            const bool last = (t == nt - 2);
            const char* a1 = cA + (size_t)(t + 1) * kstep;
            const char* a2 = last ? nA : cA + (size_t)(t + 2) * kstep; const char* b2 = last ? nB : cB + (size_t)(t + 2) * kstep;
            const char* a3 = a2 + kstep; const char* b3 = b2 + kstep;
            if (last && has_next) S.a_ready(nxt);
            if constexpr (SP2) {
            PG8_LDB(B0, 0, 0); PG8_LDB(B1, 0, 1); PG8_SCHED; PG8_LDA(At, 0, 0); PG8_STAGE(PG8_SA(1, 1), a1 + hstep, voffA);
            PG8_WAIT_V(8); PG8_WAIT_L(0); PG8_BAR; PG8_MMA(0, 0, At, B0); PG8_MMA(0, 1, At, B1); PG8_BAR; PG8_SCHED;
            PG8_LDA(At, 0, 1); PG8_STAGE(PG8_SB(0, 0), b2, voffB); PG8_STAGE(PG8_SB(0, 1), b2 + hstep, voffB); PG8_STAGE(PG8_SA(0, 0), a2, voffA);
            PG8_WAIT_V(8); PG8_WAIT_L(0); PG8_BAR; PG8_MMA(1, 0, At, B0); PG8_MMA(1, 1, At, B1); PG8_BAR; PG8_SCHED;
            PG8_LDB(B0, 1, 0); PG8_LDB(B1, 1, 1); PG8_SCHED; PG8_LDA(At, 1, 0); PG8_STAGE(PG8_SA(0, 1), a2 + hstep, voffA);
            PG8_WAIT_V(8); PG8_WAIT_L(0); PG8_BAR; PG8_MMA(0, 0, At, B0); PG8_MMA(0, 1, At, B1); PG8_BAR; PG8_SCHED;
            PG8_LDA(At, 1, 1); PG8_STAGE(PG8_SB(1, 0), b3, voffB); PG8_STAGE(PG8_SB(1, 1), b3 + hstep, voffB); PG8_STAGE(PG8_SA(1, 0), a3, voffA);
            PG8_WAIT_V(8); PG8_WAIT_L(0); PG8_BAR; PG8_MMA(1, 0, At, B0); PG8_MMA(1, 1, At, B1); PG8_BAR; PG8_SCHED;
            } else {
            PG8_LDB(B0, 0, 0); PG8_SCHED; PG8_LDA(At, 0, 0); PG8_STAGE(PG8_SA(1, 1), a1 + hstep, voffA);
            PG8_WAIT_L(8); PG8_BAR; PG8_WAIT_L(0); PG8_MMA(0, 0, At, B0); PG8_BAR; PG8_SCHED;
            PG8_LDB(B1, 0, 1); PG8_STAGE(PG8_SB(0, 0), b2, voffB);
            PG8_BAR; PG8_WAIT_L(0); PG8_MMA(0, 1, At, B1); PG8_BAR;
            PG8_LDA(At, 0, 1); PG8_STAGE(PG8_SA(0, 0), a2, voffA);
            PG8_BAR; PG8_WAIT_L(0); PG8_MMA(1, 0, At, B0); PG8_BAR; PG8_SCHED;
            PG8_STAGE(PG8_SB(0, 1), b2 + hstep, voffB);
            PG8_WAIT_V(6); PG8_BAR; PG8_MMA(1, 1, At, B1); PG8_BAR;
            PG8_LDB(B0, 1, 0); PG8_SCHED; PG8_LDA(At, 1, 0); PG8_STAGE(PG8_SA(0, 1), a2 + hstep, voffA);
            PG8_WAIT_L(8); PG8_BAR; PG8_WAIT_L(0); PG8_MMA(0, 0, At, B0); PG8_BAR; PG8_SCHED;
            PG8_LDB(B1, 1, 1); PG8_STAGE(PG8_SB(1, 0), b3, voffB);
            PG8_BAR; PG8_WAIT_L(0); PG8_MMA(0, 1, At, B1); PG8_BAR;
            PG8_LDA(At, 1, 1); PG8_STAGE(PG8_SA(1, 0), a3, voffA);
            PG8_BAR; PG8_WAIT_L(0); PG8_MMA(1, 0, At, B0); PG8_BAR; PG8_SCHED;
            PG8_STAGE(PG8_SB(1, 1), b3 + hstep, voffB);
            PG8_WAIT_V(6); PG8_BAR; PG8_MMA(1, 1, At, B1); PG8_BAR;
            }
        }
        if constexpr (ALIGN_EPI) { if (wr == 0) PG8_BAR; }
        if constexpr (!Epi::AFTER_DRAIN) { E(acc, cur, wr, wc, fr, fq);
#ifdef DBG_EPI2
            E(acc, cur, wr, wc, fr, fq);
#endif
            S.done(cur); }
        if (!has_next) break;
#pragma unroll
        for (int a = 0; a < 2; ++a)
#pragma unroll
            for (int b = 0; b < 2; ++b)
#pragma unroll
                for (int m = 0; m < 4; ++m)
#pragma unroll
                    for (int n = 0; n < 2; ++n) acc[a][b][m][n] = (f32x4){0.f, 0.f, 0.f, 0.f};
        cur = nxt; cA = nA; cB = nB; ++ui;
        if constexpr (ALIGN_EPI) { if (wr == 1) PG8_BAR; }
    }
    PG8_WAIT_V(0);
    if constexpr (!ALIGN_EPI) { if (wr == 0) PG8_BAR; }
    PG8_BAR;
    if constexpr (Epi::AFTER_DRAIN) { E.fused(acc, cur, wr, wc, fr, fq, lds, wid, lane); S.done(cur); }
#undef PG8_SA
#undef PG8_SB
#undef PG8_STAGE
#undef PG8_LDA
#undef PG8_LDB
#undef PG8_MMA
#undef PG8_WAIT_V
#undef PG8_WAIT_L
#undef PG8_BAR
#undef PG8_SCHED
}
}


#ifndef PG8_SP2
#define PG8_SP2 true
#endif
#ifndef PG8_ALIGN
#define PG8_ALIGN true
#endif
#define GAS __attribute__((address_space(1)))
#define LAS __attribute__((address_space(3)))
typedef unsigned short bf16;
typedef unsigned v4u __attribute__((ext_vector_type(4)));
typedef float f32x4 __attribute__((ext_vector_type(4)));
typedef short bf16x8 __attribute__((ext_vector_type(8)));
typedef GAS unsigned gu32;
typedef GAS unsigned long long gu64;
#define RLX_AGENT __ATOMIC_RELAXED, __HIP_MEMORY_SCOPE_AGENT
#define LDS_WAIT() asm volatile("s_waitcnt lgkmcnt(0)" ::: "memory")
#define VM_WAIT() asm volatile("s_waitcnt vmcnt(0)" ::: "memory")
__device__ __forceinline__ unsigned long long rt() { return __builtin_amdgcn_s_memrealtime(); }
__device__ __forceinline__ unsigned f2bf(float f) { unsigned u = __builtin_bit_cast(unsigned, f); return (u + 0x7fffu + ((u >> 16) & 1u)) >> 16; }
__device__ __forceinline__ unsigned pk2(float lo, float hi) { return f2bf(lo) | (f2bf(hi) << 16); }

#define XB_TMO      128
#define XB_XCNT(j)  (256  + 64 * (j))
#define XB_XSUB(j)  (1280 + 64 * (j))
#define XB_XGEN(j)  (2304 + 64 * (j))
#define XB_TOP      3328
#define XB_TOPGEN   3392
#define XCD_BAR_WORDS 3456
#define XB_SPIN_CAP (1u << 18)

__device__ __forceinline__ unsigned xb_ld(unsigned* p)              { return __hip_atomic_load(p, __ATOMIC_RELAXED, __HIP_MEMORY_SCOPE_AGENT); }
__device__ __forceinline__ unsigned xb_add(unsigned* p, unsigned v) { return __hip_atomic_fetch_add(p, v, __ATOMIC_RELAXED, __HIP_MEMORY_SCOPE_AGENT); }
__device__ __forceinline__ unsigned xb_xcc_id() { return (unsigned)__builtin_amdgcn_s_getreg((3 << 11) | 20) & 0xFu; }
#define XB_SPIN(cond, bar) do { unsigned _sp = 0; while (cond) { __builtin_amdgcn_s_sleep(1); \
    if ((++_sp & 255u) == 0u) { if (xb_ld(&(bar)[XB_TMO])) break; if (_sp > XB_SPIN_CAP) { atomicAdd(&(bar)[XB_TMO], 1u); break; } } } } while (0)

struct XcdBarrier {
    unsigned* bar; unsigned x;
    volatile LAS unsigned* st;
};

__device__ __forceinline__ XcdBarrier xcd_barrier_post(unsigned* bar, volatile LAS unsigned* st) {
    XcdBarrier b; b.bar = bar; b.x = xb_xcc_id(); b.st = st;
    if (threadIdx.x == 0) (void)xb_add(&bar[XB_XCNT(b.x)], 1u);
    return b;
}
__device__ __forceinline__ void xcd_barrier_complete(unsigned* bar, unsigned x, unsigned& nloc, unsigned& nx) {
    const unsigned G = gridDim.x * gridDim.y * gridDim.z;
    unsigned sum, cnt, mine, sp = 0u;
    for (;;) {
        sum = 0u; cnt = 0u; mine = 0u;
#pragma unroll
        for (unsigned j = 0; j < 16; ++j) { const unsigned c = xb_ld(&bar[XB_XCNT(j)]); sum += c; cnt += (c > 0u) ? 1u : 0u; mine = (j == x) ? c : mine; }
        if (sum == G) break;
        __builtin_amdgcn_s_sleep(1);
        if ((++sp & 255u) == 0u) { if (xb_ld(&bar[XB_TMO])) break; if (sp > XB_SPIN_CAP) { atomicAdd(&bar[XB_TMO], 1u); break; } }
    }
    nloc = mine > 0u ? mine : 1u; nx = cnt > 0u ? cnt : 1u;
}

__device__ __forceinline__ void xcd_barrier(const XcdBarrier& b) {
    asm volatile("s_waitcnt vmcnt(0)" ::: "memory");
    __syncthreads();
    if (threadIdx.x == 0) {
        unsigned* bar = b.bar;
        __builtin_amdgcn_s_waitcnt(0);
        unsigned nloc = b.st[0], nx = b.st[1];
        if (nloc == 0u) { xcd_barrier_complete(bar, b.x, nloc, nx); b.st[0] = nloc; b.st[1] = nx; }
        const unsigned old = xb_add(&bar[XB_XSUB(b.x)], 1u);
        const unsigned gen = old / nloc;
        if (old + 1u == (gen + 1u) * nloc) {
            __builtin_amdgcn_fence(__ATOMIC_RELEASE, "agent");
            asm volatile("s_waitcnt vmcnt(0)" ::: "memory");
            const unsigned og = xb_add(&bar[XB_TOP], 1u);
            const unsigned tg = og / nx;
            if (og + 1u == (tg + 1u) * nx) xb_add(&bar[XB_TOPGEN], 1u);
            else XB_SPIN(xb_ld(&bar[XB_TOPGEN]) == tg, bar);
            __builtin_amdgcn_fence(__ATOMIC_ACQUIRE, "agent");
            xb_add(&bar[XB_XGEN(b.x)], 1u);
            asm volatile("s_waitcnt vmcnt(0)" ::: "memory");
        } else {
            XB_SPIN(xb_ld(&bar[XB_XGEN(b.x)]) == gen, bar);
            __builtin_amdgcn_fence(__ATOMIC_ACQUIRE, "agent");
            asm volatile("s_waitcnt vmcnt(0)" ::: "memory");
        }
    }
    __syncthreads();
}


constexpr int NWAVES = 8, NTHR = 512;
constexpr int MP = 16384, MS = 256, MT = 16640, DM = 1024, TP = 2048;
constexpr int NG1 = 3840, NIN = 3864;
constexpr float EPS = 1e-6f, LOG2E = 1.4426950408889634f, LN2 = 0.6931471805599453f;
constexpr size_t OFF_SB = 17039360, OFF_NSA = 34078720, OFF_WINP = 42598400, OFF_WINS = 43646976, OUT_TOTAL = 47841280;
enum { IN_XP = 0, IN_XS, IN_PP, IN_PS, IN_CSB, IN_CNSA, IN_SWIN, IN_PT, IN_NORMG, IN_WIN, IN_QG, IN_KCG, IN_KSG, IN_KWG, IN_PEK, IN_W1K, IN_W2K, IN_PEV, IN_W1V, IN_W2V, IN_WOUT, IN_WPLE, IN_WG, N_INPUTS };

constexpr size_t MiB = 1u << 20;
constexpr size_t WS_CTL = 0, CTL_ZERO_BYTES = 1 * MiB;
constexpr size_t WS_WIN_T = 2 * MiB, WS_W1T = 11 * MiB, WS_W2T = 13 * MiB, WS_WOUT_T = 14 * MiB, WS_WG_T = 16 * MiB, WS_WPLE_T = 18 * MiB;
constexpr size_t WS_RSTD = 19 * MiB, WS_BR = 20 * MiB, WS_HBF = 24 * MiB, WS_PBF = 58 * MiB;
constexpr size_t WS_QA = 68 * MiB, WS_KA = 86 * MiB, WS_VA = 104 * MiB, WS_GA = 122 * MiB, WS_QB = 140 * MiB, WS_GB = 158 * MiB;
constexpr size_t WS_KSEL = 176 * MiB, WS_VSEL = 182 * MiB, WS_KWIN = 188 * MiB, WS_VWIN = 194 * MiB;
constexpr size_t WS_ACMP_P = 200 * MiB, WS_HIDP = 208 * MiB, WS_HIDS = 210 * MiB, WS_KCS = 226 * MiB, WS_VCS = 228 * MiB;
constexpr size_t WS_OW = 232 * MiB, WS_U = 248 * MiB, WS_T1 = 282 * MiB, WS_HB2 = 316 * MiB, WS_ACMP_S = 352 * MiB, WS_END = 480 * MiB;
constexpr int CW_BAR = 4096;
constexpr int CW_Q = 16384;
constexpr int CW_PANEL = 32768;
constexpr int CW_PANEL2 = 40960;
constexpr int CW_BIAS = 65536;

constexpr int RING_BYTES = 131072, LDSCTL_OFF = RING_BYTES, MISC_OFF = LDSCTL_OFF + 320, LDS_BYTES = 147456;

typedef float f32x16 __attribute__((ext_vector_type(16)));
typedef short s16x4 __attribute__((ext_vector_type(4)));
typedef float f32x2_t __attribute__((ext_vector_type(2)));
typedef __bf16 bf16x2_t __attribute__((ext_vector_type(2)));
typedef unsigned v2u __attribute__((ext_vector_type(2)));
__device__ __forceinline__ unsigned cvtpk(float lo, float hi) { f32x2_t v = {lo, hi}; bf16x2_t b = __builtin_convertvector(v, bf16x2_t); return __builtin_bit_cast(unsigned, b); }
__device__ __forceinline__ float bf_lo(unsigned w) { return __builtin_bit_cast(float, w << 16); }
__device__ __forceinline__ float bf_hi(unsigned w) { return __builtin_bit_cast(float, w & 0xffff0000u); }
__device__ __forceinline__ float fexp2(float x) { return __builtin_amdgcn_exp2f(x); }
__device__ __forceinline__ float flog2(float x) { return __builtin_amdgcn_logf(x); }
__device__ __forceinline__ float frcp(float x) { return __builtin_amdgcn_rcpf(x); }
__device__ __forceinline__ float sigmoidf_(float x) { return frcp(1.f + fexp2(-x * LOG2E)); }
__device__ __forceinline__ float siluf_(float x) { return x * sigmoidf_(x); }
__device__ __forceinline__ float wave_sum(float v) {
#pragma unroll
    for (int o = 1; o < 64; o <<= 1) v += __shfl_xor(v, o);
    return v;
}
__device__ __forceinline__ float wave_max(float v) {
#pragma unroll
    for (int o = 1; o < 64; o <<= 1) v = fmaxf(v, __shfl_xor(v, o));
    return v;
}

struct Args { const void* in[N_INPUTS]; float* out; unsigned char* ws; int ph_lo, ph_hi; };

__device__ __forceinline__ void p0_transpose_item(const float* __restrict__ W, int ldw, int col0, const float* __restrict__ gsc, bf16* WT, int K, int drow0, int k0, LAS float* scr, int lane) {
#pragma unroll 16
    for (int i = 0; i < 32; ++i) { const int kk = 2 * i + (lane >> 5); float v = W[(size_t)(k0 + kk) * ldw + col0 + (lane & 31)]; if (gsc) v *= gsc[k0 + kk]; scr[kk * 33 + (lane & 31)] = v; }
    LDS_WAIT(); asm volatile("" ::: "memory");
    const int c = lane & 7;
#pragma unroll
    for (int j = 0; j < 4; ++j) { const int n = (lane >> 3) + 8 * j; const LAS float* s = scr + (8 * c) * 33 + n;
        v4u o; o.x = pk2(s[0 * 33], s[1 * 33]); o.y = pk2(s[2 * 33], s[3 * 33]); o.z = pk2(s[4 * 33], s[5 * 33]); o.w = pk2(s[6 * 33], s[7 * 33]);
        *(GAS v4u*)(WT + (size_t)(drow0 + n) * K + k0 + 8 * c) = o; }
    LDS_WAIT(); asm volatile("" ::: "memory");
}
__host__ __device__ __forceinline__ int g1_role(int pn) { return (int)((0xec9b7a15d483620ull >> (4 * pn)) & 15); }
__device__ __forceinline__ int g1_src_col(int n) { const int t = g1_role(n >> 8), gm = n & 255, lam = 64 * ((gm >> 5) & 3) + 32 * (gm >> 7) + (gm & 31); return (t < 13 ? t * 256 : 3352 + (t - 13) * 256) + lam; }

constexpr int WBR_OFF = 67584, WBR_PITCH = 2064;

__device__ __forceinline__ void p0_prologue(const Args& a, LAS unsigned char* lds, int tid, int lane, int wave, int vcu, int G, int rep = 0) {
    const int gw = vcu * NWAVES + wave, NGW = G * NWAVES;
    unsigned char* ws = a.ws;
    const float* w_in = (const float*)a.in[IN_WIN]; const float* norm_g = (const float*)a.in[IN_NORMG];
    { LAS unsigned char* wbr = lds + WBR_OFF;
      for (int i0 = 0; i0 < 48; i0 += 24) { float v[24], gk[24];
#pragma unroll
          for (int i = 0; i < 24; ++i) { const int idx = tid + NTHR * (i0 + i), k = idx / 24, c = idx - 24 * k; v[i] = w_in[(size_t)k * NIN + 3328 + c]; gk[i] = norm_g[k]; }
#pragma unroll
          for (int i = 0; i < 24; ++i) { const int idx = tid + NTHR * (i0 + i), k = idx / 24, c = idx - 24 * k; *(LAS unsigned short*)(wbr + c * WBR_PITCH + k * 2) = (unsigned short)f2bf(v[i] * gk[i]); } } }
    { LAS float* scr = (LAS float*)(lds + wave * 8448);
      constexpr int I0 = 16 * 120, I1 = 32 * 8, I3 = 4 * 2, I5 = 16 * 32, I7 = 4 * 32, NITEMS = I0 + 2 * I1 + 2 * I3 + 2 * I5 + I7;
      for (int it = gw; it < NITEMS; it += NGW) {
          int r = it;
          if (r < I0) { const int kb = r / 120, nb = r % 120; p0_transpose_item(w_in, NIN, g1_src_col(32 * nb), norm_g, (bf16*)(ws + WS_WIN_T), 1024, 32 * nb, 64 * kb, scr, lane); continue; } r -= I0;
          if (r < I1) { const int kb = r / 8, nb = r % 8; p0_transpose_item((const float*)a.in[IN_W1K], 256, 32 * nb, nullptr, (bf16*)(ws + WS_W1T), 2048, 32 * nb, 64 * kb, scr, lane); continue; } r -= I1;
          if (r < I1) { const int kb = r / 8, nb = r % 8; p0_transpose_item((const float*)a.in[IN_W1V], 256, 32 * nb, nullptr, (bf16*)(ws + WS_W1T), 2048, 256 + 32 * nb, 64 * kb, scr, lane); continue; } r -= I1;
          if (r < I3) { const int kb = r / 2, nb = r % 2; p0_transpose_item((const float*)a.in[IN_W2K], 64, 32 * nb, nullptr, (bf16*)(ws + WS_W2T), 256, 32 * nb, 64 * kb, scr, lane); continue; } r -= I3;
          if (r < I3) { const int kb = r / 2, nb = r % 2; p0_transpose_item((const float*)a.in[IN_W2V], 64, 32 * nb, nullptr, (bf16*)(ws + WS_W2T), 256, 64 + 32 * nb, 64 * kb, scr, lane); continue; } r -= I3;
          if (r < I5) { const int kb = r / 32, nb = r % 32; p0_transpose_item((const float*)a.in[IN_WOUT], 1024, 32 * nb, nullptr, (bf16*)(ws + WS_WOUT_T), 1024, 32 * nb, 64 * kb, scr, lane); continue; } r -= I5;
          if (r < I5) { const int kb = r / 32, nb = r % 32; p0_transpose_item((const float*)a.in[IN_WG], 1024, 32 * nb, nullptr, (bf16*)(ws + WS_WG_T), 1024, 32 * nb, 64 * kb, scr, lane); continue; } r -= I5;
          { const int kb = r / 32, nb = r % 32; p0_transpose_item((const float*)a.in[IN_WPLE], 1024, 32 * nb, nullptr, (bf16*)(ws + WS_WPLE_T), 256, 32 * nb, 64 * kb, scr, lane); }
      } }
    __syncthreads();
    { const float* xp = (const float*)a.in[IN_XP]; const float* xs = (const float*)a.in[IN_XS];
      bf16* hbf = (bf16*)(ws + WS_HBF); float* rstd = (float*)(ws + WS_RSTD); float* BR = (float*)(ws + WS_BR);
      const LAS unsigned char* wbr = lds + WBR_OFF;
      for (int rg = gw; rg < MT / 16; rg += NGW) {
          const int m = rg * 16 + (lane & 15), kq = lane >> 4;
          const float* xr = (m < MP) ? xp + (size_t)m * DM : xs + (size_t)(m - MP) * DM;
          f32x4 c0 = {0.f, 0.f, 0.f, 0.f}, c1 = {0.f, 0.f, 0.f, 0.f}; float ssq = 0.f;
#pragma unroll 8
          for (int s = 0; s < 32; ++s) {
              const f32x4 v0 = *(const GAS f32x4*)(xr + 32 * s + 8 * kq), v1 = *(const GAS f32x4*)(xr + 32 * s + 8 * kq + 4);
              ssq += (v0.x * v0.x + v0.y * v0.y) + (v0.z * v0.z + v0.w * v0.w) + (v1.x * v1.x + v1.y * v1.y) + (v1.z * v1.z + v1.w * v1.w);
              v4u pa; pa.x = pk2(v0.x, v0.y); pa.y = pk2(v0.z, v0.w); pa.z = pk2(v1.x, v1.y); pa.w = pk2(v1.z, v1.w);
              *(GAS v4u*)(hbf + (size_t)m * DM + 32 * s + 8 * kq) = pa;
              const bf16x8 af = __builtin_bit_cast(bf16x8, pa);
              const bf16x8 b0 = *(const LAS bf16x8*)(wbr + (lane & 15) * WBR_PITCH + (32 * s + 8 * kq) * 2);
              const bf16x8 b1 = *(const LAS bf16x8*)(wbr + (16 + (lane & 7)) * WBR_PITCH + (32 * s + 8 * kq) * 2);
              c0 = __builtin_amdgcn_mfma_f32_16x16x32_bf16(af, b0, c0, 0, 0, 0);
              c1 = __builtin_amdgcn_mfma_f32_16x16x32_bf16(af, b1, c1, 0, 0, 0);
          }
          ssq += __shfl_xor(ssq, 16); ssq += __shfl_xor(ssq, 32);
          const float rs = 1.f / sqrtf(ssq * (1.f / DM) + EPS);
          if (kq == 0) rstd[m] = rs;
#pragma unroll
          for (int r = 0; r < 4; ++r) { const int R = 4 * kq + r; const float rsR = __shfl(rs, R); const size_t row = (size_t)rg * 16 + R;
              BR[row * 24 + (lane & 15)] = sigmoidf_(c0[r] * rsR);
              if ((lane & 15) < 8) BR[row * 24 + 16 + (lane & 15)] = sigmoidf_(c1[r] * rsR); }
      } }
    { const float* pp = (const float*)a.in[IN_PP]; const float* ps = (const float*)a.in[IN_PS]; bf16* pbf = (bf16*)(ws + WS_PBF);
      for (int base = (vcu * NTHR + tid); base < MT * 32; base += 8 * G * NTHR) { f32x4 v0[8], v1[8];
#pragma unroll
          for (int u = 0; u < 8; ++u) { const int idx = base + u * G * NTHR; if (idx < MT * 32) { const int row = idx >> 5, c8 = (idx & 31) * 8;
              const float* src = (row < MP) ? pp + (size_t)row * 256 + c8 : ps + (size_t)(row - MP) * 256 + c8; v0[u] = *(const GAS f32x4*)src; v1[u] = *(const GAS f32x4*)(src + 4); } }
#pragma unroll
          for (int u = 0; u < 8; ++u) { const int idx = base + u * G * NTHR; if (idx < MT * 32) { const int row = idx >> 5, c8 = (idx & 31) * 8;
              v4u o; o.x = pk2(v0[u].x, v0[u].y); o.y = pk2(v0[u].z, v0[u].w); o.z = pk2(v1[u].x, v1[u].y); o.w = pk2(v1[u].z, v1[u].w);
              *(GAS v4u*)(pbf + (size_t)row * 256 + c8) = o; } } } }
    { const float* sw = (const float*)a.in[IN_SWIN]; float* dst = a.out + OFF_WINS;
      for (int base = (vcu * NTHR + tid); base < 32 * 504 * 64; base += 8 * G * NTHR) { f32x4 v[8];
#pragma unroll
          for (int u = 0; u < 8; ++u) { const int idx = base + u * G * NTHR; if (idx < 32 * 504 * 64) { const int q = idx & 63, i = (idx >> 6) % 504, b = (idx >> 6) / 504; v[u] = *(const GAS f32x4*)(sw + ((size_t)(b * 512 + i + 8) * 256) + q * 4); } }
#pragma unroll
          for (int u = 0; u < 8; ++u) { const int idx = base + u * G * NTHR; if (idx < 32 * 504 * 64) { const int q = idx & 63, i = (idx >> 6) % 504, b = (idx >> 6) / 504; *(GAS f32x4*)(dst + ((size_t)(b * 512 + i) * 256) + q * 4) = v[u]; } } } }
    { float* bias = (float*)(ws + WS_CTL) + CW_BIAS;
      if (rep == 0) for (int job = gw; job < 256; job += NGW) { const int slot = job >> 7, jc = (job >> 4) & 7, kc = job & 15, j = jc * 32 + (lane & 31), k0 = kc * 128 + (lane >> 5) * 64;
          const float* W1 = (const float*)a.in[slot ? IN_W1V : IN_W1K]; const float* pe = (const float*)a.in[slot ? IN_PEV : IN_PEK];
          float acc = 0.f;
#pragma unroll 16
          for (int k = 0; k < 64; ++k) acc += pe[k0 + k] * W1[(size_t)(k0 + k) * 256 + j];
          acc += __shfl_xor(acc, 32);
          if (lane < 32) atomicAdd(bias + slot * 256 + j, acc); } }
}

namespace pg8 {
#ifdef EPI_NT_STORES
#define EPI_ST(ptr, val) __builtin_nontemporal_store((val), (ptr))
#else
#define EPI_ST(ptr, val) (*(ptr) = (val))
#endif
__device__ __forceinline__ void st8_bf16(bf16_t* p, f32x4 a, f32x4 b) { u32x4 w; w.x = cvtpk(a[0], a[1]); w.y = cvtpk(a[2], a[3]); w.z = cvtpk(b[0], b[1]); w.w = cvtpk(b[2], b[3]); EPI_ST((u32x4*)p, w); }
__device__ __forceinline__ void st8_f32(float* p, f32x4 a, f32x4 b) { EPI_ST((f32x4*)p, a); EPI_ST((f32x4*)(p + 4), b); }
__device__ __forceinline__ f32x4 silu4(f32x4 v) { f32x4 r; for (int i = 0; i < 4; ++i) r[i] = siluf_(v[i]); return r; }

struct EpiG1 {
    static constexpr bool PERM = true, AFTER_DRAIN = false;
    float* out; const float* rstd; bf16_t *QA, *KA, *VA, *GA, *QB, *GB, *KSEL, *VSEL, *KWIN, *VWIN, *ACMP; const float *q_g, *ks_g, *kw_g, *pe_k, *pe_v;
    __device__ __forceinline__ void operator()(const f32x4 (&acc)[2][2][4][2], const Unit& u, int wr, int wc, int fr_, int fq_) const {
        int fr = fr_, fq = fq_;
#ifndef G1_NOLAUNDER
        asm volatile("" : "+v"(fr), "+v"(fq));
#endif
#ifdef DBG_G1EPI2
        for (int dupe = 0; dupe < 2; ++dupe) {
#endif
        const int pn = g1_role(u.pn);
        float rsv[2][4];
#pragma unroll
        for (int ai = 0; ai < 2; ++ai)
#pragma unroll
            for (int m = 0; m < 4; ++m) rsv[ai][m] = rstd[u.pm * BM + ai * HALF + wr * 64 + m * 16 + fr];
#pragma unroll
        for (int ai = 0; ai < 2; ++ai)
#pragma unroll
            for (int m = 0; m < 4; ++m) {
#ifndef G1_NOROWCLOBBER
                asm volatile("" ::: "memory");
#endif
                const int row = u.pm * BM + ai * HALF + wr * 64 + m * 16 + fr; const float rs = rsv[ai][m];
#define A0(bj) (acc[ai][bj][m][0])
#define A1(bj) (acc[ai][bj][m][1])
                const int lam0 = 64 * wc + 8 * fq;
                if (pn < 2) {
                    const float sc = rs * 0.125f;
#pragma unroll
                    for (int bj = 0; bj < 2; ++bj) st8_bf16(QA + (size_t)row * 512 + pn * 256 + lam0 + 32 * bj, A0(bj) * sc, A1(bj) * sc);
                } else if (pn < 6) {
                    const int sl = (pn >= 4) ? 1 : 0, col = (pn & 1) * 256 + lam0; bf16_t* B = KA + (size_t)sl * ((WS_VA - WS_KA) / 2);
#pragma unroll
                    for (int bj = 0; bj < 2; ++bj) { const f32x4 x0 = A0(bj) * rs, x1 = A1(bj) * rs; st8_f32(out + OFF_SB + (size_t)row * 1024 + sl * 512 + col + 32 * bj, x0, x1); st8_bf16(B + (size_t)row * 512 + col + 32 * bj, x0, x1); }
                } else if (pn < 8) {
#pragma unroll
                    for (int bj = 0; bj < 2; ++bj) st8_bf16(GA + (size_t)row * 512 + (pn - 6) * 256 + lam0 + 32 * bj, silu4(A0(bj) * rs), silu4(A1(bj) * rs));
                } else if (pn >= 13) {
#pragma unroll
                    for (int bj = 0; bj < 2; ++bj) st8_bf16(GB + (size_t)row * 512 + (pn - 13) * 256 + lam0 + 32 * bj, silu4(A0(bj) * rs), silu4(A1(bj) * rs));
                } else {
                    float ssq = 0.f;
#pragma unroll
                    for (int bj = 0; bj < 2; ++bj) { const f32x4 a0 = A0(bj), a1 = A1(bj); ssq += (a0[0] * a0[0] + a0[1] * a0[1]) + (a0[2] * a0[2] + a0[3] * a0[3]) + (a1[0] * a1[0] + a1[1] * a1[1]) + (a1[2] * a1[2] + a1[3] * a1[3]); }
                    ssq += __shfl_xor(ssq, 16); ssq += __shfl_xor(ssq, 32);
                    const float hr = rs / sqrtf(ssq * rs * rs * (1.f / 64.f) + EPS);
                    if (pn < 10) {
                        const float sc = hr * (0.125f * LOG2E);
#pragma unroll
                        for (int bj = 0; bj < 2; ++bj) { const int d0 = 32 * bj + 8 * fq; const f32x4 g0 = *(const f32x4*)(q_g + d0), g1 = *(const f32x4*)(q_g + d0 + 4);
                            st8_bf16(QB + (size_t)row * 512 + (pn - 8) * 256 + lam0 + 32 * bj, A0(bj) * g0 * sc, A1(bj) * g1 * sc); }
                    } else if (pn == 10) {
                        const int t = row & 2047, b = row >> 11, c = t >> 5, p = t & 31, slot = wc >> 1, g = wc & 1; const float* pe = pe_k + (ptrdiff_t)slot * (pe_v - pe_k);
#pragma unroll
                        for (int bj = 0; bj < 2; ++bj) { const int lam = lam0 + 32 * bj, d0 = 32 * bj + 8 * fq; const f32x4 x0 = A0(bj) * rs, x1 = A1(bj) * rs;
                            st8_f32(out + OFF_NSA + (size_t)row * 512 + lam, x0, x1);
                            if (row < MP) { const f32x4 e0 = *(const f32x4*)(pe + p * 64 + d0), e1 = *(const f32x4*)(pe + p * 64 + d0 + 4);
                                st8_bf16(ACMP + ((size_t)slot * 1024 + (size_t)(b * 64 + c) * 2 + g) * 2048 + p * 64 + d0, x0 + e0, x1 + e1); } }
                    } else if (pn == 11) {
#pragma unroll
                        for (int bj = 0; bj < 2; ++bj) { const int lam = lam0 + 32 * bj, d0 = 32 * bj + 8 * fq; f32x4 x0, x1;
                            if (wc < 2) { const f32x4 g0 = *(const f32x4*)(ks_g + d0), g1 = *(const f32x4*)(ks_g + d0 + 4); x0 = A0(bj) * g0 * hr; x1 = A1(bj) * g1 * hr; } else { x0 = A0(bj) * rs; x1 = A1(bj) * rs; }
                            st8_f32(out + OFF_NSA + (size_t)row * 512 + 256 + lam, x0, x1);
                            st8_bf16(KSEL + (size_t)(wc >> 1) * ((WS_VSEL - WS_KSEL) / 2) + (size_t)row * 128 + (lam & 127), x0, x1); }
                    } else {
                        float* wdst = nullptr;
                        if (row >= MP) { const int si = row - MP; wdst = out + OFF_WINS + ((size_t)((si >> 3) * 512 + 504 + (si & 7))) * 256; }
                        else if ((row & 2047) >= 1536) wdst = out + OFF_WINP + ((size_t)((row >> 11) * 512 + (row & 2047) - 1536)) * 256;
#pragma unroll
                        for (int bj = 0; bj < 2; ++bj) { const int lam = lam0 + 32 * bj, d0 = 32 * bj + 8 * fq; f32x4 x0, x1;
                            if (wc < 2) { const f32x4 g0 = *(const f32x4*)(kw_g + d0), g1 = *(const f32x4*)(kw_g + d0 + 4); x0 = A0(bj) * g0 * hr; x1 = A1(bj) * g1 * hr; } else { x0 = A0(bj) * rs; x1 = A1(bj) * rs; }
                            if (wdst) st8_f32(wdst + lam, x0, x1);
                            st8_bf16(KWIN + (size_t)(wc >> 1) * ((WS_VWIN - WS_KWIN) / 2) + (size_t)row * 128 + (lam & 127), x0, x1); }
                    }
                }
#undef A0
#undef A1
            }
#ifdef DBG_G1EPI2
        }
#endif
    }
};
struct EpiNone { static constexpr bool PERM = true, AFTER_DRAIN = false;
    __device__ __forceinline__ void operator()(const f32x4 (&acc)[2][2][4][2], const Unit& u, int wr, int wc, int fr, int fq) const { if (acc[0][0][0][0][0] == 123456.789f) __builtin_trap(); } };
struct EpiHid {
    static constexpr bool PERM = true, AFTER_DRAIN = false;
    bf16_t* O;
    __device__ __forceinline__ void operator()(const f32x4 (&acc)[2][2][4][2], const Unit& u, int wr, int wc, int fr_, int fq_) const {
        int fr = fr_, fq = fq_; asm volatile("" : "+v"(fr), "+v"(fq));
#pragma unroll
        for (int ai = 0; ai < 2; ++ai)
#pragma unroll
            for (int m = 0; m < 4; ++m) { const int row = u.pm * BM + ai * HALF + wr * 64 + m * 16 + fr;
#pragma unroll
                for (int bj = 0; bj < 2; ++bj) st8_bf16(O + (size_t)row * 256 + bj * HALF + wc * 32 + 8 * fq, silu4(acc[ai][bj][m][0]), silu4(acc[ai][bj][m][1])); }
    }
};
struct EpiOut {
    static constexpr bool PERM = true, AFTER_DRAIN = false;
    const bf16_t* XB; bf16_t* HB;
    __device__ __forceinline__ void operator()(const f32x4 (&acc)[2][2][4][2], const Unit& u, int wr, int wc, int fr_, int fq_) const {
        int fr = fr_, fq = fq_; asm volatile("" : "+v"(fr), "+v"(fq));
#pragma unroll
        for (int ai = 0; ai < 2; ++ai) {
            u32x4 xv[4][2];
#pragma unroll
            for (int m = 0; m < 4; ++m) { const int row = u.pm * BM + ai * HALF + wr * 64 + m * 16 + fr;
#pragma unroll
                for (int bj = 0; bj < 2; ++bj) { const int col = u.pn * BM + bj * HALF + wc * 32 + 8 * fq; xv[m][bj] = *(const u32x4*)(XB + (size_t)row * DM + col); } }
#pragma unroll
            for (int m = 0; m < 4; ++m) { const int row = u.pm * BM + ai * HALF + wr * 64 + m * 16 + fr;
#pragma unroll
                for (int bj = 0; bj < 2; ++bj) { const int col = u.pn * BM + bj * HALF + wc * 32 + 8 * fq; const u32x4 x = xv[m][bj];
                    const f32x4 x0 = {bf_lo(x.x), bf_hi(x.x), bf_lo(x.y), bf_hi(x.y)}, x1 = {bf_lo(x.z), bf_hi(x.z), bf_lo(x.w), bf_hi(x.w)};
                    st8_bf16(HB + (size_t)row * DM + col, x0 + acc[ai][bj][m][0], x1 + acc[ai][bj][m][1]); } }
        }
    }
};
struct EpiFinal {
    static constexpr bool PERM = true, AFTER_DRAIN = false;
    float* Y; const bf16_t* T1; const bf16_t* HB;
    __device__ __forceinline__ void operator()(const f32x4 (&acc)[2][2][4][2], const Unit& u, int wr, int wc, int fr_, int fq_) const {
        int fr = fr_, fq = fq_; asm volatile("" : "+v"(fr), "+v"(fq));
#pragma unroll
        for (int ai = 0; ai < 2; ++ai) {
            u32x4 tv[4][2], hv[4][2];
#pragma unroll
            for (int m = 0; m < 4; ++m) { const int row = u.pm * BM + ai * HALF + wr * 64 + m * 16 + fr;
#pragma unroll
                for (int bj = 0; bj < 2; ++bj) { const int col = u.pn * BM + bj * HALF + wc * 32 + 8 * fq; tv[m][bj] = *(const u32x4*)(T1 + (size_t)row * DM + col); hv[m][bj] = *(const u32x4*)(HB + (size_t)row * DM + col); } }
#pragma unroll
            for (int m = 0; m < 4; ++m) { const int row = u.pm * BM + ai * HALF + wr * 64 + m * 16 + fr;
#pragma unroll
                for (int bj = 0; bj < 2; ++bj) { const int col = u.pn * BM + bj * HALF + wc * 32 + 8 * fq; float* yp = Y + (size_t)row * DM + col;
                    const u32x4 t = tv[m][bj], hb = hv[m][bj]; const f32x4 a0 = acc[ai][bj][m][0], a1 = acc[ai][bj][m][1];
                    f32x4 y0, y1;
                    y0[0] = bf_lo(hb.x) + sigmoidf_(a0[0]) * bf_lo(t.x); y0[1] = bf_hi(hb.x) + sigmoidf_(a0[1]) * bf_hi(t.x); y0[2] = bf_lo(hb.y) + sigmoidf_(a0[2]) * bf_lo(t.y); y0[3] = bf_hi(hb.y) + sigmoidf_(a0[3]) * bf_hi(t.y);
                    y1[0] = bf_lo(hb.z) + sigmoidf_(a1[0]) * bf_lo(t.z); y1[1] = bf_hi(hb.z) + sigmoidf_(a1[1]) * bf_hi(t.z); y1[2] = bf_lo(hb.w) + sigmoidf_(a1[2]) * bf_lo(t.w); y1[3] = bf_hi(hb.w) + sigmoidf_(a1[3]) * bf_hi(t.w);
#ifdef Y_NT_STORES
                    __builtin_nontemporal_store(y0, (f32x4*)yp); __builtin_nontemporal_store(y1, (f32x4*)(yp + 4));
#else
                    st8_f32(yp, y0, y1);
#endif
                    } }
        }
    }
};
struct DiagOrder {
    int n, per, G, c;
    __device__ __forceinline__ bool next(int i, Unit& u) const { const int L = i * G + c; if (L >= n) return false; u.pm = L; u.pn = L / per; return true; }
    __device__ __forceinline__ void a_ready(const Unit&) const {}
    __device__ __forceinline__ void done(const Unit&) const {}
};
struct EpiHidB {
    bf16_t* O; const float* bias;
    __device__ __forceinline__ void operator()(const f32x4 (&acc)[2][2][4][2], int pm, int wr, int wc, int fr_, int fq_) const {
        int fr = fr_, fq = fq_; asm volatile("" : "+v"(fr), "+v"(fq));
#pragma unroll
        for (int bj = 0; bj < 2; ++bj) { const int col = bj * HALF + wc * 32 + 8 * fq; const f32x4 b0 = *(const f32x4*)(bias + col), b1 = *(const f32x4*)(bias + col + 4);
#pragma unroll
            for (int ai = 0; ai < 2; ++ai)
#pragma unroll
                for (int m = 0; m < 4; ++m) { const int row = pm * BM + ai * HALF + wr * 64 + m * 16 + fr;
                    st8_bf16(O + (size_t)row * 256 + col, silu4(acc[ai][bj][m][0] + b0), silu4(acc[ai][bj][m][1] + b1)); } }
    }
};
__device__ __forceinline__ void gemm_unit_gather(PG8_LAS unsigned char* lds, const float* cn, const int* pt, const bf16_t* W1T  , int L  , const EpiHidB& E) {
    int tid_ = threadIdx.x; asm volatile("" : "+v"(tid_));
    const int tid = tid_, wid = __builtin_amdgcn_readfirstlane(tid >> 6), lane = tid & 63, wr = wid >> 2, wc = wid & 3, fr = lane & 15, fq = lane >> 4;
    const int slot = L >> 6, pmu = L & 63;
    const float* abase[4]; const bf16_t* bbase[4]; int aofs[4], bofs[4];
#pragma unroll
    for (int j = 0; j < 4; ++j) { const int q = tid + 512 * j, row = q >> 3, c8 = q & 7, R = pmu * 256 + row, b = R >> 9, c = (R >> 1) & 255, g = R & 1, pos0 = c * 32;
        abase[j] = cn + ((size_t)pt[b * 64 + (pos0 >> 7)] * 128 + (pos0 & 127)) * 512 + slot * 128 + g * 64 + c8 * 8;
        aofs[j] = (row >> 7) * HTB + lds_byte(row & 127, c8 * 8);
        const int nsrc = (row & ~31) + perm32(row & 31);
        bbase[j] = W1T + (size_t)(slot * 256 + nsrc) * 2048 + c8 * 8;
        bofs[j] = (4 + (row >> 7)) * HTB + lds_byte(row & 127, c8 * 8); }
    const int aoff = lds_byte(wr * 64 + fr, fq * 8), boff = lds_byte(wc * 32 + fr, fq * 8);
    f32x4 acc[2][2][4][2];
#pragma unroll
    for (int a = 0; a < 2; ++a)
#pragma unroll
        for (int b = 0; b < 2; ++b)
#pragma unroll
            for (int m = 0; m < 4; ++m)
#pragma unroll
                for (int n = 0; n < 2; ++n) acc[a][b][m][n] = (f32x4){0.f, 0.f, 0.f, 0.f};
    f32x4 ar[4][2]; u32x4 br[4];
#define GU_LOAD(kt) do { _Pragma("unroll") for (int j = 0; j < 4; ++j) { ar[j][0] = *(const f32x4*)(abase[j] + (size_t)(kt) * 512); ar[j][1] = *(const f32x4*)(abase[j] + (size_t)(kt) * 512 + 4); br[j] = *(const u32x4*)(bbase[j] + (kt) * 64); } } while (0)
#define GU_STORE(stg) do { _Pragma("unroll") for (int j = 0; j < 4; ++j) { u32x4 w; w.x = cvtpk(ar[j][0][0], ar[j][0][1]); w.y = cvtpk(ar[j][0][2], ar[j][0][3]); w.z = cvtpk(ar[j][1][0], ar[j][1][1]); w.w = cvtpk(ar[j][1][2], ar[j][1][3]); \
        *(PG8_LAS u32x4*)(lds + (stg) * 2 * HTB + aofs[j]) = w; *(PG8_LAS u32x4*)(lds + (stg) * 2 * HTB + bofs[j]) = br[j]; } } while (0)
    GU_LOAD(0); GU_STORE(0); GU_LOAD(1);
    for (int kt = 0; kt < 32; ++kt) {
        const int stg = kt & 1;
        __syncthreads();
        if (kt + 1 < 32) GU_STORE(stg ^ 1);
        if (kt + 2 < 32) GU_LOAD(kt + 2);
        bf16x8 At[4][2], Bf[2][2];
#pragma unroll
        for (int ai = 0; ai < 2; ++ai) {
#pragma unroll
            for (int m = 0; m < 4; ++m)
#pragma unroll
                for (int k = 0; k < 2; ++k) At[m][k] = *(const PG8_LAS bf16x8*)(lds + (stg * 2 + ai) * HTB + aoff + m * 2048 + k * 1024);
#pragma unroll
            for (int bj = 0; bj < 2; ++bj) {
#pragma unroll
                for (int n = 0; n < 2; ++n)
#pragma unroll
                    for (int k = 0; k < 2; ++k) Bf[n][k] = *(const PG8_LAS bf16x8*)(lds + (4 + stg * 2 + bj) * HTB + boff + n * 2048 + k * 1024);
#pragma unroll
                for (int m = 0; m < 4; ++m)
#pragma unroll
                    for (int n = 0; n < 2; ++n)
#pragma unroll
                        for (int k = 0; k < 2; ++k) acc[ai][bj][m][n] = __builtin_amdgcn_mfma_f32_16x16x32_bf16(Bf[n][k], At[m][k], acc[ai][bj][m][n], 0, 0, 0);
            } }
    }
#undef GU_LOAD
#undef GU_STORE
    E(acc, L, wr, wc, fr, fq);
    __syncthreads();
}
struct EpiHidB128 {
    bf16_t* O; const float* bias;
    __device__ __forceinline__ void operator()(const f32x4 (&acc)[2][4][2], int row0, int wr, int wc, int fr_, int fq_) const {
        int fr = fr_, fq = fq_; asm volatile("" : "+v"(fr), "+v"(fq));
#pragma unroll
        for (int bj = 0; bj < 2; ++bj) { const int col = bj * HALF + wc * 32 + 8 * fq; const f32x4 b0 = *(const f32x4*)(bias + col), b1 = *(const f32x4*)(bias + col + 4);
#pragma unroll
            for (int m = 0; m < 4; ++m) { const int row = row0 + wr * 64 + m * 16 + fr;
                st8_bf16(O + (size_t)row * 256 + col, silu4(acc[bj][m][0] + b0), silu4(acc[bj][m][1] + b1)); } }
    }
};
__device__ __forceinline__ void gemm_unit_gather128(PG8_LAS unsigned char* lds, const float* cn, const int* pt, const bf16_t* W1T  , int L  , const EpiHidB128& E) {
    int tid_ = threadIdx.x; asm volatile("" : "+v"(tid_));
    const int tid = tid_, wid = __builtin_amdgcn_readfirstlane(tid >> 6), lane = tid & 63, wr = wid >> 2, wc = wid & 3, fr = lane & 15, fq = lane >> 4;
    const int slot = L >> 7, pmu = L & 127;
    const float* abase[2]; const bf16_t* bbase[4]; int aofs[2], bofs[4];
#pragma unroll
    for (int j = 0; j < 2; ++j) { const int q = tid + 512 * j, row = q >> 3, c8 = q & 7, R = pmu * 128 + row, b = R >> 9, c = (R >> 1) & 255, g = R & 1, pos0 = c * 32;
        abase[j] = cn + ((size_t)pt[b * 64 + (pos0 >> 7)] * 128 + (pos0 & 127)) * 512 + slot * 128 + g * 64 + c8 * 8;
        aofs[j] = lds_byte(row, c8 * 8); }
#pragma unroll
    for (int j = 0; j < 4; ++j) { const int q = tid + 512 * j, n = q >> 3, c8 = q & 7, nsrc = (n & ~31) + perm32(n & 31);
        bbase[j] = W1T + (size_t)(slot * 256 + nsrc) * 2048 + c8 * 8;
        bofs[j] = (1 + (n >> 7)) * HTB + lds_byte(n & 127, c8 * 8); }
    const int aoff = lds_byte(wr * 64 + fr, fq * 8), boff = lds_byte(wc * 32 + fr, fq * 8);
    f32x4 acc[2][4][2];
#pragma unroll
    for (int b = 0; b < 2; ++b)
#pragma unroll
        for (int m = 0; m < 4; ++m)
#pragma unroll
            for (int n = 0; n < 2; ++n) acc[b][m][n] = (f32x4){0.f, 0.f, 0.f, 0.f};
    f32x4 ra0[2][2], ra1[2][2], ra2[2][2], ra3[2][2]; u32x4 br[4];
#define GU_LDA(ra, kt) do { _Pragma("unroll") for (int j = 0; j < 2; ++j) { ra[j][0] = *(const f32x4*)(abase[j] + (size_t)(kt) * 512); ra[j][1] = *(const f32x4*)(abase[j] + (size_t)(kt) * 512 + 4); } } while (0)
#define GU_LDB(kt) do { _Pragma("unroll") for (int j = 0; j < 4; ++j) br[j] = *(const u32x4*)(bbase[j] + (kt) * 64); } while (0)
#define GU_ST(stg, ra) do { _Pragma("unroll") for (int j = 0; j < 2; ++j) { u32x4 w; w.x = cvtpk(ra[j][0][0], ra[j][0][1]); w.y = cvtpk(ra[j][0][2], ra[j][0][3]); w.z = cvtpk(ra[j][1][0], ra[j][1][1]); w.w = cvtpk(ra[j][1][2], ra[j][1][3]); \
        *(PG8_LAS u32x4*)(lds + (stg) * 3 * HTB + aofs[j]) = w; } _Pragma("unroll") for (int j = 0; j < 4; ++j) *(PG8_LAS u32x4*)(lds + (stg) * 3 * HTB + bofs[j]) = br[j]; } while (0)
#define GU_MMA(stg) do { bf16x8 At[4][2], Bf[2][2]; \
        _Pragma("unroll") for (int m = 0; m < 4; ++m) _Pragma("unroll") for (int k = 0; k < 2; ++k) At[m][k] = *(const PG8_LAS bf16x8*)(lds + (stg) * 3 * HTB + aoff + m * 2048 + k * 1024); \
        _Pragma("unroll") for (int bj = 0; bj < 2; ++bj) { \
            _Pragma("unroll") for (int n = 0; n < 2; ++n) _Pragma("unroll") for (int k = 0; k < 2; ++k) Bf[n][k] = *(const PG8_LAS bf16x8*)(lds + ((stg) * 3 + 1 + bj) * HTB + boff + n * 2048 + k * 1024); \
            _Pragma("unroll") for (int m = 0; m < 4; ++m) _Pragma("unroll") for (int n = 0; n < 2; ++n) _Pragma("unroll") for (int k = 0; k < 2; ++k) \
                acc[bj][m][n] = __builtin_amdgcn_mfma_f32_16x16x32_bf16(Bf[n][k], At[m][k], acc[bj][m][n], 0, 0, 0); } } while (0)
#define GU_STEP(kt, stg, raN) do { __syncthreads(); if ((kt) + 1 < 32) GU_ST((stg) ^ 1, raN); if ((kt) + 5 < 32) GU_LDA(raN, (kt) + 5); GU_LDB((kt) + 2 < 32 ? (kt) + 2 : 31); GU_MMA(stg); } while (0)
    GU_LDA(ra0, 0); GU_LDB(0); GU_ST(0, ra0); GU_LDA(ra1, 1); GU_LDA(ra2, 2); GU_LDA(ra3, 3); GU_LDA(ra0, 4); GU_LDB(1);
    for (int kt = 0; kt < 32; kt += 4) { GU_STEP(kt, 0, ra1); GU_STEP(kt + 1, 1, ra2); GU_STEP(kt + 2, 0, ra3); GU_STEP(kt + 3, 1, ra0); }
#undef GU_LDA
#undef GU_LDB
#undef GU_ST
#undef GU_MMA
#undef GU_STEP
    E(acc, L * 128, wr, wc, fr, fq);
    __syncthreads();
}
__device__ __forceinline__ void gemm_unit_bf16_128(PG8_LAS unsigned char* lds, const bf16_t* A  , const bf16_t* W1T  , int slot, int row0, const EpiHidB128& E) {
    int tid_ = threadIdx.x; asm volatile("" : "+v"(tid_));
    const int tid = tid_, wid = __builtin_amdgcn_readfirstlane(tid >> 6), lane = tid & 63, wr = wid >> 2, wc = wid & 3, fr = lane & 15, fq = lane >> 4;
    const bf16_t* abase[2]; const bf16_t* bbase[4]; int aofs[2], bofs[4];
#pragma unroll
    for (int j = 0; j < 2; ++j) { const int q = tid + 512 * j, row = q >> 3, c8 = q & 7; abase[j] = A + (size_t)row * 2048 + c8 * 8; aofs[j] = lds_byte(row, c8 * 8); }
#pragma unroll
    for (int j = 0; j < 4; ++j) { const int q = tid + 512 * j, n = q >> 3, c8 = q & 7, nsrc = (n & ~31) + perm32(n & 31);
        bbase[j] = W1T + (size_t)(slot * 256 + nsrc) * 2048 + c8 * 8;
        bofs[j] = (1 + (n >> 7)) * HTB + lds_byte(n & 127, c8 * 8); }
    const int aoff = lds_byte(wr * 64 + fr, fq * 8), boff = lds_byte(wc * 32 + fr, fq * 8);
    f32x4 acc[2][4][2];
#pragma unroll
    for (int b = 0; b < 2; ++b)
#pragma unroll
        for (int m = 0; m < 4; ++m)
#pragma unroll
            for (int n = 0; n < 2; ++n) acc[b][m][n] = (f32x4){0.f, 0.f, 0.f, 0.f};
    u32x4 ra0[2], ra1[2], ra2[2], ra3[2], br[4];
#define GB_LDA(ra, kt) do { _Pragma("unroll") for (int j = 0; j < 2; ++j) ra[j] = *(const u32x4*)(abase[j] + (kt) * 64); } while (0)
#define GB_LDB(kt) do { _Pragma("unroll") for (int j = 0; j < 4; ++j) br[j] = *(const u32x4*)(bbase[j] + (kt) * 64); } while (0)
#define GB_ST(stg, ra) do { _Pragma("unroll") for (int j = 0; j < 2; ++j) *(PG8_LAS u32x4*)(lds + (stg) * 3 * HTB + aofs[j]) = ra[j]; \
        _Pragma("unroll") for (int j = 0; j < 4; ++j) *(PG8_LAS u32x4*)(lds + (stg) * 3 * HTB + bofs[j]) = br[j]; } while (0)
#define GB_MMA(stg) do { bf16x8 At[4][2], Bf[2][2]; \
        _Pragma("unroll") for (int m = 0; m < 4; ++m) _Pragma("unroll") for (int k = 0; k < 2; ++k) At[m][k] = *(const PG8_LAS bf16x8*)(lds + (stg) * 3 * HTB + aoff + m * 2048 + k * 1024); \
        _Pragma("unroll") for (int bj = 0; bj < 2; ++bj) { \
            _Pragma("unroll") for (int n = 0; n < 2; ++n) _Pragma("unroll") for (int k = 0; k < 2; ++k) Bf[n][k] = *(const PG8_LAS bf16x8*)(lds + ((stg) * 3 + 1 + bj) * HTB + boff + n * 2048 + k * 1024); \
            _Pragma("unroll") for (int m = 0; m < 4; ++m) _Pragma("unroll") for (int n = 0; n < 2; ++n) _Pragma("unroll") for (int k = 0; k < 2; ++k) \
                acc[bj][m][n] = __builtin_amdgcn_mfma_f32_16x16x32_bf16(Bf[n][k], At[m][k], acc[bj][m][n], 0, 0, 0); } } while (0)
#define GB_STEP(kt, stg, raN) do { __syncthreads(); if ((kt) + 1 < 32) GB_ST((stg) ^ 1, raN); if ((kt) + 5 < 32) GB_LDA(raN, (kt) + 5); GB_LDB((kt) + 2 < 32 ? (kt) + 2 : 31); GB_MMA(stg); } while (0)
    GB_LDA(ra0, 0); GB_LDB(0); GB_ST(0, ra0); GB_LDA(ra1, 1); GB_LDA(ra2, 2); GB_LDA(ra3, 3); GB_LDA(ra0, 4); GB_LDB(1);
    for (int kt = 0; kt < 32; kt += 4) { GB_STEP(kt, 0, ra1); GB_STEP(kt + 1, 1, ra2); GB_STEP(kt + 2, 0, ra3); GB_STEP(kt + 3, 1, ra0); }
#undef GB_LDA
#undef GB_LDB
#undef GB_ST
#undef GB_MMA
#undef GB_STEP
    E(acc, row0, wr, wc, fr, fq);
    __syncthreads();
}
struct XcdQueueOrder {
    unsigned* q; volatile PG8_LAS int* slot; int nM, nN, nwg, x;
    __device__ __forceinline__ void init(int M, int N, unsigned* q_, volatile PG8_LAS int* slot_, int xcc) { nM = M / BM; nN = N / BM; nwg = nM * nN; q = q_; slot = slot_; x = xcc & 7; }
    __device__ __forceinline__ bool next(int i, Unit& u) const {
        if (threadIdx.x == 0) { int res = -1; const int qq = nwg / NXCD, rr = nwg % NXCD;
#pragma unroll 1
            for (int k = 0; k < NXCD; ++k) { const int xx = (x + k) & 7, sz = qq + (xx < rr ? 1 : 0), st = xx < rr ? xx * (qq + 1) : rr * (qq + 1) + (xx - rr) * qq;
                if ((int)__hip_atomic_load(q + 64 * xx, __ATOMIC_RELAXED, __HIP_MEMORY_SCOPE_AGENT) >= sz) continue;
                const int t = (int)__hip_atomic_fetch_add(q + 64 * xx, 1u, __ATOMIC_RELAXED, __HIP_MEMORY_SCOPE_AGENT);
                if (t < sz) { res = st + t; break; } }
            slot[i & 1] = res; }
        asm volatile("s_waitcnt lgkmcnt(0)" ::: "memory"); __builtin_amdgcn_s_barrier(); asm volatile("" ::: "memory");
        const int wgid = slot[i & 1]; if (wgid < 0) return false;
        const int nig = WGM * nN, gid = wgid / nig, fm = gid * WGM, gsz = (nM - fm) < WGM ? (nM - fm) : WGM;
        u.pm = fm + ((wgid % nig) % gsz); u.pn = (wgid % nig) / gsz; return true;
    }
    __device__ __forceinline__ void a_ready(const Unit&) const {}
    __device__ __forceinline__ void done(const Unit&) const {}
};
struct HybridOrder {
    unsigned* q; volatile PG8_LAS int* slot; int nM, nN, nwg, ns, l0, lstride, dyn0;
    __device__ __forceinline__ bool decode(int L, Unit& u) const {
        int wgid = L; { const int qq = nwg / NXCD, r = nwg % NXCD, xcd = wgid % NXCD, off = wgid / NXCD; wgid = (xcd < r ? xcd * (qq + 1) : r * (qq + 1) + (xcd - r) * qq) + off; }
        const int nig = WGM * nN, gid = wgid / nig, fm = gid * WGM, gsz = (nM - fm) < WGM ? (nM - fm) : WGM;
        u.pm = fm + ((wgid % nig) % gsz); u.pn = (wgid % nig) / gsz; return true;
    }
    __device__ __forceinline__ bool next(int i, Unit& u) const {
        if (i < ns) return decode(l0 + i * lstride, u);
        if (threadIdx.x == 0) { int res = -1;
            if ((int)__hip_atomic_load(q, __ATOMIC_RELAXED, __HIP_MEMORY_SCOPE_AGENT) < nwg - dyn0) { const int t = (int)__hip_atomic_fetch_add(q, 1u, __ATOMIC_RELAXED, __HIP_MEMORY_SCOPE_AGENT); if (t < nwg - dyn0) res = dyn0 + t; }
            slot[i & 1] = res; }
        asm volatile("s_waitcnt lgkmcnt(0)" ::: "memory"); __builtin_amdgcn_s_barrier(); asm volatile("" ::: "memory");
        const int L = slot[i & 1]; if (L < 0) return false; return decode(L, u);
    }
    __device__ __forceinline__ void a_ready(const Unit&) const {}
    __device__ __forceinline__ void done(const Unit&) const {}
};
struct DiagQueueOrder {
    unsigned* q; volatile PG8_LAS int* slot; int n, per;
    __device__ __forceinline__ bool next(int i, Unit& u) const {
        if (threadIdx.x == 0) { int res = -1;
            if ((int)__hip_atomic_load(q, __ATOMIC_RELAXED, __HIP_MEMORY_SCOPE_AGENT) < n) { const int t = (int)__hip_atomic_fetch_add(q, 1u, __ATOMIC_RELAXED, __HIP_MEMORY_SCOPE_AGENT); if (t < n) res = t; }
            slot[i & 1] = res; }
        asm volatile("s_waitcnt lgkmcnt(0)" ::: "memory"); __builtin_amdgcn_s_barrier(); asm volatile("" ::: "memory");
        const int L = slot[i & 1]; if (L < 0) return false; u.pm = L; u.pn = L / per; return true;
    }
    __device__ __forceinline__ void a_ready(const Unit&) const {}
    __device__ __forceinline__ void done(const Unit&) const {}
};
struct OneUnit {
    int pm, pn;
    __device__ __forceinline__ bool next(int i, Unit& u) const { if (i > 0) return false; u.pm = pm; u.pn = pn; return true; }
    __device__ __forceinline__ void a_ready(const Unit&) const {}
    __device__ __forceinline__ void done(const Unit&) const {}
};
}

#ifndef DBG_DUP
#define DBG_DUP 0
#endif

#define MFMA32(a, b, c) __builtin_amdgcn_mfma_f32_32x32x16_bf16((a), (b), (c), 0, 0, 0)
constexpr int KP = 144, VP = 192;
constexpr int KT_BYTES = 64 * KP, VT_BYTES = 64 * VP;
typedef short v4i16_t __attribute__((ext_vector_type(4)));
__device__ __forceinline__ int kidx_of(int kh, int v, int h) { return 32 * kh + (v & 3) + 8 * (v >> 2) + 4 * h; }
__device__ __forceinline__ s16x4 vtr(const LAS unsigned char* p) { return __builtin_bit_cast(s16x4, __builtin_amdgcn_ds_read_tr16_b64_v4i16((LAS v4i16_t*)p)); }

__device__ __forceinline__ void qk64(f32x16 (&s)[2], const LAS unsigned char* Ks, const bf16x8 (&qf)[4], int lane) {
    const LAS unsigned char* kb = Ks + (lane & 31) * KP + (lane >> 5) * 16;
#pragma unroll
    for (int kh = 0; kh < 2; ++kh) { f32x16 acc; for (int i = 0; i < 16; ++i) acc[i] = 0.f;
#pragma unroll
        for (int ks = 0; ks < 4; ++ks) { const bf16x8 kf = *(const LAS bf16x8*)(kb + kh * 32 * KP + ks * 32); __builtin_amdgcn_s_setprio(1); acc = MFMA32(kf, qf[ks], acc); __builtin_amdgcn_s_setprio(0); }
        s[kh] = acc; }
}
__device__ __forceinline__ void qk64_g(f32x16 (&s)[2], const bf16* Kg, int kpitch, const bf16x8 (&qf)[4], int lane) {
    const bf16* kb = Kg + (size_t)(lane & 31) * kpitch + (lane >> 5) * 8;
    bf16x8 kf[2][4];
#pragma unroll
    for (int kh = 0; kh < 2; ++kh)
#pragma unroll
        for (int ks = 0; ks < 4; ++ks) kf[kh][ks] = *(const GAS bf16x8*)(kb + (size_t)kh * 32 * kpitch + ks * 16);
#pragma unroll
    for (int kh = 0; kh < 2; ++kh) { f32x16 acc; for (int i = 0; i < 16; ++i) acc[i] = 0.f;
        __builtin_amdgcn_s_setprio(1);
#pragma unroll
        for (int ks = 0; ks < 4; ++ks) acc = MFMA32(kf[kh][ks], qf[ks], acc);
        __builtin_amdgcn_s_setprio(0);
        s[kh] = acc; }
}
__device__ __forceinline__ void pv64(f32x16 (&o)[2], const LAS unsigned char* Vs, const f32x16 (&e)[2], int lane) {
    const int G = lane >> 4, i = lane & 15, q = i >> 2, p = i & 3, h = G >> 1;
    const LAS unsigned char* vb = Vs + (4 * h + q) * VP + (16 * (G & 1) + 4 * p) * 2;
#pragma unroll
    for (int kh = 0; kh < 2; ++kh)
#pragma unroll
        for (int s = 0; s < 2; ++s) {
            v4u pw; pw.x = cvtpk(e[kh][8 * s + 0], e[kh][8 * s + 1]); pw.y = cvtpk(e[kh][8 * s + 2], e[kh][8 * s + 3]); pw.z = cvtpk(e[kh][8 * s + 4], e[kh][8 * s + 5]); pw.w = cvtpk(e[kh][8 * s + 6], e[kh][8 * s + 7]);
            const bf16x8 pf = __builtin_bit_cast(bf16x8, pw);
#pragma unroll
            for (int dh = 0; dh < 2; ++dh) {
                const s16x4 lo = vtr(vb + (32 * kh + 16 * s) * VP + 64 * dh), hi = vtr(vb + (32 * kh + 16 * s + 8) * VP + 64 * dh);
                const bf16x8 vf = {lo[0], lo[1], lo[2], lo[3], hi[0], hi[1], hi[2], hi[3]};
                __builtin_amdgcn_s_setprio(1); o[dh] = MFMA32(vf, pf, o[dh]); __builtin_amdgcn_s_setprio(0);
            }
        }
}
__device__ __forceinline__ bf16x8 pack8(f32x4 a, f32x4 b) { v4u w; w.x = cvtpk(a[0], a[1]); w.y = cvtpk(a[2], a[3]); w.z = cvtpk(b[0], b[1]); w.w = cvtpk(b[2], b[3]); return __builtin_bit_cast(bf16x8, w); }
__device__ __forceinline__ float xhalf(float v, int h) {
    const unsigned u = __builtin_bit_cast(unsigned, v);
    auto r = __builtin_amdgcn_permlane32_swap(u, u, false, false);
    return __builtin_bit_cast(float, h ? r[0] : r[1]);
}
__device__ __forceinline__ float xmax_half(float v) {
    const unsigned u = __builtin_bit_cast(unsigned, v); auto r = __builtin_amdgcn_permlane32_swap(u, u, false, false);
    return fmaxf(__builtin_bit_cast(float, r[0]), __builtin_bit_cast(float, r[1]));
}
__device__ __forceinline__ void load_qf(bf16x8 (&qf)[4], const bf16* qrow, int lane) {
#pragma unroll
    for (int ks = 0; ks < 4; ++ks) qf[ks] = *(const GAS bf16x8*)(qrow + 16 * ks + 8 * (lane >> 5));
}
__device__ __forceinline__ v4u tile_ld(const bf16* g, int rpitch, int tid) { return *(const GAS v4u*)(g + (size_t)(tid >> 3) * rpitch + (tid & 7) * 8); }
__device__ __forceinline__ void tile_st(LAS unsigned char* t, int P, int tid, v4u v) { *(LAS v4u*)(t + (tid >> 3) * P + (tid & 7) * 16) = v; }

template <class F> __device__ __forceinline__ void softmax_tile(f32x16 (&s)[2], float& m, float& l, f32x16 (&o)[2], int h, F&& biasf) {
    float mx = -1e30f;
#pragma unroll
    for (int kh = 0; kh < 2; ++kh)
#pragma unroll
        for (int v = 0; v < 16; ++v) { const float x = s[kh][v] + biasf(kidx_of(kh, v, h)); s[kh][v] = x; mx = fmaxf(mx, x); }
    mx = xmax_half(mx);
    const float mn = fmaxf(m, mx), al = fexp2(m - mn); m = mn;
    float sum = 0.f;
#pragma unroll
    for (int kh = 0; kh < 2; ++kh)
#pragma unroll
        for (int v = 0; v < 16; ++v) { const float e = fexp2(s[kh][v] - mn); s[kh][v] = e; sum += e; }
    l = l * al + sum;
#pragma unroll
    for (int dh = 0; dh < 2; ++dh)
#pragma unroll
        for (int v = 0; v < 16; ++v) o[dh][v] *= al;
}
__device__ __forceinline__ void alibi_cinit(f32x16 (&c)[2], float slope2) {
#pragma unroll
    for (int kh = 0; kh < 2; ++kh)
#pragma unroll
        for (int v = 0; v < 16; ++v) c[kh][v] = slope2 * (float)(32 * kh + (v & 3) + 8 * (v >> 2));
}
__device__ __forceinline__ void qk64c(f32x16 (&s)[2], const LAS unsigned char* Ks, const bf16x8 (&qf)[4], const f32x16 (&cinit)[2], int lane) {
    const LAS unsigned char* kb = Ks + (lane & 31) * KP + (lane >> 5) * 16;
    bf16x8 kf[2][4];
#pragma unroll
    for (int ks = 0; ks < 4; ++ks)
#pragma unroll
        for (int kh = 0; kh < 2; ++kh) kf[kh][ks] = *(const LAS bf16x8*)(kb + kh * 32 * KP + ks * 32);
    __builtin_amdgcn_s_setprio(1);
    f32x16 a0 = MFMA32(kf[0][0], qf[0], cinit[0]), a1 = MFMA32(kf[1][0], qf[0], cinit[1]);
#pragma unroll
    for (int ks = 1; ks < 4; ++ks) { a0 = MFMA32(kf[0][ks], qf[ks], a0); a1 = MFMA32(kf[1][ks], qf[ks], a1); }
    __builtin_amdgcn_s_setprio(0);
    s[0] = a0; s[1] = a1;
}
template <bool MASKED> __device__ __forceinline__ void sm2_tile(f32x16 (&s)[2], float& m, float& l, f32x16 (&o)[2], float off, bool part, int lo, int hi) {
    float mxp = -INFINITY;
#pragma unroll
    for (int kh = 0; kh < 2; ++kh)
#pragma unroll
        for (int v = 0; v < 16; ++v) { const int Kc = 32 * kh + (v & 3) + 8 * (v >> 2); float xp = s[kh][v];
            if (MASKED) { xp = (Kc > lo && Kc <= hi) ? xp : -INFINITY; s[kh][v] = xp; }
            mxp = fmaxf(mxp, xp); }
    float mx = mxp + off; mx = xmax_half(mx);
    const float mn = part ? fmaxf(m, mx) : m, al = fexp2(m - mn); m = mn; l *= al;
#pragma unroll
    for (int dh = 0; dh < 2; ++dh)
#pragma unroll
        for (int v = 0; v < 16; ++v) o[dh][v] *= al;
    const float mb = part ? (mn - off) : INFINITY;
    float sum = 0.f;
#pragma unroll
    for (int kh = 0; kh < 2; ++kh)
#pragma unroll
        for (int v = 0; v < 16; ++v) { const float e = fexp2(s[kh][v] - mb); s[kh][v] = e; sum += e; }
    l += sum;
}
__device__ __forceinline__ void store_row_wide(bf16* rowp, v2u (&grp)[8], int h, bool pred = true) {
#pragma unroll
    for (int g = 0; g < 8; g += 2) { v2u a = grp[g], b = grp[g + 1];
        { auto r = __builtin_amdgcn_permlane32_swap(a.x, b.x, false, false); a.x = r[0]; b.x = r[1]; }
        { auto r = __builtin_amdgcn_permlane32_swap(a.y, b.y, false, false); a.y = r[0]; b.y = r[1]; }
        if (pred) { v4u w; w.x = a.x; w.y = a.y; w.z = b.x; w.w = b.y; *(GAS v4u*)(rowp + 8 * g + 8 * h) = w; } }
}
__device__ __forceinline__ void store_ot(bf16* dst, const f32x16 (&o)[2], float sc, int h) {
    v2u grp[8];
#pragma unroll
    for (int dh = 0; dh < 2; ++dh)
#pragma unroll
        for (int a = 0; a < 4; ++a) { grp[4 * dh + a].x = cvtpk(o[dh][4 * a] * sc, o[dh][4 * a + 1] * sc); grp[4 * dh + a].y = cvtpk(o[dh][4 * a + 2] * sc, o[dh][4 * a + 3] * sc); }
    store_row_wide(dst, grp, h);
}
__device__ __forceinline__ void zero_o(f32x16 (&o)[2]) { for (int dh = 0; dh < 2; ++dh) for (int v = 0; v < 16; ++v) o[dh][v] = 0.f; }

template <bool TO_LDS> __device__ __forceinline__ void l2_wave(const bf16* w2t  , const bf16* hid0, int hstride, const float* kcg  , unsigned char* dst, int dpitch_bytes, int lane) {
    const int r = lane & 31, h = lane >> 5;
    f32x16 acc[2]; zero_o(acc);
    const bf16* hp = hid0 + (size_t)r * hstride + 8 * h;
#pragma unroll
    for (int k0 = 0; k0 < 16; k0 += 8) {
        bf16x8 bfr[8], af[2][8];
#pragma unroll
        for (int k = 0; k < 8; ++k) { bfr[k] = *(const GAS bf16x8*)(hp + 16 * (k0 + k));
#pragma unroll
            for (int dh = 0; dh < 2; ++dh) af[dh][k] = *(const GAS bf16x8*)(w2t + (size_t)(32 * dh + r) * 256 + 16 * (k0 + k) + 8 * h); }
#pragma unroll
        for (int k = 0; k < 8; ++k)
#pragma unroll
            for (int dh = 0; dh < 2; ++dh) acc[dh] = MFMA32(af[dh][k], bfr[k], acc[dh]);
    }
    float sc = 1.f;
    if (kcg) { float ssq = 0.f;
#pragma unroll
        for (int dh = 0; dh < 2; ++dh)
#pragma unroll
            for (int v = 0; v < 16; ++v) ssq += acc[dh][v] * acc[dh][v];
        ssq += __shfl_xor(ssq, 32); sc = 1.f / sqrtf(ssq * (1.f / 64.f) + EPS); }
#pragma unroll
    for (int dh = 0; dh < 2; ++dh)
#pragma unroll
        for (int a = 0; a < 4; ++a) { const int d0 = 32 * dh + 8 * a + 4 * h; f32x4 x = {acc[dh][4 * a], acc[dh][4 * a + 1], acc[dh][4 * a + 2], acc[dh][4 * a + 3]};
            if (kcg) x = x * *(const f32x4*)(kcg + d0) * sc;
            v2u w; w.x = cvtpk(x[0], x[1]); w.y = cvtpk(x[2], x[3]);
            if (TO_LDS) *(LAS v2u*)((LAS unsigned char*)(uintptr_t)dst + r * dpitch_bytes + d0 * 2) = w;
            else *(GAS v2u*)(dst + (size_t)r * dpitch_bytes + d0 * 2) = w; }
}

__device__ __forceinline__ int next_item(gu32* ctr, volatile LAS int* slot) {
    __syncthreads();
    if (threadIdx.x == 0) *slot = (int)__hip_atomic_fetch_add(ctr, 1u, RLX_AGENT);
    __syncthreads();
    return *slot;
}

template <bool MASKED> __device__ __forceinline__ void sb_weights_t(f32x16 (&s)[2], float& P, int kb, int tpos, int h) {
    float gp[8];
#pragma unroll
    for (int kh = 0; kh < 2; ++kh)
#pragma unroll
        for (int aa = 0; aa < 4; ++aa) { float g = 1.f;
#pragma unroll
            for (int j = 3; j >= 0; --j) { const int v = 4 * aa + j; const float z = __builtin_amdgcn_fmed3f(s[kh][v], -80.f, 80.f);
                const float e = fexp2(z * -LOG2E), r = __builtin_amdgcn_rcpf(1.f + e);
                float sg = r, om = e * r;
                if (MASKED) { const bool ok = (kb + kidx_of(kh, v, h)) < tpos; sg = ok ? sg : 0.f; om = ok ? om : 1.f; }
                s[kh][v] = sg * g;
                g *= om; }
            gp[4 * kh + aa] = g; }
    float tot = P, off[8];
#pragma unroll
    for (int ap = 7; ap >= 0; --ap) { const float mine = gp[ap], oth = xhalf(mine, h);
        off[ap] = h == 0 ? tot * oth : tot; tot *= mine * oth; }
#pragma unroll
    for (int kh = 0; kh < 2; ++kh)
#pragma unroll
        for (int v = 0; v < 16; ++v) s[kh][v] *= off[4 * kh + (v >> 2)];
    P = tot;
}
__device__ __forceinline__ void sb_weights(f32x16 (&s)[2], float& P, int kb, int tpos, int h, bool masked) {
    if (masked) sb_weights_t<true>(s, P, kb, tpos, h); else sb_weights_t<false>(s, P, kb, tpos, h);
}
#define SB_PMIN 8.7e-27f
__device__ __forceinline__ void item_l2_sample(const Args& a, int it, int lane, int wave) {
    unsigned char* ws = a.ws; const int sb = it >> 1, g = it & 1, slot = wave & 1;
    const bf16* w2t = (const bf16*)(ws + WS_W2T) + slot * 64 * 256;
    const float* kcg = slot ? nullptr : (const float*)a.in[IN_KCG];
    for (int j = 0; j < 2; ++j) { const int ch = (wave >> 1) + 4 * j;
        const bf16* hid0 = (const bf16*)(ws + WS_HIDS) + ((size_t)slot * 16384 + (size_t)(sb * 256 + 32 * ch) * 2 + g) * 256;
        unsigned char* dst = ws + (slot ? WS_VCS : WS_KCS) + ((size_t)((sb * 2 + g) * 256 + 32 * ch)) * 128;
        l2_wave<false>(w2t, hid0, 512, kcg, dst, 128, lane); }
}
__device__ __forceinline__ void item_sb_prompt(const Args& a, LAS unsigned char* lds, int it, int lane, int wave) {
    unsigned char* ws = a.ws;
    const int qb = 7 - (it >> 6), bh = it & 63, b = bh >> 3, hd = bh & 7;
    const int r = lane & 31, h = lane >> 5, tw = 256 * qb + 32 * wave, tpos = tw + r; const size_t mrow = (size_t)b * TP + tpos;
    const bf16* QA = (const bf16*)(ws + WS_QA); const bf16* KA = (const bf16*)(ws + WS_KA) + hd * 64; const bf16* VA = (const bf16*)(ws + WS_VA) + hd * 64;
    bf16x8 qf[4]; load_qf(qf, QA + mrow * 512 + hd * 64, lane);
    LAS unsigned char* Vs = lds + wave * VT_BYTES;
    f32x16 o[2]; zero_o(o);
    float C = 1.f;
    for (int kb = (tw >> 6) << 6; kb >= 0; kb -= 64) {
        const size_t krow0 = (size_t)b * TP + kb;
        v4u vr[8];
#pragma unroll
        for (int i = 0; i < 8; ++i) vr[i] = *(const GAS v4u*)(VA + (krow0 + 8 * i + (lane >> 3)) * 512 + (lane & 7) * 8);
        f32x16 s[2]; qk64_g(s, KA + krow0 * 512, 512, qf, lane);
#pragma unroll
        for (int i = 0; i < 8; ++i) *(LAS v4u*)(Vs + (8 * i + (lane >> 3)) * VP + (lane & 7) * 16) = vr[i];
        sb_weights(s, C, kb, tpos, h, kb + 64 > tw);
        asm volatile("" ::: "memory");
        pv64(o, Vs, s, lane);
        asm volatile("" ::: "memory");
        if (__all(C < SB_PMIN)) break;
    }
    const bf16* GA = (const bf16*)(ws + WS_GA) + mrow * 512 + hd * 64; bf16* U = (bf16*)(ws + WS_U) + mrow * 1024 + hd * 64;
    v2u grp[8];
#pragma unroll
    for (int dh = 0; dh < 2; ++dh)
#pragma unroll
        for (int aa = 0; aa < 4; ++aa) { const int d0 = 32 * dh + 8 * aa + 4 * h; const v2u gw = *(const GAS v2u*)(GA + d0);
            grp[4 * dh + aa].x = cvtpk(o[dh][4 * aa] * bf_lo(gw.x), o[dh][4 * aa + 1] * bf_hi(gw.x)); grp[4 * dh + aa].y = cvtpk(o[dh][4 * aa + 2] * bf_lo(gw.y), o[dh][4 * aa + 3] * bf_hi(gw.y)); }
    store_row_wide(U, grp, h);
}
__device__ __forceinline__ void item_win_prompt(const Args& a, LAS unsigned char* lds, int it, int tid, int lane, int wave) {
    unsigned char* ws = a.ws;
    const int qp = 15 - (it >> 4), bg = it & 15, b = bg >> 1, g = bg & 1, qA = 2 * qp + 1, qB = 2 * qp;
    const int r = lane & 31, h = lane >> 5, hq = 4 * g + (wave & 3), tA = 64 * qA + 32 * (wave >> 2) + r, tB = tA - 64; const size_t mA = (size_t)b * TP + tA, mB = mA - 64;
    const float slope2 = fexp2(-(float)(hq + 1)) * LOG2E;
    bf16x8 qfA[4], qfB[4]; load_qf(qfA, (const bf16*)(ws + WS_QB) + mA * 512 + hq * 64, lane); load_qf(qfB, (const bf16*)(ws + WS_QB) + mB * 512 + hq * 64, lane);
    const bf16* KW = (const bf16*)(ws + WS_KWIN) + (size_t)b * TP * 128 + g * 64; const bf16* VW = (const bf16*)(ws + WS_VWIN) + (size_t)b * TP * 128 + g * 64;
    f32x16 oA[2], oB[2]; zero_o(oA); zero_o(oB); float mAx = -1e30f, lA = 0.f, mBx = -1e30f, lB = 0.f;
    f32x16 cinit[2]; alibi_cinit(cinit, slope2);
    const int kt_lo = qB >= 8 ? qB - 8 : 0;
    { const v4u k0 = tile_ld(KW + (size_t)(64 * qA) * 128, 128, tid), v0 = tile_ld(VW + (size_t)(64 * qA) * 128, 128, tid);
      tile_st(lds, KP, tid, k0); tile_st(lds + KT_BYTES, VP, tid, v0); }
    v4u kr = {0u, 0u, 0u, 0u}, vr = {0u, 0u, 0u, 0u};
    if (qA - 1 >= kt_lo) { kr = tile_ld(KW + (size_t)(64 * (qA - 1)) * 128, 128, tid); vr = tile_ld(VW + (size_t)(64 * (qA - 1)) * 128, 128, tid); }
    int st = 0;
    for (int kt = qA; kt >= kt_lo; --kt, st ^= 1) {
        __syncthreads();
        LAS unsigned char* Ks = lds + st * (KT_BYTES + VT_BYTES); LAS unsigned char* Vs = Ks + KT_BYTES;
        if (kt - 1 >= kt_lo) { LAS unsigned char* Kn = lds + (st ^ 1) * (KT_BYTES + VT_BYTES); tile_st(Kn, KP, tid, kr); tile_st(Kn + KT_BYTES, VP, tid, vr); }
        if (kt - 2 >= kt_lo) { kr = tile_ld(KW + (size_t)(64 * (kt - 2)) * 128, 128, tid); vr = tile_ld(VW + (size_t)(64 * (kt - 2)) * 128, 128, tid); }
        const int kb = 64 * kt; const float off = slope2 * (float)(kb + 4 * h);
        if (kt >= qA - 8) { f32x16 s[2]; qk64c(s, Ks, qfA, cinit, lane);
            if (kt == qA || kt == qA - 8) sm2_tile<true>(s, mAx, lA, oA, off, true, tA - 512 - kb - 4 * h, tA - kb - 4 * h);
            else sm2_tile<false>(s, mAx, lA, oA, off, true, 0, 0);
            pv64(oA, Vs, s, lane); }
        if (kt <= qB) { f32x16 s[2]; qk64c(s, Ks, qfB, cinit, lane);
            if (kt == qB || kt == qB - 8) sm2_tile<true>(s, mBx, lB, oB, off, true, tB - 512 - kb - 4 * h, tB - kb - 4 * h);
            else sm2_tile<false>(s, mBx, lB, oB, off, true, 0, 0);
            pv64(oB, Vs, s, lane); }
    }
    lA += __shfl_xor(lA, 32); lB += __shfl_xor(lB, 32);
    const float gA = ((const float*)(ws + WS_BR))[mA * 24 + hq * 3 + 2], gB = ((const float*)(ws + WS_BR))[mB * 24 + hq * 3 + 2];
    store_ot((bf16*)(ws + WS_OW) + mA * 512 + hq * 64, oA, gA / lA, h);
    store_ot((bf16*)(ws + WS_OW) + mB * 512 + hq * 64, oB, gB / lB, h);
}

__device__ __forceinline__ void item_sb_sample(const Args& a, LAS unsigned char* lds, int it, int lane, int wave) {
    unsigned char* ws = a.ws; const int pair = it * 8 + wave, sb = pair >> 3, hd = pair & 7;
    const int r = lane & 31, h = lane >> 5, st = r & 7, tpos = 8192 + st; const size_t mrow = (size_t)MP + sb * 8 + st;
    const float* csb = (const float*)a.in[IN_CSB]; const int* pt = (const int*)a.in[IN_PT] + sb * 64;
    bf16x8 qf[4]; load_qf(qf, (const bf16*)(ws + WS_QA) + mrow * 512 + hd * 64, lane);
    LAS unsigned char* Vs = lds + wave * VT_BYTES;
    f32x16 o[2]; zero_o(o); float C = 1.f;
    for (int blk = 128; blk >= 0; --blk) {
        const float* rows = (blk == 128) ? a.out + OFF_SB + (size_t)(MP + sb * 8) * 1024 : csb + ((size_t)pt[blk >> 1] * 128 + (blk & 1) * 64) * 1024;
        const int maxrow = blk == 128 ? 7 : 63;
        const float* kbase = rows + hd * 64; const float* vbase = rows + 512 + hd * 64;
        f32x4 kt[2][4][2];
#pragma unroll
        for (int kh = 0; kh < 2; ++kh) { const float* kp = kbase + (size_t)min(32 * kh + r, maxrow) * 1024 + 8 * h;
#pragma unroll
            for (int ks = 0; ks < 4; ++ks) { kt[kh][ks][0] = *(const GAS f32x4*)(kp + 16 * ks); kt[kh][ks][1] = *(const GAS f32x4*)(kp + 16 * ks + 4); } }
        f32x4 va[4][2], vb[4][2];
#pragma unroll
        for (int i = 0; i < 4; ++i) { const float* vp = vbase + (size_t)min(8 * i + (lane >> 3), maxrow) * 1024 + (lane & 7) * 8; va[i][0] = *(const GAS f32x4*)vp; va[i][1] = *(const GAS f32x4*)(vp + 4); }
        f32x16 s[2];
#pragma unroll
        for (int kh = 0; kh < 2; ++kh) { f32x16 acc; for (int i = 0; i < 16; ++i) acc[i] = 0.f;
#pragma unroll
            for (int ks = 0; ks < 4; ++ks) { const bf16x8 kf8 = pack8(kt[kh][ks][0], kt[kh][ks][1]); __builtin_amdgcn_s_setprio(1); acc = MFMA32(kf8, qf[ks], acc); __builtin_amdgcn_s_setprio(0); }
            s[kh] = acc; }
#pragma unroll
        for (int i = 0; i < 4; ++i) { const float* vp = vbase + (size_t)min(8 * (i + 4) + (lane >> 3), maxrow) * 1024 + (lane & 7) * 8; vb[i][0] = *(const GAS f32x4*)vp; vb[i][1] = *(const GAS f32x4*)(vp + 4); }
#pragma unroll
        for (int i = 0; i < 4; ++i) *(LAS bf16x8*)(Vs + (8 * i + (lane >> 3)) * VP + (lane & 7) * 16) = pack8(va[i][0], va[i][1]);
        sb_weights(s, C, 64 * blk, tpos, h, blk == 128);
#pragma unroll
        for (int i = 0; i < 4; ++i) *(LAS bf16x8*)(Vs + (8 * (i + 4) + (lane >> 3)) * VP + (lane & 7) * 16) = pack8(vb[i][0], vb[i][1]);
        asm volatile("" ::: "memory");
        pv64(o, Vs, s, lane);
        asm volatile("" ::: "memory");
        if (__all(C < SB_PMIN)) break;
    }
    { const bf16* GA = (const bf16*)(ws + WS_GA) + mrow * 512 + hd * 64; bf16* U = (bf16*)(ws + WS_U) + mrow * 1024 + hd * 64;
      v2u grp[8];
#pragma unroll
      for (int dh = 0; dh < 2; ++dh)
#pragma unroll
          for (int aa = 0; aa < 4; ++aa) { const int d0 = 32 * dh + 8 * aa + 4 * h; const v2u gw = *(const GAS v2u*)(GA + d0);
              grp[4 * dh + aa].x = cvtpk(o[dh][4 * aa] * bf_lo(gw.x), o[dh][4 * aa + 1] * bf_hi(gw.x)); grp[4 * dh + aa].y = cvtpk(o[dh][4 * aa + 2] * bf_lo(gw.y), o[dh][4 * aa + 3] * bf_hi(gw.y)); }
      store_row_wide(U, grp, h, r < 8); }
}

#ifndef DBG_DUP
#define DBG_DUP 0
#endif

constexpr size_t WS_KCP = 230 * MiB, WS_VCP = 231 * MiB;
constexpr int P3_KC = 0, P3_VC = KT_BYTES, P3_KS = KT_BYTES + VT_BYTES  , P3_IMPW = P3_KS + 2 * (KT_BYTES + VT_BYTES)  , P3_IMP = P3_IMPW + 8 * 32 * 33 * 4,
              P3_SEL = P3_IMP + 64 * 36 * 4, P3_UM = P3_SEL + 256;
__device__ __forceinline__ void item_nsa_prompt(const Args& a, LAS unsigned char* lds, int it, int tid, int lane, int wave) {
    unsigned char* ws = a.ws;
    const int qblk = 31 - (it >> 4), bg = it & 15, b = bg >> 1, g = bg & 1, cur = qblk;
    const int r = lane & 31, h = lane >> 5, hq = 4 * g + (wave & 3), th = wave >> 2, tpos = 64 * qblk + 32 * th + r; const size_t mrow = (size_t)b * TP + tpos;
    const float slope2 = fexp2(-(float)(hq + 1)) * LOG2E;
    { const bf16* KCP = (const bf16*)(ws + WS_KCP) + (size_t)(b * 2 + g) * 4096; const bf16* VCP = (const bf16*)(ws + WS_VCP) + (size_t)(b * 2 + g) * 4096;
      const v4u k0 = tile_ld(KCP, 64, tid), v0 = tile_ld(VCP, 64, tid); tile_st(lds + P3_KC, KP, tid, k0); tile_st(lds + P3_VC, VP, tid, v0); }
    bf16x8 qf[4]; load_qf(qf, (const bf16*)(ws + WS_QB) + mrow * 512 + hq * 64, lane);
    __syncthreads();
    f32x16 oc[2];
    for (int dupp = 0; dupp < ((DBG_DUP & 128) ? 2 : 1); ++dupp) { if (dupp) __syncthreads();
    zero_o(oc);
    { f32x16 s[2]; qk64(s, lds + P3_KC, qf, lane);
      float mx = -1e30f;
#pragma unroll
      for (int kh = 0; kh < 2; ++kh)
#pragma unroll
          for (int v = 0; v < 16; ++v) { const int ce = 32 * kidx_of(kh, v, h) + 31, dist = tpos - ce; const float x = dist >= 0 ? s[kh][v] - slope2 * (float)dist : -INFINITY; s[kh][v] = x; mx = fmaxf(mx, x); }
      mx = fmaxf(mx, __shfl_xor(mx, 32));
      float sum = 0.f;
#pragma unroll
      for (int kh = 0; kh < 2; ++kh)
#pragma unroll
          for (int v = 0; v < 16; ++v) { const float e = fexp2(s[kh][v] - mx); s[kh][v] = e; sum += e; }
      sum += __shfl_xor(sum, 32);
      const float inv = sum > 0.f ? 1.f / sum : 1.f;
#pragma unroll
      for (int kh = 0; kh < 2; ++kh)
#pragma unroll
          for (int v = 0; v < 16; ++v) s[kh][v] *= inv;
      LAS float* impw = (LAS float*)(lds + P3_IMPW) + (wave * 32 + r) * 33;
#pragma unroll
      for (int kh = 0; kh < 2; ++kh)
#pragma unroll
          for (int aa = 0; aa < 4; ++aa)
#pragma unroll
              for (int b2 = 0; b2 < 2; ++b2) impw[16 * kh + 4 * aa + 2 * h + b2] = s[kh][4 * aa + 2 * b2] + s[kh][4 * aa + 2 * b2 + 1];
      pv64(oc, lds + P3_VC, s, lane);
    }
    __syncthreads();
    { const int tk = tid >> 3, j8 = tid & 7; LAS float* imp = (LAS float*)(lds + P3_IMP) + tk * 36;
      const LAS float* iw = (const LAS float*)(lds + P3_IMPW) + (((tk >> 5) * 4) * 32 + (tk & 31)) * 33;
#pragma unroll
      for (int j = 0; j < 4; ++j) { const int blk = 4 * j8 + j; imp[blk] = (iw[blk] + iw[32 * 33 + blk]) + (iw[2 * 32 * 33 + blk] + iw[3 * 32 * 33 + blk]); }
      __syncthreads();
      unsigned bits = 0u;
      if (cur <= 15) bits = 0xffffffffu;
      else {
          float y[32];
#pragma unroll
          for (int q4 = 0; q4 < 8; ++q4) { const f32x4 v = *(const LAS f32x4*)(imp + 4 * q4); y[4 * q4] = v.x; y[4 * q4 + 1] = v.y; y[4 * q4 + 2] = v.z; y[4 * q4 + 3] = v.w; }
#pragma unroll
          for (int j = 0; j < 4; ++j) { const int blk = 4 * j8 + j;
              if (blk == 0 || blk == cur || blk == cur - 1) bits |= 1u << blk;
              else if (blk < cur - 1) { float x = 0.f;
#pragma unroll
                  for (int o2 = 0; o2 < 32; ++o2) x = (o2 == blk) ? y[o2] : x;
                  int rank = 0;
#pragma unroll
                  for (int o2 = 1; o2 < 30; ++o2) rank += (o2 <= cur - 2 && (y[o2] > x || (y[o2] == x && o2 < blk))) ? 1 : 0;
                  if (rank < 13) bits |= 1u << blk; } } }
      bits |= __shfl_xor(bits, 1); bits |= __shfl_xor(bits, 2); bits |= __shfl_xor(bits, 4);
      if (j8 == 0) ((LAS unsigned*)(lds + P3_SEL))[tk] = bits;
      __syncthreads();
      if (wave == 0) { unsigned um = ((const LAS unsigned*)(lds + P3_SEL))[lane];
#pragma unroll
          for (int o2 = 1; o2 < 64; o2 <<= 1) um |= __shfl_xor(um, o2);
          if (lane == 0) *(LAS unsigned*)(lds + P3_UM) = um; }
      __syncthreads();
    }
    }
    const unsigned selbits = ((const LAS unsigned*)(lds + P3_SEL))[32 * th + r], umask = *(const LAS unsigned*)(lds + P3_UM);
    f32x16 os[2]; zero_o(os); float m = -1e30f, l = 0.f;
    f32x16 cinit[2]; alibi_cinit(cinit, slope2);
    { const bf16* KS = (const bf16*)(ws + WS_KSEL) + (size_t)b * TP * 128 + g * 64; const bf16* VS = (const bf16*)(ws + WS_VSEL) + (size_t)b * TP * 128 + g * 64;
      unsigned todo = umask & (cur >= 31 ? 0xffffffffu : ((2u << cur) - 1u));
      int blk = 31 - __builtin_clz(todo); todo &= ~(1u << blk);
      int nb1 = todo ? 31 - __builtin_clz(todo) : -1; if (nb1 >= 0) todo &= ~(1u << nb1);
      { const v4u k0 = tile_ld(KS + (size_t)(64 * blk) * 128, 128, tid), v0 = tile_ld(VS + (size_t)(64 * blk) * 128, 128, tid);
        tile_st(lds + P3_KS, KP, tid, k0); tile_st(lds + P3_KS + KT_BYTES, VP, tid, v0); }
      v4u kr = {0u, 0u, 0u, 0u}, vr = {0u, 0u, 0u, 0u};
      if (nb1 >= 0) { kr = tile_ld(KS + (size_t)(64 * nb1) * 128, 128, tid); vr = tile_ld(VS + (size_t)(64 * nb1) * 128, 128, tid); }
      int st = 0;
      for (;;) {
          __syncthreads();
          LAS unsigned char* Ks = lds + P3_KS + st * (KT_BYTES + VT_BYTES); LAS unsigned char* Vs = Ks + KT_BYTES;
          if (nb1 >= 0) { LAS unsigned char* Kn = lds + P3_KS + (st ^ 1) * (KT_BYTES + VT_BYTES); tile_st(Kn, KP, tid, kr); tile_st(Kn + KT_BYTES, VP, tid, vr); }
          const int nb2 = todo ? 31 - __builtin_clz(todo) : -1; if (nb2 >= 0) todo &= ~(1u << nb2);
          if (nb2 >= 0) { kr = tile_ld(KS + (size_t)(64 * nb2) * 128, 128, tid); vr = tile_ld(VS + (size_t)(64 * nb2) * 128, 128, tid); }
          const int kb = 64 * blk; const bool mine = (selbits >> blk) & 1u;
          if (__any(mine)) {
              for (int dupc = 0; dupc < ((DBG_DUP & 32) ? 2 : 1); ++dupc) {
              f32x16 s[2]; qk64c(s, Ks, qf, cinit, lane);
              const float off = slope2 * (float)(kb + 4 * h);
              if (blk == cur) sm2_tile<true>(s, m, l, os, off, mine && dupc == 0, -(1 << 30), tpos - kb - 4 * h);
              else sm2_tile<false>(s, m, l, os, off, mine && dupc == 0, 0, 0);
              pv64(os, Vs, s, lane); } }
          if (nb1 < 0) break;
          blk = nb1; nb1 = nb2; st ^= 1;
      } }
    l += __shfl_xor(l, 32);
    { const float* br = (const float*)(ws + WS_BR) + mrow * 24 + hq * 3; const float g0 = br[0], g1 = br[1] / l;
      const bf16* OW = (const bf16*)(ws + WS_OW) + mrow * 512 + hq * 64; const bf16* GB = (const bf16*)(ws + WS_GB) + mrow * 512 + hq * 64; bf16* U = (bf16*)(ws + WS_U) + mrow * 1024 + 512 + hq * 64;
      v2u grp[8];
#pragma unroll
      for (int dh = 0; dh < 2; ++dh)
#pragma unroll
          for (int aa = 0; aa < 4; ++aa) { const int d0 = 32 * dh + 8 * aa + 4 * h; const v2u ow = *(const GAS v2u*)(OW + d0), gb = *(const GAS v2u*)(GB + d0);
              const float x0 = (g0 * oc[dh][4 * aa] + g1 * os[dh][4 * aa] + bf_lo(ow.x)) * bf_lo(gb.x), x1 = (g0 * oc[dh][4 * aa + 1] + g1 * os[dh][4 * aa + 1] + bf_hi(ow.x)) * bf_hi(gb.x);
              const float x2 = (g0 * oc[dh][4 * aa + 2] + g1 * os[dh][4 * aa + 2] + bf_lo(ow.y)) * bf_lo(gb.y), x3 = (g0 * oc[dh][4 * aa + 3] + g1 * os[dh][4 * aa + 3] + bf_hi(ow.y)) * bf_hi(gb.y);
              grp[4 * dh + aa].x = cvtpk(x0, x1); grp[4 * dh + aa].y = cvtpk(x2, x3); }
      store_row_wide(U, grp, h); }
}

constexpr int SM_V = 0, SM_ACC = 8 * VT_BYTES  , SM_ST = SM_ACC + 8192, SM_IMP = SM_ST + 3 * 8 * 32 * 2 * 4  , SM_SELW = SM_IMP + 8 * 128 * 4, SM_END = SM_SELW + 128;
static_assert(SM_END <= RING_BYTES, "sample NSA LDS map");
template <class F> __device__ __forceinline__ void sm_tile_f32(f32x16 (&o)[2], float& m, float& l, const float* kbase, const float* vbase, int stride, int maxrow, LAS unsigned char* Vs, const bf16x8 (&qf)[4], int lane, F&& biasf) {
    const int h = lane >> 5;
    f32x4 kt[2][4][2];
#pragma unroll
    for (int kh = 0; kh < 2; ++kh) { const int row = min(32 * kh + (lane & 31), maxrow); const float* kp = kbase + (size_t)row * stride + 8 * h;
#pragma unroll
        for (int ks = 0; ks < 4; ++ks) { kt[kh][ks][0] = *(const GAS f32x4*)(kp + 16 * ks); kt[kh][ks][1] = *(const GAS f32x4*)(kp + 16 * ks + 4); } }
    f32x4 va[4][2], vb[4][2];
#pragma unroll
    for (int i = 0; i < 4; ++i) { const float* vp = vbase + (size_t)min(8 * i + (lane >> 3), maxrow) * stride + (lane & 7) * 8; va[i][0] = *(const GAS f32x4*)vp; va[i][1] = *(const GAS f32x4*)(vp + 4); }
    f32x16 s[2];
#pragma unroll
    for (int kh = 0; kh < 2; ++kh) { f32x16 acc; for (int i = 0; i < 16; ++i) acc[i] = 0.f;
#pragma unroll
        for (int ks = 0; ks < 4; ++ks) { const bf16x8 kf8 = pack8(kt[kh][ks][0], kt[kh][ks][1]); __builtin_amdgcn_s_setprio(1); acc = MFMA32(kf8, qf[ks], acc); __builtin_amdgcn_s_setprio(0); }
        s[kh] = acc; }
#pragma unroll
    for (int i = 0; i < 4; ++i) { const float* vp = vbase + (size_t)min(8 * (i + 4) + (lane >> 3), maxrow) * stride + (lane & 7) * 8; vb[i][0] = *(const GAS f32x4*)vp; vb[i][1] = *(const GAS f32x4*)(vp + 4); }
#pragma unroll
    for (int i = 0; i < 4; ++i) *(LAS bf16x8*)(Vs + (8 * i + (lane >> 3)) * VP + (lane & 7) * 16) = pack8(va[i][0], va[i][1]);
    softmax_tile(s, m, l, o, h, biasf);
#pragma unroll
    for (int i = 0; i < 4; ++i) *(LAS bf16x8*)(Vs + (8 * (i + 4) + (lane >> 3)) * VP + (lane & 7) * 16) = pack8(vb[i][0], vb[i][1]);
    asm volatile("" ::: "memory");
    pv64(o, Vs, s, lane);
    asm volatile("" ::: "memory");
}
__device__ __forceinline__ void sm_put_stats(LAS float* st, int br, int wave, int lane, float m, float l) { if (lane < 32) { st[((br * 8 + wave) * 32 + lane) * 2] = m; st[((br * 8 + wave) * 32 + lane) * 2 + 1] = l; } }
__device__ __forceinline__ void sm_get_ML(const LAS float* st, int br, int r, float& M, float& L) {
    M = -1e30f;
#pragma unroll
    for (int w = 0; w < 8; ++w) M = fmaxf(M, st[((br * 8 + w) * 32 + r) * 2]);
    L = 0.f;
#pragma unroll
    for (int w = 0; w < 8; ++w) L += st[((br * 8 + w) * 32 + r) * 2 + 1] * fexp2(st[((br * 8 + w) * 32 + r) * 2] - M);
}
__device__ __forceinline__ void sm_put(LAS float* slice, const f32x16 (&o)[2], float f, int lane) {
    const int r = lane & 31, h = lane >> 5;
#pragma unroll
    for (int dh = 0; dh < 2; ++dh)
#pragma unroll
        for (int v = 0; v < 16; ++v) { const int d = 32 * dh + (v & 3) + 8 * (v >> 2) + 4 * h; slice[d * 32 + r] = o[dh][v] * f; }
}
__device__ __forceinline__ void item_nsa_sample(const Args& a, LAS unsigned char* lds, int it, int tid, int lane, int wave) {
    unsigned char* ws = a.ws; const int sb = it >> 1, g = it & 1;
    const int r = lane & 31, h = lane >> 5, st = r >> 2, hh = r & 3, hq = 4 * g + hh, t = 8192 + st; const size_t mrow = (size_t)MP + sb * 8 + st;
    const float* cn = (const float*)a.in[IN_CNSA]; const int* pt = (const int*)a.in[IN_PT] + sb * 64; const float* sw = (const float*)a.in[IN_SWIN];
    LAS unsigned char* Vs = lds + SM_V + wave * VT_BYTES; LAS float* acc = (LAS float*)(lds + SM_ACC); LAS float* stt = (LAS float*)(lds + SM_ST); LAS float* imp = (LAS float*)(lds + SM_IMP);
    LAS unsigned long long* selw = (LAS unsigned long long*)(lds + SM_SELW);
    const float slope2 = fexp2(-(float)(hq + 1)) * LOG2E;
    const float* br = (const float*)(ws + WS_BR) + mrow * 24 + hq * 3; const float g0 = br[0], g1 = br[1], g2 = br[2];
    bf16x8 qf[4]; load_qf(qf, (const bf16*)(ws + WS_QB) + mrow * 512 + hq * 64, lane);
    f32x16 ow[2]; zero_o(ow); float mw = -1e30f, lw = 0.f;
#pragma unroll 1
    for (int pass = 0; pass < 2; ++pass) { if (pass == 1 && wave != 4) break;
        const int j = pass == 0 ? wave : 8, i0 = 64 * j;
        const float* rows = (j < 8) ? sw + ((size_t)(sb * 512 + i0)) * 256 : a.out + OFF_WINS + ((size_t)(sb * 512 + 504)) * 256;
        sm_tile_f32(ow, mw, lw, rows + g * 64, rows + 128 + g * 64, 256, j < 8 ? 63 : 7, Vs, qf, lane, [&](int ki) { const int i = i0 + ki, dist = t - (7680 + i); return (i < 520 && dist >= 0 && dist < 512) ? -slope2 * (float)dist : -INFINITY; }); }
    if (DBG_DUP & 4) { f32x16 o2[2]; zero_o(o2); float m2 = -1e30f, l2 = 0.f;
#pragma unroll 1
        for (int pass = 0; pass < 2; ++pass) { if (pass == 1 && wave != 4) break;
            const int j = pass == 0 ? wave : 8, i0 = 64 * j;
            const float* rows = (j < 8) ? sw + ((size_t)(sb * 512 + i0)) * 256 : a.out + OFF_WINS + ((size_t)(sb * 512 + 504)) * 256;
            sm_tile_f32(o2, m2, l2, rows + g * 64, rows + 128 + g * 64, 256, j < 8 ? 63 : 7, Vs, qf, lane, [&](int ki) { const int i = i0 + ki, dist = t - (7680 + i); return (i < 520 && dist >= 0 && dist < 512) ? -slope2 * (float)dist : -INFINITY; }); }
        if (m2 == 12345.f) ow[0][0] += o2[0][0] + l2; }
    lw += __shfl_xor(lw, 32);
    sm_put_stats(stt, 2, wave, lane, mw, lw);
    f32x16 oc[2]; zero_o(oc); f32x16 ec[2]; float mc = -1e30f, lc = 0.f;
    if (wave < 4) {
        const bf16* KC = (const bf16*)(ws + WS_KCS) + ((size_t)((sb * 2 + g) * 256 + 64 * wave)) * 64; const bf16* VC = (const bf16*)(ws + WS_VCS) + ((size_t)((sb * 2 + g) * 256 + 64 * wave)) * 64;
        v4u vr[8];
#pragma unroll
        for (int i = 0; i < 8; ++i) vr[i] = *(const GAS v4u*)(VC + (size_t)(8 * i + (lane >> 3)) * 64 + (lane & 7) * 8);
        qk64_g(ec, KC, 64, qf, lane);
#pragma unroll
        for (int i = 0; i < 8; ++i) *(LAS v4u*)(Vs + (8 * i + (lane >> 3)) * VP + (lane & 7) * 16) = vr[i];
        const int c0 = 64 * wave;
        softmax_tile(ec, mc, lc, oc, h, [&](int ki) { return -slope2 * (float)(t - (32 * (c0 + ki) + 31)); });
        asm volatile("" ::: "memory");
        pv64(oc, Vs, ec, lane);
        asm volatile("" ::: "memory");
        lc += __shfl_xor(lc, 32);
    }
    sm_put_stats(stt, 0, wave, lane, mc, lc);
    __syncthreads();
    LAS float* mbuf = (LAS float*)(lds + SM_V);
    { float M, L; sm_get_ML(stt, 2, r, M, L); sm_put(mbuf + wave * 2048, ow, (L > 0.f) ? g2 * fexp2(mw - M) / L : 0.f, lane); }
    if (wave < 4) { float M, L; sm_get_ML(stt, 0, r, M, L); const float f = fexp2(mc - M) / L;
        sm_put(mbuf + (8 + wave) * 2048, oc, g0 * f, lane);
#pragma unroll
        for (int kh = 0; kh < 2; ++kh)
#pragma unroll
            for (int aa = 0; aa < 4; ++aa)
#pragma unroll
                for (int b2 = 0; b2 < 2; ++b2) { float v = (ec[kh][4 * aa + 2 * b2] + ec[kh][4 * aa + 2 * b2 + 1]) * f; v += __shfl_xor(v, 1); v += __shfl_xor(v, 2);
                    if (hh == 0) imp[st * 128 + 32 * wave + 16 * kh + 4 * aa + 2 * h + b2] = v; } }
    __syncthreads();
    { f32x4 sum = {0.f, 0.f, 0.f, 0.f};
#pragma unroll
      for (int w = 0; w < 12; ++w) sum += *(const LAS f32x4*)(mbuf + w * 2048 + tid * 4);
      *(LAS f32x4*)(acc + tid * 4) = sum; }
    for (int dup = 0; dup < ((DBG_DUP & 2) ? 2 : 1); ++dup)
    { const LAS float* im = imp + wave * 128; bool s0, s1;
      { const int blk = lane; if (blk == 0) s0 = true; else { const float x = im[blk]; int rank = 0; for (int o2 = 1; o2 <= 126; ++o2) { const float y = im[o2]; rank += (y > x || (y == x && o2 < blk)) ? 1 : 0; } s0 = rank < 13; } }
      { const int blk = lane + 64; if (blk == 127) s1 = true; else { const float x = im[blk]; int rank = 0; for (int o2 = 1; o2 <= 126; ++o2) { const float y = im[o2]; rank += (y > x || (y == x && o2 < blk)) ? 1 : 0; } s1 = rank < 13; } }
      const unsigned long long b0 = __ballot(s0), b1 = __ballot(s1);
      if (lane == 0) { selw[2 * wave] = b0; selw[2 * wave + 1] = b1; } }
    __syncthreads();
    f32x16 os[2]; zero_o(os); float ms = -1e30f, ls = 0.f;
    { unsigned long long u0 = 0ull, u1 = 0ull;
#pragma unroll
      for (int s8 = 0; s8 < 8; ++s8) { u0 |= selw[2 * s8]; u1 |= selw[2 * s8 + 1]; }
      const unsigned long long my0 = selw[2 * st], my1 = selw[2 * st + 1];
      int cnt = 0;
      for (int dup8 = 0; dup8 < ((DBG_DUP & 8) ? 2 : 1); ++dup8)
      for (int half = 0; half < 3; ++half) { unsigned long long bits = half == 0 ? u0 : (half == 1 ? u1 : 1ull);
          while (bits) { const int bi = __builtin_ctzll(bits); bits &= bits - 1; const int blk = 64 * half + bi;
              if ((cnt++ & 7) != wave) continue;
              const float* rows = (blk < 128) ? cn + ((size_t)pt[blk >> 1] * 128 + (blk & 1) * 64) * 512 : a.out + OFF_NSA + ((size_t)(MP + sb * 8)) * 512;
              const bool mine = (dup8 == 0) && (half == 0 ? ((my0 >> bi) & 1ull) : (half == 1 ? ((my1 >> bi) & 1ull) : true));
              const int kb = 64 * blk;
              sm_tile_f32(os, ms, ls, rows + 256 + g * 64, rows + 384 + g * 64, 512, blk < 128 ? 63 : 7, Vs, qf, lane, [&](int ki) { const int dist = t - (kb + ki); return (mine && dist >= 0) ? -slope2 * (float)dist : -INFINITY; }); } } }
    ls += __shfl_xor(ls, 32);
    sm_put_stats(stt, 1, wave, lane, ms, ls);
    __syncthreads();
    { float M, L; sm_get_ML(stt, 1, r, M, L); sm_put(mbuf + wave * 2048, os, (L > 0.f) ? g1 * fexp2(ms - M) / L : 0.f, lane); }
    __syncthreads();
    { f32x4 sum = *(const LAS f32x4*)(acc + tid * 4);
#pragma unroll
      for (int w = 0; w < 8; ++w) sum += *(const LAS f32x4*)(mbuf + w * 2048 + tid * 4);
      *(LAS f32x4*)(acc + tid * 4) = sum; }
    __syncthreads();
    { const int r2 = tid >> 4, d4 = (tid & 15) * 4; const size_t m2 = (size_t)MP + sb * 8 + (r2 >> 2); const int hq2 = 4 * g + (r2 & 3);
      const v2u gb = *(const GAS v2u*)((const bf16*)(ws + WS_GB) + m2 * 512 + hq2 * 64 + d4);
      v2u w; w.x = cvtpk(acc[(d4 + 0) * 32 + r2] * bf_lo(gb.x), acc[(d4 + 1) * 32 + r2] * bf_hi(gb.x)); w.y = cvtpk(acc[(d4 + 2) * 32 + r2] * bf_lo(gb.y), acc[(d4 + 3) * 32 + r2] * bf_hi(gb.y));
      *(GAS v2u*)((bf16*)(ws + WS_U) + m2 * 1024 + 512 + hq2 * 64 + d4) = w; }
}

#ifndef MK_N_LAUNCHES
#define MK_N_LAUNCHES 1
#endif
#ifndef DBG_STAGE
#define DBG_STAGE 0
#endif
constexpr int N_PHASES = 6;
constexpr int N_L2S = 64, N_SBS = 32, N_WINP = 256, N_SBP = 512, N_NP = 512, N_NS = 64;

__global__ void __launch_bounds__(NTHR, 2) mk_fwd(Args a) {
    extern __shared__ __attribute__((aligned(16))) unsigned char lds_raw[];
    LAS unsigned char* lds = (LAS unsigned char*)lds_raw;
    const int tid0 = threadIdx.x;
    const int G = gridDim.x, bx = blockIdx.x, vcu = (G % 8 == 0) ? (bx % 8) * (G / 8) + bx / 8 : bx;
    unsigned char* ws = a.ws; gu32* ctl = (gu32*)(ws + WS_CTL);
    for (int u = tid0; u < (LDS_BYTES - LDSCTL_OFF) / 4; u += NTHR) ((LAS unsigned*)(lds + LDSCTL_OFF))[u] = 0u;
    __syncthreads();
    volatile LAS unsigned* MISC = (volatile LAS unsigned*)(lds + MISC_OFF);
    volatile LAS int* qslot = (volatile LAS int*)(lds + LDSCTL_OFF + 64);
    const int lo = a.ph_lo, hi = a.ph_hi; const bool multi = (hi - lo) > 1;
    XcdBarrier bar; bar.bar = (unsigned*)(ctl + CW_BAR); bar.x = 0; bar.st = nullptr;
    if (multi) bar = xcd_barrier_post((unsigned*)(ctl + CW_BAR), MISC + 8);
#ifdef DBG_PHMASK
#define IN(k) (((DBG_PHMASK >> (k)) & 1) && lo <= (k) && (k) < hi)
#else
#define IN(k) (lo <= (k) && (k) < hi)
#endif
#define SEAM(k) do { if (IN(k) && IN((k) + 1)) xcd_barrier(bar); } while (0)
#ifndef DBG_REP
#define DBG_REP (-1)
#endif
#define NREP(k) ((DBG_REP == (k)) ? 2 : 1)
#define REPSEAM(k) do { if (rep + 1 < NREP(k)) xcd_barrier(bar); } while (0)

    if (IN(0)) _Pragma("unroll") for (int rep = 0; rep < NREP(0); ++rep) { int tid = tid0; asm volatile("" : "+v"(tid)); p0_prologue(a, lds, tid, tid & 63, __builtin_amdgcn_readfirstlane(tid >> 6), vcu, G, rep); REPSEAM(0); }
    SEAM(0);

    if (IN(1)) { _Pragma("unroll") for (int rep = 0; rep < NREP(1); ++rep) {
#ifndef DBG_P1MASK
#define DBG_P1MASK 7
#endif
        const int xcc = (int)xb_xcc_id(); volatile LAS int* gslot = (volatile LAS int*)(lds + LDSCTL_OFF + 128);
#ifndef DBG_P1REPM
#define DBG_P1REPM 7
#endif
#define P1ON(bit) ((DBG_P1MASK & (bit)) && (rep == 0 || (DBG_P1REPM & (bit))))
        const int ngb = G < 128 ? G : 128;
        if (P1ON(1) && bx < ngb) {
#pragma unroll 1
            for (int L = bx; L < 256; L += ngb) {
                pg8::EpiHidB128 E{(bf16*)(ws + WS_HIDS), (const float*)(ws + WS_CTL) + CW_BIAS + (L >> 7) * 256};
                pg8::gemm_unit_gather128(lds, (const float*)a.in[IN_CNSA], (const int*)a.in[IN_PT], (const bf16*)(ws + WS_W1T), L, E); } }
        if (P1ON(4)) { pg8::Gemm g{(const bf16*)(ws + WS_HBF), (const bf16*)(ws + WS_WIN_T), MT, NG1, 1024};
          pg8::HybridOrder S; S.q = (unsigned*)(ctl + CW_Q + 64 * 16 + 4096 * rep); S.slot = gslot; S.nM = MT / 256; S.nN = NG1 / 256; S.nwg = S.nM * S.nN; S.dyn0 = 640;
          if (G != 256) { S.ns = 0; S.l0 = 0; S.lstride = 0; S.dyn0 = 0; }
          else if (bx >= 128) { S.ns = 4; S.l0 = bx - 128; S.lstride = 128; } else { S.ns = 1; S.l0 = 512 + bx; S.lstride = 0; }
#ifdef DBG_G1STATIC
          if (rep == 1) { S.ns = 4; S.l0 = bx; S.lstride = 256; S.dyn0 = 975; if (bx + 768 >= 975) S.ns = 3; }
#endif
          pg8::EpiG1 E{a.out, (const float*)(ws + WS_RSTD), (bf16*)(ws + WS_QA), (bf16*)(ws + WS_KA), (bf16*)(ws + WS_VA), (bf16*)(ws + WS_GA), (bf16*)(ws + WS_QB), (bf16*)(ws + WS_GB),
                       (bf16*)(ws + WS_KSEL), (bf16*)(ws + WS_VSEL), (bf16*)(ws + WS_KWIN), (bf16*)(ws + WS_VWIN), (bf16*)(ws + WS_ACMP_P),
                       (const float*)a.in[IN_QG], (const float*)a.in[IN_KSG], (const float*)a.in[IN_KWG], (const float*)a.in[IN_PEK], (const float*)a.in[IN_PEV]};
#ifdef DBG_NOEPI
#if DBG_NOEPI == 2
#ifdef DBG_TILECONTIG
          if (rep == 1) { pg8::EpiBf16<0> E0{(bf16*)(ws + WS_ACMP_S), 256, nullptr, 256, (size_t)65 * 65536, 1.f};
#else
          if (rep == 1) { pg8::EpiBf16<0> E0{(bf16*)(ws + WS_ACMP_S), NG1, nullptr, 0, 0, 1.f};
#endif
          pg8::gemm_phase<pg8::EpiBf16<0>, pg8::HybridOrder, PG8_ALIGN, PG8_SP2>(lds, g, S, E0); } else
#else
          if (rep == 1) { pg8::EpiNone E0; pg8::gemm_phase<pg8::EpiNone, pg8::HybridOrder, PG8_ALIGN, PG8_SP2>(lds, g, S, E0); } else
#endif
#endif
          pg8::gemm_phase<pg8::EpiG1, pg8::HybridOrder, PG8_ALIGN, PG8_SP2>(lds, g, S, E); }
        if (P1ON(2)) { pg8::Gemm g{(const bf16*)(ws + WS_PBF), (const bf16*)(ws + WS_WPLE_T), MT, 1024, 256}; pg8::XcdQueueOrder S; S.init(MT, 1024, (unsigned*)(ctl + CW_Q + 64 * 24 + 4096 * rep), gslot, xcc);
          pg8::EpiBf16<0> E{(bf16*)(ws + WS_T1), 1024, nullptr, 0, 0, 1.f};
          pg8::gemm_phase<pg8::EpiBf16<0>, pg8::XcdQueueOrder, PG8_ALIGN, PG8_SP2, true>(lds, g, S, E); }
        REPSEAM(1); }
        SEAM(1);
    }

    if (IN(2)) { _Pragma("unroll") for (int rep = 0; rep < NREP(2); ++rep) {
#if DBG_STAGE == 1
        { v4u z = {0u, 0u, 0u, 0u}; for (size_t i = (size_t)bx * NTHR + tid0; i < (size_t)MT * 1024 / 8; i += (size_t)G * NTHR) *(GAS v4u*)((bf16*)(ws + WS_U) + i * 8) = z; }
#else
        if (bx < 16) {
            const int slot = bx >> 3, b = bx & 7;
            { pg8::EpiHidB128 E{(bf16*)(ws + WS_HIDP), (const float*)(ws + WS_CTL) + CW_BIAS + 1024  };
              pg8::gemm_unit_bf16_128(lds, (const bf16*)(ws + WS_ACMP_P) + (size_t)bx * 128 * 2048, (const bf16*)(ws + WS_W1T), slot, bx * 128, E); }
            VM_WAIT(); __syncthreads();
            int t2 = tid0; asm volatile("" : "+v"(t2)); const int ln = t2 & 63, wv = __builtin_amdgcn_readfirstlane(t2 >> 6);
            if (wv < 4) { const int g = wv >> 1, chf = wv & 1;
                const bf16* hid0 = (const bf16*)(ws + WS_HIDP) + ((size_t)slot * 1024 + (size_t)(b * 64 + 32 * chf) * 2 + g) * 256;
                unsigned char* dst = ws + (slot ? WS_VCP : WS_KCP) + ((size_t)((b * 2 + g) * 64 + 32 * chf)) * 128;
                l2_wave<false>((const bf16*)(ws + WS_W2T) + slot * 64 * 256, hid0, 512, slot ? nullptr : (const float*)a.in[IN_KCG], dst, 128, ln); } }
        for (;;) {
            int it = next_item(ctl + CW_Q + 128 * rep, qslot);
            int tid = tid0; asm volatile("" : "+v"(tid)); const int lane = tid & 63, wave = __builtin_amdgcn_readfirstlane(tid >> 6);
            if (it >= N_NS + N_SBS + N_WINP + N_SBP) break;
#ifndef DBG_IM
#define DBG_IM 63
#endif
#ifndef DBG_REPIM
#define DBG_REPIM 63
#endif
#define IMON(bit) ((DBG_IM & (bit)) && (rep == 0 || (DBG_REPIM & (bit))))
            if (it < N_NS) { if (IMON(32)) { item_l2_sample(a, it, lane, wave); if (DBG_DUP & 1) { VM_WAIT(); item_l2_sample(a, it, lane, wave); } VM_WAIT(); __syncthreads(); item_nsa_sample(a, lds, it, tid, lane, wave); if (DBG_DUP & 16) { __syncthreads(); item_nsa_sample(a, lds, it, tid, lane, wave); } } continue; } it -= N_NS;
            if (it < N_SBS) { if (IMON(2)) item_sb_sample(a, lds, it, lane, wave); continue; } it -= N_SBS;
            if (it < N_WINP) { if (IMON(4)) item_win_prompt(a, lds, it, tid, lane, wave); continue; } it -= N_WINP;
            if (IMON(8)) item_sb_prompt(a, lds, it, lane, wave);
        }
#endif
        REPSEAM(2); }
        SEAM(2);
    }

    if (IN(3)) { _Pragma("unroll") for (int rep = 0; rep < NREP(3); ++rep) {
#if DBG_STAGE != 1
        for (;;) {
            int it = next_item(ctl + CW_Q + 64 + 128 * rep, qslot);
            int tid = tid0; asm volatile("" : "+v"(tid)); const int lane = tid & 63, wave = __builtin_amdgcn_readfirstlane(tid >> 6);
            if (it >= N_NP + 8) break;
            gu32* dep1 = ctl + CW_Q + 64 * 41;
            if (it < 4 || (it >= 300 && it < 304)) {
                const bool second = it >= 300; const int pn = second ? it - 300 : it;
                if (rep == 0) {
                if (!second) { pg8::Gemm g{(const bf16*)(ws + WS_U), (const bf16*)(ws + WS_WOUT_T), MT, 1024, 1024}; pg8::OneUnit S{64, pn};
                    pg8::EpiOut E{(const bf16*)(ws + WS_HBF), (bf16*)(ws + WS_HB2)};
                    pg8::gemm_phase<pg8::EpiOut, pg8::OneUnit, PG8_ALIGN, PG8_SP2>(lds, g, S, E);
                    VM_WAIT(); __syncthreads();
                    if (tid == 0) { __builtin_amdgcn_fence(__ATOMIC_RELEASE, "agent"); VM_WAIT(); (void)__hip_atomic_fetch_add(dep1, 1u, RLX_AGENT); } }
                else {
                    if (tid == 0) { unsigned sp = 0; while (__hip_atomic_load(dep1, RLX_AGENT) < 4u) { __builtin_amdgcn_s_sleep(2); if (++sp > (1u << 22)) break; }
                        __builtin_amdgcn_fence(__ATOMIC_ACQUIRE, "agent"); VM_WAIT(); }
                    __syncthreads();
                    pg8::Gemm g{(const bf16*)(ws + WS_HB2), (const bf16*)(ws + WS_WG_T), MT, 1024, 1024}; pg8::OneUnit S{64, pn};
                    pg8::EpiFinal E{a.out, (const bf16*)(ws + WS_T1), (const bf16*)(ws + WS_HB2)};
                    pg8::gemm_phase<pg8::EpiFinal, pg8::OneUnit, PG8_ALIGN, PG8_SP2>(lds, g, S, E); }
                }
                continue; }
            it -= (it >= 304) ? 8 : 4;
            if (IMON(16)) item_nsa_prompt(a, lds, it, tid, lane, wave);
        }
#endif
        REPSEAM(3); }
        SEAM(3);
    }

    if (IN(4)) { _Pragma("unroll") for (int rep = 0; rep < NREP(4); ++rep) {
        pg8::Gemm g{(const bf16*)(ws + WS_U), (const bf16*)(ws + WS_WOUT_T), MP, 1024, 1024}; pg8::StaticOrder S; S.init(MP, 1024, G, bx);
        pg8::EpiOut E{(const bf16*)(ws + WS_HBF), (bf16*)(ws + WS_HB2)};
        pg8::gemm_phase<pg8::EpiOut, pg8::StaticOrder, PG8_ALIGN, PG8_SP2>(lds, g, S, E);
        REPSEAM(4); }
        SEAM(4);
    }
    if (IN(5)) {
        pg8::Gemm g{(const bf16*)(ws + WS_HB2), (const bf16*)(ws + WS_WG_T), MP, 1024, 1024}; pg8::StaticOrder S; S.init(MP, 1024, G, bx);
        pg8::EpiFinal E{a.out, (const bf16*)(ws + WS_T1), (const bf16*)(ws + WS_HB2)};
        pg8::gemm_phase<pg8::EpiFinal, pg8::StaticOrder, PG8_ALIGN, PG8_SP2>(lds, g, S, E);
    }
#undef IN
#undef SEAM
}

extern "C" void kernel_launch(void* const* d_in, const int* in_sizes, int n_in, void* d_out, int out_size, void* d_ws, size_t ws_size, hipStream_t stream) {
    static int grid = 0;
    if (grid == 0) {
        if (n_in != N_INPUTS || (size_t)out_size != OUT_TOTAL || ws_size < WS_END) { fprintf(stderr, "kernel_launch: unexpected shapes (n_in %d, out %d, ws %zu); nothing launched\n", n_in, out_size, ws_size); grid = -1; return; }
        int dev = 0, cus = 0;
        if (hipGetDevice(&dev) != hipSuccess || hipDeviceGetAttribute(&cus, hipDeviceAttributeMultiprocessorCount, dev) != hipSuccess) { grid = -1; return; }
        if (hipFuncSetAttribute((const void*)mk_fwd, hipFuncAttributeMaxDynamicSharedMemorySize, LDS_BYTES) != hipSuccess) { fprintf(stderr, "kernel_launch: hipFuncSetAttribute failed\n"); grid = -1; return; }
        int per_cu = 0;
        if (hipOccupancyMaxActiveBlocksPerMultiprocessor(&per_cu, (const void*)mk_fwd, NTHR, LDS_BYTES) != hipSuccess || per_cu < 1) { fprintf(stderr, "kernel_launch: occupancy query says %d\n", per_cu); per_cu = 1; }
        (void)hipGetLastError();
        grid = cus;
    }
    if (grid < 0) return;
    if (hipMemsetAsync((char*)d_ws + WS_CTL, 0, CTL_ZERO_BYTES, stream) != hipSuccess) { fprintf(stderr, "kernel_launch: memset failed\n"); return; }
    Args a{};
    for (int i = 0; i < N_INPUTS; ++i) a.in[i] = d_in[i];
    a.out = (float*)d_out; a.ws = (unsigned char*)d_ws;
#if MK_N_LAUNCHES == 1
    a.ph_lo = 0; a.ph_hi = N_PHASES;
    hipLaunchKernelGGL(mk_fwd, dim3(grid), dim3(NTHR), LDS_BYTES, stream, a);
#else
    for (int p = 0; p < N_PHASES; ++p) { a.ph_lo = p; a.ph_hi = p + 1; hipLaunchKernelGGL(mk_fwd, dim3(grid), dim3(NTHR), LDS_BYTES, stream, a); }
#endif
    const hipError_t le = hipPeekAtLastError();
    if (le != hipSuccess) fprintf(stderr, "kernel_launch: launch failed: %s\n", hipGetErrorName(le));
}
```

```cpp
#include <hip/hip_runtime.h>
#include <cstdio>
#include <cstdint>
namespace pg8 {
#define PG8_LAS __attribute__((address_space(3)))
typedef unsigned short bf16_t;
typedef short bf16x8 __attribute__((ext_vector_type(8)));
typedef float f32x4 __attribute__((ext_vector_type(4)));
typedef unsigned u32x4 __attribute__((ext_vector_type(4)));
constexpr int BM = 256, BK = 64, HALF = 128, HTB = HALF * BK * 2  , STAGE_BYTES = 8 * HTB, NXCD = 8, WGM = 8;

__host__ __device__ __forceinline__ int lds_byte(int r, int c) { const int st = (r >> 4) * 2 + (c >> 5), rr = r & 15, cc = c & 31, ob = rr * 64 + cc * 2; return st * 1024 + (ob ^ (((ob >> 9) & 1) << 5)); }
__host__ __device__ __forceinline__ void stage_rc(int b, int& R, int& C) { const int st = b / 1024, sb = b % 1024, swz = sb ^ (((sb >> 9) & 1) << 5); R = (st >> 1) * 16 + swz / 64; C = (st & 1) * 32 + (swz % 64) / 2; }
__host__ __device__ __forceinline__ int perm32(int rho) { const int n = rho >> 4, i = rho & 15; return 8 * (i >> 2) + 4 * n + (i & 3); }

struct Unit { int pm, pn; };
struct Gemm { const bf16_t* A; const bf16_t* Bt; int M, N, K; };

struct StaticOrder {
    int nM, nN, nwg, G, c;
    __host__ __device__ void init(int M, int N, int G_, int c_) { nM = M / BM; nN = N / BM; nwg = nM * nN; G = G_; c = c_; }
    __host__ __device__ bool next(int i, Unit& u) const {
        const long L = (long)i * G + c; if (L >= nwg) return false;
        int wgid = (int)L; { const int q = nwg / NXCD, r = nwg % NXCD, xcd = wgid % NXCD, off = wgid / NXCD; wgid = (xcd < r ? xcd * (q + 1) : r * (q + 1) + (xcd - r) * q) + off; }
        const int nig = WGM * nN, gid = wgid / nig, fm = gid * WGM, gsz = (nM - fm) < WGM ? (nM - fm) : WGM;
        u.pm = fm + ((wgid % nig) % gsz); u.pn = (wgid % nig) / gsz; return true;
    }
    __device__ __forceinline__ void a_ready(const Unit&) const {}
    __device__ __forceinline__ void done(const Unit&) const {}
};

__device__ __forceinline__ unsigned cvt_pk_bf16(float lo, float hi) { unsigned r; asm volatile("v_cvt_pk_bf16_f32 %0, %1, %2" : "=v"(r) : "v"(lo), "v"(hi)); return r; }
typedef float f32x2 __attribute__((ext_vector_type(2)));
__device__ __forceinline__ f32x2 gelu_pk(f32x2 v) {
    const f32x2 av = __builtin_elementwise_abs(v), d = av * 0.2316418882f + 1.0f;
    f32x2 t; t.x = __builtin_amdgcn_rcpf(d.x); t.y = __builtin_amdgcn_rcpf(d.y);
    f32x2 q = t * 0.5307027145f + (-0.7265760135f); q = q * t + 0.7107068705f; q = q * t + (-0.142248368f); q = q * t + 0.127414796f; q = q * t;
    const f32x2 s = (v * v) * (-0.72134752044f);
    f32x2 e; e.x = __builtin_amdgcn_exp2f(s.x); e.y = __builtin_amdgcn_exp2f(s.y);
    const f32x2 m = v * (q * e), r = v - m;
    f32x2 o; o.x = v.x < 0.f ? m.x : r.x; o.y = v.y < 0.f ? m.y : r.y; return o;
}

template <int ACT  > struct EpiBf16 {
    static constexpr bool PERM = true, AFTER_DRAIN = false; static_assert(ACT == 0 || ACT == 1, "EpiBf16: ACT is 0 (none) or 1 (gelu_pk)");
    bf16_t* O; int ldc; const float* bias; int split_cols; size_t split_stride; float scale0;
    __device__ __forceinline__ void operator()(const f32x4 (&acc)[2][2][4][2], const Unit& u, int wr, int wc, int fr_, int fq_) const {
        int fr = fr_, fq = fq_; asm volatile("" : "+v"(fr), "+v"(fq));
        const int row0 = u.pm * BM + wr * 64 + fr; int colt = u.pn * BM; bf16_t* base = O;
        float sc = 1.f; if (split_cols) { const int t = colt / split_cols; base += (size_t)t * split_stride; colt -= t * split_cols; if (t == 0) sc = scale0; }
        const int col0 = colt + wc * 32 + 8 * fq, bcol0 = u.pn * BM + wc * 32 + 8 * fq;
        f32x4 bv[2][2];
#pragma unroll
        for (int bj = 0; bj < 2; ++bj)
#pragma unroll
            for (int n = 0; n < 2; ++n) bv[bj][n] = bias ? *(const f32x4*)(bias + bcol0 + bj * HALF + 4 * n) : (f32x4){0.f, 0.f, 0.f, 0.f};
#pragma unroll
        for (int ai = 0; ai < 2; ++ai)
#pragma unroll
            for (int m = 0; m < 4; ++m) { bf16_t* rowp = base + (size_t)(row0 + ai * HALF + m * 16) * ldc + col0;
#pragma unroll
                for (int bj = 0; bj < 2; ++bj) { f32x4 v0 = acc[ai][bj][m][0] + bv[bj][0], v1 = acc[ai][bj][m][1] + bv[bj][1];
                    if (ACT == 1) { f32x2 a = gelu_pk((f32x2){v0[0], v0[1]}), b = gelu_pk((f32x2){v0[2], v0[3]}), c = gelu_pk((f32x2){v1[0], v1[1]}), d = gelu_pk((f32x2){v1[2], v1[3]});
                        v0 = (f32x4){a.x, a.y, b.x, b.y}; v1 = (f32x4){c.x, c.y, d.x, d.y}; }
                    v0 = v0 * sc; v1 = v1 * sc; u32x4 w; w.x = cvt_pk_bf16(v0[0], v0[1]); w.y = cvt_pk_bf16(v0[2], v0[3]); w.z = cvt_pk_bf16(v1[0], v1[1]); w.w = cvt_pk_bf16(v1[2], v1[3]);
                    *(u32x4*)(rowp + bj * HALF) = w; } }
    }
};

template <class Epi, class Sched, bool ALIGN_EPI = false, bool SP2 = false, bool OPAQUE_K = false>
__device__ __forceinline__ void gemm_phase(PG8_LAS unsigned char* lds, const Gemm g, const Sched& S, const Epi& E) {
    int tid_ = threadIdx.x;
#ifndef PG8_NOLAUNDER
    asm volatile("" : "+v"(tid_));
#endif
    const int tid = tid_, wid = __builtin_amdgcn_readfirstlane(tid >> 6), lane = tid & 63, wr = wid >> 2, wc = wid & 3, fr = lane & 15, fq = lane >> 4;
    int K_ = g.K; if (OPAQUE_K) asm volatile("" : "+s"(K_));
    const int K = K_, nt = K / BK;
    unsigned voffA[2], voffB[2];
#pragma unroll
    for (int i = 0; i < 2; ++i) { int R, C; stage_rc(tid * 16 + i * 8192, R, C); const int Rb = Epi::PERM ? ((R & ~31) + perm32(R & 31)) : R;
        voffA[i] = (unsigned)(R * K + C) * 2u; voffB[i] = (unsigned)(Rb * K + C) * 2u; }
    const size_t kstep = (size_t)(BK * 2);
    const size_t hstep = (size_t)HALF * K * 2;
    const size_t tstep = 2 * hstep;
    const unsigned ldsw = (unsigned)wid * 1024u;
    const int aoff = lds_byte(wr * 64 + fr, fq * 8), boff = lds_byte(wc * 32 + fr, fq * 8);
#define PG8_SA(b, h) (((b) * 2 + (h)) * HTB)
#define PG8_SB(b, h) ((4 + (b) * 2 + (h)) * HTB)
#define PG8_STAGE(bufoff, gbase, voff) do { _Pragma("unroll") for (int _i = 0; _i < 2; ++_i) \
        __builtin_amdgcn_global_load_lds((const unsigned*)((const char*)(gbase) + (voff)[_i]), (PG8_LAS unsigned*)(lds + (bufoff) + ldsw + _i * 8192), 16, 0, 0); } while (0)
#define PG8_LDA(dst, b, h) do { _Pragma("unroll") for (int m = 0; m < 4; ++m) _Pragma("unroll") for (int k = 0; k < 2; ++k) dst[m][k] = *(const PG8_LAS bf16x8*)(lds + PG8_SA(b, h) + aoff + m * 2048 + k * 1024); } while (0)
#define PG8_LDB(dst, b, h) do { _Pragma("unroll") for (int n = 0; n < 2; ++n) _Pragma("unroll") for (int k = 0; k < 2; ++k) dst[n][k] = *(const PG8_LAS bf16x8*)(lds + PG8_SB(b, h) + boff + n * 2048 + k * 1024); } while (0)
#define PG8_MMA(ai, bj, At, Bt) do { __builtin_amdgcn_s_setprio(1); _Pragma("unroll") for (int m = 0; m < 4; ++m) _Pragma("unroll") for (int n = 0; n < 2; ++n) _Pragma("unroll") for (int k = 0; k < 2; ++k) \
        acc[ai][bj][m][n] = __builtin_amdgcn_mfma_f32_16x16x32_bf16(Bt[n][k], At[m][k], acc[ai][bj][m][n], 0, 0, 0); __builtin_amdgcn_s_setprio(0); } while (0)
#define PG8_WAIT_V(n) asm volatile("s_waitcnt vmcnt(" #n ")" ::: "memory")
#define PG8_WAIT_L(n) asm volatile("s_waitcnt lgkmcnt(" #n ")" ::: "memory")
#define PG8_BAR __builtin_amdgcn_s_barrier()
#define PG8_SCHED __builtin_amdgcn_sched_barrier(0)
    Unit cur, nxt; int ui = 0;
    if (!S.next(0, cur)) return;
    f32x4 acc[2][2][4][2];
#pragma unroll
    for (int a = 0; a < 2; ++a)
#pragma unroll
        for (int b = 0; b < 2; ++b)
#pragma unroll
            for (int m = 0; m < 4; ++m)
#pragma unroll
                for (int n = 0; n < 2; ++n) acc[a][b][m][n] = (f32x4){0.f, 0.f, 0.f, 0.f};
    bf16x8 At[4][2], B0[2][2], B1[2][2];
    const char* cA = (const char*)g.A + (size_t)cur.pm * tstep; const char* cB = (const char*)g.Bt + (size_t)cur.pn * tstep;
    S.a_ready(cur);
    if constexpr (SP2) {
        PG8_STAGE(PG8_SB(0, 0), cB, voffB); PG8_STAGE(PG8_SB(0, 1), cB + hstep, voffB); PG8_STAGE(PG8_SA(0, 0), cA, voffA); PG8_STAGE(PG8_SA(0, 1), cA + hstep, voffA);
        if (wr == 1) PG8_BAR;
        PG8_WAIT_V(2); PG8_BAR;
        PG8_STAGE(PG8_SB(1, 0), cB + kstep, voffB); PG8_STAGE(PG8_SA(1, 0), cA + kstep, voffA); PG8_STAGE(PG8_SB(1, 1), cB + hstep + kstep, voffB);
        PG8_WAIT_V(6); PG8_BAR;
    } else {
        PG8_STAGE(PG8_SB(0, 0), cB, voffB); PG8_STAGE(PG8_SA(0, 0), cA, voffA); PG8_STAGE(PG8_SB(0, 1), cB + hstep, voffB); PG8_STAGE(PG8_SA(0, 1), cA + hstep, voffA);
        if (wr == 1) PG8_BAR;
        PG8_WAIT_V(4); PG8_BAR;
        PG8_STAGE(PG8_SB(1, 0), cB + kstep, voffB); PG8_STAGE(PG8_SA(1, 0), cA + kstep, voffA); PG8_STAGE(PG8_SB(1, 1), cB + hstep + kstep, voffB);
        PG8_WAIT_V(6); PG8_BAR;
    }
    for (;;) {
        const bool has_next = S.next(ui + 1, nxt);
        const char* nA = has_next ? (const char*)g.A + (size_t)nxt.pm * tstep : cA; const char* nB = has_next ? (const char*)g.Bt + (size_t)nxt.pn * tstep : cB;
        for (int t = 0; t < nt; t += 2) {
            const bool last = (t == nt - 2);
            const char* a1 = cA + (size_t)(t + 1) * kstep;
            const char* a2 = last ? nA : cA + (size_t)(t + 2) * kstep; const char* b2 = last ? nB : cB + (size_t)(t + 2) * kstep;
            const char* a3 = a2 + kstep; const char* b3 = b2 + kstep;
            if (last && has_next) S.a_ready(nxt);
            if constexpr (SP2) {
            PG8_LDB(B0, 0, 0); PG8_LDB(B1, 0, 1); PG8_SCHED; PG8_LDA(At, 0, 0); PG8_STAGE(PG8_SA(1, 1), a1 + hstep, voffA);
            PG8_WAIT_V(8); PG8_WAIT_L(0); PG8_BAR; PG8_MMA(0, 0, At, B0); PG8_MMA(0, 1, At, B1); PG8_BAR; PG8_SCHED;
            PG8_LDA(At, 0, 1); PG8_STAGE(PG8_SB(0, 0), b2, voffB); PG8_STAGE(PG8_SB(0, 1), b2 + hstep, voffB); PG8_STAGE(PG8_SA(0, 0), a2, voffA);
            PG8_WAIT_V(8); PG8_WAIT_L(0); PG8_BAR; PG8_MMA(1, 0, At, B0); PG8_MMA(1, 1, At, B1); PG8_BAR; PG8_SCHED;
            PG8_LDB(B0, 1, 0); PG8_LDB(B1, 1, 1); PG8_SCHED; PG8_LDA(At, 1, 0); PG8_STAGE(PG8_SA(0, 1), a2 + hstep, voffA);
            PG8_WAIT_V(8); PG8_WAIT_L(0); PG8_BAR; PG8_MMA(0, 0, At, B0); PG8_MMA(0, 1, At, B1); PG8_BAR; PG8_SCHED;
            PG8_LDA(At, 1, 1); PG8_STAGE(PG8_SB(1, 0), b3, voffB); PG8_STAGE(PG8_SB(1, 1), b3 + hstep, voffB); PG8_STAGE(PG8_SA(1, 0), a3, voffA);
            PG8_WAIT_V(8); PG8_WAIT_L(0); PG8_BAR; PG8_MMA(1, 0, At, B0); PG8_MMA(1, 1, At, B1); PG8_BAR; PG8_SCHED;
            } else {
            PG8_LDB(B0, 0, 0); PG8_SCHED; PG8_LDA(At, 0, 0); PG8_STAGE(PG8_SA(1, 1), a1 + hstep, voffA);
            PG8_WAIT_L(8); PG8_BAR; PG8_WAIT_L(0); PG8_MMA(0, 0, At, B0); PG8_BAR; PG8_SCHED;
            PG8_LDB(B1, 0, 1); PG8_STAGE(PG8_SB(0, 0), b2, voffB);
            PG8_BAR; PG8_WAIT_L(0); PG8_MMA(0, 1, At, B1); PG8_BAR;
            PG8_LDA(At, 0, 1); PG8_STAGE(PG8_SA(0, 0), a2, voffA);
            PG8_BAR; PG8_WAIT_L(0); PG8_MMA(1, 0, At, B0); PG8_BAR; PG8_SCHED;
            PG8_STAGE(PG8_SB(0, 1), b2 + hstep, voffB);
            PG8_WAIT_V(6); PG8_BAR; PG8_MMA(1, 1, At, B1); PG8_BAR;
            PG8_LDB(B0, 1, 0); PG8_SCHED; PG8_LDA(At, 1, 0); PG8_STAGE(PG8_SA(0, 1), a2 + hstep, voffA);
            PG8_WAIT_L(8); PG8_BAR; PG8_WAIT_L(0); PG8_MMA(0, 0, At, B0); PG8_BAR; PG8_SCHED;
            PG8_LDB(B1, 1, 1); PG8_STAGE(PG8_SB(1, 0), b3, voffB);
            PG8_BAR; PG8_WAIT_L(0); PG8_MMA(0, 1, At, B1); PG8_BAR;
            PG8_LDA(At, 1, 1); PG8_STAGE(PG8_SA(1, 0), a3, voffA);
            PG8_BAR; PG8_WAIT_L(0); PG8_MMA(1, 0, At, B0); PG8_BAR; PG8_SCHED;
            PG8_STAGE(PG8_SB(1, 1), b3 + hstep, voffB);
            PG8_WAIT_V(6); PG8_BAR; PG8_MMA(1, 1, At, B1); PG8_BAR;
            }
        }
        if constexpr (ALIGN_EPI) { if (wr == 0) PG8_BAR; }
        if constexpr (!Epi::AFTER_DRAIN) { E(acc, cur, wr, wc, fr, fq);
#ifdef DBG_EPI2
            E(acc, cur, wr, wc, fr, fq);
#endif
            S.done(cur); }
        if (!has_next) break;
#pragma unroll
        for (int a = 0; a < 2; ++a)
#pragma unroll
            for (int b = 0; b < 2; ++b)
#pragma unroll
                for (int m = 0; m < 4; ++m)
#pragma unroll
                    for (int n = 0; n < 2; ++n) acc[a][b][m][n] = (f32x4){0.f, 0.f, 0.f, 0.f};
        cur = nxt; cA = nA; cB = nB; ++ui;
        if constexpr (ALIGN_EPI) { if (wr == 1) PG8_BAR; }
    }
    PG8_WAIT_V(0);
    if constexpr (!ALIGN_EPI) { if (wr == 0) PG8_BAR; }
    PG8_BAR;
    if constexpr (Epi::AFTER_DRAIN) { E.fused(acc, cur, wr, wc, fr, fq, lds, wid, lane); S.done(cur); }
#undef PG8_SA
#undef PG8_SB
#undef PG8_STAGE
#undef PG8_LDA
#undef PG8_LDB
#undef PG8_MMA
#undef PG8_WAIT_V
#undef PG8_WAIT_L
#undef PG8_BAR
#undef PG8_SCHED
}
}


#ifndef PG8_SP2
#define PG8_SP2 true
#endif
#ifndef PG8_ALIGN
#define PG8_ALIGN true
#endif
#define GAS __attribute__((address_space(1)))
#define LAS __attribute__((address_space(3)))
typedef unsigned short bf16;
typedef unsigned v4u __attribute__((ext_vector_type(4)));
typedef float f32x4 __attribute__((ext_vector_type(4)));
typedef short bf16x8 __attribute__((ext_vector_type(8)));
typedef GAS unsigned gu32;
typedef GAS unsigned long long gu64;
#define RLX_AGENT __ATOMIC_RELAXED, __HIP_MEMORY_SCOPE_AGENT
#define LDS_WAIT() asm volatile("s_waitcnt lgkmcnt(0)" ::: "memory")
#define VM_WAIT() asm volatile("s_waitcnt vmcnt(0)" ::: "memory")
__device__ __forceinline__ unsigned long long rt() { return __builtin_amdgcn_s_memrealtime(); }
__device__ __forceinline__ unsigned f2bf(float f) { unsigned u = __builtin_bit_cast(unsigned, f); return (u + 0x7fffu + ((u >> 16) & 1u)) >> 16; }
__device__ __forceinline__ unsigned pk2(float lo, float hi) { return f2bf(lo) | (f2bf(hi) << 16); }

#define XB_TMO      128
#define XB_XCNT(j)  (256  + 64 * (j))
#define XB_XSUB(j)  (1280 + 64 * (j))
#define XB_XGEN(j)  (2304 + 64 * (j))
#define XB_TOP      3328
#define XB_TOPGEN   3392
#define XCD_BAR_WORDS 3456
#define XB_SPIN_CAP (1u << 18)

__device__ __forceinline__ unsigned xb_ld(unsigned* p)              { return __hip_atomic_load(p, __ATOMIC_RELAXED, __HIP_MEMORY_SCOPE_AGENT); }
__device__ __forceinline__ unsigned xb_add(unsigned* p, unsigned v) { return __hip_atomic_fetch_add(p, v, __ATOMIC_RELAXED, __HIP_MEMORY_SCOPE_AGENT); }
__device__ __forceinline__ unsigned xb_xcc_id() { return (unsigned)__builtin_amdgcn_s_getreg((3 << 11) | 20) & 0xFu; }
#define XB_SPIN(cond, bar) do { unsigned _sp = 0; while (cond) { __builtin_amdgcn_s_sleep(1); \
    if ((++_sp & 255u) == 0u) { if (xb_ld(&(bar)[XB_TMO])) break; if (_sp > XB_SPIN_CAP) { atomicAdd(&(bar)[XB_TMO], 1u); break; } } } } while (0)

struct XcdBarrier {
    unsigned* bar; unsigned x;
    volatile LAS unsigned* st;
};

__device__ __forceinline__ XcdBarrier xcd_barrier_post(unsigned* bar, volatile LAS unsigned* st) {
    XcdBarrier b; b.bar = bar; b.x = xb_xcc_id(); b.st = st;
    if (threadIdx.x == 0) (void)xb_add(&bar[XB_XCNT(b.x)], 1u);
    return b;
}
__device__ __forceinline__ void xcd_barrier_complete(unsigned* bar, unsigned x, unsigned& nloc, unsigned& nx) {
    const unsigned G = gridDim.x * gridDim.y * gridDim.z;
    unsigned sum, cnt, mine, sp = 0u;
    for (;;) {
        sum = 0u; cnt = 0u; mine = 0u;
#pragma unroll
        for (unsigned j = 0; j < 16; ++j) { const unsigned c = xb_ld(&bar[XB_XCNT(j)]); sum += c; cnt += (c > 0u) ? 1u : 0u; mine = (j == x) ? c : mine; }
        if (sum == G) break;
        __builtin_amdgcn_s_sleep(1);
        if ((++sp & 255u) == 0u) { if (xb_ld(&bar[XB_TMO])) break; if (sp > XB_SPIN_CAP) { atomicAdd(&bar[XB_TMO], 1u); break; } }
    }
    nloc = mine > 0u ? mine : 1u; nx = cnt > 0u ? cnt : 1u;
}

__device__ __forceinline__ void xcd_barrier(const XcdBarrier& b) {
    asm volatile("s_waitcnt vmcnt(0)" ::: "memory");
    __syncthreads();
    if (threadIdx.x == 0) {
        unsigned* bar = b.bar;
        __builtin_amdgcn_s_waitcnt(0);
        unsigned nloc = b.st[0], nx = b.st[1];
        if (nloc == 0u) { xcd_barrier_complete(bar, b.x, nloc, nx); b.st[0] = nloc; b.st[1] = nx; }
        const unsigned old = xb_add(&bar[XB_XSUB(b.x)], 1u);
        const unsigned gen = old / nloc;
        if (old + 1u == (gen + 1u) * nloc) {
            __builtin_amdgcn_fence(__ATOMIC_RELEASE, "agent");
            asm volatile("s_waitcnt vmcnt(0)" ::: "memory");
            const unsigned og = xb_add(&bar[XB_TOP], 1u);
            const unsigned tg = og / nx;
            if (og + 1u == (tg + 1u) * nx) xb_add(&bar[XB_TOPGEN], 1u);
            else XB_SPIN(xb_ld(&bar[XB_TOPGEN]) == tg, bar);
            __builtin_amdgcn_fence(__ATOMIC_ACQUIRE, "agent");
            xb_add(&bar[XB_XGEN(b.x)], 1u);
            asm volatile("s_waitcnt vmcnt(0)" ::: "memory");
        } else {
            XB_SPIN(xb_ld(&bar[XB_XGEN(b.x)]) == gen, bar);
            __builtin_amdgcn_fence(__ATOMIC_ACQUIRE, "agent");
            asm volatile("s_waitcnt vmcnt(0)" ::: "memory");
        }
    }
    __syncthreads();
}


constexpr int NWAVES = 8, NTHR = 512;
constexpr int MP = 16384, MS = 256, MT = 16640, DM = 1024, TP = 2048;
constexpr int NG1 = 3840, NIN = 3864;
constexpr float EPS = 1e-6f, LOG2E = 1.4426950408889634f, LN2 = 0.6931471805599453f;
constexpr size_t OFF_SB = 17039360, OFF_NSA = 34078720, OFF_WINP = 42598400, OFF_WINS = 43646976, OUT_TOTAL = 47841280;
enum { IN_XP = 0, IN_XS, IN_PP, IN_PS, IN_CSB, IN_CNSA, IN_SWIN, IN_PT, IN_NORMG, IN_WIN, IN_QG, IN_KCG, IN_KSG, IN_KWG, IN_PEK, IN_W1K, IN_W2K, IN_PEV, IN_W1V, IN_W2V, IN_WOUT, IN_WPLE, IN_WG, N_INPUTS };

constexpr size_t MiB = 1u << 20;
constexpr size_t WS_CTL = 0, CTL_ZERO_BYTES = 1 * MiB;
constexpr size_t WS_WIN_T = 2 * MiB, WS_W1T = 11 * MiB, WS_W2T = 13 * MiB, WS_WOUT_T = 14 * MiB, WS_WG_T = 16 * MiB, WS_WPLE_T = 18 * MiB;
constexpr size_t WS_RSTD = 19 * MiB, WS_BR = 20 * MiB, WS_HBF = 24 * MiB, WS_PBF = 58 * MiB;
constexpr size_t WS_QA = 68 * MiB, WS_KA = 86 * MiB, WS_VA = 104 * MiB, WS_GA = 122 * MiB, WS_QB = 140 * MiB, WS_GB = 158 * MiB;
constexpr size_t WS_KSEL = 176 * MiB, WS_VSEL = 182 * MiB, WS_KWIN = 188 * MiB, WS_VWIN = 194 * MiB;
constexpr size_t WS_ACMP_P = 200 * MiB, WS_HIDP = 208 * MiB, WS_HIDS = 210 * MiB, WS_KCS = 226 * MiB, WS_VCS = 228 * MiB;
constexpr size_t WS_OW = 232 * MiB, WS_U = 248 * MiB, WS_T1 = 282 * MiB, WS_HB2 = 316 * MiB, WS_ACMP_S = 352 * MiB, WS_END = 480 * MiB;
constexpr int CW_BAR = 4096;
constexpr int CW_Q = 16384;
constexpr int CW_PANEL = 32768;
constexpr int CW_PANEL2 = 40960;
constexpr int CW_BIAS = 65536;

constexpr int RING_BYTES = 131072, LDSCTL_OFF = RING_BYTES, MISC_OFF = LDSCTL_OFF + 320, LDS_BYTES = 147456;

typedef float f32x16 __attribute__((ext_vector_type(16)));
typedef short s16x4 __attribute__((ext_vector_type(4)));
typedef float f32x2_t __attribute__((ext_vector_type(2)));
typedef __bf16 bf16x2_t __attribute__((ext_vector_type(2)));
typedef unsigned v2u __attribute__((ext_vector_type(2)));
__device__ __forceinline__ unsigned cvtpk(float lo, float hi) { f32x2_t v = {lo, hi}; bf16x2_t b = __builtin_convertvector(v, bf16x2_t); return __builtin_bit_cast(unsigned, b); }
__device__ __forceinline__ float bf_lo(unsigned w) { return __builtin_bit_cast(float, w << 16); }
__device__ __forceinline__ float bf_hi(unsigned w) { return __builtin_bit_cast(float, w & 0xffff0000u); }
__device__ __forceinline__ float fexp2(float x) { return __builtin_amdgcn_exp2f(x); }
__device__ __forceinline__ float flog2(float x) { return __builtin_amdgcn_logf(x); }
__device__ __forceinline__ float frcp(float x) { return __builtin_amdgcn_rcpf(x); }
__device__ __forceinline__ float sigmoidf_(float x) { return frcp(1.f + fexp2(-x * LOG2E)); }
__device__ __forceinline__ float siluf_(float x) { return x * sigmoidf_(x); }
__device__ __forceinline__ float wave_sum(float v) {
#pragma unroll
    for (int o = 1; o < 64; o <<= 1) v += __shfl_xor(v, o);
    return v;
}
__device__ __forceinline__ float wave_max(float v) {
#pragma unroll
    for (int o = 1; o < 64; o <<= 1) v = fmaxf(v, __shfl_xor(v, o));
    return v;
}

struct Args { const void* in[N_INPUTS]; float* out; unsigned char* ws; int ph_lo, ph_hi; };

__device__ __forceinline__ void p0_transpose_item(const float* __restrict__ W, int ldw, int col0, const float* __restrict__ gsc, bf16* WT, int K, int drow0, int k0, LAS float* scr, int lane) {
#pragma unroll 16
    for (int i = 0; i < 32; ++i) { const int kk = 2 * i + (lane >> 5); float v = W[(size_t)(k0 + kk) * ldw + col0 + (lane & 31)]; if (gsc) v *= gsc[k0 + kk]; scr[kk * 33 + (lane & 31)] = v; }
    LDS_WAIT(); asm volatile("" ::: "memory");
    const int c = lane & 7;
#pragma unroll
    for (int j = 0; j < 4; ++j) { const int n = (lane >> 3) + 8 * j; const LAS float* s = scr + (8 * c) * 33 + n;
        v4u o; o.x = pk2(s[0 * 33], s[1 * 33]); o.y = pk2(s[2 * 33], s[3 * 33]); o.z = pk2(s[4 * 33], s[5 * 33]); o.w = pk2(s[6 * 33], s[7 * 33]);
        *(GAS v4u*)(WT + (size_t)(drow0 + n) * K + k0 + 8 * c) = o; }
    LDS_WAIT(); asm volatile("" ::: "memory");
}
__host__ __device__ __forceinline__ int g1_role(int pn) { return (int)((0xec9b7a15d483620ull >> (4 * pn)) & 15); }
__device__ __forceinline__ int g1_src_col(int n) { const int t = g1_role(n >> 8), gm = n & 255, lam = 64 * ((gm >> 5) & 3) + 32 * (gm >> 7) + (gm & 31); return (t < 13 ? t * 256 : 3352 + (t - 13) * 256) + lam; }

constexpr int WBR_OFF = 67584, WBR_PITCH = 2064;

__device__ __forceinline__ void p0_prologue(const Args& a, LAS unsigned char* lds, int tid, int lane, int wave, int vcu, int G, int rep = 0) {
    const int gw = vcu * NWAVES + wave, NGW = G * NWAVES;
    unsigned char* ws = a.ws;
    const float* w_in = (const float*)a.in[IN_WIN]; const float* norm_g = (const float*)a.in[IN_NORMG];
    { LAS unsigned char* wbr = lds + WBR_OFF;
      for (int i0 = 0; i0 < 48; i0 += 24) { float v[24], gk[24];
#pragma unroll
          for (int i = 0; i < 24; ++i) { const int idx = tid + NTHR * (i0 + i), k = idx / 24, c = idx - 24 * k; v[i] = w_in[(size_t)k * NIN + 3328 + c]; gk[i] = norm_g[k]; }
#pragma unroll
          for (int i = 0; i < 24; ++i) { const int idx = tid + NTHR * (i0 + i), k = idx / 24, c = idx - 24 * k; *(LAS unsigned short*)(wbr + c * WBR_PITCH + k * 2) = (unsigned short)f2bf(v[i] * gk[i]); } } }
    { LAS float* scr = (LAS float*)(lds + wave * 8448);
      constexpr int I0 = 16 * 120, I1 = 32 * 8, I3 = 4 * 2, I5 = 16 * 32, I7 = 4 * 32, NITEMS = I0 + 2 * I1 + 2 * I3 + 2 * I5 + I7;
      for (int it = gw; it < NITEMS; it += NGW) {
          int r = it;
          if (r < I0) { const int kb = r / 120, nb = r % 120; p0_transpose_item(w_in, NIN, g1_src_col(32 * nb), norm_g, (bf16*)(ws + WS_WIN_T), 1024, 32 * nb, 64 * kb, scr, lane); continue; } r -= I0;
          if (r < I1) { const int kb = r / 8, nb = r % 8; p0_transpose_item((const float*)a.in[IN_W1K], 256, 32 * nb, nullptr, (bf16*)(ws + WS_W1T), 2048, 32 * nb, 64 * kb, scr, lane); continue; } r -= I1;
          if (r < I1) { const int kb = r / 8, nb = r % 8; p0_transpose_item((const float*)a.in[IN_W1V], 256, 32 * nb, nullptr, (bf16*)(ws + WS_W1T), 2048, 256 + 32 * nb, 64 * kb, scr, lane); continue; } r -= I1;
          if (r < I3) { const int kb = r / 2, nb = r % 2; p0_transpose_item((const float*)a.in[IN_W2K], 64, 32 * nb, nullptr, (bf16*)(ws + WS_W2T), 256, 32 * nb, 64 * kb, scr, lane); continue; } r -= I3;
          if (r < I3) { const int kb = r / 2, nb = r % 2; p0_transpose_item((const float*)a.in[IN_W2V], 64, 32 * nb, nullptr, (bf16*)(ws + WS_W2T), 256, 64 + 32 * nb, 64 * kb, scr, lane); continue; } r -= I3;
          if (r < I5) { const int kb = r / 32, nb = r % 32; p0_transpose_item((const float*)a.in[IN_WOUT], 1024, 32 * nb, nullptr, (bf16*)(ws + WS_WOUT_T), 1024, 32 * nb, 64 * kb, scr, lane); continue; } r -= I5;
          if (r < I5) { const int kb = r / 32, nb = r % 32; p0_transpose_item((const float*)a.in[IN_WG], 1024, 32 * nb, nullptr, (bf16*)(ws + WS_WG_T), 1024, 32 * nb, 64 * kb, scr, lane); continue; } r -= I5;
          { const int kb = r / 32, nb = r % 32; p0_transpose_item((const float*)a.in[IN_WPLE], 1024, 32 * nb, nullptr, (bf16*)(ws + WS_WPLE_T), 256, 32 * nb, 64 * kb, scr, lane); }
      } }
    __syncthreads();
    { const float* xp = (const float*)a.in[IN_XP]; const float* xs = (const float*)a.in[IN_XS];
      bf16* hbf = (bf16*)(ws + WS_HBF); float* rstd = (float*)(ws + WS_RSTD); float* BR = (float*)(ws + WS_BR);
      const LAS unsigned char* wbr = lds + WBR_OFF;
      for (int rg = gw; rg < MT / 16; rg += NGW) {
          const int m = rg * 16 + (lane & 15), kq = lane >> 4;
          const float* xr = (m < MP) ? xp + (size_t)m * DM : xs + (size_t)(m - MP) * DM;
          f32x4 c0 = {0.f, 0.f, 0.f, 0.f}, c1 = {0.f, 0.f, 0.f, 0.f}; float ssq = 0.f;
#pragma unroll 8
          for (int s = 0; s < 32; ++s) {
              const f32x4 v0 = *(const GAS f32x4*)(xr + 32 * s + 8 * kq), v1 = *(const GAS f32x4*)(xr + 32 * s + 8 * kq + 4);
              ssq += (v0.x * v0.x + v0.y * v0.y) + (v0.z * v0.z + v0.w * v0.w) + (v1.x * v1.x + v1.y * v1.y) + (v1.z * v1.z + v1.w * v1.w);
              v4u pa; pa.x = pk2(v0.x, v0.y); pa.y = pk2(v0.z, v0.w); pa.z = pk2(v1.x, v1.y); pa.w = pk2(v1.z, v1.w);
              *(GAS v4u*)(hbf + (size_t)m * DM + 32 * s + 8 * kq) = pa;
              const bf16x8 af = __builtin_bit_cast(bf16x8, pa);
              const bf16x8 b0 = *(const LAS bf16x8*)(wbr + (lane & 15) * WBR_PITCH + (32 * s + 8 * kq) * 2);
              const bf16x8 b1 = *(const LAS bf16x8*)(wbr + (16 + (lane & 7)) * WBR_PITCH + (32 * s + 8 * kq) * 2);
              c0 = __builtin_amdgcn_mfma_f32_16x16x32_bf16(af, b0, c0, 0, 0, 0);
              c1 = __builtin_amdgcn_mfma_f32_16x16x32_bf16(af, b1, c1, 0, 0, 0);
          }
          ssq += __shfl_xor(ssq, 16); ssq += __shfl_xor(ssq, 32);
          const float rs = 1.f / sqrtf(ssq * (1.f / DM) + EPS);
          if (kq == 0) rstd[m] = rs;
#pragma unroll
          for (int r = 0; r < 4; ++r) { const int R = 4 * kq + r; const float rsR = __shfl(rs, R); const size_t row = (size_t)rg * 16 + R;
              BR[row * 24 + (lane & 15)] = sigmoidf_(c0[r] * rsR);
              if ((lane & 15) < 8) BR[row * 24 + 16 + (lane & 15)] = sigmoidf_(c1[r] * rsR); }
      } }
    { const float* pp = (const float*)a.in[IN_PP]; const float* ps = (const float*)a.in[IN_PS]; bf16* pbf = (bf16*)(ws + WS_PBF);
      for (int base = (vcu * NTHR + tid); base < MT * 32; base += 8 * G * NTHR) { f32x4 v0[8], v1[8];
#pragma unroll
          for (int u = 0; u < 8; ++u) { const int idx = base + u * G * NTHR; if (idx < MT * 32) { const int row = idx >> 5, c8 = (idx & 31) * 8;
              const float* src = (row < MP) ? pp + (size_t)row * 256 + c8 : ps + (size_t)(row - MP) * 256 + c8; v0[u] = *(const GAS f32x4*)src; v1[u] = *(const GAS f32x4*)(src + 4); } }
#pragma unroll
          for (int u = 0; u < 8; ++u) { const int idx = base + u * G * NTHR; if (idx < MT * 32) { const int row = idx >> 5, c8 = (idx & 31) * 8;
              v4u o; o.x = pk2(v0[u].x, v0[u].y); o.y = pk2(v0[u].z, v0[u].w); o.z = pk2(v1[u].x, v1[u].y); o.w = pk2(v1[u].z, v1[u].w);
              *(GAS v4u*)(pbf + (size_t)row * 256 + c8) = o; } } } }
    { const float* sw = (const float*)a.in[IN_SWIN]; float* dst = a.out + OFF_WINS;
      for (int base = (vcu * NTHR + tid); base < 32 * 504 * 64; base += 8 * G * NTHR) { f32x4 v[8];
#pragma unroll
          for (int u = 0; u < 8; ++u) { const int idx = base + u * G * NTHR; if (idx < 32 * 504 * 64) { const int q = idx & 63, i = (idx >> 6) % 504, b = (idx >> 6) / 504; v[u] = *(const GAS f32x4*)(sw + ((size_t)(b * 512 + i + 8) * 256) + q * 4); } }
#pragma unroll
          for (int u = 0; u < 8; ++u) { const int idx = base + u * G * NTHR; if (idx < 32 * 504 * 64) { const int q = idx & 63, i = (idx >> 6) % 504, b = (idx >> 6) / 504; *(GAS f32x4*)(dst + ((size_t)(b * 512 + i) * 256) + q * 4) = v[u]; } } } }
    { float* bias = (float*)(ws + WS_CTL) + CW_BIAS;
      if (rep == 0) for (int job = gw; job < 256; job += NGW) { const int slot = job >> 7, jc = (job >> 4) & 7, kc = job & 15, j = jc * 32 + (lane & 31), k0 = kc * 128 + (lane >> 5) * 64;
          const float* W1 = (const float*)a.in[slot ? IN_W1V : IN_W1K]; const float* pe = (const float*)a.in[slot ? IN_PEV : IN_PEK];
          float acc = 0.f;
#pragma unroll 16
          for (int k = 0; k < 64; ++k) acc += pe[k0 + k] * W1[(size_t)(k0 + k) * 256 + j];
          acc += __shfl_xor(acc, 32);
          if (lane < 32) atomicAdd(bias + slot * 256 + j, acc); } }
}

namespace pg8 {
#ifdef EPI_NT_STORES
#define EPI_ST(ptr, val) __builtin_nontemporal_store((val), (ptr))
#else
#define EPI_ST(ptr, val) (*(ptr) = (val))
#endif
__device__ __forceinline__ void st8_bf16(bf16_t* p, f32x4 a, f32x4 b) { u32x4 w; w.x = cvtpk(a[0], a[1]); w.y = cvtpk(a[2], a[3]); w.z = cvtpk(b[0], b[1]); w.w = cvtpk(b[2], b[3]); EPI_ST((u32x4*)p, w); }
__device__ __forceinline__ void st8_f32(float* p, f32x4 a, f32x4 b) { EPI_ST((f32x4*)p, a); EPI_ST((f32x4*)(p + 4), b); }
__device__ __forceinline__ f32x4 silu4(f32x4 v) { f32x4 r; for (int i = 0; i < 4; ++i) r[i] = siluf_(v[i]); return r; }

struct EpiG1 {
    static constexpr bool PERM = true, AFTER_DRAIN = false;
    float* out; const float* rstd; bf16_t *QA, *KA, *VA, *GA, *QB, *GB, *KSEL, *VSEL, *KWIN, *VWIN, *ACMP; const float *q_g, *ks_g, *kw_g, *pe_k, *pe_v;
    __device__ __forceinline__ void operator()(const f32x4 (&acc)[2][2][4][2], const Unit& u, int wr, int wc, int fr_, int fq_) const {
        int fr = fr_, fq = fq_;
#ifndef G1_NOLAUNDER
        asm volatile("" : "+v"(fr), "+v"(fq));
#endif
#ifdef DBG_G1EPI2
        for (int dupe = 0; dupe < 2; ++dupe) {
#endif
        const int pn = g1_role(u.pn);
        float rsv[2][4];
#pragma unroll
        for (int ai = 0; ai < 2; ++ai)
#pragma unroll
            for (int m = 0; m < 4; ++m) rsv[ai][m] = rstd[u.pm * BM + ai * HALF + wr * 64 + m * 16 + fr];
#pragma unroll
        for (int ai = 0; ai < 2; ++ai)
#pragma unroll
            for (int m = 0; m < 4; ++m) {
#ifndef G1_NOROWCLOBBER
                asm volatile("" ::: "memory");
#endif
                const int row = u.pm * BM + ai * HALF + wr * 64 + m * 16 + fr; const float rs = rsv[ai][m];
#define A0(bj) (acc[ai][bj][m][0])
#define A1(bj) (acc[ai][bj][m][1])
                const int lam0 = 64 * wc + 8 * fq;
                if (pn < 2) {
                    const float sc = rs * 0.125f;
#pragma unroll
                    for (int bj = 0; bj < 2; ++bj) st8_bf16(QA + (size_t)row * 512 + pn * 256 + lam0 + 32 * bj, A0(bj) * sc, A1(bj) * sc);
                } else if (pn < 6) {
                    const int sl = (pn >= 4) ? 1 : 0, col = (pn & 1) * 256 + lam0; bf16_t* B = KA + (size_t)sl * ((WS_VA - WS_KA) / 2);
#pragma unroll
                    for (int bj = 0; bj < 2; ++bj) { const f32x4 x0 = A0(bj) * rs, x1 = A1(bj) * rs; st8_f32(out + OFF_SB + (size_t)row * 1024 + sl * 512 + col + 32 * bj, x0, x1); st8_bf16(B + (size_t)row * 512 + col + 32 * bj, x0, x1); }
                } else if (pn < 8) {
#pragma unroll
                    for (int bj = 0; bj < 2; ++bj) st8_bf16(GA + (size_t)row * 512 + (pn - 6) * 256 + lam0 + 32 * bj, silu4(A0(bj) * rs), silu4(A1(bj) * rs));
                } else if (pn >= 13) {
#pragma unroll
                    for (int bj = 0; bj < 2; ++bj) st8_bf16(GB + (size_t)row * 512 + (pn - 13) * 256 + lam0 + 32 * bj, silu4(A0(bj) * rs), silu4(A1(bj) * rs));
                } else {
                    float ssq = 0.f;
#pragma unroll
                    for (int bj = 0; bj < 2; ++bj) { const f32x4 a0 = A0(bj), a1 = A1(bj); ssq += (a0[0] * a0[0] + a0[1] * a0[1]) + (a0[2] * a0[2] + a0[3] * a0[3]) + (a1[0] * a1[0] + a1[1] * a1[1]) + (a1[2] * a1[2] + a1[3] * a1[3]); }
                    ssq += __shfl_xor(ssq, 16); ssq += __shfl_xor(ssq, 32);
                    const float hr = rs / sqrtf(ssq * rs * rs * (1.f / 64.f) + EPS);
                    if (pn < 10) {
                        const float sc = hr * (0.125f * LOG2E);
#pragma unroll
                        for (int bj = 0; bj < 2; ++bj) { const int d0 = 32 * bj + 8 * fq; const f32x4 g0 = *(const f32x4*)(q_g + d0), g1 = *(const f32x4*)(q_g + d0 + 4);
                            st8_bf16(QB + (size_t)row * 512 + (pn - 8) * 256 + lam0 + 32 * bj, A0(bj) * g0 * sc, A1(bj) * g1 * sc); }
                    } else if (pn == 10) {
                        const int t = row & 2047, b = row >> 11, c = t >> 5, p = t & 31, slot = wc >> 1, g = wc & 1; const float* pe = pe_k + (ptrdiff_t)slot * (pe_v - pe_k);
#pragma unroll
                        for (int bj = 0; bj < 2; ++bj) { const int lam = lam0 + 32 * bj, d0 = 32 * bj + 8 * fq; const f32x4 x0 = A0(bj) * rs, x1 = A1(bj) * rs;
                            st8_f32(out + OFF_NSA + (size_t)row * 512 + lam, x0, x1);
                            if (row < MP) { const f32x4 e0 = *(const f32x4*)(pe + p * 64 + d0), e1 = *(const f32x4*)(pe + p * 64 + d0 + 4);
                                st8_bf16(ACMP + ((size_t)slot * 1024 + (size_t)(b * 64 + c) * 2 + g) * 2048 + p * 64 + d0, x0 + e0, x1 + e1); } }
                    } else if (pn == 11) {
#pragma unroll
                        for (int bj = 0; bj < 2; ++bj) { const int lam = lam0 + 32 * bj, d0 = 32 * bj + 8 * fq; f32x4 x0, x1;
                            if (wc < 2) { const f32x4 g0 = *(const f32x4*)(ks_g + d0), g1 = *(const f32x4*)(ks_g + d0 + 4); x0 = A0(bj) * g0 * hr; x1 = A1(bj) * g1 * hr; } else { x0 = A0(bj) * rs; x1 = A1(bj) * rs; }
                            st8_f32(out + OFF_NSA + (size_t)row * 512 + 256 + lam, x0, x1);
                            st8_bf16(KSEL + (size_t)(wc >> 1) * ((WS_VSEL - WS_KSEL) / 2) + (size_t)row * 128 + (lam & 127), x0, x1); }
                    } else {
                        float* wdst = nullptr;
                        if (row >= MP) { const int si = row - MP; wdst = out + OFF_WINS + ((size_t)((si >> 3) * 512 + 504 + (si & 7))) * 256; }
                        else if ((row & 2047) >= 1536) wdst = out + OFF_WINP + ((size_t)((row >> 11) * 512 + (row & 2047) - 1536)) * 256;
#pragma unroll
                        for (int bj = 0; bj < 2; ++bj) { const int lam = lam0 + 32 * bj, d0 = 32 * bj + 8 * fq; f32x4 x0, x1;
                            if (wc < 2) { const f32x4 g0 = *(const f32x4*)(kw_g + d0), g1 = *(const f32x4*)(kw_g + d0 + 4); x0 = A0(bj) * g0 * hr; x1 = A1(bj) * g1 * hr; } else { x0 = A0(bj) * rs; x1 = A1(bj) * rs; }
                            if (wdst) st8_f32(wdst + lam, x0, x1);
                            st8_bf16(KWIN + (size_t)(wc >> 1) * ((WS_VWIN - WS_KWIN) / 2) + (size_t)row * 128 + (lam & 127), x0, x1); }
                    }
                }
#undef A0
#undef A1
            }
#ifdef DBG_G1EPI2
        }
#endif
    }
};
struct EpiNone { static constexpr bool PERM = true, AFTER_DRAIN = false;
    __device__ __forceinline__ void operator()(const f32x4 (&acc)[2][2][4][2], const Unit& u, int wr, int wc, int fr, int fq) const { if (acc[0][0][0][0][0] == 123456.789f) __builtin_trap(); } };
struct EpiHid {
    static constexpr bool PERM = true, AFTER_DRAIN = false;
    bf16_t* O;
    __device__ __forceinline__ void operator()(const f32x4 (&acc)[2][2][4][2], const Unit& u, int wr, int wc, int fr_, int fq_) const {
        int fr = fr_, fq = fq_; asm volatile("" : "+v"(fr), "+v"(fq));
#pragma unroll
        for (int ai = 0; ai < 2; ++ai)
#pragma unroll
            for (int m = 0; m < 4; ++m) { const int row = u.pm * BM + ai * HALF + wr * 64 + m * 16 + fr;
#pragma unroll
                for (int bj = 0; bj < 2; ++bj) st8_bf16(O + (size_t)row * 256 + bj * HALF + wc * 32 + 8 * fq, silu4(acc[ai][bj][m][0]), silu4(acc[ai][bj][m][1])); }
    }
};
struct EpiOut {
    static constexpr bool PERM = true, AFTER_DRAIN = false;
    const bf16_t* XB; bf16_t* HB;
    __device__ __forceinline__ void operator()(const f32x4 (&acc)[2][2][4][2], const Unit& u, int wr, int wc, int fr_, int fq_) const {
        int fr = fr_, fq = fq_; asm volatile("" : "+v"(fr), "+v"(fq));
#pragma unroll
        for (int ai = 0; ai < 2; ++ai) {
            u32x4 xv[4][2];
#pragma unroll
            for (int m = 0; m < 4; ++m) { const int row = u.pm * BM + ai * HALF + wr * 64 + m * 16 + fr;
#pragma unroll
                for (int bj = 0; bj < 2; ++bj) { const int col = u.pn * BM + bj * HALF + wc * 32 + 8 * fq; xv[m][bj] = *(const u32x4*)(XB + (size_t)row * DM + col); } }
#pragma unroll
            for (int m = 0; m < 4; ++m) { const int row = u.pm * BM + ai * HALF + wr * 64 + m * 16 + fr;
#pragma unroll
                for (int bj = 0; bj < 2; ++bj) { const int col = u.pn * BM + bj * HALF + wc * 32 + 8 * fq; const u32x4 x = xv[m][bj];
                    const f32x4 x0 = {bf_lo(x.x), bf_hi(x.x), bf_lo(x.y), bf_hi(x.y)}, x1 = {bf_lo(x.z), bf_hi(x.z), bf_lo(x.w), bf_hi(x.w)};
                    st8_bf16(HB + (size_t)row * DM + col, x0 + acc[ai][bj][m][0], x1 + acc[ai][bj][m][1]); } }
        }
    }
};
struct EpiFinal {
    static constexpr bool PERM = true, AFTER_DRAIN = false;
    float* Y; const bf16_t* T1; const bf16_t* HB;
    __device__ __forceinline__ void operator()(const f32x4 (&acc)[2][2][4][2], const Unit& u, int wr, int wc, int fr_, int fq_) const {
        int fr = fr_, fq = fq_; asm volatile("" : "+v"(fr), "+v"(fq));
#pragma unroll
        for (int ai = 0; ai < 2; ++ai) {
            u32x4 tv[4][2], hv[4][2];
#pragma unroll
            for (int m = 0; m < 4; ++m) { const int row = u.pm * BM + ai * HALF + wr * 64 + m * 16 + fr;
#pragma unroll
                for (int bj = 0; bj < 2; ++bj) { const int col = u.pn * BM + bj * HALF + wc * 32 + 8 * fq; tv[m][bj] = *(const u32x4*)(T1 + (size_t)row * DM + col); hv[m][bj] = *(const u32x4*)(HB + (size_t)row * DM + col); } }
#pragma unroll
            for (int m = 0; m < 4; ++m) { const int row = u.pm * BM + ai * HALF + wr * 64 + m * 16 + fr;
#pragma unroll
                for (int bj = 0; bj < 2; ++bj) { const int col = u.pn * BM + bj * HALF + wc * 32 + 8 * fq; float* yp = Y + (size_t)row * DM + col;
                    const u32x4 t = tv[m][bj], hb = hv[m][bj]; const f32x4 a0 = acc[ai][bj][m][0], a1 = acc[ai][bj][m][1];
                    f32x4 y0, y1;
                    y0[0] = bf_lo(hb.x) + sigmoidf_(a0[0]) * bf_lo(t.x); y0[1] = bf_hi(hb.x) + sigmoidf_(a0[1]) * bf_hi(t.x); y0[2] = bf_lo(hb.y) + sigmoidf_(a0[2]) * bf_lo(t.y); y0[3] = bf_hi(hb.y) + sigmoidf_(a0[3]) * bf_hi(t.y);
                    y1[0] = bf_lo(hb.z) + sigmoidf_(a1[0]) * bf_lo(t.z); y1[1] = bf_hi(hb.z) + sigmoidf_(a1[1]) * bf_hi(t.z); y1[2] = bf_lo(hb.w) + sigmoidf_(a1[2]) * bf_lo(t.w); y1[3] = bf_hi(hb.w) + sigmoidf_(a1[3]) * bf_hi(t.w);
#ifdef Y_NT_STORES
                    __builtin_nontemporal_store(y0, (f32x4*)yp); __builtin_nontemporal_store(y1, (f32x4*)(yp + 4));
#else
                    st8_f32(yp, y0, y1);
#endif
                    } }
        }
    }
};
struct DiagOrder {
    int n, per, G, c;
    __device__ __forceinline__ bool next(int i, Unit& u) const { const int L = i * G + c; if (L >= n) return false; u.pm = L; u.pn = L / per; return true; }
    __device__ __forceinline__ void a_ready(const Unit&) const {}
    __device__ __forceinline__ void done(const Unit&) const {}
};
struct EpiHidB {
    bf16_t* O; const float* bias;
    __device__ __forceinline__ void operator()(const f32x4 (&acc)[2][2][4][2], int pm, int wr, int wc, int fr_, int fq_) const {
        int fr = fr_, fq = fq_; asm volatile("" : "+v"(fr), "+v"(fq));
#pragma unroll
        for (int bj = 0; bj < 2; ++bj) { const int col = bj * HALF + wc * 32 + 8 * fq; const f32x4 b0 = *(const f32x4*)(bias + col), b1 = *(const f32x4*)(bias + col + 4);
#pragma unroll
            for (int ai = 0; ai < 2; ++ai)
#pragma unroll
                for (int m = 0; m < 4; ++m) { const int row = pm * BM + ai * HALF + wr * 64 + m * 16 + fr;
                    st8_bf16(O + (size_t)row * 256 + col, silu4(acc[ai][bj][m][0] + b0), silu4(acc[ai][bj][m][1] + b1)); } }
    }
};
__device__ __forceinline__ void gemm_unit_gather(PG8_LAS unsigned char* lds, const float* cn, const int* pt, const bf16_t* W1T  , int L  , const EpiHidB& E) {
    int tid_ = threadIdx.x; asm volatile("" : "+v"(tid_));
    const int tid = tid_, wid = __builtin_amdgcn_readfirstlane(tid >> 6), lane = tid & 63, wr = wid >> 2, wc = wid & 3, fr = lane & 15, fq = lane >> 4;
    const int slot = L >> 6, pmu = L & 63;
    const float* abase[4]; const bf16_t* bbase[4]; int aofs[4], bofs[4];
#pragma unroll
    for (int j = 0; j < 4; ++j) { const int q = tid + 512 * j, row = q >> 3, c8 = q & 7, R = pmu * 256 + row, b = R >> 9, c = (R >> 1) & 255, g = R & 1, pos0 = c * 32;
        abase[j] = cn + ((size_t)pt[b * 64 + (pos0 >> 7)] * 128 + (pos0 & 127)) * 512 + slot * 128 + g * 64 + c8 * 8;
        aofs[j] = (row >> 7) * HTB + lds_byte(row & 127, c8 * 8);
        const int nsrc = (row & ~31) + perm32(row & 31);
        bbase[j] = W1T + (size_t)(slot * 256 + nsrc) * 2048 + c8 * 8;
        bofs[j] = (4 + (row >> 7)) * HTB + lds_byte(row & 127, c8 * 8); }
    const int aoff = lds_byte(wr * 64 + fr, fq * 8), boff = lds_byte(wc * 32 + fr, fq * 8);
    f32x4 acc[2][2][4][2];
#pragma unroll
    for (int a = 0; a < 2; ++a)
#pragma unroll
        for (int b = 0; b < 2; ++b)
#pragma unroll
            for (int m = 0; m < 4; ++m)
#pragma unroll
                for (int n = 0; n < 2; ++n) acc[a][b][m][n] = (f32x4){0.f, 0.f, 0.f, 0.f};
    f32x4 ar[4][2]; u32x4 br[4];
#define GU_LOAD(kt) do { _Pragma("unroll") for (int j = 0; j < 4; ++j) { ar[j][0] = *(const f32x4*)(abase[j] + (size_t)(kt) * 512); ar[j][1] = *(const f32x4*)(abase[j] + (size_t)(kt) * 512 + 4); br[j] = *(const u32x4*)(bbase[j] + (kt) * 64); } } while (0)
#define GU_STORE(stg) do { _Pragma("unroll") for (int j = 0; j < 4; ++j) { u32x4 w; w.x = cvtpk(ar[j][0][0], ar[j][0][1]); w.y = cvtpk(ar[j][0][2], ar[j][0][3]); w.z = cvtpk(ar[j][1][0], ar[j][1][1]); w.w = cvtpk(ar[j][1][2], ar[j][1][3]); \
        *(PG8_LAS u32x4*)(lds + (stg) * 2 * HTB + aofs[j]) = w; *(PG8_LAS u32x4*)(lds + (stg) * 2 * HTB + bofs[j]) = br[j]; } } while (0)
    GU_LOAD(0); GU_STORE(0); GU_LOAD(1);
    for (int kt = 0; kt < 32; ++kt) {
        const int stg = kt & 1;
        __syncthreads();
        if (kt + 1 < 32) GU_STORE(stg ^ 1);
        if (kt + 2 < 32) GU_LOAD(kt + 2);
        bf16x8 At[4][2], Bf[2][2];
#pragma unroll
        for (int ai = 0; ai < 2; ++ai) {
#pragma unroll
            for (int m = 0; m < 4; ++m)
#pragma unroll
                for (int k = 0; k < 2; ++k) At[m][k] = *(const PG8_LAS bf16x8*)(lds + (stg * 2 + ai) * HTB + aoff + m * 2048 + k * 1024);
#pragma unroll
            for (int bj = 0; bj < 2; ++bj) {
#pragma unroll
                for (int n = 0; n < 2; ++n)
#pragma unroll
                    for (int k = 0; k < 2; ++k) Bf[n][k] = *(const PG8_LAS bf16x8*)(lds + (4 + stg * 2 + bj) * HTB + boff + n * 2048 + k * 1024);
#pragma unroll
                for (int m = 0; m < 4; ++m)
#pragma unroll
                    for (int n = 0; n < 2; ++n)
#pragma unroll
                        for (int k = 0; k < 2; ++k) acc[ai][bj][m][n] = __builtin_amdgcn_mfma_f32_16x16x32_bf16(Bf[n][k], At[m][k], acc[ai][bj][m][n], 0, 0, 0);
            } }
    }
#undef GU_LOAD
#undef GU_STORE
    E(acc, L, wr, wc, fr, fq);
    __syncthreads();
}
struct EpiHidB128 {
    bf16_t* O; const float* bias;
    __device__ __forceinline__ void operator()(const f32x4 (&acc)[2][4][2], int row0, int wr, int wc, int fr_, int fq_) const {
        int fr = fr_, fq = fq_; asm volatile("" : "+v"(fr), "+v"(fq));
#pragma unroll
        for (int bj = 0; bj < 2; ++bj) { const int col = bj * HALF + wc * 32 + 8 * fq; const f32x4 b0 = *(const f32x4*)(bias + col), b1 = *(const f32x4*)(bias + col + 4);
#pragma unroll
            for (int m = 0; m < 4; ++m) { const int row = row0 + wr * 64 + m * 16 + fr;
                st8_bf16(O + (size_t)row * 256 + col, silu4(acc[bj][m][0] + b0), silu4(acc[bj][m][1] + b1)); } }
    }
};
__device__ __forceinline__ void gemm_unit_gather128(PG8_LAS unsigned char* lds, const float* cn, const int* pt, const bf16_t* W1T  , int L  , const EpiHidB128& E) {
    int tid_ = threadIdx.x; asm volatile("" : "+v"(tid_));
    const int tid = tid_, wid = __builtin_amdgcn_readfirstlane(tid >> 6), lane = tid & 63, wr = wid >> 2, wc = wid & 3, fr = lane & 15, fq = lane >> 4;
    const int slot = L >> 7, pmu = L & 127;
    const float* abase[2]; const bf16_t* bbase[4]; int aofs[2], bofs[4];
#pragma unroll
    for (int j = 0; j < 2; ++j) { const int q = tid + 512 * j, row = q >> 3, c8 = q & 7, R = pmu * 128 + row, b = R >> 9, c = (R >> 1) & 255, g = R & 1, pos0 = c * 32;
        abase[j] = cn + ((size_t)pt[b * 64 + (pos0 >> 7)] * 128 + (pos0 & 127)) * 512 + slot * 128 + g * 64 + c8 * 8;
        aofs[j] = lds_byte(row, c8 * 8); }
#pragma unroll
    for (int j = 0; j < 4; ++j) { const int q = tid + 512 * j, n = q >> 3, c8 = q & 7, nsrc = (n & ~31) + perm32(n & 31);
        bbase[j] = W1T + (size_t)(slot * 256 + nsrc) * 2048 + c8 * 8;
        bofs[j] = (1 + (n >> 7)) * HTB + lds_byte(n & 127, c8 * 8); }
    const int aoff = lds_byte(wr * 64 + fr, fq * 8), boff = lds_byte(wc * 32 + fr, fq * 8);
    f32x4 acc[2][4][2];
#pragma unroll
    for (int b = 0; b < 2; ++b)
#pragma unroll
        for (int m = 0; m < 4; ++m)
#pragma unroll
            for (int n = 0; n < 2; ++n) acc[b][m][n] = (f32x4){0.f, 0.f, 0.f, 0.f};
    f32x4 ra0[2][2], ra1[2][2], ra2[2][2], ra3[2][2]; u32x4 br[4];
#define GU_LDA(ra, kt) do { _Pragma("unroll") for (int j = 0; j < 2; ++j) { ra[j][0] = *(const f32x4*)(abase[j] + (size_t)(kt) * 512); ra[j][1] = *(const f32x4*)(abase[j] + (size_t)(kt) * 512 + 4); } } while (0)
#define GU_LDB(kt) do { _Pragma("unroll") for (int j = 0; j < 4; ++j) br[j] = *(const u32x4*)(bbase[j] + (kt) * 64); } while (0)
#define GU_ST(stg, ra) do { _Pragma("unroll") for (int j = 0; j < 2; ++j) { u32x4 w; w.x = cvtpk(ra[j][0][0], ra[j][0][1]); w.y = cvtpk(ra[j][0][2], ra[j][0][3]); w.z = cvtpk(ra[j][1][0], ra[j][1][1]); w.w = cvtpk(ra[j][1][2], ra[j][1][3]); \
        *(PG8_LAS u32x4*)(lds + (stg) * 3 * HTB + aofs[j]) = w; } _Pragma("unroll") for (int j = 0; j < 4; ++j) *(PG8_LAS u32x4*)(lds + (stg) * 3 * HTB + bofs[j]) = br[j]; } while (0)
#define GU_MMA(stg) do { bf16x8 At[4][2], Bf[2][2]; \
        _Pragma("unroll") for (int m = 0; m < 4; ++m) _Pragma("unroll") for (int k = 0; k < 2; ++k) At[m][k] = *(const PG8_LAS bf16x8*)(lds + (stg) * 3 * HTB + aoff + m * 2048 + k * 1024); \
        _Pragma("unroll") for (int bj = 0; bj < 2; ++bj) { \
            _Pragma("unroll") for (int n = 0; n < 2; ++n) _Pragma("unroll") for (int k = 0; k < 2; ++k) Bf[n][k] = *(const PG8_LAS bf16x8*)(lds + ((stg) * 3 + 1 + bj) * HTB + boff + n * 2048 + k * 1024); \
            _Pragma("unroll") for (int m = 0; m < 4; ++m) _Pragma("unroll") for (int n = 0; n < 2; ++n) _Pragma("unroll") for (int k = 0; k < 2; ++k) \
                acc[bj][m][n] = __builtin_amdgcn_mfma_f32_16x16x32_bf16(Bf[n][k], At[m][k], acc[bj][m][n], 0, 0, 0); } } while (0)
#define GU_STEP(kt, stg, raN) do { __syncthreads(); if ((kt) + 1 < 32) GU_ST((stg) ^ 1, raN); if ((kt) + 5 < 32) GU_LDA(raN, (kt) + 5); GU_LDB((kt) + 2 < 32 ? (kt) + 2 : 31); GU_MMA(stg); } while (0)
    GU_LDA(ra0, 0); GU_LDB(0); GU_ST(0, ra0); GU_LDA(ra1, 1); GU_LDA(ra2, 2); GU_LDA(ra3, 3); GU_LDA(ra0, 4); GU_LDB(1);
    for (int kt = 0; kt < 32; kt += 4) { GU_STEP(kt, 0, ra1); GU_STEP(kt + 1, 1, ra2); GU_STEP(kt + 2, 0, ra3); GU_STEP(kt + 3, 1, ra0); }
#undef GU_LDA
#undef GU_LDB
#undef GU_ST
#undef GU_MMA
#undef GU_STEP
    E(acc, L * 128, wr, wc, fr, fq);
    __syncthreads();
}
__device__ __forceinline__ void gemm_unit_bf16_128(PG8_LAS unsigned char* lds, const bf16_t* A  , const bf16_t* W1T  , int slot, int row0, const EpiHidB128& E) {
    int tid_ = threadIdx.x; asm volatile("" : "+v"(tid_));
    const int tid = tid_, wid = __builtin_amdgcn_readfirstlane(tid >> 6), lane = tid & 63, wr = wid >> 2, wc = wid & 3, fr = lane & 15, fq = lane >> 4;
    const bf16_t* abase[2]; const bf16_t* bbase[4]; int aofs[2], bofs[4];
#pragma unroll
    for (int j = 0; j < 2; ++j) { const int q = tid + 512 * j, row = q >> 3, c8 = q & 7; abase[j] = A + (size_t)row * 2048 + c8 * 8; aofs[j] = lds_byte(row, c8 * 8); }
#pragma unroll
    for (int j = 0; j < 4; ++j) { const int q = tid + 512 * j, n = q >> 3, c8 = q & 7, nsrc = (n & ~31) + perm32(n & 31);
        bbase[j] = W1T + (size_t)(slot * 256 + nsrc) * 2048 + c8 * 8;
        bofs[j] = (1 + (n >> 7)) * HTB + lds_byte(n & 127, c8 * 8); }
    const int aoff = lds_byte(wr * 64 + fr, fq * 8), boff = lds_byte(wc * 32 + fr, fq * 8);
    f32x4 acc[2][4][2];
#pragma unroll
    for (int b = 0; b < 2; ++b)
#pragma unroll
        for (int m = 0; m < 4; ++m)
#pragma unroll
            for (int n = 0; n < 2; ++n) acc[b][m][n] = (f32x4){0.f, 0.f, 0.f, 0.f};
    u32x4 ra0[2], ra1[2], ra2[2], ra3[2], br[4];
#define GB_LDA(ra, kt) do { _Pragma("unroll") for (int j = 0; j < 2; ++j) ra[j] = *(const u32x4*)(abase[j] + (kt) * 64); } while (0)
#define GB_LDB(kt) do { _Pragma("unroll") for (int j = 0; j < 4; ++j) br[j] = *(const u32x4*)(bbase[j] + (kt) * 64); } while (0)
#define GB_ST(stg, ra) do { _Pragma("unroll") for (int j = 0; j < 2; ++j) *(PG8_LAS u32x4*)(lds + (stg) * 3 * HTB + aofs[j]) = ra[j]; \
        _Pragma("unroll") for (int j = 0; j < 4; ++j) *(PG8_LAS u32x4*)(lds + (stg) * 3 * HTB + bofs[j]) = br[j]; } while (0)
#define GB_MMA(stg) do { bf16x8 At[4][2], Bf[2][2]; \
        _Pragma("unroll") for (int m = 0; m < 4; ++m) _Pragma("unroll") for (int k = 0; k < 2; ++k) At[m][k] = *(const PG8_LAS bf16x8*)(lds + (stg) * 3 * HTB + aoff + m * 2048 + k * 1024); \
        _Pragma("unroll") for (int bj = 0; bj < 2; ++bj) { \
            _Pragma("unroll") for (int n = 0; n < 2; ++n) _Pragma("unroll") for (int k = 0; k < 2; ++k) Bf[n][k] = *(const PG8_LAS bf16x8*)(lds + ((stg) * 3 + 1 + bj) * HTB + boff + n * 2048 + k * 1024); \
            _Pragma("unroll") for (int m = 0; m < 4; ++m) _Pragma("unroll") for (int n = 0; n < 2; ++n) _Pragma("unroll") for (int k = 0; k < 2; ++k) \
                acc[bj][m][n] = __builtin_amdgcn_mfma_f32_16x16x32_bf16(Bf[n][k], At[m][k], acc[bj][m][n], 0, 0, 0); } } while (0)
#define GB_STEP(kt, stg, raN) do { __syncthreads(); if ((kt) + 1 < 32) GB_ST((stg) ^ 1, raN); if ((kt) + 5 < 32) GB_LDA(raN, (kt) + 5); GB_LDB((kt) + 2 < 32 ? (kt) + 2 : 31); GB_MMA(stg); } while (0)
    GB_LDA(ra0, 0); GB_LDB(0); GB_ST(0, ra0); GB_LDA(ra1, 1); GB_LDA(ra2, 2); GB_LDA(ra3, 3); GB_LDA(ra0, 4); GB_LDB(1);
    for (int kt = 0; kt < 32; kt += 4) { GB_STEP(kt, 0, ra1); GB_STEP(kt + 1, 1, ra2); GB_STEP(kt + 2, 0, ra3); GB_STEP(kt + 3, 1, ra0); }
#undef GB_LDA
#undef GB_LDB
#undef GB_ST
#undef GB_MMA
#undef GB_STEP
    E(acc, row0, wr, wc, fr, fq);
    __syncthreads();
}
struct XcdQueueOrder {
    unsigned* q; volatile PG8_LAS int* slot; int nM, nN, nwg, x;
    __device__ __forceinline__ void init(int M, int N, unsigned* q_, volatile PG8_LAS int* slot_, int xcc) { nM = M / BM; nN = N / BM; nwg = nM * nN; q = q_; slot = slot_; x = xcc & 7; }
    __device__ __forceinline__ bool next(int i, Unit& u) const {
        if (threadIdx.x == 0) { int res = -1; const int qq = nwg / NXCD, rr = nwg % NXCD;
#pragma unroll 1
            for (int k = 0; k < NXCD; ++k) { const int xx = (x + k) & 7, sz = qq + (xx < rr ? 1 : 0), st = xx < rr ? xx * (qq + 1) : rr * (qq + 1) + (xx - rr) * qq;
                if ((int)__hip_atomic_load(q + 64 * xx, __ATOMIC_RELAXED, __HIP_MEMORY_SCOPE_AGENT) >= sz) continue;
                const int t = (int)__hip_atomic_fetch_add(q + 64 * xx, 1u, __ATOMIC_RELAXED, __HIP_MEMORY_SCOPE_AGENT);
                if (t < sz) { res = st + t; break; } }
            slot[i & 1] = res; }
        asm volatile("s_waitcnt lgkmcnt(0)" ::: "memory"); __builtin_amdgcn_s_barrier(); asm volatile("" ::: "memory");
        const int wgid = slot[i & 1]; if (wgid < 0) return false;
        const int nig = WGM * nN, gid = wgid / nig, fm = gid * WGM, gsz = (nM - fm) < WGM ? (nM - fm) : WGM;
        u.pm = fm + ((wgid % nig) % gsz); u.pn = (wgid % nig) / gsz; return true;
    }
    __device__ __forceinline__ void a_ready(const Unit&) const {}
    __device__ __forceinline__ void done(const Unit&) const {}
};
struct HybridOrder {
    unsigned* q; volatile PG8_LAS int* slot; int nM, nN, nwg, ns, l0, lstride, dyn0;
    __device__ __forceinline__ bool decode(int L, Unit& u) const {
        int wgid = L; { const int qq = nwg / NXCD, r = nwg % NXCD, xcd = wgid % NXCD, off = wgid / NXCD; wgid = (xcd < r ? xcd * (qq + 1) : r * (qq + 1) + (xcd - r) * qq) + off; }
        const int nig = WGM * nN, gid = wgid / nig, fm = gid * WGM, gsz = (nM - fm) < WGM ? (nM - fm) : WGM;
        u.pm = fm + ((wgid % nig) % gsz); u.pn = (wgid % nig) / gsz; return true;
    }
    __device__ __forceinline__ bool next(int i, Unit& u) const {
        if (i < ns) return decode(l0 + i * lstride, u);
        if (threadIdx.x == 0) { int res = -1;
            if ((int)__hip_atomic_load(q, __ATOMIC_RELAXED, __HIP_MEMORY_SCOPE_AGENT) < nwg - dyn0) { const int t = (int)__hip_atomic_fetch_add(q, 1u, __ATOMIC_RELAXED, __HIP_MEMORY_SCOPE_AGENT); if (t < nwg - dyn0) res = dyn0 + t; }
            slot[i & 1] = res; }
        asm volatile("s_waitcnt lgkmcnt(0)" ::: "memory"); __builtin_amdgcn_s_barrier(); asm volatile("" ::: "memory");
        const int L = slot[i & 1]; if (L < 0) return false; return decode(L, u);
    }
    __device__ __forceinline__ void a_ready(const Unit&) const {}
    __device__ __forceinline__ void done(const Unit&) const {}
};
struct DiagQueueOrder {
    unsigned* q; volatile PG8_LAS int* slot; int n, per;
    __device__ __forceinline__ bool next(int i, Unit& u) const {
        if (threadIdx.x == 0) { int res = -1;
            if ((int)__hip_atomic_load(q, __ATOMIC_RELAXED, __HIP_MEMORY_SCOPE_AGENT) < n) { const int t = (int)__hip_atomic_fetch_add(q, 1u, __ATOMIC_RELAXED, __HIP_MEMORY_SCOPE_AGENT); if (t < n) res = t; }
            slot[i & 1] = res; }
        asm volatile("s_waitcnt lgkmcnt(0)" ::: "memory"); __builtin_amdgcn_s_barrier(); asm volatile("" ::: "memory");
        const int L = slot[i & 1]; if (L < 0) return false; u.pm = L; u.pn = L / per; return true;
    }
    __device__ __forceinline__ void a_ready(const Unit&) const {}
    __device__ __forceinline__ void done(const Unit&) const {}
};
struct OneUnit {
    int pm, pn;
    __device__ __forceinline__ bool next(int i, Unit& u) const { if (i > 0) return false; u.pm = pm; u.pn = pn; return true; }
    __device__ __forceinline__ void a_ready(const Unit&) const {}
    __device__ __forceinline__ void done(const Unit&) const {}
};
}

#ifndef DBG_DUP
#define DBG_DUP 0
#endif

#define MFMA32(a, b, c) __builtin_amdgcn_mfma_f32_32x32x16_bf16((a), (b), (c), 0, 0, 0)
constexpr int KP = 144, VP = 192;
constexpr int KT_BYTES = 64 * KP, VT_BYTES = 64 * VP;
typedef short v4i16_t __attribute__((ext_vector_type(4)));
__device__ __forceinline__ int kidx_of(int kh, int v, int h) { return 32 * kh + (v & 3) + 8 * (v >> 2) + 4 * h; }
__device__ __forceinline__ s16x4 vtr(const LAS unsigned char* p) { return __builtin_bit_cast(s16x4, __builtin_amdgcn_ds_read_tr16_b64_v4i16((LAS v4i16_t*)p)); }

__device__ __forceinline__ void qk64(f32x16 (&s)[2], const LAS unsigned char* Ks, const bf16x8 (&qf)[4], int lane) {
    const LAS unsigned char* kb = Ks + (lane & 31) * KP + (lane >> 5) * 16;
#pragma unroll
    for (int kh = 0; kh < 2; ++kh) { f32x16 acc; for (int i = 0; i < 16; ++i) acc[i] = 0.f;
#pragma unroll
        for (int ks = 0; ks < 4; ++ks) { const bf16x8 kf = *(const LAS bf16x8*)(kb + kh * 32 * KP + ks * 32); __builtin_amdgcn_s_setprio(1); acc = MFMA32(kf, qf[ks], acc); __builtin_amdgcn_s_setprio(0); }
        s[kh] = acc; }
}
__device__ __forceinline__ void qk64_g(f32x16 (&s)[2], const bf16* Kg, int kpitch, const bf16x8 (&qf)[4], int lane) {
    const bf16* kb = Kg + (size_t)(lane & 31) * kpitch + (lane >> 5) * 8;
    bf16x8 kf[2][4];
#pragma unroll
    for (int kh = 0; kh < 2; ++kh)
#pragma unroll
        for (int ks = 0; ks < 4; ++ks) kf[kh][ks] = *(const GAS bf16x8*)(kb + (size_t)kh * 32 * kpitch + ks * 16);
#pragma unroll
    for (int kh = 0; kh < 2; ++kh) { f32x16 acc; for (int i = 0; i < 16; ++i) acc[i] = 0.f;
        __builtin_amdgcn_s_setprio(1);
#pragma unroll
        for (int ks = 0; ks < 4; ++ks) acc = MFMA32(kf[kh][ks], qf[ks], acc);
        __builtin_amdgcn_s_setprio(0);
        s[kh] = acc; }
}
__device__ __forceinline__ void pv64(f32x16 (&o)[2], const LAS unsigned char* Vs, const f32x16 (&e)[2], int lane) {
    const int G = lane >> 4, i = lane & 15, q = i >> 2, p = i & 3, h = G >> 1;
    const LAS unsigned char* vb = Vs + (4 * h + q) * VP + (16 * (G & 1) + 4 * p) * 2;
#pragma unroll
    for (int kh = 0; kh < 2; ++kh)
#pragma unroll
        for (int s = 0; s < 2; ++s) {
            v4u pw; pw.x = cvtpk(e[kh][8 * s + 0], e[kh][8 * s + 1]); pw.y = cvtpk(e[kh][8 * s + 2], e[kh][8 * s + 3]); pw.z = cvtpk(e[kh][8 * s + 4], e[kh][8 * s + 5]); pw.w = cvtpk(e[kh][8 * s + 6], e[kh][8 * s + 7]);
            const bf16x8 pf = __builtin_bit_cast(bf16x8, pw);
#pragma unroll
            for (int dh = 0; dh < 2; ++dh) {
                const s16x4 lo = vtr(vb + (32 * kh + 16 * s) * VP + 64 * dh), hi = vtr(vb + (32 * kh + 16 * s + 8) * VP + 64 * dh);
                const bf16x8 vf = {lo[0], lo[1], lo[2], lo[3], hi[0], hi[1], hi[2], hi[3]};
                __builtin_amdgcn_s_setprio(1); o[dh] = MFMA32(vf, pf, o[dh]); __builtin_amdgcn_s_setprio(0);
            }
        }
}
__device__ __forceinline__ bf16x8 pack8(f32x4 a, f32x4 b) { v4u w; w.x = cvtpk(a[0], a[1]); w.y = cvtpk(a[2], a[3]); w.z = cvtpk(b[0], b[1]); w.w = cvtpk(b[2], b[3]); return __builtin_bit_cast(bf16x8, w); }
__device__ __forceinline__ float xhalf(float v, int h) {
    const unsigned u = __builtin_bit_cast(unsigned, v);
    auto r = __builtin_amdgcn_permlane32_swap(u, u, false, false);
    return __builtin_bit_cast(float, h ? r[0] : r[1]);
}
__device__ __forceinline__ float xmax_half(float v) {
    const unsigned u = __builtin_bit_cast(unsigned, v); auto r = __builtin_amdgcn_permlane32_swap(u, u, false, false);
    return fmaxf(__builtin_bit_cast(float, r[0]), __builtin_bit_cast(float, r[1]));
}
__device__ __forceinline__ void load_qf(bf16x8 (&qf)[4], const bf16* qrow, int lane) {
#pragma unroll
    for (int ks = 0; ks < 4; ++ks) qf[ks] = *(const GAS bf16x8*)(qrow + 16 * ks + 8 * (lane >> 5));
}
__device__ __forceinline__ v4u tile_ld(const bf16* g, int rpitch, int tid) { return *(const GAS v4u*)(g + (size_t)(tid >> 3) * rpitch + (tid & 7) * 8); }
__device__ __forceinline__ void tile_st(LAS unsigned char* t, int P, int tid, v4u v) { *(LAS v4u*)(t + (tid >> 3) * P + (tid & 7) * 16) = v; }

template <class F> __device__ __forceinline__ void softmax_tile(f32x16 (&s)[2], float& m, float& l, f32x16 (&o)[2], int h, F&& biasf) {
    float mx = -1e30f;
#pragma unroll
    for (int kh = 0; kh < 2; ++kh)
#pragma unroll
        for (int v = 0; v < 16; ++v) { const float x = s[kh][v] + biasf(kidx_of(kh, v, h)); s[kh][v] = x; mx = fmaxf(mx, x); }
    mx = xmax_half(mx);
    const float mn = fmaxf(m, mx), al = fexp2(m - mn); m = mn;
    float sum = 0.f;
#pragma unroll
    for (int kh = 0; kh < 2; ++kh)
#pragma unroll
        for (int v = 0; v < 16; ++v) { const float e = fexp2(s[kh][v] - mn); s[kh][v] = e; sum += e; }
    l = l * al + sum;
#pragma unroll
    for (int dh = 0; dh < 2; ++dh)
#pragma unroll
        for (int v = 0; v < 16; ++v) o[dh][v] *= al;
}
__device__ __forceinline__ void alibi_cinit(f32x16 (&c)[2], float slope2) {
#pragma unroll
    for (int kh = 0; kh < 2; ++kh)
#pragma unroll
        for (int v = 0; v < 16; ++v) c[kh][v] = slope2 * (float)(32 * kh + (v & 3) + 8 * (v >> 2));
}
__device__ __forceinline__ void qk64c(f32x16 (&s)[2], const LAS unsigned char* Ks, const bf16x8 (&qf)[4], const f32x16 (&cinit)[2], int lane) {
    const LAS unsigned char* kb = Ks + (lane & 31) * KP + (lane >> 5) * 16;
    bf16x8 kf[2][4];
#pragma unroll
    for (int ks = 0; ks < 4; ++ks)
#pragma unroll
        for (int kh = 0; kh < 2; ++kh) kf[kh][ks] = *(const LAS bf16x8*)(kb + kh * 32 * KP + ks * 32);
    __builtin_amdgcn_s_setprio(1);
    f32x16 a0 = MFMA32(kf[0][0], qf[0], cinit[0]), a1 = MFMA32(kf[1][0], qf[0], cinit[1]);
#pragma unroll
    for (int ks = 1; ks < 4; ++ks) { a0 = MFMA32(kf[0][ks], qf[ks], a0); a1 = MFMA32(kf[1][ks], qf[ks], a1); }
    __builtin_amdgcn_s_setprio(0);
    s[0] = a0; s[1] = a1;
}
template <bool MASKED> __device__ __forceinline__ void sm2_tile(f32x16 (&s)[2], float& m, float& l, f32x16 (&o)[2], float off, bool part, int lo, int hi) {
    float mxp = -INFINITY;
#pragma unroll
    for (int kh = 0; kh < 2; ++kh)
#pragma unroll
        for (int v = 0; v < 16; ++v) { const int Kc = 32 * kh + (v & 3) + 8 * (v >> 2); float xp = s[kh][v];
            if (MASKED) { xp = (Kc > lo && Kc <= hi) ? xp : -INFINITY; s[kh][v] = xp; }
            mxp = fmaxf(mxp, xp); }
    float mx = mxp + off; mx = xmax_half(mx);
    const float mn = part ? fmaxf(m, mx) : m, al = fexp2(m - mn); m = mn; l *= al;
#pragma unroll
    for (int dh = 0; dh < 2; ++dh)
#pragma unroll
        for (int v = 0; v < 16; ++v) o[dh][v] *= al;
    const float mb = part ? (mn - off) : INFINITY;
    float sum = 0.f;
#pragma unroll
    for (int kh = 0; kh < 2; ++kh)
#pragma unroll
        for (int v = 0; v < 16; ++v) { const float e = fexp2(s[kh][v] - mb); s[kh][v] = e; sum += e; }
    l += sum;
}
__device__ __forceinline__ void store_row_wide(bf16* rowp, v2u (&grp)[8], int h, bool pred = true) {
#pragma unroll
    for (int g = 0; g < 8; g += 2) { v2u a = grp[g], b = grp[g + 1];
        { auto r = __builtin_amdgcn_permlane32_swap(a.x, b.x, false, false); a.x = r[0]; b.x = r[1]; }
        { auto r = __builtin_amdgcn_permlane32_swap(a.y, b.y, false, false); a.y = r[0]; b.y = r[1]; }
        if (pred) { v4u w; w.x = a.x; w.y = a.y; w.z = b.x; w.w = b.y; *(GAS v4u*)(rowp + 8 * g + 8 * h) = w; } }
}
__device__ __forceinline__ void store_ot(bf16* dst, const f32x16 (&o)[2], float sc, int h) {
    v2u grp[8];
#pragma unroll
    for (int dh = 0; dh < 2; ++dh)
#pragma unroll
        for (int a = 0; a < 4; ++a) { grp[4 * dh + a].x = cvtpk(o[dh][4 * a] * sc, o[dh][4 * a + 1] * sc); grp[4 * dh + a].y = cvtpk(o[dh][4 * a + 2] * sc, o[dh][4 * a + 3] * sc); }
    store_row_wide(dst, grp, h);
}
__device__ __forceinline__ void zero_o(f32x16 (&o)[2]) { for (int dh = 0; dh < 2; ++dh) for (int v = 0; v < 16; ++v) o[dh][v] = 0.f; }

template <bool TO_LDS> __device__ __forceinline__ void l2_wave(const bf16* w2t  , const bf16* hid0, int hstride, const float* kcg  , unsigned char* dst, int dpitch_bytes, int lane) {
    const int r = lane & 31, h = lane >> 5;
    f32x16 acc[2]; zero_o(acc);
    const bf16* hp = hid0 + (size_t)r * hstride + 8 * h;
#pragma unroll
    for (int k0 = 0; k0 < 16; k0 += 8) {
        bf16x8 bfr[8], af[2][8];
#pragma unroll
        for (int k = 0; k < 8; ++k) { bfr[k] = *(const GAS bf16x8*)(hp + 16 * (k0 + k));
#pragma unroll
            for (int dh = 0; dh < 2; ++dh) af[dh][k] = *(const GAS bf16x8*)(w2t + (size_t)(32 * dh + r) * 256 + 16 * (k0 + k) + 8 * h); }
#pragma unroll
        for (int k = 0; k < 8; ++k)
#pragma unroll
            for (int dh = 0; dh < 2; ++dh) acc[dh] = MFMA32(af[dh][k], bfr[k], acc[dh]);
    }
    float sc = 1.f;
    if (kcg) { float ssq = 0.f;
#pragma unroll
        for (int dh = 0; dh < 2; ++dh)
#pragma unroll
            for (int v = 0; v < 16; ++v) ssq += acc[dh][v] * acc[dh][v];
        ssq += __shfl_xor(ssq, 32); sc = 1.f / sqrtf(ssq * (1.f / 64.f) + EPS); }
#pragma unroll
    for (int dh = 0; dh < 2; ++dh)
#pragma unroll
        for (int a = 0; a < 4; ++a) { const int d0 = 32 * dh + 8 * a + 4 * h; f32x4 x = {acc[dh][4 * a], acc[dh][4 * a + 1], acc[dh][4 * a + 2], acc[dh][4 * a + 3]};
            if (kcg) x = x * *(const f32x4*)(kcg + d0) * sc;
            v2u w; w.x = cvtpk(x[0], x[1]); w.y = cvtpk(x[2], x[3]);
            if (TO_LDS) *(LAS v2u*)((LAS unsigned char*)(uintptr_t)dst + r * dpitch_bytes + d0 * 2) = w;
            else *(GAS v2u*)(dst + (size_t)r * dpitch_bytes + d0 * 2) = w; }
}

__device__ __forceinline__ int next_item(gu32* ctr, volatile LAS int* slot) {
    __syncthreads();
    if (threadIdx.x == 0) *slot = (int)__hip_atomic_fetch_add(ctr, 1u, RLX_AGENT);
    __syncthreads();
    return *slot;
}

template <bool MASKED> __device__ __forceinline__ void sb_weights_t(f32x16 (&s)[2], float& P, int kb, int tpos, int h) {
    float gp[8];
#pragma unroll
    for (int kh = 0; kh < 2; ++kh)
#pragma unroll
        for (int aa = 0; aa < 4; ++aa) { float g = 1.f;
#pragma unroll
            for (int j = 3; j >= 0; --j) { const int v = 4 * aa + j; const float z = __builtin_amdgcn_fmed3f(s[kh][v], -80.f, 80.f);
                const float e = fexp2(z * -LOG2E), r = __builtin_amdgcn_rcpf(1.f + e);
                float sg = r, om = e * r;
                if (MASKED) { const bool ok = (kb + kidx_of(kh, v, h)) < tpos; sg = ok ? sg : 0.f; om = ok ? om : 1.f; }
                s[kh][v] = sg * g;
                g *= om; }
            gp[4 * kh + aa] = g; }
    float tot = P, off[8];
#pragma unroll
    for (int ap = 7; ap >= 0; --ap) { const float mine = gp[ap], oth = xhalf(mine, h);
        off[ap] = h == 0 ? tot * oth : tot; tot *= mine * oth; }
#pragma unroll
    for (int kh = 0; kh < 2; ++kh)
#pragma unroll
        for (int v = 0; v < 16; ++v) s[kh][v] *= off[4 * kh + (v >> 2)];
    P = tot;
}
__device__ __forceinline__ void sb_weights(f32x16 (&s)[2], float& P, int kb, int tpos, int h, bool masked) {
    if (masked) sb_weights_t<true>(s, P, kb, tpos, h); else sb_weights_t<false>(s, P, kb, tpos, h);
}
#define SB_PMIN 8.7e-27f
__device__ __forceinline__ void item_l2_sample(const Args& a, int it, int lane, int wave) {
    unsigned char* ws = a.ws; const int sb = it >> 1, g = it & 1, slot = wave & 1;
    const bf16* w2t = (const bf16*)(ws + WS_W2T) + slot * 64 * 256;
    const float* kcg = slot ? nullptr : (const float*)a.in[IN_KCG];
    for (int j = 0; j < 2; ++j) { const int ch = (wave >> 1) + 4 * j;
        const bf16* hid0 = (const bf16*)(ws + WS_HIDS) + ((size_t)slot * 16384 + (size_t)(sb * 256 + 32 * ch) * 2 + g) * 256;
        unsigned char* dst = ws + (slot ? WS_VCS : WS_KCS) + ((size_t)((sb * 2 + g) * 256 + 32 * ch)) * 128;
        l2_wave<false>(w2t, hid0, 512, kcg, dst, 128, lane); }
}
__device__ __forceinline__ void item_sb_prompt(const Args& a, LAS unsigned char* lds, int it, int lane, int wave) {
    unsigned char* ws = a.ws;
    const int qb = 7 - (it >> 6), bh = it & 63, b = bh >> 3, hd = bh & 7;
    const int r = lane & 31, h = lane >> 5, tw = 256 * qb + 32 * wave, tpos = tw + r; const size_t mrow = (size_t)b * TP + tpos;
    const bf16* QA = (const bf16*)(ws + WS_QA); const bf16* KA = (const bf16*)(ws + WS_KA) + hd * 64; const bf16* VA = (const bf16*)(ws + WS_VA) + hd * 64;
    bf16x8 qf[4]; load_qf(qf, QA + mrow * 512 + hd * 64, lane);
    LAS unsigned char* Vs = lds + wave * VT_BYTES;
    f32x16 o[2]; zero_o(o);
    float C = 1.f;
    for (int kb = (tw >> 6) << 6; kb >= 0; kb -= 64) {
        const size_t krow0 = (size_t)b * TP + kb;
        v4u vr[8];
#pragma unroll
        for (int i = 0; i < 8; ++i) vr[i] = *(const GAS v4u*)(VA + (krow0 + 8 * i + (lane >> 3)) * 512 + (lane & 7) * 8);
        f32x16 s[2]; qk64_g(s, KA + krow0 * 512, 512, qf, lane);
#pragma unroll
        for (int i = 0; i < 8; ++i) *(LAS v4u*)(Vs + (8 * i + (lane >> 3)) * VP + (lane & 7) * 16) = vr[i];
        sb_weights(s, C, kb, tpos, h, kb + 64 > tw);
        asm volatile("" ::: "memory");
        pv64(o, Vs, s, lane);
        asm volatile("" ::: "memory");
        if (__all(C < SB_PMIN)) break;
    }
    const bf16* GA = (const bf16*)(ws + WS_GA) + mrow * 512 + hd * 64; bf16* U = (bf16*)(ws + WS_U) + mrow * 1024 + hd * 64;
    v2u grp[8];
#pragma unroll
    for (int dh = 0; dh < 2; ++dh)
#pragma unroll
        for (int aa = 0; aa < 4; ++aa) { const int d0 = 32 * dh + 8 * aa + 4 * h; const v2u gw = *(const GAS v2u*)(GA + d0);
            grp[4 * dh + aa].x = cvtpk(o[dh][4 * aa] * bf_lo(gw.x), o[dh][4 * aa + 1] * bf_hi(gw.x)); grp[4 * dh + aa].y = cvtpk(o[dh][4 * aa + 2] * bf_lo(gw.y), o[dh][4 * aa + 3] * bf_hi(gw.y)); }
    store_row_wide(U, grp, h);
}
__device__ __forceinline__ void item_win_prompt(const Args& a, LAS unsigned char* lds, int it, int tid, int lane, int wave) {
    unsigned char* ws = a.ws;
    const int qp = 15 - (it >> 4), bg = it & 15, b = bg >> 1, g = bg & 1, qA = 2 * qp + 1, qB = 2 * qp;
    const int r = lane & 31, h = lane >> 5, hq = 4 * g + (wave & 3), tA = 64 * qA + 32 * (wave >> 2) + r, tB = tA - 64; const size_t mA = (size_t)b * TP + tA, mB = mA - 64;
    const float slope2 = fexp2(-(float)(hq + 1)) * LOG2E;
    bf16x8 qfA[4], qfB[4]; load_qf(qfA, (const bf16*)(ws + WS_QB) + mA * 512 + hq * 64, lane); load_qf(qfB, (const bf16*)(ws + WS_QB) + mB * 512 + hq * 64, lane);
    const bf16* KW = (const bf16*)(ws + WS_KWIN) + (size_t)b * TP * 128 + g * 64; const bf16* VW = (const bf16*)(ws + WS_VWIN) + (size_t)b * TP * 128 + g * 64;
    f32x16 oA[2], oB[2]; zero_o(oA); zero_o(oB); float mAx = -1e30f, lA = 0.f, mBx = -1e30f, lB = 0.f;
    f32x16 cinit[2]; alibi_cinit(cinit, slope2);
    const int kt_lo = qB >= 8 ? qB - 8 : 0;
    { const v4u k0 = tile_ld(KW + (size_t)(64 * qA) * 128, 128, tid), v0 = tile_ld(VW + (size_t)(64 * qA) * 128, 128, tid);
      tile_st(lds, KP, tid, k0); tile_st(lds + KT_BYTES, VP, tid, v0); }
    v4u kr = {0u, 0u, 0u, 0u}, vr = {0u, 0u, 0u, 0u};
    if (qA - 1 >= kt_lo) { kr = tile_ld(KW + (size_t)(64 * (qA - 1)) * 128, 128, tid); vr = tile_ld(VW + (size_t)(64 * (qA - 1)) * 128, 128, tid); }
    int st = 0;
    for (int kt = qA; kt >= kt_lo; --kt, st ^= 1) {
        __syncthreads();
        LAS unsigned char* Ks = lds + st * (KT_BYTES + VT_BYTES); LAS unsigned char* Vs = Ks + KT_BYTES;
        if (kt - 1 >= kt_lo) { LAS unsigned char* Kn = lds + (st ^ 1) * (KT_BYTES + VT_BYTES); tile_st(Kn, KP, tid, kr); tile_st(Kn + KT_BYTES, VP, tid, vr); }
        if (kt - 2 >= kt_lo) { kr = tile_ld(KW + (size_t)(64 * (kt - 2)) * 128, 128, tid); vr = tile_ld(VW + (size_t)(64 * (kt - 2)) * 128, 128, tid); }
        const int kb = 64 * kt; const float off = slope2 * (float)(kb + 4 * h);
        if (kt >= qA - 8) { f32x16 s[2]; qk64c(s, Ks, qfA, cinit, lane);
            if (kt == qA || kt == qA - 8) sm2_tile<true>(s, mAx, lA, oA, off, true, tA - 512 - kb - 4 * h, tA - kb - 4 * h);
            else sm2_tile<false>(s, mAx, lA, oA, off, true, 0, 0);
            pv64(oA, Vs, s, lane); }
        if (kt <= qB) { f32x16 s[2]; qk64c(s, Ks, qfB, cinit, lane);
            if (kt == qB || kt == qB - 8) sm2_tile<true>(s, mBx, lB, oB, off, true, tB - 512 - kb - 4 * h, tB - kb - 4 * h);
            else sm2_tile<false>(s, mBx, lB, oB, off, true, 0, 0);
            pv64(oB, Vs, s, lane); }
    }
    lA += __shfl_xor(lA, 32); lB += __shfl_xor(lB, 32);
    const float gA = ((const float*)(ws + WS_BR))[mA * 24 + hq * 3 + 2], gB = ((const float*)(ws + WS_BR))[mB * 24 + hq * 3 + 2];
    store_ot((bf16*)(ws + WS_OW) + mA * 512 + hq * 64, oA, gA / lA, h);
    store_ot((bf16*)(ws + WS_OW) + mB * 512 + hq * 64, oB, gB / lB, h);
}

__device__ __forceinline__ void item_sb_sample(const Args& a, LAS unsigned char* lds, int it, int lane, int wave) {
    unsigned char* ws = a.ws; const int pair = it * 8 + wave, sb = pair >> 3, hd = pair & 7;
    const int r = lane & 31, h = lane >> 5, st = r & 7, tpos = 8192 + st; const size_t mrow = (size_t)MP + sb * 8 + st;
    const float* csb = (const float*)a.in[IN_CSB]; const int* pt = (const int*)a.in[IN_PT] + sb * 64;
    bf16x8 qf[4]; load_qf(qf, (const bf16*)(ws + WS_QA) + mrow * 512 + hd * 64, lane);
    LAS unsigned char* Vs = lds + wave * VT_BYTES;
    f32x16 o[2]; zero_o(o); float C = 1.f;
    for (int blk = 128; blk >= 0; --blk) {
        const float* rows = (blk == 128) ? a.out + OFF_SB + (size_t)(MP + sb * 8) * 1024 : csb + ((size_t)pt[blk >> 1] * 128 + (blk & 1) * 64) * 1024;
        const int maxrow = blk == 128 ? 7 : 63;
        const float* kbase = rows + hd * 64; const float* vbase = rows + 512 + hd * 64;
        f32x4 kt[2][4][2];
#pragma unroll
        for (int kh = 0; kh < 2; ++kh) { const float* kp = kbase + (size_t)min(32 * kh + r, maxrow) * 1024 + 8 * h;
#pragma unroll
            for (int ks = 0; ks < 4; ++ks) { kt[kh][ks][0] = *(const GAS f32x4*)(kp + 16 * ks); kt[kh][ks][1] = *(const GAS f32x4*)(kp + 16 * ks + 4); } }
        f32x4 va[4][2], vb[4][2];
#pragma unroll
        for (int i = 0; i < 4; ++i) { const float* vp = vbase + (size_t)min(8 * i + (lane >> 3), maxrow) * 1024 + (lane & 7) * 8; va[i][0] = *(const GAS f32x4*)vp; va[i][1] = *(const GAS f32x4*)(vp + 4); }
        f32x16 s[2];
#pragma unroll
        for (int kh = 0; kh < 2; ++kh) { f32x16 acc; for (int i = 0; i < 16; ++i) acc[i] = 0.f;
#pragma unroll
            for (int ks = 0; ks < 4; ++ks) { const bf16x8 kf8 = pack8(kt[kh][ks][0], kt[kh][ks][1]); __builtin_amdgcn_s_setprio(1); acc = MFMA32(kf8, qf[ks], acc); __builtin_amdgcn_s_setprio(0); }
            s[kh] = acc; }
#pragma unroll
        for (int i = 0; i < 4; ++i) { const float* vp = vbase + (size_t)min(8 * (i + 4) + (lane >> 3), maxrow) * 1024 + (lane & 7) * 8; vb[i][0] = *(const GAS f32x4*)vp; vb[i][1] = *(const GAS f32x4*)(vp + 4); }
#pragma unroll
        for (int i = 0; i < 4; ++i) *(LAS bf16x8*)(Vs + (8 * i + (lane >> 3)) * VP + (lane & 7) * 16) = pack8(va[i][0], va[i][1]);
        sb_weights(s, C, 64 * blk, tpos, h, blk == 128);
#pragma unroll
        for (int i = 0; i < 4; ++i) *(LAS bf16x8*)(Vs + (8 * (i + 4) + (lane >> 3)) * VP + (lane & 7) * 16) = pack8(vb[i][0], vb[i][1]);
        asm volatile("" ::: "memory");
        pv64(o, Vs, s, lane);
        asm volatile("" ::: "memory");
        if (__all(C < SB_PMIN)) break;
    }
    { const bf16* GA = (const bf16*)(ws + WS_GA) + mrow * 512 + hd * 64; bf16* U = (bf16*)(ws + WS_U) + mrow * 1024 + hd * 64;
      v2u grp[8];
#pragma unroll
      for (int dh = 0; dh < 2; ++dh)
#pragma unroll
          for (int aa = 0; aa < 4; ++aa) { const int d0 = 32 * dh + 8 * aa + 4 * h; const v2u gw = *(const GAS v2u*)(GA + d0);
              grp[4 * dh + aa].x = cvtpk(o[dh][4 * aa] * bf_lo(gw.x), o[dh][4 * aa + 1] * bf_hi(gw.x)); grp[4 * dh + aa].y = cvtpk(o[dh][4 * aa + 2] * bf_lo(gw.y), o[dh][4 * aa + 3] * bf_hi(gw.y)); }
      store_row_wide(U, grp, h, r < 8); }
}

#ifndef DBG_DUP
#define DBG_DUP 0
#endif

constexpr size_t WS_KCP = 230 * MiB, WS_VCP = 231 * MiB;
constexpr int P3_KC = 0, P3_VC = KT_BYTES, P3_KS = KT_BYTES + VT_BYTES  , P3_IMPW = P3_KS + 2 * (KT_BYTES + VT_BYTES)  , P3_IMP = P3_IMPW + 8 * 32 * 33 * 4,
              P3_SEL = P3_IMP + 64 * 36 * 4, P3_UM = P3_SEL + 256;
__device__ __forceinline__ void item_nsa_prompt(const Args& a, LAS unsigned char* lds, int it, int tid, int lane, int wave) {
    unsigned char* ws = a.ws;
    const int qblk = 31 - (it >> 4), bg = it & 15, b = bg >> 1, g = bg & 1, cur = qblk;
    const int r = lane & 31, h = lane >> 5, hq = 4 * g + (wave & 3), th = wave >> 2, tpos = 64 * qblk + 32 * th + r; const size_t mrow = (size_t)b * TP + tpos;
    const float slope2 = fexp2(-(float)(hq + 1)) * LOG2E;
    { const bf16* KCP = (const bf16*)(ws + WS_KCP) + (size_t)(b * 2 + g) * 4096; const bf16* VCP = (const bf16*)(ws + WS_VCP) + (size_t)(b * 2 + g) * 4096;
      const v4u k0 = tile_ld(KCP, 64, tid), v0 = tile_ld(VCP, 64, tid); tile_st(lds + P3_KC, KP, tid, k0); tile_st(lds + P3_VC, VP, tid, v0); }
    bf16x8 qf[4]; load_qf(qf, (const bf16*)(ws + WS_QB) + mrow * 512 + hq * 64, lane);
    __syncthreads();
    f32x16 oc[2];
    for (int dupp = 0; dupp < ((DBG_DUP & 128) ? 2 : 1); ++dupp) { if (dupp) __syncthreads();
    zero_o(oc);
    { f32x16 s[2]; qk64(s, lds + P3_KC, qf, lane);
      float mx = -1e30f;
#pragma unroll
      for (int kh = 0; kh < 2; ++kh)
#pragma unroll
          for (int v = 0; v < 16; ++v) { const int ce = 32 * kidx_of(kh, v, h) + 31, dist = tpos - ce; const float x = dist >= 0 ? s[kh][v] - slope2 * (float)dist : -INFINITY; s[kh][v] = x; mx = fmaxf(mx, x); }
      mx = fmaxf(mx, __shfl_xor(mx, 32));
      float sum = 0.f;
#pragma unroll
      for (int kh = 0; kh < 2; ++kh)
#pragma unroll
          for (int v = 0; v < 16; ++v) { const float e = fexp2(s[kh][v] - mx); s[kh][v] = e; sum += e; }
      sum += __shfl_xor(sum, 32);
      const float inv = sum > 0.f ? 1.f / sum : 1.f;
#pragma unroll
      for (int kh = 0; kh < 2; ++kh)
#pragma unroll
          for (int v = 0; v < 16; ++v) s[kh][v] *= inv;
      LAS float* impw = (LAS float*)(lds + P3_IMPW) + (wave * 32 + r) * 33;
#pragma unroll
      for (int kh = 0; kh < 2; ++kh)
#pragma unroll
          for (int aa = 0; aa < 4; ++aa)
#pragma unroll
              for (int b2 = 0; b2 < 2; ++b2) impw[16 * kh + 4 * aa + 2 * h + b2] = s[kh][4 * aa + 2 * b2] + s[kh][4 * aa + 2 * b2 + 1];
      pv64(oc, lds + P3_VC, s, lane);
    }
    __syncthreads();
    { const int tk = tid >> 3, j8 = tid & 7; LAS float* imp = (LAS float*)(lds + P3_IMP) + tk * 36;
      const LAS float* iw = (const LAS float*)(lds + P3_IMPW) + (((tk >> 5) * 4) * 32 + (tk & 31)) * 33;
#pragma unroll
      for (int j = 0; j < 4; ++j) { const int blk = 4 * j8 + j; imp[blk] = (iw[blk] + iw[32 * 33 + blk]) + (iw[2 * 32 * 33 + blk] + iw[3 * 32 * 33 + blk]); }
      __syncthreads();
      unsigned bits = 0u;
      if (cur <= 15) bits = 0xffffffffu;
      else {
          float y[32];
#pragma unroll
          for (int q4 = 0; q4 < 8; ++q4) { const f32x4 v = *(const LAS f32x4*)(imp + 4 * q4); y[4 * q4] = v.x; y[4 * q4 + 1] = v.y; y[4 * q4 + 2] = v.z; y[4 * q4 + 3] = v.w; }
#pragma unroll
          for (int j = 0; j < 4; ++j) { const int blk = 4 * j8 + j;
              if (blk == 0 || blk == cur || blk == cur - 1) bits |= 1u << blk;
              else if (blk < cur - 1) { float x = 0.f;
#pragma unroll
                  for (int o2 = 0; o2 < 32; ++o2) x = (o2 == blk) ? y[o2] : x;
                  int rank = 0;
#pragma unroll
                  for (int o2 = 1; o2 < 30; ++o2) rank += (o2 <= cur - 2 && (y[o2] > x || (y[o2] == x && o2 < blk))) ? 1 : 0;
                  if (rank < 13) bits |= 1u << blk; } } }
      bits |= __shfl_xor(bits, 1); bits |= __shfl_xor(bits, 2); bits |= __shfl_xor(bits, 4);
      if (j8 == 0) ((LAS unsigned*)(lds + P3_SEL))[tk] = bits;
      __syncthreads();
      if (wave == 0) { unsigned um = ((const LAS unsigned*)(lds + P3_SEL))[lane];
#pragma unroll
          for (int o2 = 1; o2 < 64; o2 <<= 1) um |= __shfl_xor(um, o2);
          if (lane == 0) *(LAS unsigned*)(lds + P3_UM) = um; }
      __syncthreads();
    }
    }
    const unsigned selbits = ((const LAS unsigned*)(lds + P3_SEL))[32 * th + r], umask = *(const LAS unsigned*)(lds + P3_UM);
    f32x16 os[2]; zero_o(os); float m = -1e30f, l = 0.f;
    f32x16 cinit[2]; alibi_cinit(cinit, slope2);
    { const bf16* KS = (const bf16*)(ws + WS_KSEL) + (size_t)b * TP * 128 + g * 64; const bf16* VS = (const bf16*)(ws + WS_VSEL) + (size_t)b * TP * 128 + g * 64;
      unsigned todo = umask & (cur >= 31 ? 0xffffffffu : ((2u << cur) - 1u));
      int blk = 31 - __builtin_clz(todo); todo &= ~(1u << blk);
      int nb1 = todo ? 31 - __builtin_clz(todo) : -1; if (nb1 >= 0) todo &= ~(1u << nb1);
      { const v4u k0 = tile_ld(KS + (size_t)(64 * blk) * 128, 128, tid), v0 = tile_ld(VS + (size_t)(64 * blk) * 128, 128, tid);
        tile_st(lds + P3_KS, KP, tid, k0); tile_st(lds + P3_KS + KT_BYTES, VP, tid, v0); }
      v4u kr = {0u, 0u, 0u, 0u}, vr = {0u, 0u, 0u, 0u};
      if (nb1 >= 0) { kr = tile_ld(KS + (size_t)(64 * nb1) * 128, 128, tid); vr = tile_ld(VS + (size_t)(64 * nb1) * 128, 128, tid); }
      int st = 0;
      for (;;) {
          __syncthreads();
          LAS unsigned char* Ks = lds + P3_KS + st * (KT_BYTES + VT_BYTES); LAS unsigned char* Vs = Ks + KT_BYTES;
          if (nb1 >= 0) { LAS unsigned char* Kn = lds + P3_KS + (st ^ 1) * (KT_BYTES + VT_BYTES); tile_st(Kn, KP, tid, kr); tile_st(Kn + KT_BYTES, VP, tid, vr); }
          const int nb2 = todo ? 31 - __builtin_clz(todo) : -1; if (nb2 >= 0) todo &= ~(1u << nb2);
          if (nb2 >= 0) { kr = tile_ld(KS + (size_t)(64 * nb2) * 128, 128, tid); vr = tile_ld(VS + (size_t)(64 * nb2) * 128, 128, tid); }
          const int kb = 64 * blk; const bool mine = (selbits >> blk) & 1u;
          if (__any(mine)) {
              for (int dupc = 0; dupc < ((DBG_DUP & 32) ? 2 : 1); ++dupc) {
              f32x16 s[2]; qk64c(s, Ks, qf, cinit, lane);
              const float off = slope2 * (float)(kb + 4 * h);
              if (blk == cur) sm2_tile<true>(s, m, l, os, off, mine && dupc == 0, -(1 << 30), tpos - kb - 4 * h);
              else sm2_tile<false>(s, m, l, os, off, mine && dupc == 0, 0, 0);
              pv64(os, Vs, s, lane); } }
          if (nb1 < 0) break;
          blk = nb1; nb1 = nb2; st ^= 1;
      } }
    l += __shfl_xor(l, 32);
    { const float* br = (const float*)(ws + WS_BR) + mrow * 24 + hq * 3; const float g0 = br[0], g1 = br[1] / l;
      const bf16* OW = (const bf16*)(ws + WS_OW) + mrow * 512 + hq * 64; const bf16* GB = (const bf16*)(ws + WS_GB) + mrow * 512 + hq * 64; bf16* U = (bf16*)(ws + WS_U) + mrow * 1024 + 512 + hq * 64;
      v2u grp[8];
#pragma unroll
      for (int dh = 0; dh < 2; ++dh)
#pragma unroll
          for (int aa = 0; aa < 4; ++aa) { const int d0 = 32 * dh + 8 * aa + 4 * h; const v2u ow = *(const GAS v2u*)(OW + d0), gb = *(const GAS v2u*)(GB + d0);
              const float x0 = (g0 * oc[dh][4 * aa] + g1 * os[dh][4 * aa] + bf_lo(ow.x)) * bf_lo(gb.x), x1 = (g0 * oc[dh][4 * aa + 1] + g1 * os[dh][4 * aa + 1] + bf_hi(ow.x)) * bf_hi(gb.x);
              const float x2 = (g0 * oc[dh][4 * aa + 2] + g1 * os[dh][4 * aa + 2] + bf_lo(ow.y)) * bf_lo(gb.y), x3 = (g0 * oc[dh][4 * aa + 3] + g1 * os[dh][4 * aa + 3] + bf_hi(ow.y)) * bf_hi(gb.y);
              grp[4 * dh + aa].x = cvtpk(x0, x1); grp[4 * dh + aa].y = cvtpk(x2, x3); }
      store_row_wide(U, grp, h); }
}

constexpr int SM_V = 0, SM_ACC = 8 * VT_BYTES  , SM_ST = SM_ACC + 8192, SM_IMP = SM_ST + 3 * 8 * 32 * 2 * 4  , SM_SELW = SM_IMP + 8 * 128 * 4, SM_END = SM_SELW + 128;
static_assert(SM_END <= RING_BYTES, "sample NSA LDS map");
template <class F> __device__ __forceinline__ void sm_tile_f32(f32x16 (&o)[2], float& m, float& l, const float* kbase, const float* vbase, int stride, int maxrow, LAS unsigned char* Vs, const bf16x8 (&qf)[4], int lane, F&& biasf) {
    const int h = lane >> 5;
    f32x4 kt[2][4][2];
#pragma unroll
    for (int kh = 0; kh < 2; ++kh) { const int row = min(32 * kh + (lane & 31), maxrow); const float* kp = kbase + (size_t)row * stride + 8 * h;
#pragma unroll
        for (int ks = 0; ks < 4; ++ks) { kt[kh][ks][0] = *(const GAS f32x4*)(kp + 16 * ks); kt[kh][ks][1] = *(const GAS f32x4*)(kp + 16 * ks + 4); } }
    f32x4 va[4][2], vb[4][2];
#pragma unroll
    for (int i = 0; i < 4; ++i) { const float* vp = vbase + (size_t)min(8 * i + (lane >> 3), maxrow) * stride + (lane & 7) * 8; va[i][0] = *(const GAS f32x4*)vp; va[i][1] = *(const GAS f32x4*)(vp + 4); }
    f32x16 s[2];
#pragma unroll
    for (int kh = 0; kh < 2; ++kh) { f32x16 acc; for (int i = 0; i < 16; ++i) acc[i] = 0.f;
#pragma unroll
        for (int ks = 0; ks < 4; ++ks) { const bf16x8 kf8 = pack8(kt[kh][ks][0], kt[kh][ks][1]); __builtin_amdgcn_s_setprio(1); acc = MFMA32(kf8, qf[ks], acc); __builtin_amdgcn_s_setprio(0); }
        s[kh] = acc; }
#pragma unroll
    for (int i = 0; i < 4; ++i) { const float* vp = vbase + (size_t)min(8 * (i + 4) + (lane >> 3), maxrow) * stride + (lane & 7) * 8; vb[i][0] = *(const GAS f32x4*)vp; vb[i][1] = *(const GAS f32x4*)(vp + 4); }
#pragma unroll
    for (int i = 0; i < 4; ++i) *(LAS bf16x8*)(Vs + (8 * i + (lane >> 3)) * VP + (lane & 7) * 16) = pack8(va[i][0], va[i][1]);
    softmax_tile(s, m, l, o, h, biasf);
#pragma unroll
    for (int i = 0; i < 4; ++i) *(LAS bf16x8*)(Vs + (8 * (i + 4) + (lane >> 3)) * VP + (lane & 7) * 16) = pack8(vb[i][0], vb[i][1]);
    asm volatile("" ::: "memory");
    pv64(o, Vs, s, lane);
    asm volatile("" ::: "memory");
}
__device__ __forceinline__ void sm_put_stats(LAS float* st, int br, int wave, int lane, float m, float l) { if (lane < 32) { st[((br * 8 + wave) * 32 + lane) * 2] = m; st[((br * 8 + wave) * 32 + lane) * 2 + 1] = l; } }
__device__ __forceinline__ void sm_get_ML(const LAS float* st, int br, int r, float& M, float& L) {
    M = -1e30f;
#pragma unroll
    for (int w = 0; w < 8; ++w) M = fmaxf(M, st[((br * 8 + w) * 32 + r) * 2]);
    L = 0.f;
#pragma unroll
    for (int w = 0; w < 8; ++w) L += st[((br * 8 + w) * 32 + r) * 2 + 1] * fexp2(st[((br * 8 + w) * 32 + r) * 2] - M);
}
__device__ __forceinline__ void sm_put(LAS float* slice, const f32x16 (&o)[2], float f, int lane) {
    const int r = lane & 31, h = lane >> 5;
#pragma unroll
    for (int dh = 0; dh < 2; ++dh)
#pragma unroll
        for (int v = 0; v < 16; ++v) { const int d = 32 * dh + (v & 3) + 8 * (v >> 2) + 4 * h; slice[d * 32 + r] = o[dh][v] * f; }
}
__device__ __forceinline__ void item_nsa_sample(const Args& a, LAS unsigned char* lds, int it, int tid, int lane, int wave) {
    unsigned char* ws = a.ws; const int sb = it >> 1, g = it & 1;
    const int r = lane & 31, h = lane >> 5, st = r >> 2, hh = r & 3, hq = 4 * g + hh, t = 8192 + st; const size_t mrow = (size_t)MP + sb * 8 + st;
    const float* cn = (const float*)a.in[IN_CNSA]; const int* pt = (const int*)a.in[IN_PT] + sb * 64; const float* sw = (const float*)a.in[IN_SWIN];
    LAS unsigned char* Vs = lds + SM_V + wave * VT_BYTES; LAS float* acc = (LAS float*)(lds + SM_ACC); LAS float* stt = (LAS float*)(lds + SM_ST); LAS float* imp = (LAS float*)(lds + SM_IMP);
    LAS unsigned long long* selw = (LAS unsigned long long*)(lds + SM_SELW);
    const float slope2 = fexp2(-(float)(hq + 1)) * LOG2E;
    const float* br = (const float*)(ws + WS_BR) + mrow * 24 + hq * 3; const float g0 = br[0], g1 = br[1], g2 = br[2];
    bf16x8 qf[4]; load_qf(qf, (const bf16*)(ws + WS_QB) + mrow * 512 + hq * 64, lane);
    f32x16 ow[2]; zero_o(ow); float mw = -1e30f, lw = 0.f;
#pragma unroll 1
    for (int pass = 0; pass < 2; ++pass) { if (pass == 1 && wave != 4) break;
        const int j = pass == 0 ? wave : 8, i0 = 64 * j;
        const float* rows = (j < 8) ? sw + ((size_t)(sb * 512 + i0)) * 256 : a.out + OFF_WINS + ((size_t)(sb * 512 + 504)) * 256;
        sm_tile_f32(ow, mw, lw, rows + g * 64, rows + 128 + g * 64, 256, j < 8 ? 63 : 7, Vs, qf, lane, [&](int ki) { const int i = i0 + ki, dist = t - (7680 + i); return (i < 520 && dist >= 0 && dist < 512) ? -slope2 * (float)dist : -INFINITY; }); }
    if (DBG_DUP & 4) { f32x16 o2[2]; zero_o(o2); float m2 = -1e30f, l2 = 0.f;
#pragma unroll 1
        for (int pass = 0; pass < 2; ++pass) { if (pass == 1 && wave != 4) break;
            const int j = pass == 0 ? wave : 8, i0 = 64 * j;
            const float* rows = (j < 8) ? sw + ((size_t)(sb * 512 + i0)) * 256 : a.out + OFF_WINS + ((size_t)(sb * 512 + 504)) * 256;
            sm_tile_f32(o2, m2, l2, rows + g * 64, rows + 128 + g * 64, 256, j < 8 ? 63 : 7, Vs, qf, lane, [&](int ki) { const int i = i0 + ki, dist = t - (7680 + i); return (i < 520 && dist >= 0 && dist < 512) ? -slope2 * (float)dist : -INFINITY; }); }
        if (m2 == 12345.f) ow[0][0] += o2[0][0] + l2; }
    lw += __shfl_xor(lw, 32);
    sm_put_stats(stt, 2, wave, lane, mw, lw);
    f32x16 oc[2]; zero_o(oc); f32x16 ec[2]; float mc = -1e30f, lc = 0.f;
    if (wave < 4) {
        const bf16* KC = (const bf16*)(ws + WS_KCS) + ((size_t)((sb * 2 + g) * 256 + 64 * wave)) * 64; const bf16* VC = (const bf16*)(ws + WS_VCS) + ((size_t)((sb * 2 + g) * 256 + 64 * wave)) * 64;
        v4u vr[8];
#pragma unroll
        for (int i = 0; i < 8; ++i) vr[i] = *(const GAS v4u*)(VC + (size_t)(8 * i + (lane >> 3)) * 64 + (lane & 7) * 8);
        qk64_g(ec, KC, 64, qf, lane);
#pragma unroll
        for (int i = 0; i < 8; ++i) *(LAS v4u*)(Vs + (8 * i + (lane >> 3)) * VP + (lane & 7) * 16) = vr[i];
        const int c0 = 64 * wave;
        softmax_tile(ec, mc, lc, oc, h, [&](int ki) { return -slope2 * (float)(t - (32 * (c0 + ki) + 31)); });
        asm volatile("" ::: "memory");
        pv64(oc, Vs, ec, lane);
        asm volatile("" ::: "memory");
        lc += __shfl_xor(lc, 32);
    }
    sm_put_stats(stt, 0, wave, lane, mc, lc);
    __syncthreads();
    LAS float* mbuf = (LAS float*)(lds + SM_V);
    { float M, L; sm_get_ML(stt, 2, r, M, L); sm_put(mbuf + wave * 2048, ow, (L > 0.f) ? g2 * fexp2(mw - M) / L : 0.f, lane); }
    if (wave < 4) { float M, L; sm_get_ML(stt, 0, r, M, L); const float f = fexp2(mc - M) / L;
        sm_put(mbuf + (8 + wave) * 2048, oc, g0 * f, lane);
#pragma unroll
        for (int kh = 0; kh < 2; ++kh)
#pragma unroll
            for (int aa = 0; aa < 4; ++aa)
#pragma unroll
                for (int b2 = 0; b2 < 2; ++b2) { float v = (ec[kh][4 * aa + 2 * b2] + ec[kh][4 * aa + 2 * b2 + 1]) * f; v += __shfl_xor(v, 1); v += __shfl_xor(v, 2);
                    if (hh == 0) imp[st * 128 + 32 * wave + 16 * kh + 4 * aa + 2 * h + b2] = v; } }
    __syncthreads();
    { f32x4 sum = {0.f, 0.f, 0.f, 0.f};
#pragma unroll
      for (int w = 0; w < 12; ++w) sum += *(const LAS f32x4*)(mbuf + w * 2048 + tid * 4);
      *(LAS f32x4*)(acc + tid * 4) = sum; }
    for (int dup = 0; dup < ((DBG_DUP & 2) ? 2 : 1); ++dup)
    { const LAS float* im = imp + wave * 128; bool s0, s1;
      { const int blk = lane; if (blk == 0) s0 = true; else { const float x = im[blk]; int rank = 0; for (int o2 = 1; o2 <= 126; ++o2) { const float y = im[o2]; rank += (y > x || (y == x && o2 < blk)) ? 1 : 0; } s0 = rank < 13; } }
      { const int blk = lane + 64; if (blk == 127) s1 = true; else { const float x = im[blk]; int rank = 0; for (int o2 = 1; o2 <= 126; ++o2) { const float y = im[o2]; rank += (y > x || (y == x && o2 < blk)) ? 1 : 0; } s1 = rank < 13; } }
      const unsigned long long b0 = __ballot(s0), b1 = __ballot(s1);
      if (lane == 0) { selw[2 * wave] = b0; selw[2 * wave + 1] = b1; } }
    __syncthreads();
    f32x16 os[2]; zero_o(os); float ms = -1e30f, ls = 0.f;
    { unsigned long long u0 = 0ull, u1 = 0ull;
#pragma unroll
      for (int s8 = 0; s8 < 8; ++s8) { u0 |= selw[2 * s8]; u1 |= selw[2 * s8 + 1]; }
      const unsigned long long my0 = selw[2 * st], my1 = selw[2 * st + 1];
      int cnt = 0;
      for (int dup8 = 0; dup8 < ((DBG_DUP & 8) ? 2 : 1); ++dup8)
      for (int half = 0; half < 3; ++half) { unsigned long long bits = half == 0 ? u0 : (half == 1 ? u1 : 1ull);
          while (bits) { const int bi = __builtin_ctzll(bits); bits &= bits - 1; const int blk = 64 * half + bi;
              if ((cnt++ & 7) != wave) continue;
              const float* rows = (blk < 128) ? cn + ((size_t)pt[blk >> 1] * 128 + (blk & 1) * 64) * 512 : a.out + OFF_NSA + ((size_t)(MP + sb * 8)) * 512;
              const bool mine = (dup8 == 0) && (half == 0 ? ((my0 >> bi) & 1ull) : (half == 1 ? ((my1 >> bi) & 1ull) : true));
              const int kb = 64 * blk;
              sm_tile_f32(os, ms, ls, rows + 256 + g * 64, rows + 384 + g * 64, 512, blk < 128 ? 63 : 7, Vs, qf, lane, [&](int ki) { const int dist = t - (kb + ki); return (mine && dist >= 0) ? -slope2 * (float)dist : -INFINITY; }); } } }
    ls += __shfl_xor(ls, 32);
    sm_put_stats(stt, 1, wave, lane, ms, ls);
    __syncthreads();
    { float M, L; sm_get_ML(stt, 1, r, M, L); sm_put(mbuf + wave * 2048, os, (L > 0.f) ? g1 * fexp2(ms - M) / L : 0.f, lane); }
    __syncthreads();
    { f32x4 sum = *(const LAS f32x4*)(acc + tid * 4);
#pragma unroll
      for (int w = 0; w < 8; ++w) sum += *(const LAS f32x4*)(mbuf + w * 2048 + tid * 4);
      *(LAS f32x4*)(acc + tid * 4) = sum; }
    __syncthreads();
    { const int r2 = tid >> 4, d4 = (tid & 15) * 4; const size_t m2 = (size_t)MP + sb * 8 + (r2 >> 2); const int hq2 = 4 * g + (r2 & 3);
      const v2u gb = *(const GAS v2u*)((const bf16*)(ws + WS_GB) + m2 * 512 + hq2 * 64 + d4);
      v2u w; w.x = cvtpk(acc[(d4 + 0) * 32 + r2] * bf_lo(gb.x), acc[(d4 + 1) * 32 + r2] * bf_hi(gb.x)); w.y = cvtpk(acc[(d4 + 2) * 32 + r2] * bf_lo(gb.y), acc[(d4 + 3) * 32 + r2] * bf_hi(gb.y));
      *(GAS v2u*)((bf16*)(ws + WS_U) + m2 * 1024 + 512 + hq2 * 64 + d4) = w; }
}

#ifndef MK_N_LAUNCHES
#define MK_N_LAUNCHES 1
#endif
#ifndef DBG_STAGE
#define DBG_STAGE 0
#endif
constexpr int N_PHASES = 6;
constexpr int N_L2S = 64, N_SBS = 32, N_WINP = 256, N_SBP = 512, N_NP = 512, N_NS = 64;

__global__ void __launch_bounds__(NTHR, 2) mk_fwd(Args a) {
    extern __shared__ __attribute__((aligned(16))) unsigned char lds_raw[];
    LAS unsigned char* lds = (LAS unsigned char*)lds_raw;
    const int tid0 = threadIdx.x;
    const int G = gridDim.x, bx = blockIdx.x, vcu = (G % 8 == 0) ? (bx % 8) * (G / 8) + bx / 8 : bx;
    unsigned char* ws = a.ws; gu32* ctl = (gu32*)(ws + WS_CTL);
    for (int u = tid0; u < (LDS_BYTES - LDSCTL_OFF) / 4; u += NTHR) ((LAS unsigned*)(lds + LDSCTL_OFF))[u] = 0u;
    __syncthreads();
    volatile LAS unsigned* MISC = (volatile LAS unsigned*)(lds + MISC_OFF);
    volatile LAS int* qslot = (volatile LAS int*)(lds + LDSCTL_OFF + 64);
    const int lo = a.ph_lo, hi = a.ph_hi; const bool multi = (hi - lo) > 1;
    XcdBarrier bar; bar.bar = (unsigned*)(ctl + CW_BAR); bar.x = 0; bar.st = nullptr;
    if (multi) bar = xcd_barrier_post((unsigned*)(ctl + CW_BAR), MISC + 8);
#ifdef DBG_PHMASK
#define IN(k) (((DBG_PHMASK >> (k)) & 1) && lo <= (k) && (k) < hi)
#else
#define IN(k) (lo <= (k) && (k) < hi)
#endif
#define SEAM(k) do { if (IN(k) && IN((k) + 1)) xcd_barrier(bar); } while (0)
#ifndef DBG_REP
#define DBG_REP (-1)
#endif
#define NREP(k) ((DBG_REP == (k)) ? 2 : 1)
#define REPSEAM(k) do { if (rep + 1 < NREP(k)) xcd_barrier(bar); } while (0)

    if (IN(0)) _Pragma("unroll") for (int rep = 0; rep < NREP(0); ++rep) { int tid = tid0; asm volatile("" : "+v"(tid)); p0_prologue(a, lds, tid, tid & 63, __builtin_amdgcn_readfirstlane(tid >> 6), vcu, G, rep); REPSEAM(0); }
    SEAM(0);

    if (IN(1)) { _Pragma("unroll") for (int rep = 0; rep < NREP(1); ++rep) {
#ifndef DBG_P1MASK
#define DBG_P1MASK 7
#endif
        const int xcc = (int)xb_xcc_id(); volatile LAS int* gslot = (volatile LAS int*)(lds + LDSCTL_OFF + 128);
#ifndef DBG_P1REPM
#define DBG_P1REPM 7
#endif
#define P1ON(bit) ((DBG_P1MASK & (bit)) && (rep == 0 || (DBG_P1REPM & (bit))))
        const int ngb = G < 128 ? G : 128;
        if (P1ON(1) && bx < ngb) {
#pragma unroll 1
            for (int L = bx; L < 256; L += ngb) {
                pg8::EpiHidB128 E{(bf16*)(ws + WS_HIDS), (const float*)(ws + WS_CTL) + CW_BIAS + (L >> 7) * 256};
                pg8::gemm_unit_gather128(lds, (const float*)a.in[IN_CNSA], (const int*)a.in[IN_PT], (const bf16*)(ws + WS_W1T), L, E); } }
        if (P1ON(4)) { pg8::Gemm g{(const bf16*)(ws + WS_HBF), (const bf16*)(ws + WS_WIN_T), MT, NG1, 1024};
          pg8::HybridOrder S; S.q = (unsigned*)(ctl + CW_Q + 64 * 16 + 4096 * rep); S.slot = gslot; S.nM = MT / 256; S.nN = NG1 / 256; S.nwg = S.nM * S.nN; S.dyn0 = 640;
          if (G != 256) { S.ns = 0; S.l0 = 0; S.lstride = 0; S.dyn0 = 0; }
          else if (bx >= 128) { S.ns = 4; S.l0 = bx - 128; S.lstride = 128; } else { S.ns = 1; S.l0 = 512 + bx; S.lstride = 0; }
#ifdef DBG_G1STATIC
          if (rep == 1) { S.ns = 4; S.l0 = bx; S.lstride = 256; S.dyn0 = 975; if (bx + 768 >= 975) S.ns = 3; }
#endif
          pg8::EpiG1 E{a.out, (const float*)(ws + WS_RSTD), (bf16*)(ws + WS_QA), (bf16*)(ws + WS_KA), (bf16*)(ws + WS_VA), (bf16*)(ws + WS_GA), (bf16*)(ws + WS_QB), (bf16*)(ws + WS_GB),
                       (bf16*)(ws + WS_KSEL), (bf16*)(ws + WS_VSEL), (bf16*)(ws + WS_KWIN), (bf16*)(ws + WS_VWIN), (bf16*)(ws + WS_ACMP_P),
                       (const float*)a.in[IN_QG], (const float*)a.in[IN_KSG], (const float*)a.in[IN_KWG], (const float*)a.in[IN_PEK], (const float*)a.in[IN_PEV]};
#ifdef DBG_NOEPI
#if DBG_NOEPI == 2
#ifdef DBG_TILECONTIG
          if (rep == 1) { pg8::EpiBf16<0> E0{(bf16*)(ws + WS_ACMP_S), 256, nullptr, 256, (size_t)65 * 65536, 1.f};
#else
          if (rep == 1) { pg8::EpiBf16<0> E0{(bf16*)(ws + WS_ACMP_S), NG1, nullptr, 0, 0, 1.f};
#endif
          pg8::gemm_phase<pg8::EpiBf16<0>, pg8::HybridOrder, PG8_ALIGN, PG8_SP2>(lds, g, S, E0); } else
#else
          if (rep == 1) { pg8::EpiNone E0; pg8::gemm_phase<pg8::EpiNone, pg8::HybridOrder, PG8_ALIGN, PG8_SP2>(lds, g, S, E0); } else
#endif
#endif
          pg8::gemm_phase<pg8::EpiG1, pg8::HybridOrder, PG8_ALIGN, PG8_SP2>(lds, g, S, E); }
        if (P1ON(2)) { pg8::Gemm g{(const bf16*)(ws + WS_PBF), (const bf16*)(ws + WS_WPLE_T), MT, 1024, 256}; pg8::XcdQueueOrder S; S.init(MT, 1024, (unsigned*)(ctl + CW_Q + 64 * 24 + 4096 * rep), gslot, xcc);
          pg8::EpiBf16<0> E{(bf16*)(ws + WS_T1), 1024, nullptr, 0, 0, 1.f};
          pg8::gemm_phase<pg8::EpiBf16<0>, pg8::XcdQueueOrder, PG8_ALIGN, PG8_SP2, true>(lds, g, S, E); }
        REPSEAM(1); }
        SEAM(1);
    }

    if (IN(2)) { _Pragma("unroll") for (int rep = 0; rep < NREP(2); ++rep) {
#if DBG_STAGE == 1
        { v4u z = {0u, 0u, 0u, 0u}; for (size_t i = (size_t)bx * NTHR + tid0; i < (size_t)MT * 1024 / 8; i += (size_t)G * NTHR) *(GAS v4u*)((bf16*)(ws + WS_U) + i * 8) = z; }
#else
        if (bx < 16) {
            const int slot = bx >> 3, b = bx & 7;
            { pg8::EpiHidB128 E{(bf16*)(ws + WS_HIDP), (const float*)(ws + WS_CTL) + CW_BIAS + 1024  };
              pg8::gemm_unit_bf16_128(lds, (const bf16*)(ws + WS_ACMP_P) + (size_t)bx * 128 * 2048, (const bf16*)(ws + WS_W1T), slot, bx * 128, E); }
            VM_WAIT(); __syncthreads();
            int t2 = tid0; asm volatile("" : "+v"(t2)); const int ln = t2 & 63, wv = __builtin_amdgcn_readfirstlane(t2 >> 6);
            if (wv < 4) { const int g = wv >> 1, chf = wv & 1;
                const bf16* hid0 = (const bf16*)(ws + WS_HIDP) + ((size_t)slot * 1024 + (size_t)(b * 64 + 32 * chf) * 2 + g) * 256;
                unsigned char* dst = ws + (slot ? WS_VCP : WS_KCP) + ((size_t)((b * 2 + g) * 64 + 32 * chf)) * 128;
                l2_wave<false>((const bf16*)(ws + WS_W2T) + slot * 64 * 256, hid0, 512, slot ? nullptr : (const float*)a.in[IN_KCG], dst, 128, ln); } }
        bool arrived = false;
        for (;;) {
            int it = next_item(ctl + CW_Q + 128 * rep, qslot);
            int tid = tid0; asm volatile("" : "+v"(tid)); const int lane = tid & 63, wave = __builtin_amdgcn_readfirstlane(tid >> 6);
            if (!arrived && it >= N_NS + N_SBS + N_WINP) { arrived = true; VM_WAIT(); __syncthreads();
                if (tid == 0) { __builtin_amdgcn_s_waitcnt(0);
                    const unsigned nloc = bar.st[0]; const unsigned old = __hip_atomic_fetch_add(ctl + CW_Q + 64 * (43 + (int)bar.x), 1u, RLX_AGENT);
                    if (old + 1u == nloc * (unsigned)(rep + 1)) { __builtin_amdgcn_fence(__ATOMIC_RELEASE, "agent"); VM_WAIT(); (void)__hip_atomic_fetch_add(ctl + CW_Q + 64 * 42, 1u, RLX_AGENT); } } }
            if (it >= N_NS + N_SBS + N_WINP + N_SBP) break;
#ifndef DBG_IM
#define DBG_IM 63
#endif
#ifndef DBG_REPIM
#define DBG_REPIM 63
#endif
#define IMON(bit) ((DBG_IM & (bit)) && (rep == 0 || (DBG_REPIM & (bit))))
            if (it < N_NS) { if (IMON(32)) { item_l2_sample(a, it, lane, wave); if (DBG_DUP & 1) { VM_WAIT(); item_l2_sample(a, it, lane, wave); } VM_WAIT(); __syncthreads(); item_nsa_sample(a, lds, it, tid, lane, wave); if (DBG_DUP & 16) { __syncthreads(); item_nsa_sample(a, lds, it, tid, lane, wave); } } continue; } it -= N_NS;
            if (it < N_SBS) { if (IMON(2)) item_sb_sample(a, lds, it, lane, wave); continue; } it -= N_SBS;
            if (it < N_WINP) { if (IMON(4)) item_win_prompt(a, lds, it, tid, lane, wave); continue; } it -= N_WINP;
            if (IMON(8)) item_sb_prompt(a, lds, it, lane, wave);
        }
#endif
        REPSEAM(2); }
#ifdef SEAM2_BARRIER
        SEAM(2);
#else
        if (IN(2) && IN(3)) {
            if (tid0 == 0) { unsigned sp = 0; while (__hip_atomic_load(ctl + CW_Q + 64 * 42, RLX_AGENT) < bar.st[1] * (unsigned)NREP(2)) { __builtin_amdgcn_s_sleep(2); if (++sp > (1u << 22)) break; }
                __builtin_amdgcn_fence(__ATOMIC_ACQUIRE, "agent"); VM_WAIT(); }
            __syncthreads(); }
#endif
    }

    if (IN(3)) { _Pragma("unroll") for (int rep = 0; rep < NREP(3); ++rep) {
#if DBG_STAGE != 1
        for (;;) {
            int it = next_item(ctl + CW_Q + 64 + 128 * rep, qslot);
            int tid = tid0; asm volatile("" : "+v"(tid)); const int lane = tid & 63, wave = __builtin_amdgcn_readfirstlane(tid >> 6);
            if (it >= N_NP + 8) break;
            gu32* dep1 = ctl + CW_Q + 64 * 41;
            if (it < 4 || (it >= 300 && it < 304)) {
                const bool second = it >= 300; const int pn = second ? it - 300 : it;
                if (rep == 0) {
                if (!second) { pg8::Gemm g{(const bf16*)(ws + WS_U), (const bf16*)(ws + WS_WOUT_T), MT, 1024, 1024}; pg8::OneUnit S{64, pn};
                    pg8::EpiOut E{(const bf16*)(ws + WS_HBF), (bf16*)(ws + WS_HB2)};
                    pg8::gemm_phase<pg8::EpiOut, pg8::OneUnit, PG8_ALIGN, PG8_SP2>(lds, g, S, E);
                    VM_WAIT(); __syncthreads();
                    if (tid == 0) { __builtin_amdgcn_fence(__ATOMIC_RELEASE, "agent"); VM_WAIT(); (void)__hip_atomic_fetch_add(dep1, 1u, RLX_AGENT); } }
                else {
                    if (tid == 0) { unsigned sp = 0; while (__hip_atomic_load(dep1, RLX_AGENT) < 4u) { __builtin_amdgcn_s_sleep(2); if (++sp > (1u << 22)) break; }
                        __builtin_amdgcn_fence(__ATOMIC_ACQUIRE, "agent"); VM_WAIT(); }
                    __syncthreads();
                    pg8::Gemm g{(const bf16*)(ws + WS_HB2), (const bf16*)(ws + WS_WG_T), MT, 1024, 1024}; pg8::OneUnit S{64, pn};
                    pg8::EpiFinal E{a.out, (const bf16*)(ws + WS_T1), (const bf16*)(ws + WS_HB2)};
                    pg8::gemm_phase<pg8::EpiFinal, pg8::OneUnit, PG8_ALIGN, PG8_SP2>(lds, g, S, E); }
                }
                continue; }
            it -= (it >= 304) ? 8 : 4;
            if (IMON(16)) item_nsa_prompt(a, lds, it, tid, lane, wave);
        }
#endif
        REPSEAM(3); }
        SEAM(3);
    }

    if (IN(4)) { _Pragma("unroll") for (int rep = 0; rep < NREP(4); ++rep) {
        pg8::Gemm g{(const bf16*)(ws + WS_U), (const bf16*)(ws + WS_WOUT_T), MP, 1024, 1024}; pg8::StaticOrder S; S.init(MP, 1024, G, bx);
        pg8::EpiOut E{(const bf16*)(ws + WS_HBF), (bf16*)(ws + WS_HB2)};
        pg8::gemm_phase<pg8::EpiOut, pg8::StaticOrder, PG8_ALIGN, PG8_SP2>(lds, g, S, E);
        REPSEAM(4); }
        SEAM(4);
    }
    if (IN(5)) {
        pg8::Gemm g{(const bf16*)(ws + WS_HB2), (const bf16*)(ws + WS_WG_T), MP, 1024, 1024}; pg8::StaticOrder S; S.init(MP, 1024, G, bx);
        pg8::EpiFinal E{a.out, (const bf16*)(ws + WS_T1), (const bf16*)(ws + WS_HB2)};
        pg8::gemm_phase<pg8::EpiFinal, pg8::StaticOrder, PG8_ALIGN, PG8_SP2>(lds, g, S, E);
    }
#undef IN
#undef SEAM
}

extern "C" void kernel_launch(void* const* d_in, const int* in_sizes, int n_in, void* d_out, int out_size, void* d_ws, size_t ws_size, hipStream_t stream) {
    static int grid = 0;
    if (grid == 0) {
        if (n_in != N_INPUTS || (size_t)out_size != OUT_TOTAL || ws_size < WS_END) { fprintf(stderr, "kernel_launch: unexpected shapes (n_in %d, out %d, ws %zu); nothing launched\n", n_in, out_size, ws_size); grid = -1; return; }
        int dev = 0, cus = 0;
        if (hipGetDevice(&dev) != hipSuccess || hipDeviceGetAttribute(&cus, hipDeviceAttributeMultiprocessorCount, dev) != hipSuccess) { grid = -1; return; }
        if (hipFuncSetAttribute((const void*)mk_fwd, hipFuncAttributeMaxDynamicSharedMemorySize, LDS_BYTES) != hipSuccess) { fprintf(stderr, "kernel_launch: hipFuncSetAttribute failed\n"); grid = -1; return; }
        int per_cu = 0;
        if (hipOccupancyMaxActiveBlocksPerMultiprocessor(&per_cu, (const void*)mk_fwd, NTHR, LDS_BYTES) != hipSuccess || per_cu < 1) { fprintf(stderr, "kernel_launch: occupancy query says %d\n", per_cu); per_cu = 1; }
        (void)hipGetLastError();
        grid = cus;
    }
    if (grid < 0) return;
    if (hipMemsetAsync((char*)d_ws + WS_CTL, 0, CTL_ZERO_BYTES, stream) != hipSuccess) { fprintf(stderr, "kernel_launch: memset failed\n"); return; }
    Args a{};
    for (int i = 0; i < N_INPUTS; ++i) a.in[i] = d_in[i];
    a.out = (float*)d_out; a.ws = (unsigned char*)d_ws;
#if MK_N_LAUNCHES == 1
    a.ph_lo = 0; a.ph_hi = N_PHASES;
    hipLaunchKernelGGL(mk_fwd, dim3(grid), dim3(NTHR), LDS_BYTES, stream, a);
#else
    for (int p = 0; p < N_PHASES; ++p) { a.ph_lo = p; a.ph_hi = p + 1; hipLaunchKernelGGL(mk_fwd, dim3(grid), dim3(NTHR), LDS_BYTES, stream, a); }
#endif
    const hipError_t le = hipPeekAtLastError();
    if (le != hipSuccess) fprintf(stderr, "kernel_launch: launch failed: %s\n", hipGetErrorName(le));
}
```

```cpp
#include <hip/hip_runtime.h>
#include <cstdio>
#include <cstdint>
namespace pg8 {
#define PG8_LAS __attribute__((address_space(3)))
typedef unsigned short bf16_t;
typedef short bf16x8 __attribute__((ext_vector_type(8)));
typedef float f32x4 __attribute__((ext_vector_type(4)));
typedef unsigned u32x4 __attribute__((ext_vector_type(4)));
constexpr int BM = 256, BK = 64, HALF = 128, HTB = HALF * BK * 2  , STAGE_BYTES = 8 * HTB, NXCD = 8, WGM = 8;

__host__ __device__ __forceinline__ int lds_byte(int r, int c) { const int st = (r >> 4) * 2 + (c >> 5), rr = r & 15, cc = c & 31, ob = rr * 64 + cc * 2; return st * 1024 + (ob ^ (((ob >> 9) & 1) << 5)); }
__host__ __device__ __forceinline__ void stage_rc(int b, int& R, int& C) { const int st = b / 1024, sb = b % 1024, swz = sb ^ (((sb >> 9) & 1) << 5); R = (st >> 1) * 16 + swz / 64; C = (st & 1) * 32 + (swz % 64) / 2; }
__host__ __device__ __forceinline__ int perm32(int rho) { const int n = rho >> 4, i = rho & 15; return 8 * (i >> 2) + 4 * n + (i & 3); }

struct Unit { int pm, pn; };
struct Gemm { const bf16_t* A; const bf16_t* Bt; int M, N, K; };

struct StaticOrder {
    int nM, nN, nwg, G, c;
    __host__ __device__ void init(int M, int N, int G_, int c_) { nM = M / BM; nN = N / BM; nwg = nM * nN; G = G_; c = c_; }
    __host__ __device__ bool next(int i, Unit& u) const {
        const long L = (long)i * G + c; if (L >= nwg) return false;
        int wgid = (int)L; { const int q = nwg / NXCD, r = nwg % NXCD, xcd = wgid % NXCD, off = wgid / NXCD; wgid = (xcd < r ? xcd * (q + 1) : r * (q + 1) + (xcd - r) * q) + off; }
        const int nig = WGM * nN, gid = wgid / nig, fm = gid * WGM, gsz = (nM - fm) < WGM ? (nM - fm) : WGM;
        u.pm = fm + ((wgid % nig) % gsz); u.pn = (wgid % nig) / gsz; return true;
    }
    __device__ __forceinline__ void a_ready(const Unit&) const {}
    __device__ __forceinline__ void done(const Unit&) const {}
};

__device__ __forceinline__ unsigned cvt_pk_bf16(float lo, float hi) { unsigned r; asm volatile("v_cvt_pk_bf16_f32 %0, %1, %2" : "=v"(r) : "v"(lo), "v"(hi)); return r; }
typedef float f32x2 __attribute__((ext_vector_type(2)));
__device__ __forceinline__ f32x2 gelu_pk(f32x2 v) {
    const f32x2 av = __builtin_elementwise_abs(v), d = av * 0.2316418882f + 1.0f;
    f32x2 t; t.x = __builtin_amdgcn_rcpf(d.x); t.y = __builtin_amdgcn_rcpf(d.y);
    f32x2 q = t * 0.5307027145f + (-0.7265760135f); q = q * t + 0.7107068705f; q = q * t + (-0.142248368f); q = q * t + 0.127414796f; q = q * t;
    const f32x2 s = (v * v) * (-0.72134752044f);
    f32x2 e; e.x = __builtin_amdgcn_exp2f(s.x); e.y = __builtin_amdgcn_exp2f(s.y);
    const f32x2 m = v * (q * e), r = v - m;
    f32x2 o; o.x = v.x < 0.f ? m.x : r.x; o.y = v.y < 0.f ? m.y : r.y; return o;
}

template <int ACT  > struct EpiBf16 {
    static constexpr bool PERM = true, AFTER_DRAIN = false; static_assert(ACT == 0 || ACT == 1, "EpiBf16: ACT is 0 (none) or 1 (gelu_pk)");
    bf16_t* O; int ldc; const float* bias; int split_cols; size_t split_stride; float scale0;
    __device__ __forceinline__ void operator()(const f32x4 (&acc)[2][2][4][2], const Unit& u, int wr, int wc, int fr_, int fq_) const {
        int fr = fr_, fq = fq_; asm volatile("" : "+v"(fr), "+v"(fq));
        const int row0 = u.pm * BM + wr * 64 + fr; int colt = u.pn * BM; bf16_t* base = O;
        float sc = 1.f; if (split_cols) { const int t = colt / split_cols; base += (size_t)t * split_stride; colt -= t * split_cols; if (t == 0) sc = scale0; }
        const int col0 = colt + wc * 32 + 8 * fq, bcol0 = u.pn * BM + wc * 32 + 8 * fq;
        f32x4 bv[2][2];
#pragma unroll
        for (int bj = 0; bj < 2; ++bj)
#pragma unroll
            for (int n = 0; n < 2; ++n) bv[bj][n] = bias ? *(const f32x4*)(bias + bcol0 + bj * HALF + 4 * n) : (f32x4){0.f, 0.f, 0.f, 0.f};
#pragma unroll
        for (int ai = 0; ai < 2; ++ai)
#pragma unroll
            for (int m = 0; m < 4; ++m) { bf16_t* rowp = base + (size_t)(row0 + ai * HALF + m * 16) * ldc + col0;
#pragma unroll
                for (int bj = 0; bj < 2; ++bj) { f32x4 v0 = acc[ai][bj][m][0] + bv[bj][0], v1 = acc[ai][bj][m][1] + bv[bj][1];
                    if (ACT == 1) { f32x2 a = gelu_pk((f32x2){v0[0], v0[1]}), b = gelu_pk((f32x2){v0[2], v0[3]}), c = gelu_pk((f32x2){v1[0], v1[1]}), d = gelu_pk((f32x2){v1[2], v1[3]});
                        v0 = (f32x4){a.x, a.y, b.x, b.y}; v1 = (f32x4){c.x, c.y, d.x, d.y}; }
                    v0 = v0 * sc; v1 = v1 * sc; u32x4 w; w.x = cvt_pk_bf16(v0[0], v0[1]); w.y = cvt_pk_bf16(v0[2], v0[3]); w.z = cvt_pk_bf16(v1[0], v1[1]); w.w = cvt_pk_bf16(v1[2], v1[3]);
                    *(u32x4*)(rowp + bj * HALF) = w; } }
    }
};

template <class Epi, class Sched, bool ALIGN_EPI = false, bool SP2 = false, bool OPAQUE_K = false>
__device__ __forceinline__ void gemm_phase(PG8_LAS unsigned char* lds, const Gemm g, const Sched& S, const Epi& E) {
    int tid_ = threadIdx.x;
#ifndef PG8_NOLAUNDER
    asm volatile("" : "+v"(tid_));
#endif
    const int tid = tid_, wid = __builtin_amdgcn_readfirstlane(tid >> 6), lane = tid & 63, wr = wid >> 2, wc = wid & 3, fr = lane & 15, fq = lane >> 4;
    int K_ = g.K; if (OPAQUE_K) asm volatile("" : "+s"(K_));
    const int K = K_, nt = K / BK;
    unsigned voffA[2], voffB[2];
#pragma unroll
    for (int i = 0; i < 2; ++i) { int R, C; stage_rc(tid * 16 + i * 8192, R, C); const int Rb = Epi::PERM ? ((R & ~31) + perm32(R & 31)) : R;
        voffA[i] = (unsigned)(R * K + C) * 2u; voffB[i] = (unsigned)(Rb * K + C) * 2u; }
    const size_t kstep = (size_t)(BK * 2);
    const size_t hstep = (size_t)HALF * K * 2;
    const size_t tstep = 2 * hstep;
    const unsigned ldsw = (unsigned)wid * 1024u;
    const int aoff = lds_byte(wr * 64 + fr, fq * 8), boff = lds_byte(wc * 32 + fr, fq * 8);
#define PG8_SA(b, h) (((b) * 2 + (h)) * HTB)
#define PG8_SB(b, h) ((4 + (b) * 2 + (h)) * HTB)
#define PG8_STAGE(bufoff, gbase, voff) do { _Pragma("unroll") for (int _i = 0; _i < 2; ++_i) \
        __builtin_amdgcn_global_load_lds((const unsigned*)((const char*)(gbase) + (voff)[_i]), (PG8_LAS unsigned*)(lds + (bufoff) + ldsw + _i * 8192), 16, 0, 0); } while (0)
#define PG8_LDA(dst, b, h) do { _Pragma("unroll") for (int m = 0; m < 4; ++m) _Pragma("unroll") for (int k = 0; k < 2; ++k) dst[m][k] = *(const PG8_LAS bf16x8*)(lds + PG8_SA(b, h) + aoff + m * 2048 + k * 1024); } while (0)
#define PG8_LDB(dst, b, h) do { _Pragma("unroll") for (int n = 0; n < 2; ++n) _Pragma("unroll") for (int k = 0; k < 2; ++k) dst[n][k] = *(const PG8_LAS bf16x8*)(lds + PG8_SB(b, h) + boff + n * 2048 + k * 1024); } while (0)
#define PG8_MMA(ai, bj, At, Bt) do { __builtin_amdgcn_s_setprio(1); _Pragma("unroll") for (int m = 0; m < 4; ++m) _Pragma("unroll") for (int n = 0; n < 2; ++n) _Pragma("unroll") for (int k = 0; k < 2; ++k) \
        acc[ai][bj][m][n] = __builtin_amdgcn_mfma_f32_16x16x32_bf16(Bt[n][k], At[m][k], acc[ai][bj][m][n], 0, 0, 0); __builtin_amdgcn_s_setprio(0); } while (0)
#define PG8_WAIT_V(n) asm volatile("s_waitcnt vmcnt(" #n ")" ::: "memory")
#define PG8_WAIT_L(n) asm volatile("s_waitcnt lgkmcnt(" #n ")" ::: "memory")
#define PG8_BAR __builtin_amdgcn_s_barrier()
#define PG8_SCHED __builtin_amdgcn_sched_barrier(0)
    Unit cur, nxt; int ui = 0;
    if (!S.next(0, cur)) return;
    f32x4 acc[2][2][4][2];
#pragma unroll
    for (int a = 0; a < 2; ++a)
#pragma unroll
        for (int b = 0; b < 2; ++b)
#pragma unroll
            for (int m = 0; m < 4; ++m)
#pragma unroll
                for (int n = 0; n < 2; ++n) acc[a][b][m][n] = (f32x4){0.f, 0.f, 0.f, 0.f};
    bf16x8 At[4][2], B0[2][2], B1[2][2];
    const char* cA = (const char*)g.A + (size_t)cur.pm * tstep; const char* cB = (const char*)g.Bt + (size_t)cur.pn * tstep;
    S.a_ready(cur);
    if constexpr (SP2) {
        PG8_STAGE(PG8_SB(0, 0), cB, voffB); PG8_STAGE(PG8_SB(0, 1), cB + hstep, voffB); PG8_STAGE(PG8_SA(0, 0), cA, voffA); PG8_STAGE(PG8_SA(0, 1), cA + hstep, voffA);
        if (wr == 1) PG8_BAR;
        PG8_WAIT_V(2); PG8_BAR;
        PG8_STAGE(PG8_SB(1, 0), cB + kstep, voffB); PG8_STAGE(PG8_SA(1, 0), cA + kstep, voffA); PG8_STAGE(PG8_SB(1, 1), cB + hstep + kstep, voffB);
        PG8_WAIT_V(6); PG8_BAR;
    } else {
        PG8_STAGE(PG8_SB(0, 0), cB, voffB); PG8_STAGE(PG8_SA(0, 0), cA, voffA); PG8_STAGE(PG8_SB(0, 1), cB + hstep, voffB); PG8_STAGE(PG8_SA(0, 1), cA + hstep, voffA);
        if (wr == 1) PG8_BAR;
        PG8_WAIT_V(4); PG8_BAR;
        PG8_STAGE(PG8_SB(1, 0), cB + kstep, voffB); PG8_STAGE(PG8_SA(1, 0), cA + kstep, voffA); PG8_STAGE(PG8_SB(1, 1), cB + hstep + kstep, voffB);
        PG8_WAIT_V(6); PG8_BAR;
    }
    for (;;) {
        const bool has_next = S.next(ui + 1, nxt);
        const char* nA = has_next ? (const char*)g.A + (size_t)nxt.pm * tstep : cA; const char* nB = has_next ? (const char*)g.Bt + (size_t)nxt.pn * tstep : cB;
        for (int t = 0; t < nt; t += 2) {
            const bool last = (t == nt - 2);
            const char* a1 = cA + (size_t)(t + 1) * kstep;
            const char* a2 = last ? nA : cA + (size_t)(t + 2) * kstep; const char* b2 = last ? nB : cB + (size_t)(t + 2) * kstep;
            const char* a3 = a2 + kstep; const char* b3 = b2 + kstep;
            if (last && has_next) S.a_ready(nxt);
            if constexpr (SP2) {
            PG8_LDB(B0, 0, 0); PG8_LDB(B1, 0, 1); PG8_SCHED; PG8_LDA(At, 0, 0); PG8_STAGE(PG8_SA(1, 1), a1 + hstep, voffA);
            PG8_WAIT_V(8); PG8_WAIT_L(0); PG8_BAR; PG8_MMA(0, 0, At, B0); PG8_MMA(0, 1, At, B1); PG8_BAR; PG8_SCHED;
            PG8_LDA(At, 0, 1); PG8_STAGE(PG8_SB(0, 0), b2, voffB); PG8_STAGE(PG8_SB(0, 1), b2 + hstep, voffB); PG8_STAGE(PG8_SA(0, 0), a2, voffA);
            PG8_WAIT_V(8); PG8_WAIT_L(0); PG8_BAR; PG8_MMA(1, 0, At, B0); PG8_MMA(1, 1, At, B1); PG8_BAR; PG8_SCHED;
            PG8_LDB(B0, 1, 0); PG8_LDB(B1, 1, 1); PG8_SCHED; PG8_LDA(At, 1, 0); PG8_STAGE(PG8_SA(0, 1), a2 + hstep, voffA);
            PG8_WAIT_V(8); PG8_WAIT_L(0); PG8_BAR; PG8_MMA(0, 0, At, B0); PG8_MMA(0, 1, At, B1); PG8_BAR; PG8_SCHED;
            PG8_LDA(At, 1, 1); PG8_STAGE(PG8_SB(1, 0), b3, voffB); PG8_STAGE(PG8_SB(1, 1), b3 + hstep, voffB); PG8_STAGE(PG8_SA(1, 0), a3, voffA);
            PG8_WAIT_V(8); PG8_WAIT_L(0); PG8_BAR; PG8_MMA(1, 0, At, B0); PG8_MMA(1, 1, At, B1); PG8_BAR; PG8_SCHED;
            } else {
            PG8_LDB(B0, 0, 0); PG8_SCHED; PG8_LDA(At, 0, 0); PG8_STAGE(PG8_SA(1, 1), a1 + hstep, voffA);
            PG8_WAIT_L(8); PG8_BAR; PG8_WAIT_L(0); PG8_MMA(0, 0, At, B0); PG8_BAR; PG8_SCHED;
            PG8_LDB(B1, 0, 1); PG8_STAGE(PG8_SB(0, 0), b2, voffB);
            PG8_BAR; PG8_WAIT_L(0); PG8_MMA(0, 1, At, B1); PG8_BAR;
            PG8_LDA(At, 0, 1); PG8_STAGE(PG8_SA(0, 0), a2, voffA);
            PG8_BAR; PG8_WAIT_L(0); PG8_MMA(1, 0, At, B0); PG8_BAR; PG8_SCHED;
            PG8_STAGE(PG8_SB(0, 1), b2 + hstep, voffB);
            PG8_WAIT_V(6); PG8_BAR; PG8_MMA(1, 1, At, B1); PG8_BAR;
            PG8_LDB(B0, 1, 0); PG8_SCHED; PG8_LDA(At, 1, 0); PG8_STAGE(PG8_SA(0, 1), a2 + hstep, voffA);
            PG8_WAIT_L(8); PG8_BAR; PG8_WAIT_L(0); PG8_MMA(0, 0, At, B0); PG8_BAR; PG8_SCHED;
            PG8_LDB(B1, 1, 1); PG8_STAGE(PG8_SB(1, 0), b3, voffB);
            PG8_BAR; PG8_WAIT_L(0); PG8_MMA(0, 1, At, B1); PG8_BAR;
            PG8_LDA(At, 1, 1); PG8_STAGE(PG8_SA(1, 0), a3, voffA);
            PG8_BAR; PG8_WAIT_L(0); PG8_MMA(1, 0, At, B0); PG8_BAR; PG8_SCHED;
            PG8_STAGE(PG8_SB(1, 1), b3 + hstep, voffB);
            PG8_WAIT_V(6); PG8_BAR; PG8_MMA(1, 1, At, B1); PG8_BAR;
            }
        }
        if constexpr (ALIGN_EPI) { if (wr == 0) PG8_BAR; }
        if constexpr (!Epi::AFTER_DRAIN) { E(acc, cur, wr, wc, fr, fq);
#ifdef DBG_EPI2
            E(acc, cur, wr, wc, fr, fq);
#endif
            S.done(cur); }
        if (!has_next) break;
#pragma unroll
        for (int a = 0; a < 2; ++a)
#pragma unroll
            for (int b = 0; b < 2; ++b)
#pragma unroll
                for (int m = 0; m < 4; ++m)
#pragma unroll
                    for (int n = 0; n < 2; ++n) acc[a][b][m][n] = (f32x4){0.f, 0.f, 0.f, 0.f};
        cur = nxt; cA = nA; cB = nB; ++ui;
        if constexpr (ALIGN_EPI) { if (wr == 1) PG8_BAR; }
    }
    PG8_WAIT_V(0);
    if constexpr (!ALIGN_EPI) { if (wr == 0) PG8_BAR; }
    PG8_BAR;
    if constexpr (Epi::AFTER_DRAIN) { E.fused(acc, cur, wr, wc, fr, fq, lds, wid, lane); S.done(cur); }
#undef PG8_SA
#undef PG8_SB
#undef PG8_STAGE
#undef PG8_LDA
#undef PG8_LDB
#undef PG8_MMA
#undef PG8_WAIT_V
#undef PG8_WAIT_L
#undef PG8_BAR
#undef PG8_SCHED
}
}


#ifndef PG8_SP2
#define PG8_SP2 true
#endif
#ifndef PG8_ALIGN
#define PG8_ALIGN true
#endif
#define GAS __attribute__((address_space(1)))
#define LAS __attribute__((address_space(3)))
typedef unsigned short bf16;
typedef unsigned v4u __attribute__((ext_vector_type(4)));
typedef float f32x4 __attribute__((ext_vector_type(4)));
typedef short bf16x8 __attribute__((ext_vector_type(8)));
typedef GAS unsigned gu32;
typedef GAS unsigned long long gu64;
#define RLX_AGENT __ATOMIC_RELAXED, __HIP_MEMORY_SCOPE_AGENT
#define LDS_WAIT() asm volatile("s_waitcnt lgkmcnt(0)" ::: "memory")
#define VM_WAIT() asm volatile("s_waitcnt vmcnt(0)" ::: "memory")
__device__ __forceinline__ unsigned long long rt() { return __builtin_amdgcn_s_memrealtime(); }
__device__ __forceinline__ unsigned f2bf(float f) { unsigned u = __builtin_bit_cast(unsigned, f); return (u + 0x7fffu + ((u >> 16) & 1u)) >> 16; }
__device__ __forceinline__ unsigned pk2(float lo, float hi) { return f2bf(lo) | (f2bf(hi) << 16); }

#define XB_TMO      128
#define XB_XCNT(j)  (256  + 64 * (j))
#define XB_XSUB(j)  (1280 + 64 * (j))
#define XB_XGEN(j)  (2304 + 64 * (j))
#define XB_TOP      3328
#define XB_TOPGEN   3392
#define XCD_BAR_WORDS 3456
#define XB_SPIN_CAP (1u << 18)

__device__ __forceinline__ unsigned xb_ld(unsigned* p)              { return __hip_atomic_load(p, __ATOMIC_RELAXED, __HIP_MEMORY_SCOPE_AGENT); }
__device__ __forceinline__ unsigned xb_add(unsigned* p, unsigned v) { return __hip_atomic_fetch_add(p, v, __ATOMIC_RELAXED, __HIP_MEMORY_SCOPE_AGENT); }
__device__ __forceinline__ unsigned xb_xcc_id() { return (unsigned)__builtin_amdgcn_s_getreg((3 << 11) | 20) & 0xFu; }
#define XB_SPIN(cond, bar) do { unsigned _sp = 0; while (cond) { __builtin_amdgcn_s_sleep(1); \
    if ((++_sp & 255u) == 0u) { if (xb_ld(&(bar)[XB_TMO])) break; if (_sp > XB_SPIN_CAP) { atomicAdd(&(bar)[XB_TMO], 1u); break; } } } } while (0)

struct XcdBarrier {
    unsigned* bar; unsigned x;
    volatile LAS unsigned* st;
};

__device__ __forceinline__ XcdBarrier xcd_barrier_post(unsigned* bar, volatile LAS unsigned* st) {
    XcdBarrier b; b.bar = bar; b.x = xb_xcc_id(); b.st = st;
    if (threadIdx.x == 0) (void)xb_add(&bar[XB_XCNT(b.x)], 1u);
    return b;
}
__device__ __forceinline__ void xcd_barrier_complete(unsigned* bar, unsigned x, unsigned& nloc, unsigned& nx) {
    const unsigned G = gridDim.x * gridDim.y * gridDim.z;
    unsigned sum, cnt, mine, sp = 0u;
    for (;;) {
        sum = 0u; cnt = 0u; mine = 0u;
#pragma unroll
        for (unsigned j = 0; j < 16; ++j) { const unsigned c = xb_ld(&bar[XB_XCNT(j)]); sum += c; cnt += (c > 0u) ? 1u : 0u; mine = (j == x) ? c : mine; }
        if (sum == G) break;
        __builtin_amdgcn_s_sleep(1);
        if ((++sp & 255u) == 0u) { if (xb_ld(&bar[XB_TMO])) break; if (sp > XB_SPIN_CAP) { atomicAdd(&bar[XB_TMO], 1u); break; } }
    }
    nloc = mine > 0u ? mine : 1u; nx = cnt > 0u ? cnt : 1u;
}

__device__ __forceinline__ void xcd_barrier(const XcdBarrier& b) {
    asm volatile("s_waitcnt vmcnt(0)" ::: "memory");
    __syncthreads();
    if (threadIdx.x == 0) {
        unsigned* bar = b.bar;
        __builtin_amdgcn_s_waitcnt(0);
        unsigned nloc = b.st[0], nx = b.st[1];
        if (nloc == 0u) { xcd_barrier_complete(bar, b.x, nloc, nx); b.st[0] = nloc; b.st[1] = nx; }
        const unsigned old = xb_add(&bar[XB_XSUB(b.x)], 1u);
        const unsigned gen = old / nloc;
        if (old + 1u == (gen + 1u) * nloc) {
            __builtin_amdgcn_fence(__ATOMIC_RELEASE, "agent");
            asm volatile("s_waitcnt vmcnt(0)" ::: "memory");
            const unsigned og = xb_add(&bar[XB_TOP], 1u);
            const unsigned tg = og / nx;
            if (og + 1u == (tg + 1u) * nx) xb_add(&bar[XB_TOPGEN], 1u);
            else XB_SPIN(xb_ld(&bar[XB_TOPGEN]) == tg, bar);
            __builtin_amdgcn_fence(__ATOMIC_ACQUIRE, "agent");
            xb_add(&bar[XB_XGEN(b.x)], 1u);
            asm volatile("s_waitcnt vmcnt(0)" ::: "memory");
        } else {
            XB_SPIN(xb_ld(&bar[XB_XGEN(b.x)]) == gen, bar);
            __builtin_amdgcn_fence(__ATOMIC_ACQUIRE, "agent");
            asm volatile("s_waitcnt vmcnt(0)" ::: "memory");
        }
    }
    __syncthreads();
}


constexpr int NWAVES = 8, NTHR = 512;
constexpr int MP = 16384, MS = 256, MT = 16640, DM = 1024, TP = 2048;
constexpr int NG1 = 3840, NIN = 3864;
constexpr float EPS = 1e-6f, LOG2E = 1.4426950408889634f, LN2 = 0.6931471805599453f;
constexpr size_t OFF_SB = 17039360, OFF_NSA = 34078720, OFF_WINP = 42598400, OFF_WINS = 43646976, OUT_TOTAL = 47841280;
enum { IN_XP = 0, IN_XS, IN_PP, IN_PS, IN_CSB, IN_CNSA, IN_SWIN, IN_PT, IN_NORMG, IN_WIN, IN_QG, IN_KCG, IN_KSG, IN_KWG, IN_PEK, IN_W1K, IN_W2K, IN_PEV, IN_W1V, IN_W2V, IN_WOUT, IN_WPLE, IN_WG, N_INPUTS };

constexpr size_t MiB = 1u << 20;
constexpr size_t WS_CTL = 0, CTL_ZERO_BYTES = 1 * MiB;
constexpr size_t WS_WIN_T = 2 * MiB, WS_W1T = 11 * MiB, WS_W2T = 13 * MiB, WS_WOUT_T = 14 * MiB, WS_WG_T = 16 * MiB, WS_WPLE_T = 18 * MiB;
constexpr size_t WS_RSTD = 19 * MiB, WS_BR = 20 * MiB, WS_HBF = 24 * MiB, WS_PBF = 58 * MiB;
constexpr size_t WS_QA = 68 * MiB, WS_KA = 86 * MiB, WS_VA = 104 * MiB, WS_GA = 122 * MiB, WS_QB = 140 * MiB, WS_GB = 158 * MiB;
constexpr size_t WS_KSEL = 176 * MiB, WS_VSEL = 182 * MiB, WS_KWIN = 188 * MiB, WS_VWIN = 194 * MiB;
constexpr size_t WS_ACMP_P = 200 * MiB, WS_HIDP = 208 * MiB, WS_HIDS = 210 * MiB, WS_KCS = 226 * MiB, WS_VCS = 228 * MiB;
constexpr size_t WS_OW = 232 * MiB, WS_U = 248 * MiB, WS_T1 = 282 * MiB, WS_HB2 = 316 * MiB, WS_ACMP_S = 352 * MiB, WS_END = 480 * MiB;
constexpr int CW_BAR = 4096;
constexpr int CW_Q = 16384;
constexpr int CW_PANEL = 32768;
constexpr int CW_PANEL2 = 40960;
constexpr int CW_BIAS = 65536;

constexpr int RING_BYTES = 131072, LDSCTL_OFF = RING_BYTES, MISC_OFF = LDSCTL_OFF + 320, LDS_BYTES = 147456;

typedef float f32x16 __attribute__((ext_vector_type(16)));
typedef short s16x4 __attribute__((ext_vector_type(4)));
typedef float f32x2_t __attribute__((ext_vector_type(2)));
typedef __bf16 bf16x2_t __attribute__((ext_vector_type(2)));
typedef unsigned v2u __attribute__((ext_vector_type(2)));
__device__ __forceinline__ unsigned cvtpk(float lo, float hi) { f32x2_t v = {lo, hi}; bf16x2_t b = __builtin_convertvector(v, bf16x2_t); return __builtin_bit_cast(unsigned, b); }
__device__ __forceinline__ float bf_lo(unsigned w) { return __builtin_bit_cast(float, w << 16); }
__device__ __forceinline__ float bf_hi(unsigned w) { return __builtin_bit_cast(float, w & 0xffff0000u); }
__device__ __forceinline__ float fexp2(float x) { return __builtin_amdgcn_exp2f(x); }
__device__ __forceinline__ float flog2(float x) { return __builtin_amdgcn_logf(x); }
__device__ __forceinline__ float frcp(float x) { return __builtin_amdgcn_rcpf(x); }
__device__ __forceinline__ float sigmoidf_(float x) { return frcp(1.f + fexp2(-x * LOG2E)); }
__device__ __forceinline__ float siluf_(float x) { return x * sigmoidf_(x); }
__device__ __forceinline__ float wave_sum(float v) {
#pragma unroll
    for (int o = 1; o < 64; o <<= 1) v += __shfl_xor(v, o);
    return v;
}
__device__ __forceinline__ float wave_max(float v) {
#pragma unroll
    for (int o = 1; o < 64; o <<= 1) v = fmaxf(v, __shfl_xor(v, o));
    return v;
}

struct Args { const void* in[N_INPUTS]; float* out; unsigned char* ws; int ph_lo, ph_hi; };

__device__ __forceinline__ void p0_transpose_item(const float* __restrict__ W, int ldw, int col0, const float* __restrict__ gsc, bf16* WT, int K, int drow0, int k0, LAS float* scr, int lane) {
#pragma unroll 16
    for (int i = 0; i < 32; ++i) { const int kk = 2 * i + (lane >> 5); float v = W[(size_t)(k0 + kk) * ldw + col0 + (lane & 31)]; if (gsc) v *= gsc[k0 + kk]; scr[kk * 33 + (lane & 31)] = v; }
    LDS_WAIT(); asm volatile("" ::: "memory");
    const int c = lane & 7;
#pragma unroll
    for (int j = 0; j < 4; ++j) { const int n = (lane >> 3) + 8 * j; const LAS float* s = scr + (8 * c) * 33 + n;
        v4u o; o.x = pk2(s[0 * 33], s[1 * 33]); o.y = pk2(s[2 * 33], s[3 * 33]); o.z = pk2(s[4 * 33], s[5 * 33]); o.w = pk2(s[6 * 33], s[7 * 33]);
        *(GAS v4u*)(WT + (size_t)(drow0 + n) * K + k0 + 8 * c) = o; }
    LDS_WAIT(); asm volatile("" ::: "memory");
}
__host__ __device__ __forceinline__ int g1_role(int pn) { return (int)((0xec9b7a15d483620ull >> (4 * pn)) & 15); }
__device__ __forceinline__ int g1_src_col(int n) { const int t = g1_role(n >> 8), gm = n & 255, lam = 64 * ((gm >> 5) & 3) + 32 * (gm >> 7) + (gm & 31); return (t < 13 ? t * 256 : 3352 + (t - 13) * 256) + lam; }

constexpr int WBR_OFF = 67584, WBR_PITCH = 2064;

__device__ __forceinline__ void p0_prologue(const Args& a, LAS unsigned char* lds, int tid, int lane, int wave, int vcu, int G, int rep = 0) {
    const int gw = vcu * NWAVES + wave, NGW = G * NWAVES;
    unsigned char* ws = a.ws;
    const float* w_in = (const float*)a.in[IN_WIN]; const float* norm_g = (const float*)a.in[IN_NORMG];
    { LAS unsigned char* wbr = lds + WBR_OFF;
      for (int i0 = 0; i0 < 48; i0 += 24) { float v[24], gk[24];
#pragma unroll
          for (int i = 0; i < 24; ++i) { const int idx = tid + NTHR * (i0 + i), k = idx / 24, c = idx - 24 * k; v[i] = w_in[(size_t)k * NIN + 3328 + c]; gk[i] = norm_g[k]; }
#pragma unroll
          for (int i = 0; i < 24; ++i) { const int idx = tid + NTHR * (i0 + i), k = idx / 24, c = idx - 24 * k; *(LAS unsigned short*)(wbr + c * WBR_PITCH + k * 2) = (unsigned short)f2bf(v[i] * gk[i]); } } }
    { LAS float* scr = (LAS float*)(lds + wave * 8448);
      constexpr int I0 = 16 * 120, I1 = 32 * 8, I3 = 4 * 2, I5 = 16 * 32, I7 = 4 * 32, NITEMS = I0 + 2 * I1 + 2 * I3 + 2 * I5 + I7;
      for (int it = gw; it < NITEMS; it += NGW) {
          int r = it;
          if (r < I0) { const int kb = r / 120, nb = r % 120; p0_transpose_item(w_in, NIN, g1_src_col(32 * nb), norm_g, (bf16*)(ws + WS_WIN_T), 1024, 32 * nb, 64 * kb, scr, lane); continue; } r -= I0;
          if (r < I1) { const int kb = r / 8, nb = r % 8; p0_transpose_item((const float*)a.in[IN_W1K], 256, 32 * nb, nullptr, (bf16*)(ws + WS_W1T), 2048, 32 * nb, 64 * kb, scr, lane); continue; } r -= I1;
          if (r < I1) { const int kb = r / 8, nb = r % 8; p0_transpose_item((const float*)a.in[IN_W1V], 256, 32 * nb, nullptr, (bf16*)(ws + WS_W1T), 2048, 256 + 32 * nb, 64 * kb, scr, lane); continue; } r -= I1;
          if (r < I3) { const int kb = r / 2, nb = r % 2; p0_transpose_item((const float*)a.in[IN_W2K], 64, 32 * nb, nullptr, (bf16*)(ws + WS_W2T), 256, 32 * nb, 64 * kb, scr, lane); continue; } r -= I3;
          if (r < I3) { const int kb = r / 2, nb = r % 2; p0_transpose_item((const float*)a.in[IN_W2V], 64, 32 * nb, nullptr, (bf16*)(ws + WS_W2T), 256, 64 + 32 * nb, 64 * kb, scr, lane); continue; } r -= I3;
          if (r < I5) { const int kb = r / 32, nb = r % 32; p0_transpose_item((const float*)a.in[IN_WOUT], 1024, 32 * nb, nullptr, (bf16*)(ws + WS_WOUT_T), 1024, 32 * nb, 64 * kb, scr, lane); continue; } r -= I5;
          if (r < I5) { const int kb = r / 32, nb = r % 32; p0_transpose_item((const float*)a.in[IN_WG], 1024, 32 * nb, nullptr, (bf16*)(ws + WS_WG_T), 1024, 32 * nb, 64 * kb, scr, lane); continue; } r -= I5;
          { const int kb = r / 32, nb = r % 32; p0_transpose_item((const float*)a.in[IN_WPLE], 1024, 32 * nb, nullptr, (bf16*)(ws + WS_WPLE_T), 256, 32 * nb, 64 * kb, scr, lane); }
      } }
    __syncthreads();
    { const float* xp = (const float*)a.in[IN_XP]; const float* xs = (const float*)a.in[IN_XS];
      bf16* hbf = (bf16*)(ws + WS_HBF); float* rstd = (float*)(ws + WS_RSTD); float* BR = (float*)(ws + WS_BR);
      const LAS unsigned char* wbr = lds + WBR_OFF;
      for (int rg = gw; rg < MT / 16; rg += NGW) {
          const int m = rg * 16 + (lane & 15), kq = lane >> 4;
          const float* xr = (m < MP) ? xp + (size_t)m * DM : xs + (size_t)(m - MP) * DM;
          f32x4 c0 = {0.f, 0.f, 0.f, 0.f}, c1 = {0.f, 0.f, 0.f, 0.f}; float ssq = 0.f;
#pragma unroll 8
          for (int s = 0; s < 32; ++s) {
              const f32x4 v0 = *(const GAS f32x4*)(xr + 32 * s + 8 * kq), v1 = *(const GAS f32x4*)(xr + 32 * s + 8 * kq + 4);
              ssq += (v0.x * v0.x + v0.y * v0.y) + (v0.z * v0.z + v0.w * v0.w) + (v1.x * v1.x + v1.y * v1.y) + (v1.z * v1.z + v1.w * v1.w);
              v4u pa; pa.x = pk2(v0.x, v0.y); pa.y = pk2(v0.z, v0.w); pa.z = pk2(v1.x, v1.y); pa.w = pk2(v1.z, v1.w);
              *(GAS v4u*)(hbf + (size_t)m * DM + 32 * s + 8 * kq) = pa;
              const bf16x8 af = __builtin_bit_cast(bf16x8, pa);
              const bf16x8 b0 = *(const LAS bf16x8*)(wbr + (lane & 15) * WBR_PITCH + (32 * s + 8 * kq) * 2);
              const bf16x8 b1 = *(const LAS bf16x8*)(wbr + (16 + (lane & 7)) * WBR_PITCH + (32 * s + 8 * kq) * 2);
              c0 = __builtin_amdgcn_mfma_f32_16x16x32_bf16(af, b0, c0, 0, 0, 0);
              c1 = __builtin_amdgcn_mfma_f32_16x16x32_bf16(af, b1, c1, 0, 0, 0);
          }
          ssq += __shfl_xor(ssq, 16); ssq += __shfl_xor(ssq, 32);
          const float rs = 1.f / sqrtf(ssq * (1.f / DM) + EPS);
          if (kq == 0) rstd[m] = rs;
#pragma unroll
          for (int r = 0; r < 4; ++r) { const int R = 4 * kq + r; const float rsR = __shfl(rs, R); const size_t row = (size_t)rg * 16 + R;
              BR[row * 24 + (lane & 15)] = sigmoidf_(c0[r] * rsR);
              if ((lane & 15) < 8) BR[row * 24 + 16 + (lane & 15)] = sigmoidf_(c1[r] * rsR); }
      } }
    { const float* pp = (const float*)a.in[IN_PP]; const float* ps = (const float*)a.in[IN_PS]; bf16* pbf = (bf16*)(ws + WS_PBF);
      for (int base = (vcu * NTHR + tid); base < MT * 32; base += 8 * G * NTHR) { f32x4 v0[8], v1[8];
#pragma unroll
          for (int u = 0; u < 8; ++u) { const int idx = base + u * G * NTHR; if (idx < MT * 32) { const int row = idx >> 5, c8 = (idx & 31) * 8;
              const float* src = (row < MP) ? pp + (size_t)row * 256 + c8 : ps + (size_t)(row - MP) * 256 + c8; v0[u] = *(const GAS f32x4*)src; v1[u] = *(const GAS f32x4*)(src + 4); } }
#pragma unroll
          for (int u = 0; u < 8; ++u) { const int idx = base + u * G * NTHR; if (idx < MT * 32) { const int row = idx >> 5, c8 = (idx & 31) * 8;
              v4u o; o.x = pk2(v0[u].x, v0[u].y); o.y = pk2(v0[u].z, v0[u].w); o.z = pk2(v1[u].x, v1[u].y); o.w = pk2(v1[u].z, v1[u].w);
              *(GAS v4u*)(pbf + (size_t)row * 256 + c8) = o; } } } }
    { const float* sw = (const float*)a.in[IN_SWIN]; float* dst = a.out + OFF_WINS;
      for (int base = (vcu * NTHR + tid); base < 32 * 504 * 64; base += 8 * G * NTHR) { f32x4 v[8];
#pragma unroll
          for (int u = 0; u < 8; ++u) { const int idx = base + u * G * NTHR; if (idx < 32 * 504 * 64) { const int q = idx & 63, i = (idx >> 6) % 504, b = (idx >> 6) / 504; v[u] = *(const GAS f32x4*)(sw + ((size_t)(b * 512 + i + 8) * 256) + q * 4); } }
#pragma unroll
          for (int u = 0; u < 8; ++u) { const int idx = base + u * G * NTHR; if (idx < 32 * 504 * 64) { const int q = idx & 63, i = (idx >> 6) % 504, b = (idx >> 6) / 504; *(GAS f32x4*)(dst + ((size_t)(b * 512 + i) * 256) + q * 4) = v[u]; } } } }
    { float* bias = (float*)(ws + WS_CTL) + CW_BIAS;
      if (rep == 0) for (int job = gw; job < 256; job += NGW) { const int slot = job >> 7, jc = (job >> 4) & 7, kc = job & 15, j = jc * 32 + (lane & 31), k0 = kc * 128 + (lane >> 5) * 64;
          const float* W1 = (const float*)a.in[slot ? IN_W1V : IN_W1K]; const float* pe = (const float*)a.in[slot ? IN_PEV : IN_PEK];
          float acc = 0.f;
#pragma unroll 16
          for (int k = 0; k < 64; ++k) acc += pe[k0 + k] * W1[(size_t)(k0 + k) * 256 + j];
          acc += __shfl_xor(acc, 32);
          if (lane < 32) atomicAdd(bias + slot * 256 + j, acc); } }
}

namespace pg8 {
#ifdef EPI_NT_STORES
#define EPI_ST(ptr, val) __builtin_nontemporal_store((val), (ptr))
#else
#define EPI_ST(ptr, val) (*(ptr) = (val))
#endif
__device__ __forceinline__ void st8_bf16(bf16_t* p, f32x4 a, f32x4 b) { u32x4 w; w.x = cvtpk(a[0], a[1]); w.y = cvtpk(a[2], a[3]); w.z = cvtpk(b[0], b[1]); w.w = cvtpk(b[2], b[3]); EPI_ST((u32x4*)p, w); }
__device__ __forceinline__ void st8_f32(float* p, f32x4 a, f32x4 b) { EPI_ST((f32x4*)p, a); EPI_ST((f32x4*)(p + 4), b); }
__device__ __forceinline__ f32x4 silu4(f32x4 v) { f32x4 r; for (int i = 0; i < 4; ++i) r[i] = siluf_(v[i]); return r; }

struct EpiG1 {
    static constexpr bool PERM = true, AFTER_DRAIN = false;
    float* out; const float* rstd; bf16_t *QA, *KA, *VA, *GA, *QB, *GB, *KSEL, *VSEL, *KWIN, *VWIN, *ACMP; const float *q_g, *ks_g, *kw_g, *pe_k, *pe_v;
    __device__ __forceinline__ void operator()(const f32x4 (&acc)[2][2][4][2], const Unit& u, int wr, int wc, int fr_, int fq_) const {
        int fr = fr_, fq = fq_;
#ifndef G1_NOLAUNDER
        asm volatile("" : "+v"(fr), "+v"(fq));
#endif
#ifdef DBG_G1EPI2
        for (int dupe = 0; dupe < 2; ++dupe) {
#endif
        const int pn = g1_role(u.pn);
        float rsv[2][4];
#pragma unroll
        for (int ai = 0; ai < 2; ++ai)
#pragma unroll
            for (int m = 0; m < 4; ++m) rsv[ai][m] = rstd[u.pm * BM + ai * HALF + wr * 64 + m * 16 + fr];
#pragma unroll
        for (int ai = 0; ai < 2; ++ai)
#pragma unroll
            for (int m = 0; m < 4; ++m) {
#ifndef G1_NOROWCLOBBER
                asm volatile("" ::: "memory");
#endif
                const int row = u.pm * BM + ai * HALF + wr * 64 + m * 16 + fr; const float rs = rsv[ai][m];
#define A0(bj) (acc[ai][bj][m][0])
#define A1(bj) (acc[ai][bj][m][1])
                const int lam0 = 64 * wc + 8 * fq;
                if (pn < 2) {
                    const float sc = rs * 0.125f;
#pragma unroll
                    for (int bj = 0; bj < 2; ++bj) st8_bf16(QA + (size_t)row * 512 + pn * 256 + lam0 + 32 * bj, A0(bj) * sc, A1(bj) * sc);
                } else if (pn < 6) {
                    const int sl = (pn >= 4) ? 1 : 0, col = (pn & 1) * 256 + lam0; bf16_t* B = KA + (size_t)sl * ((WS_VA - WS_KA) / 2);
#pragma unroll
                    for (int bj = 0; bj < 2; ++bj) { const f32x4 x0 = A0(bj) * rs, x1 = A1(bj) * rs; st8_f32(out + OFF_SB + (size_t)row * 1024 + sl * 512 + col + 32 * bj, x0, x1); st8_bf16(B + (size_t)row * 512 + col + 32 * bj, x0, x1); }
                } else if (pn < 8) {
#pragma unroll
                    for (int bj = 0; bj < 2; ++bj) st8_bf16(GA + (size_t)row * 512 + (pn - 6) * 256 + lam0 + 32 * bj, silu4(A0(bj) * rs), silu4(A1(bj) * rs));
                } else if (pn >= 13) {
#pragma unroll
                    for (int bj = 0; bj < 2; ++bj) st8_bf16(GB + (size_t)row * 512 + (pn - 13) * 256 + lam0 + 32 * bj, silu4(A0(bj) * rs), silu4(A1(bj) * rs));
                } else {
                    float ssq = 0.f;
#pragma unroll
                    for (int bj = 0; bj < 2; ++bj) { const f32x4 a0 = A0(bj), a1 = A1(bj); ssq += (a0[0] * a0[0] + a0[1] * a0[1]) + (a0[2] * a0[2] + a0[3] * a0[3]) + (a1[0] * a1[0] + a1[1] * a1[1]) + (a1[2] * a1[2] + a1[3] * a1[3]); }
                    ssq += __shfl_xor(ssq, 16); ssq += __shfl_xor(ssq, 32);
                    const float hr = rs / sqrtf(ssq * rs * rs * (1.f / 64.f) + EPS);
                    if (pn < 10) {
                        const float sc = hr * (0.125f * LOG2E);
#pragma unroll
                        for (int bj = 0; bj < 2; ++bj) { const int d0 = 32 * bj + 8 * fq; const f32x4 g0 = *(const f32x4*)(q_g + d0), g1 = *(const f32x4*)(q_g + d0 + 4);
                            st8_bf16(QB + (size_t)row * 512 + (pn - 8) * 256 + lam0 + 32 * bj, A0(bj) * g0 * sc, A1(bj) * g1 * sc); }
                    } else if (pn == 10) {
                        const int t = row & 2047, b = row >> 11, c = t >> 5, p = t & 31, slot = wc >> 1, g = wc & 1; const float* pe = pe_k + (ptrdiff_t)slot * (pe_v - pe_k);
#pragma unroll
                        for (int bj = 0; bj < 2; ++bj) { const int lam = lam0 + 32 * bj, d0 = 32 * bj + 8 * fq; const f32x4 x0 = A0(bj) * rs, x1 = A1(bj) * rs;
                            st8_f32(out + OFF_NSA + (size_t)row * 512 + lam, x0, x1);
                            if (row < MP) { const f32x4 e0 = *(const f32x4*)(pe + p * 64 + d0), e1 = *(const f32x4*)(pe + p * 64 + d0 + 4);
                                st8_bf16(ACMP + ((size_t)slot * 1024 + (size_t)(b * 64 + c) * 2 + g) * 2048 + p * 64 + d0, x0 + e0, x1 + e1); } }
                    } else if (pn == 11) {
#pragma unroll
                        for (int bj = 0; bj < 2; ++bj) { const int lam = lam0 + 32 * bj, d0 = 32 * bj + 8 * fq; f32x4 x0, x1;
                            if (wc < 2) { const f32x4 g0 = *(const f32x4*)(ks_g + d0), g1 = *(const f32x4*)(ks_g + d0 + 4); x0 = A0(bj) * g0 * hr; x1 = A1(bj) * g1 * hr; } else { x0 = A0(bj) * rs; x1 = A1(bj) * rs; }
                            st8_f32(out + OFF_NSA + (size_t)row * 512 + 256 + lam, x0, x1);
                            st8_bf16(KSEL + (size_t)(wc >> 1) * ((WS_VSEL - WS_KSEL) / 2) + (size_t)row * 128 + (lam & 127), x0, x1); }
                    } else {
                        float* wdst = nullptr;
                        if (row >= MP) { const int si = row - MP; wdst = out + OFF_WINS + ((size_t)((si >> 3) * 512 + 504 + (si & 7))) * 256; }
                        else if ((row & 2047) >= 1536) wdst = out + OFF_WINP + ((size_t)((row >> 11) * 512 + (row & 2047) - 1536)) * 256;
#pragma unroll
                        for (int bj = 0; bj < 2; ++bj) { const int lam = lam0 + 32 * bj, d0 = 32 * bj + 8 * fq; f32x4 x0, x1;
                            if (wc < 2) { const f32x4 g0 = *(const f32x4*)(kw_g + d0), g1 = *(const f32x4*)(kw_g + d0 + 4); x0 = A0(bj) * g0 * hr; x1 = A1(bj) * g1 * hr; } else { x0 = A0(bj) * rs; x1 = A1(bj) * rs; }
                            if (wdst) st8_f32(wdst + lam, x0, x1);
                            st8_bf16(KWIN + (size_t)(wc >> 1) * ((WS_VWIN - WS_KWIN) / 2) + (size_t)row * 128 + (lam & 127), x0, x1); }
                    }
                }
#undef A0
#undef A1
            }
#ifdef DBG_G1EPI2
        }
#endif
    }
};
struct EpiNone { static constexpr bool PERM = true, AFTER_DRAIN = false;
    __device__ __forceinline__ void operator()(const f32x4 (&acc)[2][2][4][2], const Unit& u, int wr, int wc, int fr, int fq) const { if (acc[0][0][0][0][0] == 123456.789f) __builtin_trap(); } };
struct EpiHid {
    static constexpr bool PERM = true, AFTER_DRAIN = false;
    bf16_t* O;
    __device__ __forceinline__ void operator()(const f32x4 (&acc)[2][2][4][2], const Unit& u, int wr, int wc, int fr_, int fq_) const {
        int fr = fr_, fq = fq_; asm volatile("" : "+v"(fr), "+v"(fq));
#pragma unroll
        for (int ai = 0; ai < 2; ++ai)
#pragma unroll
            for (int m = 0; m < 4; ++m) { const int row = u.pm * BM + ai * HALF + wr * 64 + m * 16 + fr;
#pragma unroll
                for (int bj = 0; bj < 2; ++bj) st8_bf16(O + (size_t)row * 256 + bj * HALF + wc * 32 + 8 * fq, silu4(acc[ai][bj][m][0]), silu4(acc[ai][bj][m][1])); }
    }
};
struct EpiOut {
    static constexpr bool PERM = true, AFTER_DRAIN = false;
    const bf16_t* XB; bf16_t* HB;
    __device__ __forceinline__ void operator()(const f32x4 (&acc)[2][2][4][2], const Unit& u, int wr, int wc, int fr_, int fq_) const {
        int fr = fr_, fq = fq_; asm volatile("" : "+v"(fr), "+v"(fq));
#pragma unroll
        for (int ai = 0; ai < 2; ++ai) {
            u32x4 xv[4][2];
#pragma unroll
            for (int m = 0; m < 4; ++m) { const int row = u.pm * BM + ai * HALF + wr * 64 + m * 16 + fr;
#pragma unroll
                for (int bj = 0; bj < 2; ++bj) { const int col = u.pn * BM + bj * HALF + wc * 32 + 8 * fq; xv[m][bj] = *(const u32x4*)(XB + (size_t)row * DM + col); } }
#pragma unroll
            for (int m = 0; m < 4; ++m) { const int row = u.pm * BM + ai * HALF + wr * 64 + m * 16 + fr;
#pragma unroll
                for (int bj = 0; bj < 2; ++bj) { const int col = u.pn * BM + bj * HALF + wc * 32 + 8 * fq; const u32x4 x = xv[m][bj];
                    const f32x4 x0 = {bf_lo(x.x), bf_hi(x.x), bf_lo(x.y), bf_hi(x.y)}, x1 = {bf_lo(x.z), bf_hi(x.z), bf_lo(x.w), bf_hi(x.w)};
                    st8_bf16(HB + (size_t)row * DM + col, x0 + acc[ai][bj][m][0], x1 + acc[ai][bj][m][1]); } }
        }
    }
};
struct EpiFinal {
    static constexpr bool PERM = true, AFTER_DRAIN = false;
    float* Y; const bf16_t* T1; const bf16_t* HB;
    __device__ __forceinline__ void operator()(const f32x4 (&acc)[2][2][4][2], const Unit& u, int wr, int wc, int fr_, int fq_) const {
        int fr = fr_, fq = fq_; asm volatile("" : "+v"(fr), "+v"(fq));
#pragma unroll
        for (int ai = 0; ai < 2; ++ai) {
            u32x4 tv[4][2], hv[4][2];
#pragma unroll
            for (int m = 0; m < 4; ++m) { const int row = u.pm * BM + ai * HALF + wr * 64 + m * 16 + fr;
#pragma unroll
                for (int bj = 0; bj < 2; ++bj) { const int col = u.pn * BM + bj * HALF + wc * 32 + 8 * fq; tv[m][bj] = *(const u32x4*)(T1 + (size_t)row * DM + col); hv[m][bj] = *(const u32x4*)(HB + (size_t)row * DM + col); } }
#pragma unroll
            for (int m = 0; m < 4; ++m) { const int row = u.pm * BM + ai * HALF + wr * 64 + m * 16 + fr;
#pragma unroll
                for (int bj = 0; bj < 2; ++bj) { const int col = u.pn * BM + bj * HALF + wc * 32 + 8 * fq; float* yp = Y + (size_t)row * DM + col;
                    const u32x4 t = tv[m][bj], hb = hv[m][bj]; const f32x4 a0 = acc[ai][bj][m][0], a1 = acc[ai][bj][m][1];
                    f32x4 y0, y1;
                    y0[0] = bf_lo(hb.x) + sigmoidf_(a0[0]) * bf_lo(t.x); y0[1] = bf_hi(hb.x) + sigmoidf_(a0[1]) * bf_hi(t.x); y0[2] = bf_lo(hb.y) + sigmoidf_(a0[2]) * bf_lo(t.y); y0[3] = bf_hi(hb.y) + sigmoidf_(a0[3]) * bf_hi(t.y);
                    y1[0] = bf_lo(hb.z) + sigmoidf_(a1[0]) * bf_lo(t.z); y1[1] = bf_hi(hb.z) + sigmoidf_(a1[1]) * bf_hi(t.z); y1[2] = bf_lo(hb.w) + sigmoidf_(a1[2]) * bf_lo(t.w); y1[3] = bf_hi(hb.w) + sigmoidf_(a1[3]) * bf_hi(t.w);
#ifdef Y_NT_STORES
                    __builtin_nontemporal_store(y0, (f32x4*)yp); __builtin_nontemporal_store(y1, (f32x4*)(yp + 4));
#else
                    st8_f32(yp, y0, y1);
#endif
                    } }
        }
    }
};
struct DiagOrder {
    int n, per, G, c;
    __device__ __forceinline__ bool next(int i, Unit& u) const { const int L = i * G + c; if (L >= n) return false; u.pm = L; u.pn = L / per; return true; }
    __device__ __forceinline__ void a_ready(const Unit&) const {}
    __device__ __forceinline__ void done(const Unit&) const {}
};
struct EpiHidB {
    bf16_t* O; const float* bias;
    __device__ __forceinline__ void operator()(const f32x4 (&acc)[2][2][4][2], int pm, int wr, int wc, int fr_, int fq_) const {
        int fr = fr_, fq = fq_; asm volatile("" : "+v"(fr), "+v"(fq));
#pragma unroll
        for (int bj = 0; bj < 2; ++bj) { const int col = bj * HALF + wc * 32 + 8 * fq; const f32x4 b0 = *(const f32x4*)(bias + col), b1 = *(const f32x4*)(bias + col + 4);
#pragma unroll
            for (int ai = 0; ai < 2; ++ai)
#pragma unroll
                for (int m = 0; m < 4; ++m) { const int row = pm * BM + ai * HALF + wr * 64 + m * 16 + fr;
                    st8_bf16(O + (size_t)row * 256 + col, silu4(acc[ai][bj][m][0] + b0), silu4(acc[ai][bj][m][1] + b1)); } }
    }
};
__device__ __forceinline__ void gemm_unit_gather(PG8_LAS unsigned char* lds, const float* cn, const int* pt, const bf16_t* W1T  , int L  , const EpiHidB& E) {
    int tid_ = threadIdx.x; asm volatile("" : "+v"(tid_));
    const int tid = tid_, wid = __builtin_amdgcn_readfirstlane(tid >> 6), lane = tid & 63, wr = wid >> 2, wc = wid & 3, fr = lane & 15, fq = lane >> 4;
    const int slot = L >> 6, pmu = L & 63;
    const float* abase[4]; const bf16_t* bbase[4]; int aofs[4], bofs[4];
#pragma unroll
    for (int j = 0; j < 4; ++j) { const int q = tid + 512 * j, row = q >> 3, c8 = q & 7, R = pmu * 256 + row, b = R >> 9, c = (R >> 1) & 255, g = R & 1, pos0 = c * 32;
        abase[j] = cn + ((size_t)pt[b * 64 + (pos0 >> 7)] * 128 + (pos0 & 127)) * 512 + slot * 128 + g * 64 + c8 * 8;
        aofs[j] = (row >> 7) * HTB + lds_byte(row & 127, c8 * 8);
        const int nsrc = (row & ~31) + perm32(row & 31);
        bbase[j] = W1T + (size_t)(slot * 256 + nsrc) * 2048 + c8 * 8;
        bofs[j] = (4 + (row >> 7)) * HTB + lds_byte(row & 127, c8 * 8); }
    const int aoff = lds_byte(wr * 64 + fr, fq * 8), boff = lds_byte(wc * 32 + fr, fq * 8);
    f32x4 acc[2][2][4][2];
#pragma unroll
    for (int a = 0; a < 2; ++a)
#pragma unroll
        for (int b = 0; b < 2; ++b)
#pragma unroll
            for (int m = 0; m < 4; ++m)
#pragma unroll
                for (int n = 0; n < 2; ++n) acc[a][b][m][n] = (f32x4){0.f, 0.f, 0.f, 0.f};
    f32x4 ar[4][2]; u32x4 br[4];
#define GU_LOAD(kt) do { _Pragma("unroll") for (int j = 0; j < 4; ++j) { ar[j][0] = *(const f32x4*)(abase[j] + (size_t)(kt) * 512); ar[j][1] = *(const f32x4*)(abase[j] + (size_t)(kt) * 512 + 4); br[j] = *(const u32x4*)(bbase[j] + (kt) * 64); } } while (0)
#define GU_STORE(stg) do { _Pragma("unroll") for (int j = 0; j < 4; ++j) { u32x4 w; w.x = cvtpk(ar[j][0][0], ar[j][0][1]); w.y = cvtpk(ar[j][0][2], ar[j][0][3]); w.z = cvtpk(ar[j][1][0], ar[j][1][1]); w.w = cvtpk(ar[j][1][2], ar[j][1][3]); \
        *(PG8_LAS u32x4*)(lds + (stg) * 2 * HTB + aofs[j]) = w; *(PG8_LAS u32x4*)(lds + (stg) * 2 * HTB + bofs[j]) = br[j]; } } while (0)
    GU_LOAD(0); GU_STORE(0); GU_LOAD(1);
    for (int kt = 0; kt < 32; ++kt) {
        const int stg = kt & 1;
        __syncthreads();
        if (kt + 1 < 32) GU_STORE(stg ^ 1);
        if (kt + 2 < 32) GU_LOAD(kt + 2);
        bf16x8 At[4][2], Bf[2][2];
#pragma unroll
        for (int ai = 0; ai < 2; ++ai) {
#pragma unroll
            for (int m = 0; m < 4; ++m)
#pragma unroll
                for (int k = 0; k < 2; ++k) At[m][k] = *(const PG8_LAS bf16x8*)(lds + (stg * 2 + ai) * HTB + aoff + m * 2048 + k * 1024);
#pragma unroll
            for (int bj = 0; bj < 2; ++bj) {
#pragma unroll
                for (int n = 0; n < 2; ++n)
#pragma unroll
                    for (int k = 0; k < 2; ++k) Bf[n][k] = *(const PG8_LAS bf16x8*)(lds + (4 + stg * 2 + bj) * HTB + boff + n * 2048 + k * 1024);
#pragma unroll
                for (int m = 0; m < 4; ++m)
#pragma unroll
                    for (int n = 0; n < 2; ++n)
#pragma unroll
                        for (int k = 0; k < 2; ++k) acc[ai][bj][m][n] = __builtin_amdgcn_mfma_f32_16x16x32_bf16(Bf[n][k], At[m][k], acc[ai][bj][m][n], 0, 0, 0);
            } }
    }
#undef GU_LOAD
#undef GU_STORE
    E(acc, L, wr, wc, fr, fq);
    __syncthreads();
}
struct EpiHidB128 {
    bf16_t* O; const float* bias;
    __device__ __forceinline__ void operator()(const f32x4 (&acc)[2][4][2], int row0, int wr, int wc, int fr_, int fq_) const {
        int fr = fr_, fq = fq_; asm volatile("" : "+v"(fr), "+v"(fq));
#pragma unroll
        for (int bj = 0; bj < 2; ++bj) { const int col = bj * HALF + wc * 32 + 8 * fq; const f32x4 b0 = *(const f32x4*)(bias + col), b1 = *(const f32x4*)(bias + col + 4);
#pragma unroll
            for (int m = 0; m < 4; ++m) { const int row = row0 + wr * 64 + m * 16 + fr;
                st8_bf16(O + (size_t)row * 256 + col, silu4(acc[bj][m][0] + b0), silu4(acc[bj][m][1] + b1)); } }
    }
};
__device__ __forceinline__ void gemm_unit_gather128(PG8_LAS unsigned char* lds, const float* cn, const int* pt, const bf16_t* W1T  , int L  , const EpiHidB128& E) {
    int tid_ = threadIdx.x; asm volatile("" : "+v"(tid_));
    const int tid = tid_, wid = __builtin_amdgcn_readfirstlane(tid >> 6), lane = tid & 63, wr = wid >> 2, wc = wid & 3, fr = lane & 15, fq = lane >> 4;
    const int slot = L >> 7, pmu = L & 127;
    const float* abase[2]; const bf16_t* bbase[4]; int aofs[2], bofs[4];
#pragma unroll
    for (int j = 0; j < 2; ++j) { const int q = tid + 512 * j, row = q >> 3, c8 = q & 7, R = pmu * 128 + row, b = R >> 9, c = (R >> 1) & 255, g = R & 1, pos0 = c * 32;
        abase[j] = cn + ((size_t)pt[b * 64 + (pos0 >> 7)] * 128 + (pos0 & 127)) * 512 + slot * 128 + g * 64 + c8 * 8;
        aofs[j] = lds_byte(row, c8 * 8); }
#pragma unroll
    for (int j = 0; j < 4; ++j) { const int q = tid + 512 * j, n = q >> 3, c8 = q & 7, nsrc = (n & ~31) + perm32(n & 31);
        bbase[j] = W1T + (size_t)(slot * 256 + nsrc) * 2048 + c8 * 8;
        bofs[j] = (1 + (n >> 7)) * HTB + lds_byte(n & 127, c8 * 8); }
    const int aoff = lds_byte(wr * 64 + fr, fq * 8), boff = lds_byte(wc * 32 + fr, fq * 8);
    f32x4 acc[2][4][2];
#pragma unroll
    for (int b = 0; b < 2; ++b)
#pragma unroll
        for (int m = 0; m < 4; ++m)
#pragma unroll
            for (int n = 0; n < 2; ++n) acc[b][m][n] = (f32x4){0.f, 0.f, 0.f, 0.f};
    f32x4 ra0[2][2], ra1[2][2], ra2[2][2], ra3[2][2]; u32x4 br[4];
#define GU_LDA(ra, kt) do { _Pragma("unroll") for (int j = 0; j < 2; ++j) { ra[j][0] = *(const f32x4*)(abase[j] + (size_t)(kt) * 512); ra[j][1] = *(const f32x4*)(abase[j] + (size_t)(kt) * 512 + 4); } } while (0)
#define GU_LDB(kt) do { _Pragma("unroll") for (int j = 0; j < 4; ++j) br[j] = *(const u32x4*)(bbase[j] + (kt) * 64); } while (0)
#define GU_ST(stg, ra) do { _Pragma("unroll") for (int j = 0; j < 2; ++j) { u32x4 w; w.x = cvtpk(ra[j][0][0], ra[j][0][1]); w.y = cvtpk(ra[j][0][2], ra[j][0][3]); w.z = cvtpk(ra[j][1][0], ra[j][1][1]); w.w = cvtpk(ra[j][1][2], ra[j][1][3]); \
        *(PG8_LAS u32x4*)(lds + (stg) * 3 * HTB + aofs[j]) = w; } _Pragma("unroll") for (int j = 0; j < 4; ++j) *(PG8_LAS u32x4*)(lds + (stg) * 3 * HTB + bofs[j]) = br[j]; } while (0)
#define GU_MMA(stg) do { bf16x8 At[4][2], Bf[2][2]; \
        _Pragma("unroll") for (int m = 0; m < 4; ++m) _Pragma("unroll") for (int k = 0; k < 2; ++k) At[m][k] = *(const PG8_LAS bf16x8*)(lds + (stg) * 3 * HTB + aoff + m * 2048 + k * 1024); \
        _Pragma("unroll") for (int bj = 0; bj < 2; ++bj) { \
            _Pragma("unroll") for (int n = 0; n < 2; ++n) _Pragma("unroll") for (int k = 0; k < 2; ++k) Bf[n][k] = *(const PG8_LAS bf16x8*)(lds + ((stg) * 3 + 1 + bj) * HTB + boff + n * 2048 + k * 1024); \
            _Pragma("unroll") for (int m = 0; m < 4; ++m) _Pragma("unroll") for (int n = 0; n < 2; ++n) _Pragma("unroll") for (int k = 0; k < 2; ++k) \
                acc[bj][m][n] = __builtin_amdgcn_mfma_f32_16x16x32_bf16(Bf[n][k], At[m][k], acc[bj][m][n], 0, 0, 0); } } while (0)
#define GU_STEP(kt, stg, raN) do { __syncthreads(); if ((kt) + 1 < 32) GU_ST((stg) ^ 1, raN); if ((kt) + 5 < 32) GU_LDA(raN, (kt) + 5); GU_LDB((kt) + 2 < 32 ? (kt) + 2 : 31); GU_MMA(stg); } while (0)
    GU_LDA(ra0, 0); GU_LDB(0); GU_ST(0, ra0); GU_LDA(ra1, 1); GU_LDA(ra2, 2); GU_LDA(ra3, 3); GU_LDA(ra0, 4); GU_LDB(1);
    for (int kt = 0; kt < 32; kt += 4) { GU_STEP(kt, 0, ra1); GU_STEP(kt + 1, 1, ra2); GU_STEP(kt + 2, 0, ra3); GU_STEP(kt + 3, 1, ra0); }
#undef GU_LDA
#undef GU_LDB
#undef GU_ST
#undef GU_MMA
#undef GU_STEP
    E(acc, L * 128, wr, wc, fr, fq);
    __syncthreads();
}
__device__ __forceinline__ void gemm_unit_bf16_128(PG8_LAS unsigned char* lds, const bf16_t* A  , const bf16_t* W1T  , int slot, int row0, const EpiHidB128& E) {
    int tid_ = threadIdx.x; asm volatile("" : "+v"(tid_));
    const int tid = tid_, wid = __builtin_amdgcn_readfirstlane(tid >> 6), lane = tid & 63, wr = wid >> 2, wc = wid & 3, fr = lane & 15, fq = lane >> 4;
    const bf16_t* abase[2]; const bf16_t* bbase[4]; int aofs[2], bofs[4];
#pragma unroll
    for (int j = 0; j < 2; ++j) { const int q = tid + 512 * j, row = q >> 3, c8 = q & 7; abase[j] = A + (size_t)row * 2048 + c8 * 8; aofs[j] = lds_byte(row, c8 * 8); }
#pragma unroll
    for (int j = 0; j < 4; ++j) { const int q = tid + 512 * j, n = q >> 3, c8 = q & 7, nsrc = (n & ~31) + perm32(n & 31);
        bbase[j] = W1T + (size_t)(slot * 256 + nsrc) * 2048 + c8 * 8;
        bofs[j] = (1 + (n >> 7)) * HTB + lds_byte(n & 127, c8 * 8); }
    const int aoff = lds_byte(wr * 64 + fr, fq * 8), boff = lds_byte(wc * 32 + fr, fq * 8);
    f32x4 acc[2][4][2];
#pragma unroll
    for (int b = 0; b < 2; ++b)
#pragma unroll
        for (int m = 0; m < 4; ++m)
#pragma unroll
            for (int n = 0; n < 2; ++n) acc[b][m][n] = (f32x4){0.f, 0.f, 0.f, 0.f};
    u32x4 ra0[2], ra1[2], ra2[2], ra3[2], br[4];
#define GB_LDA(ra, kt) do { _Pragma("unroll") for (int j = 0; j < 2; ++j) ra[j] = *(const u32x4*)(abase[j] + (kt) * 64); } while (0)
#define GB_LDB(kt) do { _Pragma("unroll") for (int j = 0; j < 4; ++j) br[j] = *(const u32x4*)(bbase[j] + (kt) * 64); } while (0)
#define GB_ST(stg, ra) do { _Pragma("unroll") for (int j = 0; j < 2; ++j) *(PG8_LAS u32x4*)(lds + (stg) * 3 * HTB + aofs[j]) = ra[j]; \
        _Pragma("unroll") for (int j = 0; j < 4; ++j) *(PG8_LAS u32x4*)(lds + (stg) * 3 * HTB + bofs[j]) = br[j]; } while (0)
#define GB_MMA(stg) do { bf16x8 At[4][2], Bf[2][2]; \
        _Pragma("unroll") for (int m = 0; m < 4; ++m) _Pragma("unroll") for (int k = 0; k < 2; ++k) At[m][k] = *(const PG8_LAS bf16x8*)(lds + (stg) * 3 * HTB + aoff + m * 2048 + k * 1024); \
        _Pragma("unroll") for (int bj = 0; bj < 2; ++bj) { \
            _Pragma("unroll") for (int n = 0; n < 2; ++n) _Pragma("unroll") for (int k = 0; k < 2; ++k) Bf[n][k] = *(const PG8_LAS bf16x8*)(lds + ((stg) * 3 + 1 + bj) * HTB + boff + n * 2048 + k * 1024); \
            _Pragma("unroll") for (int m = 0; m < 4; ++m) _Pragma("unroll") for (int n = 0; n < 2; ++n) _Pragma("unroll") for (int k = 0; k < 2; ++k) \
                acc[bj][m][n] = __builtin_amdgcn_mfma_f32_16x16x32_bf16(Bf[n][k], At[m][k], acc[bj][m][n], 0, 0, 0); } } while (0)
#define GB_STEP(kt, stg, raN) do { __syncthreads(); if ((kt) + 1 < 32) GB_ST((stg) ^ 1, raN); if ((kt) + 5 < 32) GB_LDA(raN, (kt) + 5); GB_LDB((kt) + 2 < 32 ? (kt) + 2 : 31); GB_MMA(stg); } while (0)
    GB_LDA(ra0, 0); GB_LDB(0); GB_ST(0, ra0); GB_LDA(ra1, 1); GB_LDA(ra2, 2); GB_LDA(ra3, 3); GB_LDA(ra0, 4); GB_LDB(1);
    for (int kt = 0; kt < 32; kt += 4) { GB_STEP(kt, 0, ra1); GB_STEP(kt + 1, 1, ra2); GB_STEP(kt + 2, 0, ra3); GB_STEP(kt + 3, 1, ra0); }
#undef GB_LDA
#undef GB_LDB
#undef GB_ST
#undef GB_MMA
#undef GB_STEP
    E(acc, row0, wr, wc, fr, fq);
    __syncthreads();
}
struct XcdQueueOrder {
    unsigned* q; volatile PG8_LAS int* slot; int nM, nN, nwg, x;
    __device__ __forceinline__ void init(int M, int N, unsigned* q_, volatile PG8_LAS int* slot_, int xcc) { nM = M / BM; nN = N / BM; nwg = nM * nN; q = q_; slot = slot_; x = xcc & 7; }
    __device__ __forceinline__ bool next(int i, Unit& u) const {
        if (threadIdx.x == 0) { int res = -1; const int qq = nwg / NXCD, rr = nwg % NXCD;
#pragma unroll 1
            for (int k = 0; k < NXCD; ++k) { const int xx = (x + k) & 7, sz = qq + (xx < rr ? 1 : 0), st = xx < rr ? xx * (qq + 1) : rr * (qq + 1) + (xx - rr) * qq;
                if ((int)__hip_atomic_load(q + 64 * xx, __ATOMIC_RELAXED, __HIP_MEMORY_SCOPE_AGENT) >= sz) continue;
                const int t = (int)__hip_atomic_fetch_add(q + 64 * xx, 1u, __ATOMIC_RELAXED, __HIP_MEMORY_SCOPE_AGENT);
                if (t < sz) { res = st + t; break; } }
            slot[i & 1] = res; }
        asm volatile("s_waitcnt lgkmcnt(0)" ::: "memory"); __builtin_amdgcn_s_barrier(); asm volatile("" ::: "memory");
        const int wgid = slot[i & 1]; if (wgid < 0) return false;
        const int nig = WGM * nN, gid = wgid / nig, fm = gid * WGM, gsz = (nM - fm) < WGM ? (nM - fm) : WGM;
        u.pm = fm + ((wgid % nig) % gsz); u.pn = (wgid % nig) / gsz; return true;
    }
    __device__ __forceinline__ void a_ready(const Unit&) const {}
    __device__ __forceinline__ void done(const Unit&) const {}
};
struct HybridOrder {
    unsigned* q; volatile PG8_LAS int* slot; int nM, nN, nwg, ns, l0, lstride, dyn0;
    __device__ __forceinline__ bool decode(int L, Unit& u) const {
        int wgid = L; { const int qq = nwg / NXCD, r = nwg % NXCD, xcd = wgid % NXCD, off = wgid / NXCD; wgid = (xcd < r ? xcd * (qq + 1) : r * (qq + 1) + (xcd - r) * qq) + off; }
        const int nig = WGM * nN, gid = wgid / nig, fm = gid * WGM, gsz = (nM - fm) < WGM ? (nM - fm) : WGM;
        u.pm = fm + ((wgid % nig) % gsz); u.pn = (wgid % nig) / gsz; return true;
    }
    __device__ __forceinline__ bool next(int i, Unit& u) const {
        if (i < ns) return decode(l0 + i * lstride, u);
        if (threadIdx.x == 0) { int res = -1;
            if ((int)__hip_atomic_load(q, __ATOMIC_RELAXED, __HIP_MEMORY_SCOPE_AGENT) < nwg - dyn0) { const int t = (int)__hip_atomic_fetch_add(q, 1u, __ATOMIC_RELAXED, __HIP_MEMORY_SCOPE_AGENT); if (t < nwg - dyn0) res = dyn0 + t; }
            slot[i & 1] = res; }
        asm volatile("s_waitcnt lgkmcnt(0)" ::: "memory"); __builtin_amdgcn_s_barrier(); asm volatile("" ::: "memory");
        const int L = slot[i & 1]; if (L < 0) return false; return decode(L, u);
    }
    __device__ __forceinline__ void a_ready(const Unit&) const {}
    __device__ __forceinline__ void done(const Unit&) const {}
};
struct DiagQueueOrder {
    unsigned* q; volatile PG8_LAS int* slot; int n, per;
    __device__ __forceinline__ bool next(int i, Unit& u) const {
        if (threadIdx.x == 0) { int res = -1;
            if ((int)__hip_atomic_load(q, __ATOMIC_RELAXED, __HIP_MEMORY_SCOPE_AGENT) < n) { const int t = (int)__hip_atomic_fetch_add(q, 1u, __ATOMIC_RELAXED, __HIP_MEMORY_SCOPE_AGENT); if (t < n) res = t; }
            slot[i & 1] = res; }
        asm volatile("s_waitcnt lgkmcnt(0)" ::: "memory"); __builtin_amdgcn_s_barrier(); asm volatile("" ::: "memory");
        const int L = slot[i & 1]; if (L < 0) return false; u.pm = L; u.pn = L / per; return true;
    }
    __device__ __forceinline__ void a_ready(const Unit&) const {}
    __device__ __forceinline__ void done(const Unit&) const {}
};
struct OneUnit {
    int pm, pn;
    __device__ __forceinline__ bool next(int i, Unit& u) const { if (i > 0) return false; u.pm = pm; u.pn = pn; return true; }
    __device__ __forceinline__ void a_ready(const Unit&) const {}
    __device__ __forceinline__ void done(const Unit&) const {}
};
}

#ifndef DBG_DUP
#define DBG_DUP 0
#endif

#define MFMA32(a, b, c) __builtin_amdgcn_mfma_f32_32x32x16_bf16((a), (b), (c), 0, 0, 0)
constexpr int KP = 144, VP = 192;
constexpr int KT_BYTES = 64 * KP, VT_BYTES = 64 * VP;
typedef short v4i16_t __attribute__((ext_vector_type(4)));
__device__ __forceinline__ int kidx_of(int kh, int v, int h) { return 32 * kh + (v & 3) + 8 * (v >> 2) + 4 * h; }
__device__ __forceinline__ s16x4 vtr(const LAS unsigned char* p) { return __builtin_bit_cast(s16x4, __builtin_amdgcn_ds_read_tr16_b64_v4i16((LAS v4i16_t*)p)); }

__device__ __forceinline__ void qk64(f32x16 (&s)[2], const LAS unsigned char* Ks, const bf16x8 (&qf)[4], int lane) {
    const LAS unsigned char* kb = Ks + (lane & 31) * KP + (lane >> 5) * 16;
#pragma unroll
    for (int kh = 0; kh < 2; ++kh) { f32x16 acc; for (int i = 0; i < 16; ++i) acc[i] = 0.f;
#pragma unroll
        for (int ks = 0; ks < 4; ++ks) { const bf16x8 kf = *(const LAS bf16x8*)(kb + kh * 32 * KP + ks * 32); __builtin_amdgcn_s_setprio(1); acc = MFMA32(kf, qf[ks], acc); __builtin_amdgcn_s_setprio(0); }
        s[kh] = acc; }
}
__device__ __forceinline__ void qk64_g(f32x16 (&s)[2], const bf16* Kg, int kpitch, const bf16x8 (&qf)[4], int lane) {
    const bf16* kb = Kg + (size_t)(lane & 31) * kpitch + (lane >> 5) * 8;
    bf16x8 kf[2][4];
#pragma unroll
    for (int kh = 0; kh < 2; ++kh)
#pragma unroll
        for (int ks = 0; ks < 4; ++ks) kf[kh][ks] = *(const GAS bf16x8*)(kb + (size_t)kh * 32 * kpitch + ks * 16);
#pragma unroll
    for (int kh = 0; kh < 2; ++kh) { f32x16 acc; for (int i = 0; i < 16; ++i) acc[i] = 0.f;
        __builtin_amdgcn_s_setprio(1);
#pragma unroll
        for (int ks = 0; ks < 4; ++ks) acc = MFMA32(kf[kh][ks], qf[ks], acc);
        __builtin_amdgcn_s_setprio(0);
        s[kh] = acc; }
}
__device__ __forceinline__ void pv64(f32x16 (&o)[2], const LAS unsigned char* Vs, const f32x16 (&e)[2], int lane) {
    const int G = lane >> 4, i = lane & 15, q = i >> 2, p = i & 3, h = G >> 1;
    const LAS unsigned char* vb = Vs + (4 * h + q) * VP + (16 * (G & 1) + 4 * p) * 2;
#pragma unroll
    for (int kh = 0; kh < 2; ++kh)
#pragma unroll
        for (int s = 0; s < 2; ++s) {
            v4u pw; pw.x = cvtpk(e[kh][8 * s + 0], e[kh][8 * s + 1]); pw.y = cvtpk(e[kh][8 * s + 2], e[kh][8 * s + 3]); pw.z = cvtpk(e[kh][8 * s + 4], e[kh][8 * s + 5]); pw.w = cvtpk(e[kh][8 * s + 6], e[kh][8 * s + 7]);
            const bf16x8 pf = __builtin_bit_cast(bf16x8, pw);
#pragma unroll
            for (int dh = 0; dh < 2; ++dh) {
                const s16x4 lo = vtr(vb + (32 * kh + 16 * s) * VP + 64 * dh), hi = vtr(vb + (32 * kh + 16 * s + 8) * VP + 64 * dh);
                const bf16x8 vf = {lo[0], lo[1], lo[2], lo[3], hi[0], hi[1], hi[2], hi[3]};
                __builtin_amdgcn_s_setprio(1); o[dh] = MFMA32(vf, pf, o[dh]); __builtin_amdgcn_s_setprio(0);
            }
        }
}
__device__ __forceinline__ bf16x8 pack8(f32x4 a, f32x4 b) { v4u w; w.x = cvtpk(a[0], a[1]); w.y = cvtpk(a[2], a[3]); w.z = cvtpk(b[0], b[1]); w.w = cvtpk(b[2], b[3]); return __builtin_bit_cast(bf16x8, w); }
__device__ __forceinline__ float xhalf(float v, int h) {
    const unsigned u = __builtin_bit_cast(unsigned, v);
    auto r = __builtin_amdgcn_permlane32_swap(u, u, false, false);
    return __builtin_bit_cast(float, h ? r[0] : r[1]);
}
__device__ __forceinline__ float xmax_half(float v) {
    const unsigned u = __builtin_bit_cast(unsigned, v); auto r = __builtin_amdgcn_permlane32_swap(u, u, false, false);
    return fmaxf(__builtin_bit_cast(float, r[0]), __builtin_bit_cast(float, r[1]));
}
__device__ __forceinline__ void load_qf(bf16x8 (&qf)[4], const bf16* qrow, int lane) {
#pragma unroll
    for (int ks = 0; ks < 4; ++ks) qf[ks] = *(const GAS bf16x8*)(qrow + 16 * ks + 8 * (lane >> 5));
}
__device__ __forceinline__ v4u tile_ld(const bf16* g, int rpitch, int tid) { return *(const GAS v4u*)(g + (size_t)(tid >> 3) * rpitch + (tid & 7) * 8); }
__device__ __forceinline__ void tile_st(LAS unsigned char* t, int P, int tid, v4u v) { *(LAS v4u*)(t + (tid >> 3) * P + (tid & 7) * 16) = v; }

template <class F> __device__ __forceinline__ void softmax_tile(f32x16 (&s)[2], float& m, float& l, f32x16 (&o)[2], int h, F&& biasf) {
    float mx = -1e30f;
#pragma unroll
    for (int kh = 0; kh < 2; ++kh)
#pragma unroll
        for (int v = 0; v < 16; ++v) { const float x = s[kh][v] + biasf(kidx_of(kh, v, h)); s[kh][v] = x; mx = fmaxf(mx, x); }
    mx = xmax_half(mx);
    const float mn = fmaxf(m, mx), al = fexp2(m - mn); m = mn;
    float sum = 0.f;
#pragma unroll
    for (int kh = 0; kh < 2; ++kh)
#pragma unroll
        for (int v = 0; v < 16; ++v) { const float e = fexp2(s[kh][v] - mn); s[kh][v] = e; sum += e; }
    l = l * al + sum;
#pragma unroll
    for (int dh = 0; dh < 2; ++dh)
#pragma unroll
        for (int v = 0; v < 16; ++v) o[dh][v] *= al;
}
__device__ __forceinline__ void alibi_cinit(f32x16 (&c)[2], float slope2) {
#pragma unroll
    for (int kh = 0; kh < 2; ++kh)
#pragma unroll
        for (int v = 0; v < 16; ++v) c[kh][v] = slope2 * (float)(32 * kh + (v & 3) + 8 * (v >> 2));
}
__device__ __forceinline__ void qk64c(f32x16 (&s)[2], const LAS unsigned char* Ks, const bf16x8 (&qf)[4], const f32x16 (&cinit)[2], int lane) {
    const LAS unsigned char* kb = Ks + (lane & 31) * KP + (lane >> 5) * 16;
    bf16x8 kf[2][4];
#pragma unroll
    for (int ks = 0; ks < 4; ++ks)
#pragma unroll
        for (int kh = 0; kh < 2; ++kh) kf[kh][ks] = *(const LAS bf16x8*)(kb + kh * 32 * KP + ks * 32);
    __builtin_amdgcn_s_setprio(1);
    f32x16 a0 = MFMA32(kf[0][0], qf[0], cinit[0]), a1 = MFMA32(kf[1][0], qf[0], cinit[1]);
#pragma unroll
    for (int ks = 1; ks < 4; ++ks) { a0 = MFMA32(kf[0][ks], qf[ks], a0); a1 = MFMA32(kf[1][ks], qf[ks], a1); }
    __builtin_amdgcn_s_setprio(0);
    s[0] = a0; s[1] = a1;
}
template <bool MASKED> __device__ __forceinline__ void sm2_tile(f32x16 (&s)[2], float& m, float& l, f32x16 (&o)[2], float off, bool part, int lo, int hi) {
    float mxp = -INFINITY;
#pragma unroll
    for (int kh = 0; kh < 2; ++kh)
#pragma unroll
        for (int v = 0; v < 16; ++v) { const int Kc = 32 * kh + (v & 3) + 8 * (v >> 2); float xp = s[kh][v];
            if (MASKED) { xp = (Kc > lo && Kc <= hi) ? xp : -INFINITY; s[kh][v] = xp; }
            mxp = fmaxf(mxp, xp); }
    float mx = mxp + off; mx = xmax_half(mx);
    const float mn = part ? fmaxf(m, mx) : m, al = fexp2(m - mn); m = mn; l *= al;
#pragma unroll
    for (int dh = 0; dh < 2; ++dh)
#pragma unroll
        for (int v = 0; v < 16; ++v) o[dh][v] *= al;
    const float mb = part ? (mn - off) : INFINITY;
    float sum = 0.f;
#pragma unroll
    for (int kh = 0; kh < 2; ++kh)
#pragma unroll
        for (int v = 0; v < 16; ++v) { const float e = fexp2(s[kh][v] - mb); s[kh][v] = e; sum += e; }
    l += sum;
}
__device__ __forceinline__ void store_row_wide(bf16* rowp, v2u (&grp)[8], int h, bool pred = true) {
#pragma unroll
    for (int g = 0; g < 8; g += 2) { v2u a = grp[g], b = grp[g + 1];
        { auto r = __builtin_amdgcn_permlane32_swap(a.x, b.x, false, false); a.x = r[0]; b.x = r[1]; }
        { auto r = __builtin_amdgcn_permlane32_swap(a.y, b.y, false, false); a.y = r[0]; b.y = r[1]; }
        if (pred) { v4u w; w.x = a.x; w.y = a.y; w.z = b.x; w.w = b.y; *(GAS v4u*)(rowp + 8 * g + 8 * h) = w; } }
}
__device__ __forceinline__ void store_ot(bf16* dst, const f32x16 (&o)[2], float sc, int h) {
    v2u grp[8];
#pragma unroll
    for (int dh = 0; dh < 2; ++dh)
#pragma unroll
        for (int a = 0; a < 4; ++a) { grp[4 * dh + a].x = cvtpk(o[dh][4 * a] * sc, o[dh][4 * a + 1] * sc); grp[4 * dh + a].y = cvtpk(o[dh][4 * a + 2] * sc, o[dh][4 * a + 3] * sc); }
    store_row_wide(dst, grp, h);
}
__device__ __forceinline__ void zero_o(f32x16 (&o)[2]) { for (int dh = 0; dh < 2; ++dh) for (int v = 0; v < 16; ++v) o[dh][v] = 0.f; }

template <bool TO_LDS> __device__ __forceinline__ void l2_wave(const bf16* w2t  , const bf16* hid0, int hstride, const float* kcg  , unsigned char* dst, int dpitch_bytes, int lane) {
    const int r = lane & 31, h = lane >> 5;
    f32x16 acc[2]; zero_o(acc);
    const bf16* hp = hid0 + (size_t)r * hstride + 8 * h;
#pragma unroll
    for (int k0 = 0; k0 < 16; k0 += 8) {
        bf16x8 bfr[8], af[2][8];
#pragma unroll
        for (int k = 0; k < 8; ++k) { bfr[k] = *(const GAS bf16x8*)(hp + 16 * (k0 + k));
#pragma unroll
            for (int dh = 0; dh < 2; ++dh) af[dh][k] = *(const GAS bf16x8*)(w2t + (size_t)(32 * dh + r) * 256 + 16 * (k0 + k) + 8 * h); }
#pragma unroll
        for (int k = 0; k < 8; ++k)
#pragma unroll
            for (int dh = 0; dh < 2; ++dh) acc[dh] = MFMA32(af[dh][k], bfr[k], acc[dh]);
    }
    float sc = 1.f;
    if (kcg) { float ssq = 0.f;
#pragma unroll
        for (int dh = 0; dh < 2; ++dh)
#pragma unroll
            for (int v = 0; v < 16; ++v) ssq += acc[dh][v] * acc[dh][v];
        ssq += __shfl_xor(ssq, 32); sc = 1.f / sqrtf(ssq * (1.f / 64.f) + EPS); }
#pragma unroll
    for (int dh = 0; dh < 2; ++dh)
#pragma unroll
        for (int a = 0; a < 4; ++a) { const int d0 = 32 * dh + 8 * a + 4 * h; f32x4 x = {acc[dh][4 * a], acc[dh][4 * a + 1], acc[dh][4 * a + 2], acc[dh][4 * a + 3]};
            if (kcg) x = x * *(const f32x4*)(kcg + d0) * sc;
            v2u w; w.x = cvtpk(x[0], x[1]); w.y = cvtpk(x[2], x[3]);
            if (TO_LDS) *(LAS v2u*)((LAS unsigned char*)(uintptr_t)dst + r * dpitch_bytes + d0 * 2) = w;
            else *(GAS v2u*)(dst + (size_t)r * dpitch_bytes + d0 * 2) = w; }
}

__device__ __forceinline__ int next_item(gu32* ctr, volatile LAS int* slot) {
    __syncthreads();
    if (threadIdx.x == 0) *slot = (int)__hip_atomic_fetch_add(ctr, 1u, RLX_AGENT);
    __syncthreads();
    return *slot;
}

template <bool MASKED> __device__ __forceinline__ void sb_weights_t(f32x16 (&s)[2], float& P, int kb, int tpos, int h) {
    float gp[8];
#pragma unroll
    for (int kh = 0; kh < 2; ++kh)
#pragma unroll
        for (int aa = 0; aa < 4; ++aa) { float g = 1.f;
#pragma unroll
            for (int j = 3; j >= 0; --j) { const int v = 4 * aa + j; const float z = __builtin_amdgcn_fmed3f(s[kh][v], -80.f, 80.f);
                const float e = fexp2(z * -LOG2E), r = __builtin_amdgcn_rcpf(1.f + e);
                float sg = r, om = e * r;
                if (MASKED) { const bool ok = (kb + kidx_of(kh, v, h)) < tpos; sg = ok ? sg : 0.f; om = ok ? om : 1.f; }
                s[kh][v] = sg * g;
                g *= om; }
            gp[4 * kh + aa] = g; }
    float tot = P, off[8];
#pragma unroll
    for (int ap = 7; ap >= 0; --ap) { const float mine = gp[ap], oth = xhalf(mine, h);
        off[ap] = h == 0 ? tot * oth : tot; tot *= mine * oth; }
#pragma unroll
    for (int kh = 0; kh < 2; ++kh)
#pragma unroll
        for (int v = 0; v < 16; ++v) s[kh][v] *= off[4 * kh + (v >> 2)];
    P = tot;
}
__device__ __forceinline__ void sb_weights(f32x16 (&s)[2], float& P, int kb, int tpos, int h, bool masked) {
    if (masked) sb_weights_t<true>(s, P, kb, tpos, h); else sb_weights_t<false>(s, P, kb, tpos, h);
}
#define SB_PMIN 8.7e-27f
__device__ __forceinline__ void item_l2_sample(const Args& a, int it, int lane, int wave) {
    unsigned char* ws = a.ws; const int sb = it >> 1, g = it & 1, slot = wave & 1;
    const bf16* w2t = (const bf16*)(ws + WS_W2T) + slot * 64 * 256;
    const float* kcg = slot ? nullptr : (const float*)a.in[IN_KCG];
    for (int j = 0; j < 2; ++j) { const int ch = (wave >> 1) + 4 * j;
        const bf16* hid0 = (const bf16*)(ws + WS_HIDS) + ((size_t)slot * 16384 + (size_t)(sb * 256 + 32 * ch) * 2 + g) * 256;
        unsigned char* dst = ws + (slot ? WS_VCS : WS_KCS) + ((size_t)((sb * 2 + g) * 256 + 32 * ch)) * 128;
        l2_wave<false>(w2t, hid0, 512, kcg, dst, 128, lane); }
}
__device__ __forceinline__ void item_sb_prompt(const Args& a, LAS unsigned char* lds, int it, int lane, int wave) {
    unsigned char* ws = a.ws;
    const int qb = 7 - (it >> 6), bh = it & 63, b = bh >> 3, hd = bh & 7;
    const int r = lane & 31, h = lane >> 5, tw = 256 * qb + 32 * wave, tpos = tw + r; const size_t mrow = (size_t)b * TP + tpos;
    const bf16* QA = (const bf16*)(ws + WS_QA); const bf16* KA = (const bf16*)(ws + WS_KA) + hd * 64; const bf16* VA = (const bf16*)(ws + WS_VA) + hd * 64;
    bf16x8 qf[4]; load_qf(qf, QA + mrow * 512 + hd * 64, lane);
    LAS unsigned char* Vs = lds + wave * VT_BYTES;
    f32x16 o[2]; zero_o(o);
    float C = 1.f;
    for (int kb = (tw >> 6) << 6; kb >= 0; kb -= 64) {
        const size_t krow0 = (size_t)b * TP + kb;
        v4u vr[8];
#pragma unroll
        for (int i = 0; i < 8; ++i) vr[i] = *(const GAS v4u*)(VA + (krow0 + 8 * i + (lane >> 3)) * 512 + (lane & 7) * 8);
        f32x16 s[2]; qk64_g(s, KA + krow0 * 512, 512, qf, lane);
#pragma unroll
        for (int i = 0; i < 8; ++i) *(LAS v4u*)(Vs + (8 * i + (lane >> 3)) * VP + (lane & 7) * 16) = vr[i];
        sb_weights(s, C, kb, tpos, h, kb + 64 > tw);
        asm volatile("" ::: "memory");
        pv64(o, Vs, s, lane);
        asm volatile("" ::: "memory");
        if (__all(C < SB_PMIN)) break;
    }
    const bf16* GA = (const bf16*)(ws + WS_GA) + mrow * 512 + hd * 64; bf16* U = (bf16*)(ws + WS_U) + mrow * 1024 + hd * 64;
    v2u grp[8];
#pragma unroll
    for (int dh = 0; dh < 2; ++dh)
#pragma unroll
        for (int aa = 0; aa < 4; ++aa) { const int d0 = 32 * dh + 8 * aa + 4 * h; const v2u gw = *(const GAS v2u*)(GA + d0);
            grp[4 * dh + aa].x = cvtpk(o[dh][4 * aa] * bf_lo(gw.x), o[dh][4 * aa + 1] * bf_hi(gw.x)); grp[4 * dh + aa].y = cvtpk(o[dh][4 * aa + 2] * bf_lo(gw.y), o[dh][4 * aa + 3] * bf_hi(gw.y)); }
    store_row_wide(U, grp, h);
}
__device__ __forceinline__ void item_win_prompt(const Args& a, LAS unsigned char* lds, int it, int tid, int lane, int wave) {
    unsigned char* ws = a.ws;
    const int qp = 15 - (it >> 4), bg = it & 15, b = bg >> 1, g = bg & 1, qA = 2 * qp + 1, qB = 2 * qp;
    const int r = lane & 31, h = lane >> 5, hq = 4 * g + (wave & 3), tA = 64 * qA + 32 * (wave >> 2) + r, tB = tA - 64; const size_t mA = (size_t)b * TP + tA, mB = mA - 64;
    const float slope2 = fexp2(-(float)(hq + 1)) * LOG2E;
    bf16x8 qfA[4], qfB[4]; load_qf(qfA, (const bf16*)(ws + WS_QB) + mA * 512 + hq * 64, lane); load_qf(qfB, (const bf16*)(ws + WS_QB) + mB * 512 + hq * 64, lane);
    const bf16* KW = (const bf16*)(ws + WS_KWIN) + (size_t)b * TP * 128 + g * 64; const bf16* VW = (const bf16*)(ws + WS_VWIN) + (size_t)b * TP * 128 + g * 64;
    f32x16 oA[2], oB[2]; zero_o(oA); zero_o(oB); float mAx = -1e30f, lA = 0.f, mBx = -1e30f, lB = 0.f;
    f32x16 cinit[2]; alibi_cinit(cinit, slope2);
    const int kt_lo = qB >= 8 ? qB - 8 : 0;
    { const v4u k0 = tile_ld(KW + (size_t)(64 * qA) * 128, 128, tid), v0 = tile_ld(VW + (size_t)(64 * qA) * 128, 128, tid);
      tile_st(lds, KP, tid, k0); tile_st(lds + KT_BYTES, VP, tid, v0); }
    v4u kr = {0u, 0u, 0u, 0u}, vr = {0u, 0u, 0u, 0u};
    if (qA - 1 >= kt_lo) { kr = tile_ld(KW + (size_t)(64 * (qA - 1)) * 128, 128, tid); vr = tile_ld(VW + (size_t)(64 * (qA - 1)) * 128, 128, tid); }
    int st = 0;
    for (int kt = qA; kt >= kt_lo; --kt, st ^= 1) {
        __syncthreads();
        LAS unsigned char* Ks = lds + st * (KT_BYTES + VT_BYTES); LAS unsigned char* Vs = Ks + KT_BYTES;
        if (kt - 1 >= kt_lo) { LAS unsigned char* Kn = lds + (st ^ 1) * (KT_BYTES + VT_BYTES); tile_st(Kn, KP, tid, kr); tile_st(Kn + KT_BYTES, VP, tid, vr); }
        if (kt - 2 >= kt_lo) { kr = tile_ld(KW + (size_t)(64 * (kt - 2)) * 128, 128, tid); vr = tile_ld(VW + (size_t)(64 * (kt - 2)) * 128, 128, tid); }
        const int kb = 64 * kt; const float off = slope2 * (float)(kb + 4 * h);
        if (kt >= qA - 8) { f32x16 s[2]; qk64c(s, Ks, qfA, cinit, lane);
            if (kt == qA || kt == qA - 8) sm2_tile<true>(s, mAx, lA, oA, off, true, tA - 512 - kb - 4 * h, tA - kb - 4 * h);
            else sm2_tile<false>(s, mAx, lA, oA, off, true, 0, 0);
            pv64(oA, Vs, s, lane); }
        if (kt <= qB) { f32x16 s[2]; qk64c(s, Ks, qfB, cinit, lane);
            if (kt == qB || kt == qB - 8) sm2_tile<true>(s, mBx, lB, oB, off, true, tB - 512 - kb - 4 * h, tB - kb - 4 * h);
            else sm2_tile<false>(s, mBx, lB, oB, off, true, 0, 0);
            pv64(oB, Vs, s, lane); }
    }
    lA += __shfl_xor(lA, 32); lB += __shfl_xor(lB, 32);
    const float gA = ((const float*)(ws + WS_BR))[mA * 24 + hq * 3 + 2], gB = ((const float*)(ws + WS_BR))[mB * 24 + hq * 3 + 2];
    store_ot((bf16*)(ws + WS_OW) + mA * 512 + hq * 64, oA, gA / lA, h);
    store_ot((bf16*)(ws + WS_OW) + mB * 512 + hq * 64, oB, gB / lB, h);
}

__device__ __forceinline__ void item_sb_sample(const Args& a, LAS unsigned char* lds, int it, int lane, int wave) {
    unsigned char* ws = a.ws; const int pair = it * 8 + wave, sb = pair >> 3, hd = pair & 7;
    const int r = lane & 31, h = lane >> 5, st = r & 7, tpos = 8192 + st; const size_t mrow = (size_t)MP + sb * 8 + st;
    const float* csb = (const float*)a.in[IN_CSB]; const int* pt = (const int*)a.in[IN_PT] + sb * 64;
    bf16x8 qf[4]; load_qf(qf, (const bf16*)(ws + WS_QA) + mrow * 512 + hd * 64, lane);
    LAS unsigned char* Vs = lds + wave * VT_BYTES;
    f32x16 o[2]; zero_o(o); float C = 1.f;
    for (int blk = 128; blk >= 0; --blk) {
        const float* rows = (blk == 128) ? a.out + OFF_SB + (size_t)(MP + sb * 8) * 1024 : csb + ((size_t)pt[blk >> 1] * 128 + (blk & 1) * 64) * 1024;
        const int maxrow = blk == 128 ? 7 : 63;
        const float* kbase = rows + hd * 64; const float* vbase = rows + 512 + hd * 64;
        f32x4 kt[2][4][2];
#pragma unroll
        for (int kh = 0; kh < 2; ++kh) { const float* kp = kbase + (size_t)min(32 * kh + r, maxrow) * 1024 + 8 * h;
#pragma unroll
            for (int ks = 0; ks < 4; ++ks) { kt[kh][ks][0] = *(const GAS f32x4*)(kp + 16 * ks); kt[kh][ks][1] = *(const GAS f32x4*)(kp + 16 * ks + 4); } }
        f32x4 va[4][2], vb[4][2];
#pragma unroll
        for (int i = 0; i < 4; ++i) { const float* vp = vbase + (size_t)min(8 * i + (lane >> 3), maxrow) * 1024 + (lane & 7) * 8; va[i][0] = *(const GAS f32x4*)vp; va[i][1] = *(const GAS f32x4*)(vp + 4); }
        f32x16 s[2];
#pragma unroll
        for (int kh = 0; kh < 2; ++kh) { f32x16 acc; for (int i = 0; i < 16; ++i) acc[i] = 0.f;
#pragma unroll
            for (int ks = 0; ks < 4; ++ks) { const bf16x8 kf8 = pack8(kt[kh][ks][0], kt[kh][ks][1]); __builtin_amdgcn_s_setprio(1); acc = MFMA32(kf8, qf[ks], acc); __builtin_amdgcn_s_setprio(0); }
            s[kh] = acc; }
#pragma unroll
        for (int i = 0; i < 4; ++i) { const float* vp = vbase + (size_t)min(8 * (i + 4) + (lane >> 3), maxrow) * 1024 + (lane & 7) * 8; vb[i][0] = *(const GAS f32x4*)vp; vb[i][1] = *(const GAS f32x4*)(vp + 4); }
#pragma unroll
        for (int i = 0; i < 4; ++i) *(LAS bf16x8*)(Vs + (8 * i + (lane >> 3)) * VP + (lane & 7) * 16) = pack8(va[i][0], va[i][1]);
        sb_weights(s, C, 64 * blk, tpos, h, blk == 128);
#pragma unroll
        for (int i = 0; i < 4; ++i) *(LAS bf16x8*)(Vs + (8 * (i + 4) + (lane >> 3)) * VP + (lane & 7) * 16) = pack8(vb[i][0], vb[i][1]);
        asm volatile("" ::: "memory");
        pv64(o, Vs, s, lane);
        asm volatile("" ::: "memory");
        if (__all(C < SB_PMIN)) break;
    }
    { const bf16* GA = (const bf16*)(ws + WS_GA) + mrow * 512 + hd * 64; bf16* U = (bf16*)(ws + WS_U) + mrow * 1024 + hd * 64;
      v2u grp[8];
#pragma unroll
      for (int dh = 0; dh < 2; ++dh)
#pragma unroll
          for (int aa = 0; aa < 4; ++aa) { const int d0 = 32 * dh + 8 * aa + 4 * h; const v2u gw = *(const GAS v2u*)(GA + d0);
              grp[4 * dh + aa].x = cvtpk(o[dh][4 * aa] * bf_lo(gw.x), o[dh][4 * aa + 1] * bf_hi(gw.x)); grp[4 * dh + aa].y = cvtpk(o[dh][4 * aa + 2] * bf_lo(gw.y), o[dh][4 * aa + 3] * bf_hi(gw.y)); }
      store_row_wide(U, grp, h, r < 8); }
}

#ifndef DBG_DUP
#define DBG_DUP 0
#endif

constexpr size_t WS_KCP = 230 * MiB, WS_VCP = 231 * MiB;
constexpr int P3_KC = 0, P3_VC = KT_BYTES, P3_KS = KT_BYTES + VT_BYTES  , P3_IMPW = P3_KS + 2 * (KT_BYTES + VT_BYTES)  , P3_IMP = P3_IMPW + 8 * 32 * 33 * 4,
              P3_SEL = P3_IMP + 64 * 36 * 4, P3_UM = P3_SEL + 256;
__device__ __forceinline__ void item_nsa_prompt(const Args& a, LAS unsigned char* lds, int it, int tid, int lane, int wave) {
    unsigned char* ws = a.ws;
    const int qblk = 31 - (it >> 4), bg = it & 15, b = bg >> 1, g = bg & 1, cur = qblk;
    const int r = lane & 31, h = lane >> 5, hq = 4 * g + (wave & 3), th = wave >> 2, tpos = 64 * qblk + 32 * th + r; const size_t mrow = (size_t)b * TP + tpos;
    const float slope2 = fexp2(-(float)(hq + 1)) * LOG2E;
    { const bf16* KCP = (const bf16*)(ws + WS_KCP) + (size_t)(b * 2 + g) * 4096; const bf16* VCP = (const bf16*)(ws + WS_VCP) + (size_t)(b * 2 + g) * 4096;
      const v4u k0 = tile_ld(KCP, 64, tid), v0 = tile_ld(VCP, 64, tid); tile_st(lds + P3_KC, KP, tid, k0); tile_st(lds + P3_VC, VP, tid, v0); }
    bf16x8 qf[4]; load_qf(qf, (const bf16*)(ws + WS_QB) + mrow * 512 + hq * 64, lane);
    __syncthreads();
    f32x16 oc[2];
    for (int dupp = 0; dupp < ((DBG_DUP & 128) ? 2 : 1); ++dupp) { if (dupp) __syncthreads();
    zero_o(oc);
    { f32x16 s[2]; qk64(s, lds + P3_KC, qf, lane);
      float mx = -1e30f;
#pragma unroll
      for (int kh = 0; kh < 2; ++kh)
#pragma unroll
          for (int v = 0; v < 16; ++v) { const int ce = 32 * kidx_of(kh, v, h) + 31, dist = tpos - ce; const float x = dist >= 0 ? s[kh][v] - slope2 * (float)dist : -INFINITY; s[kh][v] = x; mx = fmaxf(mx, x); }
      mx = fmaxf(mx, __shfl_xor(mx, 32));
      float sum = 0.f;
#pragma unroll
      for (int kh = 0; kh < 2; ++kh)
#pragma unroll
          for (int v = 0; v < 16; ++v) { const float e = fexp2(s[kh][v] - mx); s[kh][v] = e; sum += e; }
      sum += __shfl_xor(sum, 32);
      const float inv = sum > 0.f ? 1.f / sum : 1.f;
#pragma unroll
      for (int kh = 0; kh < 2; ++kh)
#pragma unroll
          for (int v = 0; v < 16; ++v) s[kh][v] *= inv;
      LAS float* impw = (LAS float*)(lds + P3_IMPW) + (wave * 32 + r) * 33;
#pragma unroll
      for (int kh = 0; kh < 2; ++kh)
#pragma unroll
          for (int aa = 0; aa < 4; ++aa)
#pragma unroll
              for (int b2 = 0; b2 < 2; ++b2) impw[16 * kh + 4 * aa + 2 * h + b2] = s[kh][4 * aa + 2 * b2] + s[kh][4 * aa + 2 * b2 + 1];
      pv64(oc, lds + P3_VC, s, lane);
    }
    __syncthreads();
    { const int tk = tid >> 3, j8 = tid & 7; LAS float* imp = (LAS float*)(lds + P3_IMP) + tk * 36;
      const LAS float* iw = (const LAS float*)(lds + P3_IMPW) + (((tk >> 5) * 4) * 32 + (tk & 31)) * 33;
#pragma unroll
      for (int j = 0; j < 4; ++j) { const int blk = 4 * j8 + j; imp[blk] = (iw[blk] + iw[32 * 33 + blk]) + (iw[2 * 32 * 33 + blk] + iw[3 * 32 * 33 + blk]); }
      __syncthreads();
      unsigned bits = 0u;
      if (cur <= 15) bits = 0xffffffffu;
      else {
          float y[32];
#pragma unroll
          for (int q4 = 0; q4 < 8; ++q4) { const f32x4 v = *(const LAS f32x4*)(imp + 4 * q4); y[4 * q4] = v.x; y[4 * q4 + 1] = v.y; y[4 * q4 + 2] = v.z; y[4 * q4 + 3] = v.w; }
#pragma unroll
          for (int j = 0; j < 4; ++j) { const int blk = 4 * j8 + j;
              if (blk == 0 || blk == cur || blk == cur - 1) bits |= 1u << blk;
              else if (blk < cur - 1) { float x = 0.f;
#pragma unroll
                  for (int o2 = 0; o2 < 32; ++o2) x = (o2 == blk) ? y[o2] : x;
                  int rank = 0;
#pragma unroll
                  for (int o2 = 1; o2 < 30; ++o2) rank += (o2 <= cur - 2 && (y[o2] > x || (y[o2] == x && o2 < blk))) ? 1 : 0;
                  if (rank < 13) bits |= 1u << blk; } } }
      bits |= __shfl_xor(bits, 1); bits |= __shfl_xor(bits, 2); bits |= __shfl_xor(bits, 4);
      if (j8 == 0) ((LAS unsigned*)(lds + P3_SEL))[tk] = bits;
      __syncthreads();
      if (wave == 0) { unsigned um = ((const LAS unsigned*)(lds + P3_SEL))[lane];
#pragma unroll
          for (int o2 = 1; o2 < 64; o2 <<= 1) um |= __shfl_xor(um, o2);
          if (lane == 0) *(LAS unsigned*)(lds + P3_UM) = um; }
      __syncthreads();
    }
    }
    const unsigned selbits = ((const LAS unsigned*)(lds + P3_SEL))[32 * th + r], umask = *(const LAS unsigned*)(lds + P3_UM);
    f32x16 os[2]; zero_o(os); float m = -1e30f, l = 0.f;
    f32x16 cinit[2]; alibi_cinit(cinit, slope2);
    { const bf16* KS = (const bf16*)(ws + WS_KSEL) + (size_t)b * TP * 128 + g * 64; const bf16* VS = (const bf16*)(ws + WS_VSEL) + (size_t)b * TP * 128 + g * 64;
      unsigned todo = umask & (cur >= 31 ? 0xffffffffu : ((2u << cur) - 1u));
      int blk = 31 - __builtin_clz(todo); todo &= ~(1u << blk);
      int nb1 = todo ? 31 - __builtin_clz(todo) : -1; if (nb1 >= 0) todo &= ~(1u << nb1);
      { const v4u k0 = tile_ld(KS + (size_t)(64 * blk) * 128, 128, tid), v0 = tile_ld(VS + (size_t)(64 * blk) * 128, 128, tid);
        tile_st(lds + P3_KS, KP, tid, k0); tile_st(lds + P3_KS + KT_BYTES, VP, tid, v0); }
      v4u kr = {0u, 0u, 0u, 0u}, vr = {0u, 0u, 0u, 0u};
      if (nb1 >= 0) { kr = tile_ld(KS + (size_t)(64 * nb1) * 128, 128, tid); vr = tile_ld(VS + (size_t)(64 * nb1) * 128, 128, tid); }
      int st = 0;
      for (;;) {
          __syncthreads();
          LAS unsigned char* Ks = lds + P3_KS + st * (KT_BYTES + VT_BYTES); LAS unsigned char* Vs = Ks + KT_BYTES;
          if (nb1 >= 0) { LAS unsigned char* Kn = lds + P3_KS + (st ^ 1) * (KT_BYTES + VT_BYTES); tile_st(Kn, KP, tid, kr); tile_st(Kn + KT_BYTES, VP, tid, vr); }
          const int nb2 = todo ? 31 - __builtin_clz(todo) : -1; if (nb2 >= 0) todo &= ~(1u << nb2);
          if (nb2 >= 0) { kr = tile_ld(KS + (size_t)(64 * nb2) * 128, 128, tid); vr = tile_ld(VS + (size_t)(64 * nb2) * 128, 128, tid); }
          const int kb = 64 * blk; const bool mine = (selbits >> blk) & 1u;
          if (__any(mine)) {
              for (int dupc = 0; dupc < ((DBG_DUP & 32) ? 2 : 1); ++dupc) {
              f32x16 s[2]; qk64c(s, Ks, qf, cinit, lane);
              const float off = slope2 * (float)(kb + 4 * h);
              if (blk == cur) sm2_tile<true>(s, m, l, os, off, mine && dupc == 0, -(1 << 30), tpos - kb - 4 * h);
              else sm2_tile<false>(s, m, l, os, off, mine && dupc == 0, 0, 0);
              pv64(os, Vs, s, lane); } }
          if (nb1 < 0) break;
          blk = nb1; nb1 = nb2; st ^= 1;
      } }
    l += __shfl_xor(l, 32);
    { const float* br = (const float*)(ws + WS_BR) + mrow * 24 + hq * 3; const float g0 = br[0], g1 = br[1] / l;
      const bf16* OW = (const bf16*)(ws + WS_OW) + mrow * 512 + hq * 64; const bf16* GB = (const bf16*)(ws + WS_GB) + mrow * 512 + hq * 64; bf16* U = (bf16*)(ws + WS_U) + mrow * 1024 + 512 + hq * 64;
      v2u grp[8];
#pragma unroll
      for (int dh = 0; dh < 2; ++dh)
#pragma unroll
          for (int aa = 0; aa < 4; ++aa) { const int d0 = 32 * dh + 8 * aa + 4 * h; const v2u ow = *(const GAS v2u*)(OW + d0), gb = *(const GAS v2u*)(GB + d0);
              const float x0 = (g0 * oc[dh][4 * aa] + g1 * os[dh][4 * aa] + bf_lo(ow.x)) * bf_lo(gb.x), x1 = (g0 * oc[dh][4 * aa + 1] + g1 * os[dh][4 * aa + 1] + bf_hi(ow.x)) * bf_hi(gb.x);
              const float x2 = (g0 * oc[dh][4 * aa + 2] + g1 * os[dh][4 * aa + 2] + bf_lo(ow.y)) * bf_lo(gb.y), x3 = (g0 * oc[dh][4 * aa + 3] + g1 * os[dh][4 * aa + 3] + bf_hi(ow.y)) * bf_hi(gb.y);
              grp[4 * dh + aa].x = cvtpk(x0, x1); grp[4 * dh + aa].y = cvtpk(x2, x3); }
      store_row_wide(U, grp, h); }
}

constexpr int SM_V = 0, SM_ACC = 8 * VT_BYTES  , SM_ST = SM_ACC + 8192, SM_IMP = SM_ST + 3 * 8 * 32 * 2 * 4  , SM_SELW = SM_IMP + 8 * 128 * 4, SM_END = SM_SELW + 128;
static_assert(SM_END <= RING_BYTES, "sample NSA LDS map");
template <class F> __device__ __forceinline__ void sm_tile_f32(f32x16 (&o)[2], float& m, float& l, const float* kbase, const float* vbase, int stride, int maxrow, LAS unsigned char* Vs, const bf16x8 (&qf)[4], int lane, F&& biasf) {
    const int h = lane >> 5;
    f32x4 kt[2][4][2];
#pragma unroll
    for (int kh = 0; kh < 2; ++kh) { const int row = min(32 * kh + (lane & 31), maxrow); const float* kp = kbase + (size_t)row * stride + 8 * h;
#pragma unroll
        for (int ks = 0; ks < 4; ++ks) { kt[kh][ks][0] = *(const GAS f32x4*)(kp + 16 * ks); kt[kh][ks][1] = *(const GAS f32x4*)(kp + 16 * ks + 4); } }
    f32x4 va[4][2], vb[4][2];
#pragma unroll
    for (int i = 0; i < 4; ++i) { const float* vp = vbase + (size_t)min(8 * i + (lane >> 3), maxrow) * stride + (lane & 7) * 8; va[i][0] = *(const GAS f32x4*)vp; va[i][1] = *(const GAS f32x4*)(vp + 4); }
    f32x16 s[2];
#pragma unroll
    for (int kh = 0; kh < 2; ++kh) { f32x16 acc; for (int i = 0; i < 16; ++i) acc[i] = 0.f;
#pragma unroll
        for (int ks = 0; ks < 4; ++ks) { const bf16x8 kf8 = pack8(kt[kh][ks][0], kt[kh][ks][1]); __builtin_amdgcn_s_setprio(1); acc = MFMA32(kf8, qf[ks], acc); __builtin_amdgcn_s_setprio(0); }
        s[kh] = acc; }
#pragma unroll
    for (int i = 0; i < 4; ++i) { const float* vp = vbase + (size_t)min(8 * (i + 4) + (lane >> 3), maxrow) * stride + (lane & 7) * 8; vb[i][0] = *(const GAS f32x4*)vp; vb[i][1] = *(const GAS f32x4*)(vp + 4); }
#pragma unroll
    for (int i = 0; i < 4; ++i) *(LAS bf16x8*)(Vs + (8 * i + (lane >> 3)) * VP + (lane & 7) * 16) = pack8(va[i][0], va[i][1]);
    softmax_tile(s, m, l, o, h, biasf);
#pragma unroll
    for (int i = 0; i < 4; ++i) *(LAS bf16x8*)(Vs + (8 * (i + 4) + (lane >> 3)) * VP + (lane & 7) * 16) = pack8(vb[i][0], vb[i][1]);
    asm volatile("" ::: "memory");
    pv64(o, Vs, s, lane);
    asm volatile("" ::: "memory");
}
__device__ __forceinline__ void sm_put_stats(LAS float* st, int br, int wave, int lane, float m, float l) { if (lane < 32) { st[((br * 8 + wave) * 32 + lane) * 2] = m; st[((br * 8 + wave) * 32 + lane) * 2 + 1] = l; } }
__device__ __forceinline__ void sm_get_ML(const LAS float* st, int br, int r, float& M, float& L) {
    M = -1e30f;
#pragma unroll
    for (int w = 0; w < 8; ++w) M = fmaxf(M, st[((br * 8 + w) * 32 + r) * 2]);
    L = 0.f;
#pragma unroll
    for (int w = 0; w < 8; ++w) L += st[((br * 8 + w) * 32 + r) * 2 + 1] * fexp2(st[((br * 8 + w) * 32 + r) * 2] - M);
}
__device__ __forceinline__ void sm_put(LAS float* slice, const f32x16 (&o)[2], float f, int lane) {
    const int r = lane & 31, h = lane >> 5;
#pragma unroll
    for (int dh = 0; dh < 2; ++dh)
#pragma unroll
        for (int v = 0; v < 16; ++v) { const int d = 32 * dh + (v & 3) + 8 * (v >> 2) + 4 * h; slice[d * 32 + r] = o[dh][v] * f; }
}
__device__ __forceinline__ void item_nsa_sample(const Args& a, LAS unsigned char* lds, int it, int tid, int lane, int wave) {
    unsigned char* ws = a.ws; const int sb = it >> 1, g = it & 1;
    const int r = lane & 31, h = lane >> 5, st = r >> 2, hh = r & 3, hq = 4 * g + hh, t = 8192 + st; const size_t mrow = (size_t)MP + sb * 8 + st;
    const float* cn = (const float*)a.in[IN_CNSA]; const int* pt = (const int*)a.in[IN_PT] + sb * 64; const float* sw = (const float*)a.in[IN_SWIN];
    LAS unsigned char* Vs = lds + SM_V + wave * VT_BYTES; LAS float* acc = (LAS float*)(lds + SM_ACC); LAS float* stt = (LAS float*)(lds + SM_ST); LAS float* imp = (LAS float*)(lds + SM_IMP);
    LAS unsigned long long* selw = (LAS unsigned long long*)(lds + SM_SELW);
    const float slope2 = fexp2(-(float)(hq + 1)) * LOG2E;
    const float* br = (const float*)(ws + WS_BR) + mrow * 24 + hq * 3; const float g0 = br[0], g1 = br[1], g2 = br[2];
    bf16x8 qf[4]; load_qf(qf, (const bf16*)(ws + WS_QB) + mrow * 512 + hq * 64, lane);
    f32x16 ow[2]; zero_o(ow); float mw = -1e30f, lw = 0.f;
#pragma unroll 1
    for (int pass = 0; pass < 2; ++pass) { if (pass == 1 && wave != 4) break;
        const int j = pass == 0 ? wave : 8, i0 = 64 * j;
        const float* rows = (j < 8) ? sw + ((size_t)(sb * 512 + i0)) * 256 : a.out + OFF_WINS + ((size_t)(sb * 512 + 504)) * 256;
        sm_tile_f32(ow, mw, lw, rows + g * 64, rows + 128 + g * 64, 256, j < 8 ? 63 : 7, Vs, qf, lane, [&](int ki) { const int i = i0 + ki, dist = t - (7680 + i); return (i < 520 && dist >= 0 && dist < 512) ? -slope2 * (float)dist : -INFINITY; }); }
    if (DBG_DUP & 4) { f32x16 o2[2]; zero_o(o2); float m2 = -1e30f, l2 = 0.f;
#pragma unroll 1
        for (int pass = 0; pass < 2; ++pass) { if (pass == 1 && wave != 4) break;
            const int j = pass == 0 ? wave : 8, i0 = 64 * j;
            const float* rows = (j < 8) ? sw + ((size_t)(sb * 512 + i0)) * 256 : a.out + OFF_WINS + ((size_t)(sb * 512 + 504)) * 256;
            sm_tile_f32(o2, m2, l2, rows + g * 64, rows + 128 + g * 64, 256, j < 8 ? 63 : 7, Vs, qf, lane, [&](int ki) { const int i = i0 + ki, dist = t - (7680 + i); return (i < 520 && dist >= 0 && dist < 512) ? -slope2 * (float)dist : -INFINITY; }); }
        if (m2 == 12345.f) ow[0][0] += o2[0][0] + l2; }
    lw += __shfl_xor(lw, 32);
    sm_put_stats(stt, 2, wave, lane, mw, lw);
    f32x16 oc[2]; zero_o(oc); f32x16 ec[2]; float mc = -1e30f, lc = 0.f;
    if (wave < 4) {
        const bf16* KC = (const bf16*)(ws + WS_KCS) + ((size_t)((sb * 2 + g) * 256 + 64 * wave)) * 64; const bf16* VC = (const bf16*)(ws + WS_VCS) + ((size_t)((sb * 2 + g) * 256 + 64 * wave)) * 64;
        v4u vr[8];
#pragma unroll
        for (int i = 0; i < 8; ++i) vr[i] = *(const GAS v4u*)(VC + (size_t)(8 * i + (lane >> 3)) * 64 + (lane & 7) * 8);
        qk64_g(ec, KC, 64, qf, lane);
#pragma unroll
        for (int i = 0; i < 8; ++i) *(LAS v4u*)(Vs + (8 * i + (lane >> 3)) * VP + (lane & 7) * 16) = vr[i];
        const int c0 = 64 * wave;
        softmax_tile(ec, mc, lc, oc, h, [&](int ki) { return -slope2 * (float)(t - (32 * (c0 + ki) + 31)); });
        asm volatile("" ::: "memory");
        pv64(oc, Vs, ec, lane);
        asm volatile("" ::: "memory");
        lc += __shfl_xor(lc, 32);
    }
    sm_put_stats(stt, 0, wave, lane, mc, lc);
    __syncthreads();
    LAS float* mbuf = (LAS float*)(lds + SM_V);
    { float M, L; sm_get_ML(stt, 2, r, M, L); sm_put(mbuf + wave * 2048, ow, (L > 0.f) ? g2 * fexp2(mw - M) / L : 0.f, lane); }
    if (wave < 4) { float M, L; sm_get_ML(stt, 0, r, M, L); const float f = fexp2(mc - M) / L;
        sm_put(mbuf + (8 + wave) * 2048, oc, g0 * f, lane);
#pragma unroll
        for (int kh = 0; kh < 2; ++kh)
#pragma unroll
            for (int aa = 0; aa < 4; ++aa)
#pragma unroll
                for (int b2 = 0; b2 < 2; ++b2) { float v = (ec[kh][4 * aa + 2 * b2] + ec[kh][4 * aa + 2 * b2 + 1]) * f; v += __shfl_xor(v, 1); v += __shfl_xor(v, 2);
                    if (hh == 0) imp[st * 128 + 32 * wave + 16 * kh + 4 * aa + 2 * h + b2] = v; } }
    __syncthreads();
    { f32x4 sum = {0.f, 0.f, 0.f, 0.f};
#pragma unroll
      for (int w = 0; w < 12; ++w) sum += *(const LAS f32x4*)(mbuf + w * 2048 + tid * 4);
      *(LAS f32x4*)(acc + tid * 4) = sum; }
    for (int dup = 0; dup < ((DBG_DUP & 2) ? 2 : 1); ++dup)
    { const LAS float* im = imp + wave * 128; bool s0, s1;
      { const int blk = lane; if (blk == 0) s0 = true; else { const float x = im[blk]; int rank = 0; for (int o2 = 1; o2 <= 126; ++o2) { const float y = im[o2]; rank += (y > x || (y == x && o2 < blk)) ? 1 : 0; } s0 = rank < 13; } }
      { const int blk = lane + 64; if (blk == 127) s1 = true; else { const float x = im[blk]; int rank = 0; for (int o2 = 1; o2 <= 126; ++o2) { const float y = im[o2]; rank += (y > x || (y == x && o2 < blk)) ? 1 : 0; } s1 = rank < 13; } }
      const unsigned long long b0 = __ballot(s0), b1 = __ballot(s1);
      if (lane == 0) { selw[2 * wave] = b0; selw[2 * wave + 1] = b1; } }
    __syncthreads();
    f32x16 os[2]; zero_o(os); float ms = -1e30f, ls = 0.f;
    { unsigned long long u0 = 0ull, u1 = 0ull;
#pragma unroll
      for (int s8 = 0; s8 < 8; ++s8) { u0 |= selw[2 * s8]; u1 |= selw[2 * s8 + 1]; }
      const unsigned long long my0 = selw[2 * st], my1 = selw[2 * st + 1];
      int cnt = 0;
      for (int dup8 = 0; dup8 < ((DBG_DUP & 8) ? 2 : 1); ++dup8)
      for (int half = 0; half < 3; ++half) { unsigned long long bits = half == 0 ? u0 : (half == 1 ? u1 : 1ull);
          while (bits) { const int bi = __builtin_ctzll(bits); bits &= bits - 1; const int blk = 64 * half + bi;
              if ((cnt++ & 7) != wave) continue;
              const float* rows = (blk < 128) ? cn + ((size_t)pt[blk >> 1] * 128 + (blk & 1) * 64) * 512 : a.out + OFF_NSA + ((size_t)(MP + sb * 8)) * 512;
              const bool mine = (dup8 == 0) && (half == 0 ? ((my0 >> bi) & 1ull) : (half == 1 ? ((my1 >> bi) & 1ull) : true));
              const int kb = 64 * blk;
              sm_tile_f32(os, ms, ls, rows + 256 + g * 64, rows + 384 + g * 64, 512, blk < 128 ? 63 : 7, Vs, qf, lane, [&](int ki) { const int dist = t - (kb + ki); return (mine && dist >= 0) ? -slope2 * (float)dist : -INFINITY; }); } } }
    ls += __shfl_xor(ls, 32);
    sm_put_stats(stt, 1, wave, lane, ms, ls);
    __syncthreads();
    { float M, L; sm_get_ML(stt, 1, r, M, L); sm_put(mbuf + wave * 2048, os, (L > 0.f) ? g1 * fexp2(ms - M) / L : 0.f, lane); }
    __syncthreads();
    { f32x4 sum = *(const LAS f32x4*)(acc + tid * 4);
#pragma unroll
      for (int w = 0; w < 8; ++w) sum += *(const LAS f32x4*)(mbuf + w * 2048 + tid * 4);
      *(LAS f32x4*)(acc + tid * 4) = sum; }
    __syncthreads();
    { const int r2 = tid >> 4, d4 = (tid & 15) * 4; const size_t m2 = (size_t)MP + sb * 8 + (r2 >> 2); const int hq2 = 4 * g + (r2 & 3);
      const v2u gb = *(const GAS v2u*)((const bf16*)(ws + WS_GB) + m2 * 512 + hq2 * 64 + d4);
      v2u w; w.x = cvtpk(acc[(d4 + 0) * 32 + r2] * bf_lo(gb.x), acc[(d4 + 1) * 32 + r2] * bf_hi(gb.x)); w.y = cvtpk(acc[(d4 + 2) * 32 + r2] * bf_lo(gb.y), acc[(d4 + 3) * 32 + r2] * bf_hi(gb.y));
      *(GAS v2u*)((bf16*)(ws + WS_U) + m2 * 1024 + 512 + hq2 * 64 + d4) = w; }
}

#ifndef MK_N_LAUNCHES
#define MK_N_LAUNCHES 1
#endif
#ifndef DBG_STAGE
#define DBG_STAGE 0
#endif
constexpr int N_PHASES = 6;
constexpr int N_L2S = 64, N_SBS = 32, N_WINP = 256, N_SBP = 512, N_NP = 512, N_NS = 64;

__global__ void __launch_bounds__(NTHR, 2) mk_fwd(Args a) {
    extern __shared__ __attribute__((aligned(16))) unsigned char lds_raw[];
    LAS unsigned char* lds = (LAS unsigned char*)lds_raw;
    const int tid0 = threadIdx.x;
    const int G = gridDim.x, bx = blockIdx.x, vcu = (G % 8 == 0) ? (bx % 8) * (G / 8) + bx / 8 : bx;
    unsigned char* ws = a.ws; gu32* ctl = (gu32*)(ws + WS_CTL);
    for (int u = tid0; u < (LDS_BYTES - LDSCTL_OFF) / 4; u += NTHR) ((LAS unsigned*)(lds + LDSCTL_OFF))[u] = 0u;
    __syncthreads();
    volatile LAS unsigned* MISC = (volatile LAS unsigned*)(lds + MISC_OFF);
    volatile LAS int* qslot = (volatile LAS int*)(lds + LDSCTL_OFF + 64);
    const int lo = a.ph_lo, hi = a.ph_hi; const bool multi = (hi - lo) > 1;
    XcdBarrier bar; bar.bar = (unsigned*)(ctl + CW_BAR); bar.x = 0; bar.st = nullptr;
    if (multi) bar = xcd_barrier_post((unsigned*)(ctl + CW_BAR), MISC + 8);
#ifdef DBG_PHMASK
#define IN(k) (((DBG_PHMASK >> (k)) & 1) && lo <= (k) && (k) < hi)
#else
#define IN(k) (lo <= (k) && (k) < hi)
#endif
#define SEAM(k) do { if (IN(k) && IN((k) + 1)) xcd_barrier(bar); } while (0)
#ifndef DBG_REP
#define DBG_REP (-1)
#endif
#define NREP(k) ((DBG_REP == (k)) ? 2 : 1)
#define REPSEAM(k) do { if (rep + 1 < NREP(k)) xcd_barrier(bar); } while (0)

    if (IN(0)) _Pragma("unroll") for (int rep = 0; rep < NREP(0); ++rep) { int tid = tid0; asm volatile("" : "+v"(tid)); p0_prologue(a, lds, tid, tid & 63, __builtin_amdgcn_readfirstlane(tid >> 6), vcu, G, rep); REPSEAM(0); }
    SEAM(0);

    if (IN(1)) { _Pragma("unroll") for (int rep = 0; rep < NREP(1); ++rep) {
#ifndef DBG_P1MASK
#define DBG_P1MASK 7
#endif
        const int xcc = (int)xb_xcc_id(); volatile LAS int* gslot = (volatile LAS int*)(lds + LDSCTL_OFF + 128);
#ifndef DBG_P1REPM
#define DBG_P1REPM 7
#endif
#define P1ON(bit) ((DBG_P1MASK & (bit)) && (rep == 0 || (DBG_P1REPM & (bit))))
        const int ngb = G < 128 ? G : 128;
        if (P1ON(1) && bx < ngb) {
#pragma unroll 1
            for (int L = bx; L < 256; L += ngb) {
                pg8::EpiHidB128 E{(bf16*)(ws + WS_HIDS), (const float*)(ws + WS_CTL) + CW_BIAS + (L >> 7) * 256};
                pg8::gemm_unit_gather128(lds, (const float*)a.in[IN_CNSA], (const int*)a.in[IN_PT], (const bf16*)(ws + WS_W1T), L, E); } }
        if (P1ON(4)) { pg8::Gemm g{(const bf16*)(ws + WS_HBF), (const bf16*)(ws + WS_WIN_T), MT, NG1, 1024};
          pg8::HybridOrder S; S.q = (unsigned*)(ctl + CW_Q + 64 * 16 + 4096 * rep); S.slot = gslot; S.nM = MT / 256; S.nN = NG1 / 256; S.nwg = S.nM * S.nN; S.dyn0 = 640;
          if (G != 256) { S.ns = 0; S.l0 = 0; S.lstride = 0; S.dyn0 = 0; }
          else if (bx >= 128) { S.ns = 4; S.l0 = bx - 128; S.lstride = 128; } else { S.ns = 1; S.l0 = 512 + bx; S.lstride = 0; }
#ifdef DBG_G1STATIC
          if (rep == 1) { S.ns = 4; S.l0 = bx; S.lstride = 256; S.dyn0 = 975; if (bx + 768 >= 975) S.ns = 3; }
#endif
          pg8::EpiG1 E{a.out, (const float*)(ws + WS_RSTD), (bf16*)(ws + WS_QA), (bf16*)(ws + WS_KA), (bf16*)(ws + WS_VA), (bf16*)(ws + WS_GA), (bf16*)(ws + WS_QB), (bf16*)(ws + WS_GB),
                       (bf16*)(ws + WS_KSEL), (bf16*)(ws + WS_VSEL), (bf16*)(ws + WS_KWIN), (bf16*)(ws + WS_VWIN), (bf16*)(ws + WS_ACMP_P),
                       (const float*)a.in[IN_QG], (const float*)a.in[IN_KSG], (const float*)a.in[IN_KWG], (const float*)a.in[IN_PEK], (const float*)a.in[IN_PEV]};
#ifdef DBG_NOEPI
#if DBG_NOEPI == 2
#ifdef DBG_TILECONTIG
          if (rep == 1) { pg8::EpiBf16<0> E0{(bf16*)(ws + WS_ACMP_S), 256, nullptr, 256, (size_t)65 * 65536, 1.f};
#else
          if (rep == 1) { pg8::EpiBf16<0> E0{(bf16*)(ws + WS_ACMP_S), NG1, nullptr, 0, 0, 1.f};
#endif
          pg8::gemm_phase<pg8::EpiBf16<0>, pg8::HybridOrder, PG8_ALIGN, PG8_SP2>(lds, g, S, E0); } else
#else
          if (rep == 1) { pg8::EpiNone E0; pg8::gemm_phase<pg8::EpiNone, pg8::HybridOrder, PG8_ALIGN, PG8_SP2>(lds, g, S, E0); } else
#endif
#endif
          pg8::gemm_phase<pg8::EpiG1, pg8::HybridOrder, PG8_ALIGN, PG8_SP2>(lds, g, S, E); }
#ifndef SEAM1_BARRIER
        { VM_WAIT(); __syncthreads();
          if (tid0 == 0) { __builtin_amdgcn_s_waitcnt(0);
              const unsigned nloc = bar.st[0]; const unsigned old = __hip_atomic_fetch_add(ctl + CW_Q + 64 * (61 + (int)bar.x), 1u, RLX_AGENT);
              if (old + 1u == nloc * (unsigned)(rep + 1)) { __builtin_amdgcn_fence(__ATOMIC_RELEASE, "agent"); VM_WAIT(); (void)__hip_atomic_fetch_add(ctl + CW_Q + 64 * 60, 1u, RLX_AGENT); } } }
#endif
        if (P1ON(2)) { pg8::Gemm g{(const bf16*)(ws + WS_PBF), (const bf16*)(ws + WS_WPLE_T), MT, 1024, 256}; pg8::XcdQueueOrder S; S.init(MT, 1024, (unsigned*)(ctl + CW_Q + 64 * 24 + 4096 * rep), gslot, xcc);
          pg8::EpiBf16<0> E{(bf16*)(ws + WS_T1), 1024, nullptr, 0, 0, 1.f};
          pg8::gemm_phase<pg8::EpiBf16<0>, pg8::XcdQueueOrder, PG8_ALIGN, PG8_SP2, true>(lds, g, S, E); }
        REPSEAM(1); }
#ifdef SEAM1_BARRIER
        SEAM(1);
#else
        if (IN(1) && IN(2)) {
            if (tid0 == 0) { unsigned sp = 0; while (__hip_atomic_load(ctl + CW_Q + 64 * 60, RLX_AGENT) < bar.st[1] * (unsigned)NREP(1)) { __builtin_amdgcn_s_sleep(2); if (++sp > (1u << 22)) break; }
                __builtin_amdgcn_fence(__ATOMIC_ACQUIRE, "agent"); VM_WAIT(); }
            __syncthreads(); }
#endif
    }

    if (IN(2)) { _Pragma("unroll") for (int rep = 0; rep < NREP(2); ++rep) {
#if DBG_STAGE == 1
        { v4u z = {0u, 0u, 0u, 0u}; for (size_t i = (size_t)bx * NTHR + tid0; i < (size_t)MT * 1024 / 8; i += (size_t)G * NTHR) *(GAS v4u*)((bf16*)(ws + WS_U) + i * 8) = z; }
#else
        if (bx < 16) {
            const int slot = bx >> 3, b = bx & 7;
            { pg8::EpiHidB128 E{(bf16*)(ws + WS_HIDP), (const float*)(ws + WS_CTL) + CW_BIAS + 1024  };
              pg8::gemm_unit_bf16_128(lds, (const bf16*)(ws + WS_ACMP_P) + (size_t)bx * 128 * 2048, (const bf16*)(ws + WS_W1T), slot, bx * 128, E); }
            VM_WAIT(); __syncthreads();
            int t2 = tid0; asm volatile("" : "+v"(t2)); const int ln = t2 & 63, wv = __builtin_amdgcn_readfirstlane(t2 >> 6);
            if (wv < 4) { const int g = wv >> 1, chf = wv & 1;
                const bf16* hid0 = (const bf16*)(ws + WS_HIDP) + ((size_t)slot * 1024 + (size_t)(b * 64 + 32 * chf) * 2 + g) * 256;
                unsigned char* dst = ws + (slot ? WS_VCP : WS_KCP) + ((size_t)((b * 2 + g) * 64 + 32 * chf)) * 128;
                l2_wave<false>((const bf16*)(ws + WS_W2T) + slot * 64 * 256, hid0, 512, slot ? nullptr : (const float*)a.in[IN_KCG], dst, 128, ln); } }
        bool arrived = false;
        for (;;) {
            int it = next_item(ctl + CW_Q + 128 * rep, qslot);
            int tid = tid0; asm volatile("" : "+v"(tid)); const int lane = tid & 63, wave = __builtin_amdgcn_readfirstlane(tid >> 6);
            if (!arrived && it >= N_NS + N_SBS + N_WINP) { arrived = true; VM_WAIT(); __syncthreads();
                if (tid == 0) { __builtin_amdgcn_s_waitcnt(0);
                    const unsigned nloc = bar.st[0]; const unsigned old = __hip_atomic_fetch_add(ctl + CW_Q + 64 * (43 + (int)bar.x), 1u, RLX_AGENT);
                    if (old + 1u == nloc * (unsigned)(rep + 1)) { __builtin_amdgcn_fence(__ATOMIC_RELEASE, "agent"); VM_WAIT(); (void)__hip_atomic_fetch_add(ctl + CW_Q + 64 * 42, 1u, RLX_AGENT); } } }
            if (it >= N_NS + N_SBS + N_WINP + N_SBP) break;
#ifndef DBG_IM
#define DBG_IM 63
#endif
#ifndef DBG_REPIM
#define DBG_REPIM 63
#endif
#define IMON(bit) ((DBG_IM & (bit)) && (rep == 0 || (DBG_REPIM & (bit))))
            if (it < N_NS) { if (IMON(32)) { item_l2_sample(a, it, lane, wave); if (DBG_DUP & 1) { VM_WAIT(); item_l2_sample(a, it, lane, wave); } VM_WAIT(); __syncthreads(); item_nsa_sample(a, lds, it, tid, lane, wave); if (DBG_DUP & 16) { __syncthreads(); item_nsa_sample(a, lds, it, tid, lane, wave); } } continue; } it -= N_NS;
            if (it < N_SBS) { if (IMON(2)) item_sb_sample(a, lds, it, lane, wave); continue; } it -= N_SBS;
            if (it < N_WINP) { if (IMON(4)) item_win_prompt(a, lds, it, tid, lane, wave); continue; } it -= N_WINP;
            if (IMON(8)) item_sb_prompt(a, lds, it, lane, wave);
        }
#endif
        REPSEAM(2); }
#ifdef SEAM2_BARRIER
        SEAM(2);
#else
        if (IN(2) && IN(3)) {
            if (tid0 == 0) { unsigned sp = 0; while (__hip_atomic_load(ctl + CW_Q + 64 * 42, RLX_AGENT) < bar.st[1] * (unsigned)NREP(2)) { __builtin_amdgcn_s_sleep(2); if (++sp > (1u << 22)) break; }
                __builtin_amdgcn_fence(__ATOMIC_ACQUIRE, "agent"); VM_WAIT(); }
            __syncthreads(); }
#endif
    }

    if (IN(3)) { _Pragma("unroll") for (int rep = 0; rep < NREP(3); ++rep) {
#if DBG_STAGE != 1
        for (;;) {
            int it = next_item(ctl + CW_Q + 64 + 128 * rep, qslot);
            int tid = tid0; asm volatile("" : "+v"(tid)); const int lane = tid & 63, wave = __builtin_amdgcn_readfirstlane(tid >> 6);
            if (it >= N_NP + 8) break;
            gu32* dep1 = ctl + CW_Q + 64 * 41;
            if (it < 4 || (it >= 300 && it < 304)) {
                const bool second = it >= 300; const int pn = second ? it - 300 : it;
                if (rep == 0) {
                if (!second) { pg8::Gemm g{(const bf16*)(ws + WS_U), (const bf16*)(ws + WS_WOUT_T), MT, 1024, 1024}; pg8::OneUnit S{64, pn};
                    pg8::EpiOut E{(const bf16*)(ws + WS_HBF), (bf16*)(ws + WS_HB2)};
                    pg8::gemm_phase<pg8::EpiOut, pg8::OneUnit, PG8_ALIGN, PG8_SP2>(lds, g, S, E);
                    VM_WAIT(); __syncthreads();
                    if (tid == 0) { __builtin_amdgcn_fence(__ATOMIC_RELEASE, "agent"); VM_WAIT(); (void)__hip_atomic_fetch_add(dep1, 1u, RLX_AGENT); } }
                else {
                    if (tid == 0) { unsigned sp = 0; while (__hip_atomic_load(dep1, RLX_AGENT) < 4u) { __builtin_amdgcn_s_sleep(2); if (++sp > (1u << 22)) break; }
                        __builtin_amdgcn_fence(__ATOMIC_ACQUIRE, "agent"); VM_WAIT(); }
                    __syncthreads();
                    pg8::Gemm g{(const bf16*)(ws + WS_HB2), (const bf16*)(ws + WS_WG_T), MT, 1024, 1024}; pg8::OneUnit S{64, pn};
                    pg8::EpiFinal E{a.out, (const bf16*)(ws + WS_T1), (const bf16*)(ws + WS_HB2)};
                    pg8::gemm_phase<pg8::EpiFinal, pg8::OneUnit, PG8_ALIGN, PG8_SP2>(lds, g, S, E); }
                }
                continue; }
            it -= (it >= 304) ? 8 : 4;
            if (IMON(16)) item_nsa_prompt(a, lds, it, tid, lane, wave);
        }
#endif
        REPSEAM(3); }
        SEAM(3);
    }

    if (IN(4)) { _Pragma("unroll") for (int rep = 0; rep < NREP(4); ++rep) {
        pg8::Gemm g{(const bf16*)(ws + WS_U), (const bf16*)(ws + WS_WOUT_T), MP, 1024, 1024}; pg8::StaticOrder S; S.init(MP, 1024, G, bx);
        pg8::EpiOut E{(const bf16*)(ws + WS_HBF), (bf16*)(ws + WS_HB2)};
        pg8::gemm_phase<pg8::EpiOut, pg8::StaticOrder, PG8_ALIGN, PG8_SP2>(lds, g, S, E);
        REPSEAM(4); }
        SEAM(4);
    }
    if (IN(5)) {
        pg8::Gemm g{(const bf16*)(ws + WS_HB2), (const bf16*)(ws + WS_WG_T), MP, 1024, 1024}; pg8::StaticOrder S; S.init(MP, 1024, G, bx);
        pg8::EpiFinal E{a.out, (const bf16*)(ws + WS_T1), (const bf16*)(ws + WS_HB2)};
        pg8::gemm_phase<pg8::EpiFinal, pg8::StaticOrder, PG8_ALIGN, PG8_SP2>(lds, g, S, E);
    }
#undef IN
#undef SEAM
}

extern "C" void kernel_launch(void* const* d_in, const int* in_sizes, int n_in, void* d_out, int out_size, void* d_ws, size_t ws_size, hipStream_t stream) {
    static int grid = 0;
    if (grid == 0) {
        if (n_in != N_INPUTS || (size_t)out_size != OUT_TOTAL || ws_size < WS_END) { fprintf(stderr, "kernel_launch: unexpected shapes (n_in %d, out %d, ws %zu); nothing launched\n", n_in, out_size, ws_size); grid = -1; return; }
        int dev = 0, cus = 0;
        if (hipGetDevice(&dev) != hipSuccess || hipDeviceGetAttribute(&cus, hipDeviceAttributeMultiprocessorCount, dev) != hipSuccess) { grid = -1; return; }
        if (hipFuncSetAttribute((const void*)mk_fwd, hipFuncAttributeMaxDynamicSharedMemorySize, LDS_BYTES) != hipSuccess) { fprintf(stderr, "kernel_launch: hipFuncSetAttribute failed\n"); grid = -1; return; }
        int per_cu = 0;
        if (hipOccupancyMaxActiveBlocksPerMultiprocessor(&per_cu, (const void*)mk_fwd, NTHR, LDS_BYTES) != hipSuccess || per_cu < 1) { fprintf(stderr, "kernel_launch: occupancy query says %d\n", per_cu); per_cu = 1; }
        (void)hipGetLastError();
        grid = cus;
    }
    if (grid < 0) return;
    if (hipMemsetAsync((char*)d_ws + WS_CTL, 0, CTL_ZERO_BYTES, stream) != hipSuccess) { fprintf(stderr, "kernel_launch: memset failed\n"); return; }
    Args a{};
    for (int i = 0; i < N_INPUTS; ++i) a.in[i] = d_in[i];
    a.out = (float*)d_out; a.ws = (unsigned char*)d_ws;
#if MK_N_LAUNCHES == 1
    a.ph_lo = 0; a.ph_hi = N_PHASES;
    hipLaunchKernelGGL(mk_fwd, dim3(grid), dim3(NTHR), LDS_BYTES, stream, a);
#else
    for (int p = 0; p < N_PHASES; ++p) { a.ph_lo = p; a.ph_hi = p + 1; hipLaunchKernelGGL(mk_fwd, dim3(grid), dim3(NTHR), LDS_BYTES, stream, a); }
#endif
    const hipError_t le = hipPeekAtLastError();
    if (le != hipSuccess) fprintf(stderr, "kernel_launch: launch failed: %s\n", hipGetErrorName(le));
}
```

```cpp
#include <hip/hip_runtime.h>
#include <cstdio>
#include <cstdint>
namespace pg8 {
#define PG8_LAS __attribute__((address_space(3)))
typedef unsigned short bf16_t;
typedef short bf16x8 __attribute__((ext_vector_type(8)));
typedef float f32x4 __attribute__((ext_vector_type(4)));
typedef unsigned u32x4 __attribute__((ext_vector_type(4)));
constexpr int BM = 256, BK = 64, HALF = 128, HTB = HALF * BK * 2  , STAGE_BYTES = 8 * HTB, NXCD = 8, WGM = 8;

__host__ __device__ __forceinline__ int lds_byte(int r, int c) { const int st = (r >> 4) * 2 + (c >> 5), rr = r & 15, cc = c & 31, ob = rr * 64 + cc * 2; return st * 1024 + (ob ^ (((ob >> 9) & 1) << 5)); }
__host__ __device__ __forceinline__ void stage_rc(int b, int& R, int& C) { const int st = b / 1024, sb = b % 1024, swz = sb ^ (((sb >> 9) & 1) << 5); R = (st >> 1) * 16 + swz / 64; C = (st & 1) * 32 + (swz % 64) / 2; }
__host__ __device__ __forceinline__ int perm32(int rho) { const int n = rho >> 4, i = rho & 15; return 8 * (i >> 2) + 4 * n + (i & 3); }

struct Unit { int pm, pn; };
struct Gemm { const bf16_t* A; const bf16_t* Bt; int M, N, K; };

struct StaticOrder {
    int nM, nN, nwg, G, c;
    __host__ __device__ void init(int M, int N, int G_, int c_) { nM = M / BM; nN = N / BM; nwg = nM * nN; G = G_; c = c_; }
    __host__ __device__ bool next(int i, Unit& u) const {
        const long L = (long)i * G + c; if (L >= nwg) return false;
        int wgid = (int)L; { const int q = nwg / NXCD, r = nwg % NXCD, xcd = wgid % NXCD, off = wgid / NXCD; wgid = (xcd < r ? xcd * (q + 1) : r * (q + 1) + (xcd - r) * q) + off; }
        const int nig = WGM * nN, gid = wgid / nig, fm = gid * WGM, gsz = (nM - fm) < WGM ? (nM - fm) : WGM;
        u.pm = fm + ((wgid % nig) % gsz); u.pn = (wgid % nig) / gsz; return true;
    }
    __device__ __forceinline__ void a_ready(const Unit&) const {}
    __device__ __forceinline__ void done(const Unit&) const {}
};

__device__ __forceinline__ unsigned cvt_pk_bf16(float lo, float hi) { unsigned r; asm volatile("v_cvt_pk_bf16_f32 %0, %1, %2" : "=v"(r) : "v"(lo), "v"(hi)); return r; }
typedef float f32x2 __attribute__((ext_vector_type(2)));
__device__ __forceinline__ f32x2 gelu_pk(f32x2 v) {
    const f32x2 av = __builtin_elementwise_abs(v), d = av * 0.2316418882f + 1.0f;
    f32x2 t; t.x = __builtin_amdgcn_rcpf(d.x); t.y = __builtin_amdgcn_rcpf(d.y);
    f32x2 q = t * 0.5307027145f + (-0.7265760135f); q = q * t + 0.7107068705f; q = q * t + (-0.142248368f); q = q * t + 0.127414796f; q = q * t;
    const f32x2 s = (v * v) * (-0.72134752044f);
    f32x2 e; e.x = __builtin_amdgcn_exp2f(s.x); e.y = __builtin_amdgcn_exp2f(s.y);
    const f32x2 m = v * (q * e), r = v - m;
    f32x2 o; o.x = v.x < 0.f ? m.x : r.x; o.y = v.y < 0.f ? m.y : r.y; return o;
}

template <int ACT  > struct EpiBf16 {
    static constexpr bool PERM = true, AFTER_DRAIN = false; static_assert(ACT == 0 || ACT == 1, "EpiBf16: ACT is 0 (none) or 1 (gelu_pk)");
    bf16_t* O; int ldc; const float* bias; int split_cols; size_t split_stride; float scale0;
    __device__ __forceinline__ void operator()(const f32x4 (&acc)[2][2][4][2], const Unit& u, int wr, int wc, int fr_, int fq_) const {
        int fr = fr_, fq = fq_; asm volatile("" : "+v"(fr), "+v"(fq));
        const int row0 = u.pm * BM + wr * 64 + fr; int colt = u.pn * BM; bf16_t* base = O;
        float sc = 1.f; if (split_cols) { const int t = colt / split_cols; base += (size_t)t * split_stride; colt -= t * split_cols; if (t == 0) sc = scale0; }
        const int col0 = colt + wc * 32 + 8 * fq, bcol0 = u.pn * BM + wc * 32 + 8 * fq;
        f32x4 bv[2][2];
#pragma unroll
        for (int bj = 0; bj < 2; ++bj)
#pragma unroll
            for (int n = 0; n < 2; ++n) bv[bj][n] = bias ? *(const f32x4*)(bias + bcol0 + bj * HALF + 4 * n) : (f32x4){0.f, 0.f, 0.f, 0.f};
#pragma unroll
        for (int ai = 0; ai < 2; ++ai)
#pragma unroll
            for (int m = 0; m < 4; ++m) { bf16_t* rowp = base + (size_t)(row0 + ai * HALF + m * 16) * ldc + col0;
#pragma unroll
                for (int bj = 0; bj < 2; ++bj) { f32x4 v0 = acc[ai][bj][m][0] + bv[bj][0], v1 = acc[ai][bj][m][1] + bv[bj][1];
                    if (ACT == 1) { f32x2 a = gelu_pk((f32x2){v0[0], v0[1]}), b = gelu_pk((f32x2){v0[2], v0[3]}), c = gelu_pk((f32x2){v1[0], v1[1]}), d = gelu_pk((f32x2){v1[2], v1[3]});
                        v0 = (f32x4){a.x, a.y, b.x, b.y}; v1 = (f32x4){c.x, c.y, d.x, d.y}; }
                    v0 = v0 * sc; v1 = v1 * sc; u32x4 w; w.x = cvt_pk_bf16(v0[0], v0[1]); w.y = cvt_pk_bf16(v0[2], v0[3]); w.z = cvt_pk_bf16(v1[0], v1[1]); w.w = cvt_pk_bf16(v1[2], v1[3]);
                    *(u32x4*)(rowp + bj * HALF) = w; } }
    }
};

template <class Epi, class Sched, bool ALIGN_EPI = false, bool SP2 = false, bool OPAQUE_K = false>
__device__ __forceinline__ void gemm_phase(PG8_LAS unsigned char* lds, const Gemm g, const Sched& S, const Epi& E) {
    int tid_ = threadIdx.x;
#ifndef PG8_NOLAUNDER
    asm volatile("" : "+v"(tid_));
#endif
    const int tid = tid_, wid = __builtin_amdgcn_readfirstlane(tid >> 6), lane = tid & 63, wr = wid >> 2, wc = wid & 3, fr = lane & 15, fq = lane >> 4;
    int K_ = g.K; if (OPAQUE_K) asm volatile("" : "+s"(K_));
    const int K = K_, nt = K / BK;
    unsigned voffA[2], voffB[2];
#pragma unroll
    for (int i = 0; i < 2; ++i) { int R, C; stage_rc(tid * 16 + i * 8192, R, C); const int Rb = Epi::PERM ? ((R & ~31) + perm32(R & 31)) : R;
        voffA[i] = (unsigned)(R * K + C) * 2u; voffB[i] = (unsigned)(Rb * K + C) * 2u; }
    const size_t kstep = (size_t)(BK * 2);
    const size_t hstep = (size_t)HALF * K * 2;
    const size_t tstep = 2 * hstep;
    const unsigned ldsw = (unsigned)wid * 1024u;
    const int aoff = lds_byte(wr * 64 + fr, fq * 8), boff = lds_byte(wc * 32 + fr, fq * 8);
#define PG8_SA(b, h) (((b) * 2 + (h)) * HTB)
#define PG8_SB(b, h) ((4 + (b) * 2 + (h)) * HTB)
#define PG8_STAGE(bufoff, gbase, voff) do { _Pragma("unroll") for (int _i = 0; _i < 2; ++_i) \
        __builtin_amdgcn_global_load_lds((const unsigned*)((const char*)(gbase) + (voff)[_i]), (PG8_LAS unsigned*)(lds + (bufoff) + ldsw + _i * 8192), 16, 0, 0); } while (0)
#define PG8_LDA(dst, b, h) do { _Pragma("unroll") for (int m = 0; m < 4; ++m) _Pragma("unroll") for (int k = 0; k < 2; ++k) dst[m][k] = *(const PG8_LAS bf16x8*)(lds + PG8_SA(b, h) + aoff + m * 2048 + k * 1024); } while (0)
#define PG8_LDB(dst, b, h) do { _Pragma("unroll") for (int n = 0; n < 2; ++n) _Pragma("unroll") for (int k = 0; k < 2; ++k) dst[n][k] = *(const PG8_LAS bf16x8*)(lds + PG8_SB(b, h) + boff + n * 2048 + k * 1024); } while (0)
#define PG8_MMA(ai, bj, At, Bt) do { __builtin_amdgcn_s_setprio(1); _Pragma("unroll") for (int m = 0; m < 4; ++m) _Pragma("unroll") for (int n = 0; n < 2; ++n) _Pragma("unroll") for (int k = 0; k < 2; ++k) \
        acc[ai][bj][m][n] = __builtin_amdgcn_mfma_f32_16x16x32_bf16(Bt[n][k], At[m][k], acc[ai][bj][m][n], 0, 0, 0); __builtin_amdgcn_s_setprio(0); } while (0)
#define PG8_WAIT_V(n) asm volatile("s_waitcnt vmcnt(" #n ")" ::: "memory")
#define PG8_WAIT_L(n) asm volatile("s_waitcnt lgkmcnt(" #n ")" ::: "memory")
#define PG8_BAR __builtin_amdgcn_s_barrier()
#define PG8_SCHED __builtin_amdgcn_sched_barrier(0)
    Unit cur, nxt; int ui = 0;
    if (!S.next(0, cur)) return;
    f32x4 acc[2][2][4][2];
#pragma unroll
    for (int a = 0; a < 2; ++a)
#pragma unroll
        for (int b = 0; b < 2; ++b)
#pragma unroll
            for (int m = 0; m < 4; ++m)
#pragma unroll
                for (int n = 0; n < 2; ++n) acc[a][b][m][n] = (f32x4){0.f, 0.f, 0.f, 0.f};
    bf16x8 At[4][2], B0[2][2], B1[2][2];
    const char* cA = (const char*)g.A + (size_t)cur.pm * tstep; const char* cB = (const char*)g.Bt + (size_t)cur.pn * tstep;
    S.a_ready(cur);
    if constexpr (SP2) {
        PG8_STAGE(PG8_SB(0, 0), cB, voffB); PG8_STAGE(PG8_SB(0, 1), cB + hstep, voffB); PG8_STAGE(PG8_SA(0, 0), cA, voffA); PG8_STAGE(PG8_SA(0, 1), cA + hstep, voffA);
        if (wr == 1) PG8_BAR;
        PG8_WAIT_V(2); PG8_BAR;
        PG8_STAGE(PG8_SB(1, 0), cB + kstep, voffB); PG8_STAGE(PG8_SA(1, 0), cA + kstep, voffA); PG8_STAGE(PG8_SB(1, 1), cB + hstep + kstep, voffB);
        PG8_WAIT_V(6); PG8_BAR;
    } else {
        PG8_STAGE(PG8_SB(0, 0), cB, voffB); PG8_STAGE(PG8_SA(0, 0), cA, voffA); PG8_STAGE(PG8_SB(0, 1), cB + hstep, voffB); PG8_STAGE(PG8_SA(0, 1), cA + hstep, voffA);
        if (wr == 1) PG8_BAR;
        PG8_WAIT_V(4); PG8_BAR;
        PG8_STAGE(PG8_SB(1, 0), cB + kstep, voffB); PG8_STAGE(PG8_SA(1, 0), cA + kstep, voffA); PG8_STAGE(PG8_SB(1, 1), cB + hstep + kstep, voffB);
        PG8_WAIT_V(6); PG8_BAR;
    }
    for (;;) {
        const bool has_next = S.next(ui + 1, nxt);
        const char* nA = has_next ? (const char*)g.A + (size_t)nxt.pm * tstep : cA; const char* nB = has_next ? (const char*)g.Bt + (size_t)nxt.pn * tstep : cB;
        for (int t = 0; t < nt; t += 2) {
            const bool last = (t == nt - 2);
            const char* a1 = cA + (size_t)(t + 1) * kstep;
            const char* a2 = last ? nA : cA + (size_t)(t + 2) * kstep; const char* b2 = last ? nB : cB + (size_t)(t + 2) * kstep;
            const char* a3 = a2 + kstep; const char* b3 = b2 + kstep;
            if (last && has_next) S.a_ready(nxt);
            if constexpr (SP2) {
            PG8_LDB(B0, 0, 0); PG8_LDB(B1, 0, 1); PG8_SCHED; PG8_LDA(At, 0, 0); PG8_STAGE(PG8_SA(1, 1), a1 + hstep, voffA);
            PG8_WAIT_V(8); PG8_WAIT_L(0); PG8_BAR; PG8_MMA(0, 0, At, B0); PG8_MMA(0, 1, At, B1); PG8_BAR; PG8_SCHED;
            PG8_LDA(At, 0, 1); PG8_STAGE(PG8_SB(0, 0), b2, voffB); PG8_STAGE(PG8_SB(0, 1), b2 + hstep, voffB); PG8_STAGE(PG8_SA(0, 0), a2, voffA);
            PG8_WAIT_V(8); PG8_WAIT_L(0); PG8_BAR; PG8_MMA(1, 0, At, B0); PG8_MMA(1, 1, At, B1); PG8_BAR; PG8_SCHED;
            PG8_LDB(B0, 1, 0); PG8_LDB(B1, 1, 1); PG8_SCHED; PG8_LDA(At, 1, 0); PG8_STAGE(PG8_SA(0, 1), a2 + hstep, voffA);
            PG8_WAIT_V(8); PG8_WAIT_L(0); PG8_BAR; PG8_MMA(0, 0, At, B0); PG8_MMA(0, 1, At, B1); PG8_BAR; PG8_SCHED;
            PG8_LDA(At, 1, 1); PG8_STAGE(PG8_SB(1, 0), b3, voffB); PG8_STAGE(PG8_SB(1, 1), b3 + hstep, voffB); PG8_STAGE(PG8_SA(1, 0), a3, voffA);
            PG8_WAIT_V(8); PG8_WAIT_L(0); PG8_BAR; PG8_MMA(1, 0, At, B0); PG8_MMA(1, 1, At, B1); PG8_BAR; PG8_SCHED;
            } else {
            PG8_LDB(B0, 0, 0); PG8_SCHED; PG8_LDA(At, 0, 0); PG8_STAGE(PG8_SA(1, 1), a1 + hstep, voffA);
            PG8_WAIT_L(8); PG8_BAR; PG8_WAIT_L(0); PG8_MMA(0, 0, At, B0); PG8_BAR; PG8_SCHED;
            PG8_LDB(B1, 0, 1); PG8_STAGE(PG8_SB(0, 0), b2, voffB);
            PG8_BAR; PG8_WAIT_L(0); PG8_MMA(0, 1, At, B1); PG8_BAR;
            PG8_LDA(At, 0, 1); PG8_STAGE(PG8_SA(0, 0), a2, voffA);
            PG8_BAR; PG8_WAIT_L(0); PG8_MMA(1, 0, At, B0); PG8_BAR; PG8_SCHED;
            PG8_STAGE(PG8_SB(0, 1), b2 + hstep, voffB);
            PG8_WAIT_V(6); PG8_BAR; PG8_MMA(1, 1, At, B1); PG8_BAR;
            PG8_LDB(B0, 1, 0); PG8_SCHED; PG8_LDA(At, 1, 0); PG8_STAGE(PG8_SA(0, 1), a2 + hstep, voffA);
            PG8_WAIT_L(8); PG8_BAR; PG8_WAIT_L(0); PG8_MMA(0, 0, At, B0); PG8_BAR; PG8_SCHED;
            PG8_LDB(B1, 1, 1); PG8_STAGE(PG8_SB(1, 0), b3, voffB);
            PG8_BAR; PG8_WAIT_L(0); PG8_MMA(0, 1, At, B1); PG8_BAR;
            PG8_LDA(At, 1, 1); PG8_STAGE(PG8_SA(1, 0), a3, voffA);
            PG8_BAR; PG8_WAIT_L(0); PG8_MMA(1, 0, At, B0); PG8_BAR; PG8_SCHED;
            PG8_STAGE(PG8_SB(1, 1), b3 + hstep, voffB);
            PG8_WAIT_V(6); PG8_BAR; PG8_MMA(1, 1, At, B1); PG8_BAR;
            }
        }
        if constexpr (ALIGN_EPI) { if (wr == 0) PG8_BAR; }
        if constexpr (!Epi::AFTER_DRAIN) { E(acc, cur, wr, wc, fr, fq);
#ifdef DBG_EPI2
            E(acc, cur, wr, wc, fr, fq);
#endif
            S.done(cur); }
        if (!has_next) break;
#pragma unroll
        for (int a = 0; a < 2; ++a)
#pragma unroll
            for (int b = 0; b < 2; ++b)
#pragma unroll
                for (int m = 0; m < 4; ++m)
#pragma unroll
                    for (int n = 0; n < 2; ++n) acc[a][b][m][n] = (f32x4){0.f, 0.f, 0.f, 0.f};
        cur = nxt; cA = nA; cB = nB; ++ui;
        if constexpr (ALIGN_EPI) { if (wr == 1) PG8_BAR; }
    }
    PG8_WAIT_V(0);
    if constexpr (!ALIGN_EPI) { if (wr == 0) PG8_BAR; }
    PG8_BAR;
    if constexpr (Epi::AFTER_DRAIN) { E.fused(acc, cur, wr, wc, fr, fq, lds, wid, lane); S.done(cur); }
#undef PG8_SA
#undef PG8_SB
#undef PG8_STAGE
#undef PG8_LDA
#undef PG8_LDB
#undef PG8_MMA
#undef PG8_WAIT_V
#undef PG8_WAIT_L
#undef PG8_BAR
#undef PG8_SCHED
}
}


#ifndef PG8_SP2
#define PG8_SP2 true
#endif
#ifndef PG8_ALIGN
#define PG8_ALIGN true
#endif
#define GAS __attribute__((address_space(1)))
#define LAS __attribute__((address_space(3)))
typedef unsigned short bf16;
typedef unsigned v4u __attribute__((ext_vector_type(4)));
typedef float f32x4 __attribute__((ext_vector_type(4)));
typedef short bf16x8 __attribute__((ext_vector_type(8)));
typedef GAS unsigned gu32;
typedef GAS unsigned long long gu64;
#define RLX_AGENT __ATOMIC_RELAXED, __HIP_MEMORY_SCOPE_AGENT
#define LDS_WAIT() asm volatile("s_waitcnt lgkmcnt(0)" ::: "memory")
#define VM_WAIT() asm volatile("s_waitcnt vmcnt(0)" ::: "memory")
__device__ __forceinline__ unsigned long long rt() { return __builtin_amdgcn_s_memrealtime(); }
__device__ __forceinline__ unsigned f2bf(float f) { unsigned u = __builtin_bit_cast(unsigned, f); return (u + 0x7fffu + ((u >> 16) & 1u)) >> 16; }
__device__ __forceinline__ unsigned pk2(float lo, float hi) { return f2bf(lo) | (f2bf(hi) << 16); }

#define XB_TMO      128
#define XB_XCNT(j)  (256  + 64 * (j))
#define XB_XSUB(j)  (1280 + 64 * (j))
#define XB_XGEN(j)  (2304 + 64 * (j))
#define XB_TOP      3328
#define XB_TOPGEN   3392
#define XCD_BAR_WORDS 3456
#define XB_SPIN_CAP (1u << 18)

__device__ __forceinline__ unsigned xb_ld(unsigned* p)              { return __hip_atomic_load(p, __ATOMIC_RELAXED, __HIP_MEMORY_SCOPE_AGENT); }
__device__ __forceinline__ unsigned xb_add(unsigned* p, unsigned v) { return __hip_atomic_fetch_add(p, v, __ATOMIC_RELAXED, __HIP_MEMORY_SCOPE_AGENT); }
__device__ __forceinline__ unsigned xb_xcc_id() { return (unsigned)__builtin_amdgcn_s_getreg((3 << 11) | 20) & 0xFu; }
#define XB_SPIN(cond, bar) do { unsigned _sp = 0; while (cond) { __builtin_amdgcn_s_sleep(1); \
    if ((++_sp & 255u) == 0u) { if (xb_ld(&(bar)[XB_TMO])) break; if (_sp > XB_SPIN_CAP) { atomicAdd(&(bar)[XB_TMO], 1u); break; } } } } while (0)

struct XcdBarrier {
    unsigned* bar; unsigned x;
    volatile LAS unsigned* st;
};

__device__ __forceinline__ XcdBarrier xcd_barrier_post(unsigned* bar, volatile LAS unsigned* st) {
    XcdBarrier b; b.bar = bar; b.x = xb_xcc_id(); b.st = st;
    if (threadIdx.x == 0) (void)xb_add(&bar[XB_XCNT(b.x)], 1u);
    return b;
}
__device__ __forceinline__ void xcd_barrier_complete(unsigned* bar, unsigned x, unsigned& nloc, unsigned& nx) {
    const unsigned G = gridDim.x * gridDim.y * gridDim.z;
    unsigned sum, cnt, mine, sp = 0u;
    for (;;) {
        sum = 0u; cnt = 0u; mine = 0u;
#pragma unroll
        for (unsigned j = 0; j < 16; ++j) { const unsigned c = xb_ld(&bar[XB_XCNT(j)]); sum += c; cnt += (c > 0u) ? 1u : 0u; mine = (j == x) ? c : mine; }
        if (sum == G) break;
        __builtin_amdgcn_s_sleep(1);
        if ((++sp & 255u) == 0u) { if (xb_ld(&bar[XB_TMO])) break; if (sp > XB_SPIN_CAP) { atomicAdd(&bar[XB_TMO], 1u); break; } }
    }
    nloc = mine > 0u ? mine : 1u; nx = cnt > 0u ? cnt : 1u;
}

__device__ __forceinline__ void xcd_barrier(const XcdBarrier& b) {
    asm volatile("s_waitcnt vmcnt(0)" ::: "memory");
    __syncthreads();
    if (threadIdx.x == 0) {
        unsigned* bar = b.bar;
        __builtin_amdgcn_s_waitcnt(0);
        unsigned nloc = b.st[0], nx = b.st[1];
        if (nloc == 0u) { xcd_barrier_complete(bar, b.x, nloc, nx); b.st[0] = nloc; b.st[1] = nx; }
        const unsigned old = xb_add(&bar[XB_XSUB(b.x)], 1u);
        const unsigned gen = old / nloc;
        if (old + 1u == (gen + 1u) * nloc) {
            __builtin_amdgcn_fence(__ATOMIC_RELEASE, "agent");
            asm volatile("s_waitcnt vmcnt(0)" ::: "memory");
            const unsigned og = xb_add(&bar[XB_TOP], 1u);
            const unsigned tg = og / nx;
            if (og + 1u == (tg + 1u) * nx) xb_add(&bar[XB_TOPGEN], 1u);
            else XB_SPIN(xb_ld(&bar[XB_TOPGEN]) == tg, bar);
            __builtin_amdgcn_fence(__ATOMIC_ACQUIRE, "agent");
            xb_add(&bar[XB_XGEN(b.x)], 1u);
            asm volatile("s_waitcnt vmcnt(0)" ::: "memory");
        } else {
            XB_SPIN(xb_ld(&bar[XB_XGEN(b.x)]) == gen, bar);
            __builtin_amdgcn_fence(__ATOMIC_ACQUIRE, "agent");
            asm volatile("s_waitcnt vmcnt(0)" ::: "memory");
        }
    }
    __syncthreads();
}


constexpr int NWAVES = 8, NTHR = 512;
constexpr int MP = 16384, MS = 256, MT = 16640, DM = 1024, TP = 2048;
constexpr int NG1 = 3840, NIN = 3864;
constexpr float EPS = 1e-6f, LOG2E = 1.4426950408889634f, LN2 = 0.6931471805599453f;
constexpr size_t OFF_SB = 17039360, OFF_NSA = 34078720, OFF_WINP = 42598400, OFF_WINS = 43646976, OUT_TOTAL = 47841280;
enum { IN_XP = 0, IN_XS, IN_PP, IN_PS, IN_CSB, IN_CNSA, IN_SWIN, IN_PT, IN_NORMG, IN_WIN, IN_QG, IN_KCG, IN_KSG, IN_KWG, IN_PEK, IN_W1K, IN_W2K, IN_PEV, IN_W1V, IN_W2V, IN_WOUT, IN_WPLE, IN_WG, N_INPUTS };

constexpr size_t MiB = 1u << 20;
constexpr size_t WS_CTL = 0, CTL_ZERO_BYTES = 1 * MiB;
constexpr size_t WS_WIN_T = 2 * MiB, WS_W1T = 11 * MiB, WS_W2T = 13 * MiB, WS_WOUT_T = 14 * MiB, WS_WG_T = 16 * MiB, WS_WPLE_T = 18 * MiB;
constexpr size_t WS_RSTD = 19 * MiB, WS_BR = 20 * MiB, WS_HBF = 24 * MiB, WS_PBF = 58 * MiB;
constexpr size_t WS_QA = 68 * MiB, WS_KA = 86 * MiB, WS_VA = 104 * MiB, WS_GA = 122 * MiB, WS_QB = 140 * MiB, WS_GB = 158 * MiB;
constexpr size_t WS_KSEL = 176 * MiB, WS_VSEL = 182 * MiB, WS_KWIN = 188 * MiB, WS_VWIN = 194 * MiB;
constexpr size_t WS_ACMP_P = 200 * MiB, WS_HIDP = 208 * MiB, WS_HIDS = 210 * MiB, WS_KCS = 226 * MiB, WS_VCS = 228 * MiB;
constexpr size_t WS_OW = 232 * MiB, WS_U = 248 * MiB, WS_T1 = 282 * MiB, WS_HB2 = 316 * MiB, WS_ACMP_S = 352 * MiB, WS_END = 480 * MiB;
constexpr int CW_BAR = 4096;
constexpr int CW_Q = 16384;
constexpr int CW_PANEL = 32768;
constexpr int CW_PANEL2 = 40960;
constexpr int CW_BIAS = 65536;

constexpr int RING_BYTES = 131072, LDSCTL_OFF = RING_BYTES, MISC_OFF = LDSCTL_OFF + 320, LDS_BYTES = 147456;

typedef float f32x16 __attribute__((ext_vector_type(16)));
typedef short s16x4 __attribute__((ext_vector_type(4)));
typedef float f32x2_t __attribute__((ext_vector_type(2)));
typedef __bf16 bf16x2_t __attribute__((ext_vector_type(2)));
typedef unsigned v2u __attribute__((ext_vector_type(2)));
__device__ __forceinline__ unsigned cvtpk(float lo, float hi) { f32x2_t v = {lo, hi}; bf16x2_t b = __builtin_convertvector(v, bf16x2_t); return __builtin_bit_cast(unsigned, b); }
__device__ __forceinline__ float bf_lo(unsigned w) { return __builtin_bit_cast(float, w << 16); }
__device__ __forceinline__ float bf_hi(unsigned w) { return __builtin_bit_cast(float, w & 0xffff0000u); }
__device__ __forceinline__ float fexp2(float x) { return __builtin_amdgcn_exp2f(x); }
__device__ __forceinline__ float flog2(float x) { return __builtin_amdgcn_logf(x); }
__device__ __forceinline__ float frcp(float x) { return __builtin_amdgcn_rcpf(x); }
__device__ __forceinline__ float sigmoidf_(float x) { return frcp(1.f + fexp2(-x * LOG2E)); }
__device__ __forceinline__ float siluf_(float x) { return x * sigmoidf_(x); }
__device__ __forceinline__ float wave_sum(float v) {
#pragma unroll
    for (int o = 1; o < 64; o <<= 1) v += __shfl_xor(v, o);
    return v;
}
__device__ __forceinline__ float wave_max(float v) {
#pragma unroll
    for (int o = 1; o < 64; o <<= 1) v = fmaxf(v, __shfl_xor(v, o));
    return v;
}

struct Args { const void* in[N_INPUTS]; float* out; unsigned char* ws; int ph_lo, ph_hi; };

__device__ __forceinline__ void p0_transpose_item(const float* __restrict__ W, int ldw, int col0, const float* __restrict__ gsc, bf16* WT, int K, int drow0, int k0, LAS float* scr, int lane) {
#pragma unroll 16
    for (int i = 0; i < 32; ++i) { const int kk = 2 * i + (lane >> 5); float v = W[(size_t)(k0 + kk) * ldw + col0 + (lane & 31)]; if (gsc) v *= gsc[k0 + kk]; scr[kk * 33 + (lane & 31)] = v; }
    LDS_WAIT(); asm volatile("" ::: "memory");
    const int c = lane & 7;
#pragma unroll
    for (int j = 0; j < 4; ++j) { const int n = (lane >> 3) + 8 * j; const LAS float* s = scr + (8 * c) * 33 + n;
        v4u o; o.x = pk2(s[0 * 33], s[1 * 33]); o.y = pk2(s[2 * 33], s[3 * 33]); o.z = pk2(s[4 * 33], s[5 * 33]); o.w = pk2(s[6 * 33], s[7 * 33]);
        *(GAS v4u*)(WT + (size_t)(drow0 + n) * K + k0 + 8 * c) = o; }
    LDS_WAIT(); asm volatile("" ::: "memory");
}
__host__ __device__ __forceinline__ int g1_role(int pn) { return (int)((0xec9b7a15d483620ull >> (4 * pn)) & 15); }
__device__ __forceinline__ int g1_src_col(int n) { const int t = g1_role(n >> 8), gm = n & 255, lam = 64 * ((gm >> 5) & 3) + 32 * (gm >> 7) + (gm & 31); return (t < 13 ? t * 256 : 3352 + (t - 13) * 256) + lam; }

constexpr int WBR_OFF = 67584, WBR_PITCH = 2064;

__device__ __forceinline__ void p0_prologue(const Args& a, LAS unsigned char* lds, int tid, int lane, int wave, int vcu, int G, int rep = 0) {
    const int gw = vcu * NWAVES + wave, NGW = G * NWAVES;
    unsigned char* ws = a.ws;
    const float* w_in = (const float*)a.in[IN_WIN]; const float* norm_g = (const float*)a.in[IN_NORMG];
    { LAS unsigned char* wbr = lds + WBR_OFF;
      for (int i0 = 0; i0 < 48; i0 += 24) { float v[24], gk[24];
#pragma unroll
          for (int i = 0; i < 24; ++i) { const int idx = tid + NTHR * (i0 + i), k = idx / 24, c = idx - 24 * k; v[i] = w_in[(size_t)k * NIN + 3328 + c]; gk[i] = norm_g[k]; }
#pragma unroll
          for (int i = 0; i < 24; ++i) { const int idx = tid + NTHR * (i0 + i), k = idx / 24, c = idx - 24 * k; *(LAS unsigned short*)(wbr + c * WBR_PITCH + k * 2) = (unsigned short)f2bf(v[i] * gk[i]); } } }
    { LAS float* scr = (LAS float*)(lds + wave * 8448);
      constexpr int I0 = 16 * 120, I1 = 32 * 8, I3 = 4 * 2, I5 = 16 * 32, I7 = 4 * 32, NITEMS = I0 + 2 * I1 + 2 * I3 + 2 * I5 + I7;
      for (int it = gw; it < NITEMS; it += NGW) {
          int r = it;
          if (r < I0) { const int kb = r / 120, nb = r % 120; p0_transpose_item(w_in, NIN, g1_src_col(32 * nb), norm_g, (bf16*)(ws + WS_WIN_T), 1024, 32 * nb, 64 * kb, scr, lane); continue; } r -= I0;
          if (r < I1) { const int kb = r / 8, nb = r % 8; p0_transpose_item((const float*)a.in[IN_W1K], 256, 32 * nb, nullptr, (bf16*)(ws + WS_W1T), 2048, 32 * nb, 64 * kb, scr, lane); continue; } r -= I1;
          if (r < I1) { const int kb = r / 8, nb = r % 8; p0_transpose_item((const float*)a.in[IN_W1V], 256, 32 * nb, nullptr, (bf16*)(ws + WS_W1T), 2048, 256 + 32 * nb, 64 * kb, scr, lane); continue; } r -= I1;
          if (r < I3) { const int kb = r / 2, nb = r % 2; p0_transpose_item((const float*)a.in[IN_W2K], 64, 32 * nb, nullptr, (bf16*)(ws + WS_W2T), 256, 32 * nb, 64 * kb, scr, lane); continue; } r -= I3;
          if (r < I3) { const int kb = r / 2, nb = r % 2; p0_transpose_item((const float*)a.in[IN_W2V], 64, 32 * nb, nullptr, (bf16*)(ws + WS_W2T), 256, 64 + 32 * nb, 64 * kb, scr, lane); continue; } r -= I3;
          if (r < I5) { const int kb = r / 32, nb = r % 32; p0_transpose_item((const float*)a.in[IN_WOUT], 1024, 32 * nb, nullptr, (bf16*)(ws + WS_WOUT_T), 1024, 32 * nb, 64 * kb, scr, lane); continue; } r -= I5;
          if (r < I5) { const int kb = r / 32, nb = r % 32; p0_transpose_item((const float*)a.in[IN_WG], 1024, 32 * nb, nullptr, (bf16*)(ws + WS_WG_T), 1024, 32 * nb, 64 * kb, scr, lane); continue; } r -= I5;
          { const int kb = r / 32, nb = r % 32; p0_transpose_item((const float*)a.in[IN_WPLE], 1024, 32 * nb, nullptr, (bf16*)(ws + WS_WPLE_T), 256, 32 * nb, 64 * kb, scr, lane); }
      } }
    __syncthreads();
    { const float* xp = (const float*)a.in[IN_XP]; const float* xs = (const float*)a.in[IN_XS];
      bf16* hbf = (bf16*)(ws + WS_HBF); float* rstd = (float*)(ws + WS_RSTD); float* BR = (float*)(ws + WS_BR);
      const LAS unsigned char* wbr = lds + WBR_OFF;
      for (int rg = gw; rg < MT / 16; rg += NGW) {
          const int m = rg * 16 + (lane & 15), kq = lane >> 4;
          const float* xr = (m < MP) ? xp + (size_t)m * DM : xs + (size_t)(m - MP) * DM;
          f32x4 c0 = {0.f, 0.f, 0.f, 0.f}, c1 = {0.f, 0.f, 0.f, 0.f}; float ssq = 0.f;
#pragma unroll 8
          for (int s = 0; s < 32; ++s) {
              const f32x4 v0 = *(const GAS f32x4*)(xr + 32 * s + 8 * kq), v1 = *(const GAS f32x4*)(xr + 32 * s + 8 * kq + 4);
              ssq += (v0.x * v0.x + v0.y * v0.y) + (v0.z * v0.z + v0.w * v0.w) + (v1.x * v1.x + v1.y * v1.y) + (v1.z * v1.z + v1.w * v1.w);
              v4u pa; pa.x = pk2(v0.x, v0.y); pa.y = pk2(v0.z, v0.w); pa.z = pk2(v1.x, v1.y); pa.w = pk2(v1.z, v1.w);
              *(GAS v4u*)(hbf + (size_t)m * DM + 32 * s + 8 * kq) = pa;
              const bf16x8 af = __builtin_bit_cast(bf16x8, pa);
              const bf16x8 b0 = *(const LAS bf16x8*)(wbr + (lane & 15) * WBR_PITCH + (32 * s + 8 * kq) * 2);
              const bf16x8 b1 = *(const LAS bf16x8*)(wbr + (16 + (lane & 7)) * WBR_PITCH + (32 * s + 8 * kq) * 2);
              c0 = __builtin_amdgcn_mfma_f32_16x16x32_bf16(af, b0, c0, 0, 0, 0);
              c1 = __builtin_amdgcn_mfma_f32_16x16x32_bf16(af, b1, c1, 0, 0, 0);
          }
          ssq += __shfl_xor(ssq, 16); ssq += __shfl_xor(ssq, 32);
          const float rs = 1.f / sqrtf(ssq * (1.f / DM) + EPS);
          if (kq == 0) rstd[m] = rs;
#pragma unroll
          for (int r = 0; r < 4; ++r) { const int R = 4 * kq + r; const float rsR = __shfl(rs, R); const size_t row = (size_t)rg * 16 + R;
              BR[row * 24 + (lane & 15)] = sigmoidf_(c0[r] * rsR);
              if ((lane & 15) < 8) BR[row * 24 + 16 + (lane & 15)] = sigmoidf_(c1[r] * rsR); }
      } }
    { const float* pp = (const float*)a.in[IN_PP]; const float* ps = (const float*)a.in[IN_PS]; bf16* pbf = (bf16*)(ws + WS_PBF);
      for (int base = (vcu * NTHR + tid); base < MT * 32; base += 8 * G * NTHR) { f32x4 v0[8], v1[8];
#pragma unroll
          for (int u = 0; u < 8; ++u) { const int idx = base + u * G * NTHR; if (idx < MT * 32) { const int row = idx >> 5, c8 = (idx & 31) * 8;
              const float* src = (row < MP) ? pp + (size_t)row * 256 + c8 : ps + (size_t)(row - MP) * 256 + c8; v0[u] = *(const GAS f32x4*)src; v1[u] = *(const GAS f32x4*)(src + 4); } }
#pragma unroll
          for (int u = 0; u < 8; ++u) { const int idx = base + u * G * NTHR; if (idx < MT * 32) { const int row = idx >> 5, c8 = (idx & 31) * 8;
              v4u o; o.x = pk2(v0[u].x, v0[u].y); o.y = pk2(v0[u].z, v0[u].w); o.z = pk2(v1[u].x, v1[u].y); o.w = pk2(v1[u].z, v1[u].w);
              *(GAS v4u*)(pbf + (size_t)row * 256 + c8) = o; } } } }
#ifdef WINCOPY_P0
    { const float* sw = (const float*)a.in[IN_SWIN]; float* dst = a.out + OFF_WINS;
      for (int base = (vcu * NTHR + tid); base < 32 * 504 * 64; base += 8 * G * NTHR) { f32x4 v[8];
#pragma unroll
          for (int u = 0; u < 8; ++u) { const int idx = base + u * G * NTHR; if (idx < 32 * 504 * 64) { const int q = idx & 63, i = (idx >> 6) % 504, b = (idx >> 6) / 504; v[u] = *(const GAS f32x4*)(sw + ((size_t)(b * 512 + i + 8) * 256) + q * 4); } }
#pragma unroll
          for (int u = 0; u < 8; ++u) { const int idx = base + u * G * NTHR; if (idx < 32 * 504 * 64) { const int q = idx & 63, i = (idx >> 6) % 504, b = (idx >> 6) / 504; *(GAS f32x4*)(dst + ((size_t)(b * 512 + i) * 256) + q * 4) = v[u]; } } } }
#endif
    { float* bias = (float*)(ws + WS_CTL) + CW_BIAS;
      if (rep == 0) for (int job = gw; job < 256; job += NGW) { const int slot = job >> 7, jc = (job >> 4) & 7, kc = job & 15, j = jc * 32 + (lane & 31), k0 = kc * 128 + (lane >> 5) * 64;
          const float* W1 = (const float*)a.in[slot ? IN_W1V : IN_W1K]; const float* pe = (const float*)a.in[slot ? IN_PEV : IN_PEK];
          float acc = 0.f;
#pragma unroll 16
          for (int k = 0; k < 64; ++k) acc += pe[k0 + k] * W1[(size_t)(k0 + k) * 256 + j];
          acc += __shfl_xor(acc, 32);
          if (lane < 32) atomicAdd(bias + slot * 256 + j, acc); } }
}

namespace pg8 {
#ifdef EPI_NT_STORES
#define EPI_ST(ptr, val) __builtin_nontemporal_store((val), (ptr))
#else
#define EPI_ST(ptr, val) (*(ptr) = (val))
#endif
__device__ __forceinline__ void st8_bf16(bf16_t* p, f32x4 a, f32x4 b) { u32x4 w; w.x = cvtpk(a[0], a[1]); w.y = cvtpk(a[2], a[3]); w.z = cvtpk(b[0], b[1]); w.w = cvtpk(b[2], b[3]); EPI_ST((u32x4*)p, w); }
__device__ __forceinline__ void st8_f32(float* p, f32x4 a, f32x4 b) { EPI_ST((f32x4*)p, a); EPI_ST((f32x4*)(p + 4), b); }
__device__ __forceinline__ f32x4 silu4(f32x4 v) { f32x4 r; for (int i = 0; i < 4; ++i) r[i] = siluf_(v[i]); return r; }

struct EpiG1 {
    static constexpr bool PERM = true, AFTER_DRAIN = false;
    float* out; const float* rstd; bf16_t *QA, *KA, *VA, *GA, *QB, *GB, *KSEL, *VSEL, *KWIN, *VWIN, *ACMP; const float *q_g, *ks_g, *kw_g, *pe_k, *pe_v;
    __device__ __forceinline__ void operator()(const f32x4 (&acc)[2][2][4][2], const Unit& u, int wr, int wc, int fr_, int fq_) const {
        int fr = fr_, fq = fq_;
#ifndef G1_NOLAUNDER
        asm volatile("" : "+v"(fr), "+v"(fq));
#endif
#ifdef DBG_G1EPI2
        for (int dupe = 0; dupe < 2; ++dupe) {
#endif
        const int pn = g1_role(u.pn);
        float rsv[2][4];
#pragma unroll
        for (int ai = 0; ai < 2; ++ai)
#pragma unroll
            for (int m = 0; m < 4; ++m) rsv[ai][m] = rstd[u.pm * BM + ai * HALF + wr * 64 + m * 16 + fr];
#pragma unroll
        for (int ai = 0; ai < 2; ++ai)
#pragma unroll
            for (int m = 0; m < 4; ++m) {
#ifndef G1_NOROWCLOBBER
                asm volatile("" ::: "memory");
#endif
                const int row = u.pm * BM + ai * HALF + wr * 64 + m * 16 + fr; const float rs = rsv[ai][m];
#define A0(bj) (acc[ai][bj][m][0])
#define A1(bj) (acc[ai][bj][m][1])
                const int lam0 = 64 * wc + 8 * fq;
                if (pn < 2) {
                    const float sc = rs * 0.125f;
#pragma unroll
                    for (int bj = 0; bj < 2; ++bj) st8_bf16(QA + (size_t)row * 512 + pn * 256 + lam0 + 32 * bj, A0(bj) * sc, A1(bj) * sc);
                } else if (pn < 6) {
                    const int sl = (pn >= 4) ? 1 : 0, col = (pn & 1) * 256 + lam0; bf16_t* B = KA + (size_t)sl * ((WS_VA - WS_KA) / 2);
#pragma unroll
                    for (int bj = 0; bj < 2; ++bj) { const f32x4 x0 = A0(bj) * rs, x1 = A1(bj) * rs; st8_f32(out + OFF_SB + (size_t)row * 1024 + sl * 512 + col + 32 * bj, x0, x1); st8_bf16(B + (size_t)row * 512 + col + 32 * bj, x0, x1); }
                } else if (pn < 8) {
#pragma unroll
                    for (int bj = 0; bj < 2; ++bj) st8_bf16(GA + (size_t)row * 512 + (pn - 6) * 256 + lam0 + 32 * bj, silu4(A0(bj) * rs), silu4(A1(bj) * rs));
                } else if (pn >= 13) {
#pragma unroll
                    for (int bj = 0; bj < 2; ++bj) st8_bf16(GB + (size_t)row * 512 + (pn - 13) * 256 + lam0 + 32 * bj, silu4(A0(bj) * rs), silu4(A1(bj) * rs));
                } else {
                    float ssq = 0.f;
#pragma unroll
                    for (int bj = 0; bj < 2; ++bj) { const f32x4 a0 = A0(bj), a1 = A1(bj); ssq += (a0[0] * a0[0] + a0[1] * a0[1]) + (a0[2] * a0[2] + a0[3] * a0[3]) + (a1[0] * a1[0] + a1[1] * a1[1]) + (a1[2] * a1[2] + a1[3] * a1[3]); }
                    ssq += __shfl_xor(ssq, 16); ssq += __shfl_xor(ssq, 32);
                    const float hr = rs / sqrtf(ssq * rs * rs * (1.f / 64.f) + EPS);
                    if (pn < 10) {
                        const float sc = hr * (0.125f * LOG2E);
#pragma unroll
                        for (int bj = 0; bj < 2; ++bj) { const int d0 = 32 * bj + 8 * fq; const f32x4 g0 = *(const f32x4*)(q_g + d0), g1 = *(const f32x4*)(q_g + d0 + 4);
                            st8_bf16(QB + (size_t)row * 512 + (pn - 8) * 256 + lam0 + 32 * bj, A0(bj) * g0 * sc, A1(bj) * g1 * sc); }
                    } else if (pn == 10) {
                        const int t = row & 2047, b = row >> 11, c = t >> 5, p = t & 31, slot = wc >> 1, g = wc & 1; const float* pe = pe_k + (ptrdiff_t)slot * (pe_v - pe_k);
#pragma unroll
                        for (int bj = 0; bj < 2; ++bj) { const int lam = lam0 + 32 * bj, d0 = 32 * bj + 8 * fq; const f32x4 x0 = A0(bj) * rs, x1 = A1(bj) * rs;
                            st8_f32(out + OFF_NSA + (size_t)row * 512 + lam, x0, x1);
                            if (row < MP) { const f32x4 e0 = *(const f32x4*)(pe + p * 64 + d0), e1 = *(const f32x4*)(pe + p * 64 + d0 + 4);
                                st8_bf16(ACMP + ((size_t)slot * 1024 + (size_t)(b * 64 + c) * 2 + g) * 2048 + p * 64 + d0, x0 + e0, x1 + e1); } }
                    } else if (pn == 11) {
#pragma unroll
                        for (int bj = 0; bj < 2; ++bj) { const int lam = lam0 + 32 * bj, d0 = 32 * bj + 8 * fq; f32x4 x0, x1;
                            if (wc < 2) { const f32x4 g0 = *(const f32x4*)(ks_g + d0), g1 = *(const f32x4*)(ks_g + d0 + 4); x0 = A0(bj) * g0 * hr; x1 = A1(bj) * g1 * hr; } else { x0 = A0(bj) * rs; x1 = A1(bj) * rs; }
                            st8_f32(out + OFF_NSA + (size_t)row * 512 + 256 + lam, x0, x1);
                            st8_bf16(KSEL + (size_t)(wc >> 1) * ((WS_VSEL - WS_KSEL) / 2) + (size_t)row * 128 + (lam & 127), x0, x1); }
                    } else {
                        float* wdst = nullptr;
                        if (row >= MP) { const int si = row - MP; wdst = out + OFF_WINS + ((size_t)((si >> 3) * 512 + 504 + (si & 7))) * 256; }
                        else if ((row & 2047) >= 1536) wdst = out + OFF_WINP + ((size_t)((row >> 11) * 512 + (row & 2047) - 1536)) * 256;
#pragma unroll
                        for (int bj = 0; bj < 2; ++bj) { const int lam = lam0 + 32 * bj, d0 = 32 * bj + 8 * fq; f32x4 x0, x1;
                            if (wc < 2) { const f32x4 g0 = *(const f32x4*)(kw_g + d0), g1 = *(const f32x4*)(kw_g + d0 + 4); x0 = A0(bj) * g0 * hr; x1 = A1(bj) * g1 * hr; } else { x0 = A0(bj) * rs; x1 = A1(bj) * rs; }
                            if (wdst) st8_f32(wdst + lam, x0, x1);
                            st8_bf16(KWIN + (size_t)(wc >> 1) * ((WS_VWIN - WS_KWIN) / 2) + (size_t)row * 128 + (lam & 127), x0, x1); }
                    }
                }
#undef A0
#undef A1
            }
#ifdef DBG_G1EPI2
        }
#endif
    }
};
struct EpiNone { static constexpr bool PERM = true, AFTER_DRAIN = false;
    __device__ __forceinline__ void operator()(const f32x4 (&acc)[2][2][4][2], const Unit& u, int wr, int wc, int fr, int fq) const { if (acc[0][0][0][0][0] == 123456.789f) __builtin_trap(); } };
struct EpiHid {
    static constexpr bool PERM = true, AFTER_DRAIN = false;
    bf16_t* O;
    __device__ __forceinline__ void operator()(const f32x4 (&acc)[2][2][4][2], const Unit& u, int wr, int wc, int fr_, int fq_) const {
        int fr = fr_, fq = fq_; asm volatile("" : "+v"(fr), "+v"(fq));
#pragma unroll
        for (int ai = 0; ai < 2; ++ai)
#pragma unroll
            for (int m = 0; m < 4; ++m) { const int row = u.pm * BM + ai * HALF + wr * 64 + m * 16 + fr;
#pragma unroll
                for (int bj = 0; bj < 2; ++bj) st8_bf16(O + (size_t)row * 256 + bj * HALF + wc * 32 + 8 * fq, silu4(acc[ai][bj][m][0]), silu4(acc[ai][bj][m][1])); }
    }
};
struct EpiOut {
    static constexpr bool PERM = true, AFTER_DRAIN = false;
    const bf16_t* XB; bf16_t* HB;
    __device__ __forceinline__ void operator()(const f32x4 (&acc)[2][2][4][2], const Unit& u, int wr, int wc, int fr_, int fq_) const {
        int fr = fr_, fq = fq_; asm volatile("" : "+v"(fr), "+v"(fq));
#pragma unroll
        for (int ai = 0; ai < 2; ++ai) {
            u32x4 xv[4][2];
#pragma unroll
            for (int m = 0; m < 4; ++m) { const int row = u.pm * BM + ai * HALF + wr * 64 + m * 16 + fr;
#pragma unroll
                for (int bj = 0; bj < 2; ++bj) { const int col = u.pn * BM + bj * HALF + wc * 32 + 8 * fq; xv[m][bj] = *(const u32x4*)(XB + (size_t)row * DM + col); } }
#pragma unroll
            for (int m = 0; m < 4; ++m) { const int row = u.pm * BM + ai * HALF + wr * 64 + m * 16 + fr;
#pragma unroll
                for (int bj = 0; bj < 2; ++bj) { const int col = u.pn * BM + bj * HALF + wc * 32 + 8 * fq; const u32x4 x = xv[m][bj];
                    const f32x4 x0 = {bf_lo(x.x), bf_hi(x.x), bf_lo(x.y), bf_hi(x.y)}, x1 = {bf_lo(x.z), bf_hi(x.z), bf_lo(x.w), bf_hi(x.w)};
                    st8_bf16(HB + (size_t)row * DM + col, x0 + acc[ai][bj][m][0], x1 + acc[ai][bj][m][1]); } }
        }
    }
};
struct EpiFinal {
    static constexpr bool PERM = true, AFTER_DRAIN = false;
    float* Y; const bf16_t* T1; const bf16_t* HB;
    __device__ __forceinline__ void operator()(const f32x4 (&acc)[2][2][4][2], const Unit& u, int wr, int wc, int fr_, int fq_) const {
        int fr = fr_, fq = fq_; asm volatile("" : "+v"(fr), "+v"(fq));
#pragma unroll
        for (int ai = 0; ai < 2; ++ai) {
            u32x4 tv[4][2], hv[4][2];
#pragma unroll
            for (int m = 0; m < 4; ++m) { const int row = u.pm * BM + ai * HALF + wr * 64 + m * 16 + fr;
#pragma unroll
                for (int bj = 0; bj < 2; ++bj) { const int col = u.pn * BM + bj * HALF + wc * 32 + 8 * fq; tv[m][bj] = *(const u32x4*)(T1 + (size_t)row * DM + col); hv[m][bj] = *(const u32x4*)(HB + (size_t)row * DM + col); } }
#pragma unroll
            for (int m = 0; m < 4; ++m) { const int row = u.pm * BM + ai * HALF + wr * 64 + m * 16 + fr;
#pragma unroll
                for (int bj = 0; bj < 2; ++bj) { const int col = u.pn * BM + bj * HALF + wc * 32 + 8 * fq; float* yp = Y + (size_t)row * DM + col;
                    const u32x4 t = tv[m][bj], hb = hv[m][bj]; const f32x4 a0 = acc[ai][bj][m][0], a1 = acc[ai][bj][m][1];
                    f32x4 y0, y1;
                    y0[0] = bf_lo(hb.x) + sigmoidf_(a0[0]) * bf_lo(t.x); y0[1] = bf_hi(hb.x) + sigmoidf_(a0[1]) * bf_hi(t.x); y0[2] = bf_lo(hb.y) + sigmoidf_(a0[2]) * bf_lo(t.y); y0[3] = bf_hi(hb.y) + sigmoidf_(a0[3]) * bf_hi(t.y);
                    y1[0] = bf_lo(hb.z) + sigmoidf_(a1[0]) * bf_lo(t.z); y1[1] = bf_hi(hb.z) + sigmoidf_(a1[1]) * bf_hi(t.z); y1[2] = bf_lo(hb.w) + sigmoidf_(a1[2]) * bf_lo(t.w); y1[3] = bf_hi(hb.w) + sigmoidf_(a1[3]) * bf_hi(t.w);
#ifdef Y_NT_STORES
                    __builtin_nontemporal_store(y0, (f32x4*)yp); __builtin_nontemporal_store(y1, (f32x4*)(yp + 4));
#else
                    st8_f32(yp, y0, y1);
#endif
                    } }
        }
    }
};
struct DiagOrder {
    int n, per, G, c;
    __device__ __forceinline__ bool next(int i, Unit& u) const { const int L = i * G + c; if (L >= n) return false; u.pm = L; u.pn = L / per; return true; }
    __device__ __forceinline__ void a_ready(const Unit&) const {}
    __device__ __forceinline__ void done(const Unit&) const {}
};
struct EpiHidB {
    bf16_t* O; const float* bias;
    __device__ __forceinline__ void operator()(const f32x4 (&acc)[2][2][4][2], int pm, int wr, int wc, int fr_, int fq_) const {
        int fr = fr_, fq = fq_; asm volatile("" : "+v"(fr), "+v"(fq));
#pragma unroll
        for (int bj = 0; bj < 2; ++bj) { const int col = bj * HALF + wc * 32 + 8 * fq; const f32x4 b0 = *(const f32x4*)(bias + col), b1 = *(const f32x4*)(bias + col + 4);
#pragma unroll
            for (int ai = 0; ai < 2; ++ai)
#pragma unroll
                for (int m = 0; m < 4; ++m) { const int row = pm * BM + ai * HALF + wr * 64 + m * 16 + fr;
                    st8_bf16(O + (size_t)row * 256 + col, silu4(acc[ai][bj][m][0] + b0), silu4(acc[ai][bj][m][1] + b1)); } }
    }
};
__device__ __forceinline__ void gemm_unit_gather(PG8_LAS unsigned char* lds, const float* cn, const int* pt, const bf16_t* W1T  , int L  , const EpiHidB& E) {
    int tid_ = threadIdx.x; asm volatile("" : "+v"(tid_));
    const int tid = tid_, wid = __builtin_amdgcn_readfirstlane(tid >> 6), lane = tid & 63, wr = wid >> 2, wc = wid & 3, fr = lane & 15, fq = lane >> 4;
    const int slot = L >> 6, pmu = L & 63;
    const float* abase[4]; const bf16_t* bbase[4]; int aofs[4], bofs[4];
#pragma unroll
    for (int j = 0; j < 4; ++j) { const int q = tid + 512 * j, row = q >> 3, c8 = q & 7, R = pmu * 256 + row, b = R >> 9, c = (R >> 1) & 255, g = R & 1, pos0 = c * 32;
        abase[j] = cn + ((size_t)pt[b * 64 + (pos0 >> 7)] * 128 + (pos0 & 127)) * 512 + slot * 128 + g * 64 + c8 * 8;
        aofs[j] = (row >> 7) * HTB + lds_byte(row & 127, c8 * 8);
        const int nsrc = (row & ~31) + perm32(row & 31);
        bbase[j] = W1T + (size_t)(slot * 256 + nsrc) * 2048 + c8 * 8;
        bofs[j] = (4 + (row >> 7)) * HTB + lds_byte(row & 127, c8 * 8); }
    const int aoff = lds_byte(wr * 64 + fr, fq * 8), boff = lds_byte(wc * 32 + fr, fq * 8);
    f32x4 acc[2][2][4][2];
#pragma unroll
    for (int a = 0; a < 2; ++a)
#pragma unroll
        for (int b = 0; b < 2; ++b)
#pragma unroll
            for (int m = 0; m < 4; ++m)
#pragma unroll
                for (int n = 0; n < 2; ++n) acc[a][b][m][n] = (f32x4){0.f, 0.f, 0.f, 0.f};
    f32x4 ar[4][2]; u32x4 br[4];
#define GU_LOAD(kt) do { _Pragma("unroll") for (int j = 0; j < 4; ++j) { ar[j][0] = *(const f32x4*)(abase[j] + (size_t)(kt) * 512); ar[j][1] = *(const f32x4*)(abase[j] + (size_t)(kt) * 512 + 4); br[j] = *(const u32x4*)(bbase[j] + (kt) * 64); } } while (0)
#define GU_STORE(stg) do { _Pragma("unroll") for (int j = 0; j < 4; ++j) { u32x4 w; w.x = cvtpk(ar[j][0][0], ar[j][0][1]); w.y = cvtpk(ar[j][0][2], ar[j][0][3]); w.z = cvtpk(ar[j][1][0], ar[j][1][1]); w.w = cvtpk(ar[j][1][2], ar[j][1][3]); \
        *(PG8_LAS u32x4*)(lds + (stg) * 2 * HTB + aofs[j]) = w; *(PG8_LAS u32x4*)(lds + (stg) * 2 * HTB + bofs[j]) = br[j]; } } while (0)
    GU_LOAD(0); GU_STORE(0); GU_LOAD(1);
    for (int kt = 0; kt < 32; ++kt) {
        const int stg = kt & 1;
        __syncthreads();
        if (kt + 1 < 32) GU_STORE(stg ^ 1);
        if (kt + 2 < 32) GU_LOAD(kt + 2);
        bf16x8 At[4][2], Bf[2][2];
#pragma unroll
        for (int ai = 0; ai < 2; ++ai) {
#pragma unroll
            for (int m = 0; m < 4; ++m)
#pragma unroll
                for (int k = 0; k < 2; ++k) At[m][k] = *(const PG8_LAS bf16x8*)(lds + (stg * 2 + ai) * HTB + aoff + m * 2048 + k * 1024);
#pragma unroll
            for (int bj = 0; bj < 2; ++bj) {
#pragma unroll
                for (int n = 0; n < 2; ++n)
#pragma unroll
                    for (int k = 0; k < 2; ++k) Bf[n][k] = *(const PG8_LAS bf16x8*)(lds + (4 + stg * 2 + bj) * HTB + boff + n * 2048 + k * 1024);
#pragma unroll
                for (int m = 0; m < 4; ++m)
#pragma unroll
                    for (int n = 0; n < 2; ++n)
#pragma unroll
                        for (int k = 0; k < 2; ++k) acc[ai][bj][m][n] = __builtin_amdgcn_mfma_f32_16x16x32_bf16(Bf[n][k], At[m][k], acc[ai][bj][m][n], 0, 0, 0);
            } }
    }
#undef GU_LOAD
#undef GU_STORE
    E(acc, L, wr, wc, fr, fq);
    __syncthreads();
}
struct EpiHidB128 {
    bf16_t* O; const float* bias;
    __device__ __forceinline__ void operator()(const f32x4 (&acc)[2][4][2], int row0, int wr, int wc, int fr_, int fq_) const {
        int fr = fr_, fq = fq_; asm volatile("" : "+v"(fr), "+v"(fq));
#pragma unroll
        for (int bj = 0; bj < 2; ++bj) { const int col = bj * HALF + wc * 32 + 8 * fq; const f32x4 b0 = *(const f32x4*)(bias + col), b1 = *(const f32x4*)(bias + col + 4);
#pragma unroll
            for (int m = 0; m < 4; ++m) { const int row = row0 + wr * 64 + m * 16 + fr;
                st8_bf16(O + (size_t)row * 256 + col, silu4(acc[bj][m][0] + b0), silu4(acc[bj][m][1] + b1)); } }
    }
};
__device__ __forceinline__ void gemm_unit_gather128(PG8_LAS unsigned char* lds, const float* cn, const int* pt, const bf16_t* W1T  , int L  , const EpiHidB128& E) {
    int tid_ = threadIdx.x; asm volatile("" : "+v"(tid_));
    const int tid = tid_, wid = __builtin_amdgcn_readfirstlane(tid >> 6), lane = tid & 63, wr = wid >> 2, wc = wid & 3, fr = lane & 15, fq = lane >> 4;
    const int slot = L >> 7, pmu = L & 127;
    const float* abase[2]; const bf16_t* bbase[4]; int aofs[2], bofs[4];
#pragma unroll
    for (int j = 0; j < 2; ++j) { const int q = tid + 512 * j, row = q >> 3, c8 = q & 7, R = pmu * 128 + row, b = R >> 9, c = (R >> 1) & 255, g = R & 1, pos0 = c * 32;
        abase[j] = cn + ((size_t)pt[b * 64 + (pos0 >> 7)] * 128 + (pos0 & 127)) * 512 + slot * 128 + g * 64 + c8 * 8;
        aofs[j] = lds_byte(row, c8 * 8); }
#pragma unroll
    for (int j = 0; j < 4; ++j) { const int q = tid + 512 * j, n = q >> 3, c8 = q & 7, nsrc = (n & ~31) + perm32(n & 31);
        bbase[j] = W1T + (size_t)(slot * 256 + nsrc) * 2048 + c8 * 8;
        bofs[j] = (1 + (n >> 7)) * HTB + lds_byte(n & 127, c8 * 8); }
    const int aoff = lds_byte(wr * 64 + fr, fq * 8), boff = lds_byte(wc * 32 + fr, fq * 8);
    f32x4 acc[2][4][2];
#pragma unroll
    for (int b = 0; b < 2; ++b)
#pragma unroll
        for (int m = 0; m < 4; ++m)
#pragma unroll
            for (int n = 0; n < 2; ++n) acc[b][m][n] = (f32x4){0.f, 0.f, 0.f, 0.f};
    f32x4 ra0[2][2], ra1[2][2], ra2[2][2], ra3[2][2]; u32x4 br[4];
#define GU_LDA(ra, kt) do { _Pragma("unroll") for (int j = 0; j < 2; ++j) { ra[j][0] = *(const f32x4*)(abase[j] + (size_t)(kt) * 512); ra[j][1] = *(const f32x4*)(abase[j] + (size_t)(kt) * 512 + 4); } } while (0)
#define GU_LDB(kt) do { _Pragma("unroll") for (int j = 0; j < 4; ++j) br[j] = *(const u32x4*)(bbase[j] + (kt) * 64); } while (0)
#define GU_ST(stg, ra) do { _Pragma("unroll") for (int j = 0; j < 2; ++j) { u32x4 w; w.x = cvtpk(ra[j][0][0], ra[j][0][1]); w.y = cvtpk(ra[j][0][2], ra[j][0][3]); w.z = cvtpk(ra[j][1][0], ra[j][1][1]); w.w = cvtpk(ra[j][1][2], ra[j][1][3]); \
        *(PG8_LAS u32x4*)(lds + (stg) * 3 * HTB + aofs[j]) = w; } _Pragma("unroll") for (int j = 0; j < 4; ++j) *(PG8_LAS u32x4*)(lds + (stg) * 3 * HTB + bofs[j]) = br[j]; } while (0)
#define GU_MMA(stg) do { bf16x8 At[4][2], Bf[2][2]; \
        _Pragma("unroll") for (int m = 0; m < 4; ++m) _Pragma("unroll") for (int k = 0; k < 2; ++k) At[m][k] = *(const PG8_LAS bf16x8*)(lds + (stg) * 3 * HTB + aoff + m * 2048 + k * 1024); \
        _Pragma("unroll") for (int bj = 0; bj < 2; ++bj) { \
            _Pragma("unroll") for (int n = 0; n < 2; ++n) _Pragma("unroll") for (int k = 0; k < 2; ++k) Bf[n][k] = *(const PG8_LAS bf16x8*)(lds + ((stg) * 3 + 1 + bj) * HTB + boff + n * 2048 + k * 1024); \
            _Pragma("unroll") for (int m = 0; m < 4; ++m) _Pragma("unroll") for (int n = 0; n < 2; ++n) _Pragma("unroll") for (int k = 0; k < 2; ++k) \
                acc[bj][m][n] = __builtin_amdgcn_mfma_f32_16x16x32_bf16(Bf[n][k], At[m][k], acc[bj][m][n], 0, 0, 0); } } while (0)
#define GU_STEP(kt, stg, raN) do { __syncthreads(); if ((kt) + 1 < 32) GU_ST((stg) ^ 1, raN); if ((kt) + 5 < 32) GU_LDA(raN, (kt) + 5); GU_LDB((kt) + 2 < 32 ? (kt) + 2 : 31); GU_MMA(stg); } while (0)
    GU_LDA(ra0, 0); GU_LDB(0); GU_ST(0, ra0); GU_LDA(ra1, 1); GU_LDA(ra2, 2); GU_LDA(ra3, 3); GU_LDA(ra0, 4); GU_LDB(1);
    for (int kt = 0; kt < 32; kt += 4) { GU_STEP(kt, 0, ra1); GU_STEP(kt + 1, 1, ra2); GU_STEP(kt + 2, 0, ra3); GU_STEP(kt + 3, 1, ra0); }
#undef GU_LDA
#undef GU_LDB
#undef GU_ST
#undef GU_MMA
#undef GU_STEP
    E(acc, L * 128, wr, wc, fr, fq);
    __syncthreads();
}
__device__ __forceinline__ void gemm_unit_bf16_128(PG8_LAS unsigned char* lds, const bf16_t* A  , const bf16_t* W1T  , int slot, int row0, const EpiHidB128& E) {
    int tid_ = threadIdx.x; asm volatile("" : "+v"(tid_));
    const int tid = tid_, wid = __builtin_amdgcn_readfirstlane(tid >> 6), lane = tid & 63, wr = wid >> 2, wc = wid & 3, fr = lane & 15, fq = lane >> 4;
    const bf16_t* abase[2]; const bf16_t* bbase[4]; int aofs[2], bofs[4];
#pragma unroll
    for (int j = 0; j < 2; ++j) { const int q = tid + 512 * j, row = q >> 3, c8 = q & 7; abase[j] = A + (size_t)row * 2048 + c8 * 8; aofs[j] = lds_byte(row, c8 * 8); }
#pragma unroll
    for (int j = 0; j < 4; ++j) { const int q = tid + 512 * j, n = q >> 3, c8 = q & 7, nsrc = (n & ~31) + perm32(n & 31);
        bbase[j] = W1T + (size_t)(slot * 256 + nsrc) * 2048 + c8 * 8;
        bofs[j] = (1 + (n >> 7)) * HTB + lds_byte(n & 127, c8 * 8); }
    const int aoff = lds_byte(wr * 64 + fr, fq * 8), boff = lds_byte(wc * 32 + fr, fq * 8);
    f32x4 acc[2][4][2];
#pragma unroll
    for (int b = 0; b < 2; ++b)
#pragma unroll
        for (int m = 0; m < 4; ++m)
#pragma unroll
            for (int n = 0; n < 2; ++n) acc[b][m][n] = (f32x4){0.f, 0.f, 0.f, 0.f};
    u32x4 ra0[2], ra1[2], ra2[2], ra3[2], br[4];
#define GB_LDA(ra, kt) do { _Pragma("unroll") for (int j = 0; j < 2; ++j) ra[j] = *(const u32x4*)(abase[j] + (kt) * 64); } while (0)
#define GB_LDB(kt) do { _Pragma("unroll") for (int j = 0; j < 4; ++j) br[j] = *(const u32x4*)(bbase[j] + (kt) * 64); } while (0)
#define GB_ST(stg, ra) do { _Pragma("unroll") for (int j = 0; j < 2; ++j) *(PG8_LAS u32x4*)(lds + (stg) * 3 * HTB + aofs[j]) = ra[j]; \
        _Pragma("unroll") for (int j = 0; j < 4; ++j) *(PG8_LAS u32x4*)(lds + (stg) * 3 * HTB + bofs[j]) = br[j]; } while (0)
#define GB_MMA(stg) do { bf16x8 At[4][2], Bf[2][2]; \
        _Pragma("unroll") for (int m = 0; m < 4; ++m) _Pragma("unroll") for (int k = 0; k < 2; ++k) At[m][k] = *(const PG8_LAS bf16x8*)(lds + (stg) * 3 * HTB + aoff + m * 2048 + k * 1024); \
        _Pragma("unroll") for (int bj = 0; bj < 2; ++bj) { \
            _Pragma("unroll") for (int n = 0; n < 2; ++n) _Pragma("unroll") for (int k = 0; k < 2; ++k) Bf[n][k] = *(const PG8_LAS bf16x8*)(lds + ((stg) * 3 + 1 + bj) * HTB + boff + n * 2048 + k * 1024); \
            _Pragma("unroll") for (int m = 0; m < 4; ++m) _Pragma("unroll") for (int n = 0; n < 2; ++n) _Pragma("unroll") for (int k = 0; k < 2; ++k) \
                acc[bj][m][n] = __builtin_amdgcn_mfma_f32_16x16x32_bf16(Bf[n][k], At[m][k], acc[bj][m][n], 0, 0, 0); } } while (0)
#define GB_STEP(kt, stg, raN) do { __syncthreads(); if ((kt) + 1 < 32) GB_ST((stg) ^ 1, raN); if ((kt) + 5 < 32) GB_LDA(raN, (kt) + 5); GB_LDB((kt) + 2 < 32 ? (kt) + 2 : 31); GB_MMA(stg); } while (0)
    GB_LDA(ra0, 0); GB_LDB(0); GB_ST(0, ra0); GB_LDA(ra1, 1); GB_LDA(ra2, 2); GB_LDA(ra3, 3); GB_LDA(ra0, 4); GB_LDB(1);
    for (int kt = 0; kt < 32; kt += 4) { GB_STEP(kt, 0, ra1); GB_STEP(kt + 1, 1, ra2); GB_STEP(kt + 2, 0, ra3); GB_STEP(kt + 3, 1, ra0); }
#undef GB_LDA
#undef GB_LDB
#undef GB_ST
#undef GB_MMA
#undef GB_STEP
    E(acc, row0, wr, wc, fr, fq);
    __syncthreads();
}
struct XcdQueueOrder {
    unsigned* q; volatile PG8_LAS int* slot; int nM, nN, nwg, x;
    __device__ __forceinline__ void init(int M, int N, unsigned* q_, volatile PG8_LAS int* slot_, int xcc) { nM = M / BM; nN = N / BM; nwg = nM * nN; q = q_; slot = slot_; x = xcc & 7; }
    __device__ __forceinline__ bool next(int i, Unit& u) const {
        if (threadIdx.x == 0) { int res = -1; const int qq = nwg / NXCD, rr = nwg % NXCD;
#pragma unroll 1
            for (int k = 0; k < NXCD; ++k) { const int xx = (x + k) & 7, sz = qq + (xx < rr ? 1 : 0), st = xx < rr ? xx * (qq + 1) : rr * (qq + 1) + (xx - rr) * qq;
                if ((int)__hip_atomic_load(q + 64 * xx, __ATOMIC_RELAXED, __HIP_MEMORY_SCOPE_AGENT) >= sz) continue;
                const int t = (int)__hip_atomic_fetch_add(q + 64 * xx, 1u, __ATOMIC_RELAXED, __HIP_MEMORY_SCOPE_AGENT);
                if (t < sz) { res = st + t; break; } }
            slot[i & 1] = res; }
        asm volatile("s_waitcnt lgkmcnt(0)" ::: "memory"); __builtin_amdgcn_s_barrier(); asm volatile("" ::: "memory");
        const int wgid = slot[i & 1]; if (wgid < 0) return false;
        const int nig = WGM * nN, gid = wgid / nig, fm = gid * WGM, gsz = (nM - fm) < WGM ? (nM - fm) : WGM;
        u.pm = fm + ((wgid % nig) % gsz); u.pn = (wgid % nig) / gsz; return true;
    }
    __device__ __forceinline__ void a_ready(const Unit&) const {}
    __device__ __forceinline__ void done(const Unit&) const {}
};
struct HybridOrder {
    unsigned* q; volatile PG8_LAS int* slot; int nM, nN, nwg, ns, l0, lstride, dyn0;
    __device__ __forceinline__ bool decode(int L, Unit& u) const {
        int wgid = L; { const int qq = nwg / NXCD, r = nwg % NXCD, xcd = wgid % NXCD, off = wgid / NXCD; wgid = (xcd < r ? xcd * (qq + 1) : r * (qq + 1) + (xcd - r) * qq) + off; }
        const int nig = WGM * nN, gid = wgid / nig, fm = gid * WGM, gsz = (nM - fm) < WGM ? (nM - fm) : WGM;
        u.pm = fm + ((wgid % nig) % gsz); u.pn = (wgid % nig) / gsz; return true;
    }
    __device__ __forceinline__ bool next(int i, Unit& u) const {
        if (i < ns) return decode(l0 + i * lstride, u);
        if (threadIdx.x == 0) { int res = -1;
            if ((int)__hip_atomic_load(q, __ATOMIC_RELAXED, __HIP_MEMORY_SCOPE_AGENT) < nwg - dyn0) { const int t = (int)__hip_atomic_fetch_add(q, 1u, __ATOMIC_RELAXED, __HIP_MEMORY_SCOPE_AGENT); if (t < nwg - dyn0) res = dyn0 + t; }
            slot[i & 1] = res; }
        asm volatile("s_waitcnt lgkmcnt(0)" ::: "memory"); __builtin_amdgcn_s_barrier(); asm volatile("" ::: "memory");
        const int L = slot[i & 1]; if (L < 0) return false; return decode(L, u);
    }
    __device__ __forceinline__ void a_ready(const Unit&) const {}
    __device__ __forceinline__ void done(const Unit&) const {}
};
struct DiagQueueOrder {
    unsigned* q; volatile PG8_LAS int* slot; int n, per;
    __device__ __forceinline__ bool next(int i, Unit& u) const {
        if (threadIdx.x == 0) { int res = -1;
            if ((int)__hip_atomic_load(q, __ATOMIC_RELAXED, __HIP_MEMORY_SCOPE_AGENT) < n) { const int t = (int)__hip_atomic_fetch_add(q, 1u, __ATOMIC_RELAXED, __HIP_MEMORY_SCOPE_AGENT); if (t < n) res = t; }
            slot[i & 1] = res; }
        asm volatile("s_waitcnt lgkmcnt(0)" ::: "memory"); __builtin_amdgcn_s_barrier(); asm volatile("" ::: "memory");
        const int L = slot[i & 1]; if (L < 0) return false; u.pm = L; u.pn = L / per; return true;
    }
    __device__ __forceinline__ void a_ready(const Unit&) const {}
    __device__ __forceinline__ void done(const Unit&) const {}
};
struct OneUnit {
    int pm, pn;
    __device__ __forceinline__ bool next(int i, Unit& u) const { if (i > 0) return false; u.pm = pm; u.pn = pn; return true; }
    __device__ __forceinline__ void a_ready(const Unit&) const {}
    __device__ __forceinline__ void done(const Unit&) const {}
};
}

#ifndef DBG_DUP
#define DBG_DUP 0
#endif

#define MFMA32(a, b, c) __builtin_amdgcn_mfma_f32_32x32x16_bf16((a), (b), (c), 0, 0, 0)
constexpr int KP = 144, VP = 192;
constexpr int KT_BYTES = 64 * KP, VT_BYTES = 64 * VP;
typedef short v4i16_t __attribute__((ext_vector_type(4)));
__device__ __forceinline__ int kidx_of(int kh, int v, int h) { return 32 * kh + (v & 3) + 8 * (v >> 2) + 4 * h; }
__device__ __forceinline__ s16x4 vtr(const LAS unsigned char* p) { return __builtin_bit_cast(s16x4, __builtin_amdgcn_ds_read_tr16_b64_v4i16((LAS v4i16_t*)p)); }

__device__ __forceinline__ void qk64(f32x16 (&s)[2], const LAS unsigned char* Ks, const bf16x8 (&qf)[4], int lane) {
    const LAS unsigned char* kb = Ks + (lane & 31) * KP + (lane >> 5) * 16;
#pragma unroll
    for (int kh = 0; kh < 2; ++kh) { f32x16 acc; for (int i = 0; i < 16; ++i) acc[i] = 0.f;
#pragma unroll
        for (int ks = 0; ks < 4; ++ks) { const bf16x8 kf = *(const LAS bf16x8*)(kb + kh * 32 * KP + ks * 32); __builtin_amdgcn_s_setprio(1); acc = MFMA32(kf, qf[ks], acc); __builtin_amdgcn_s_setprio(0); }
        s[kh] = acc; }
}
__device__ __forceinline__ void qk64_g(f32x16 (&s)[2], const bf16* Kg, int kpitch, const bf16x8 (&qf)[4], int lane) {
    const bf16* kb = Kg + (size_t)(lane & 31) * kpitch + (lane >> 5) * 8;
    bf16x8 kf[2][4];
#pragma unroll
    for (int kh = 0; kh < 2; ++kh)
#pragma unroll
        for (int ks = 0; ks < 4; ++ks) kf[kh][ks] = *(const GAS bf16x8*)(kb + (size_t)kh * 32 * kpitch + ks * 16);
#pragma unroll
    for (int kh = 0; kh < 2; ++kh) { f32x16 acc; for (int i = 0; i < 16; ++i) acc[i] = 0.f;
        __builtin_amdgcn_s_setprio(1);
#pragma unroll
        for (int ks = 0; ks < 4; ++ks) acc = MFMA32(kf[kh][ks], qf[ks], acc);
        __builtin_amdgcn_s_setprio(0);
        s[kh] = acc; }
}
__device__ __forceinline__ void pv64(f32x16 (&o)[2], const LAS unsigned char* Vs, const f32x16 (&e)[2], int lane) {
    const int G = lane >> 4, i = lane & 15, q = i >> 2, p = i & 3, h = G >> 1;
    const LAS unsigned char* vb = Vs + (4 * h + q) * VP + (16 * (G & 1) + 4 * p) * 2;
#pragma unroll
    for (int kh = 0; kh < 2; ++kh)
#pragma unroll
        for (int s = 0; s < 2; ++s) {
            v4u pw; pw.x = cvtpk(e[kh][8 * s + 0], e[kh][8 * s + 1]); pw.y = cvtpk(e[kh][8 * s + 2], e[kh][8 * s + 3]); pw.z = cvtpk(e[kh][8 * s + 4], e[kh][8 * s + 5]); pw.w = cvtpk(e[kh][8 * s + 6], e[kh][8 * s + 7]);
            const bf16x8 pf = __builtin_bit_cast(bf16x8, pw);
#pragma unroll
            for (int dh = 0; dh < 2; ++dh) {
                const s16x4 lo = vtr(vb + (32 * kh + 16 * s) * VP + 64 * dh), hi = vtr(vb + (32 * kh + 16 * s + 8) * VP + 64 * dh);
                const bf16x8 vf = {lo[0], lo[1], lo[2], lo[3], hi[0], hi[1], hi[2], hi[3]};
                __builtin_amdgcn_s_setprio(1); o[dh] = MFMA32(vf, pf, o[dh]); __builtin_amdgcn_s_setprio(0);
            }
        }
}
__device__ __forceinline__ bf16x8 pack8(f32x4 a, f32x4 b) { v4u w; w.x = cvtpk(a[0], a[1]); w.y = cvtpk(a[2], a[3]); w.z = cvtpk(b[0], b[1]); w.w = cvtpk(b[2], b[3]); return __builtin_bit_cast(bf16x8, w); }
__device__ __forceinline__ float xhalf(float v, int h) {
    const unsigned u = __builtin_bit_cast(unsigned, v);
    auto r = __builtin_amdgcn_permlane32_swap(u, u, false, false);
    return __builtin_bit_cast(float, h ? r[0] : r[1]);
}
__device__ __forceinline__ float xmax_half(float v) {
    const unsigned u = __builtin_bit_cast(unsigned, v); auto r = __builtin_amdgcn_permlane32_swap(u, u, false, false);
    return fmaxf(__builtin_bit_cast(float, r[0]), __builtin_bit_cast(float, r[1]));
}
__device__ __forceinline__ void load_qf(bf16x8 (&qf)[4], const bf16* qrow, int lane) {
#pragma unroll
    for (int ks = 0; ks < 4; ++ks) qf[ks] = *(const GAS bf16x8*)(qrow + 16 * ks + 8 * (lane >> 5));
}
__device__ __forceinline__ v4u tile_ld(const bf16* g, int rpitch, int tid) { return *(const GAS v4u*)(g + (size_t)(tid >> 3) * rpitch + (tid & 7) * 8); }
__device__ __forceinline__ void tile_st(LAS unsigned char* t, int P, int tid, v4u v) { *(LAS v4u*)(t + (tid >> 3) * P + (tid & 7) * 16) = v; }

template <class F> __device__ __forceinline__ void softmax_tile(f32x16 (&s)[2], float& m, float& l, f32x16 (&o)[2], int h, F&& biasf) {
    float mx = -1e30f;
#pragma unroll
    for (int kh = 0; kh < 2; ++kh)
#pragma unroll
        for (int v = 0; v < 16; ++v) { const float x = s[kh][v] + biasf(kidx_of(kh, v, h)); s[kh][v] = x; mx = fmaxf(mx, x); }
    mx = xmax_half(mx);
    const float mn = fmaxf(m, mx), al = fexp2(m - mn); m = mn;
    float sum = 0.f;
#pragma unroll
    for (int kh = 0; kh < 2; ++kh)
#pragma unroll
        for (int v = 0; v < 16; ++v) { const float e = fexp2(s[kh][v] - mn); s[kh][v] = e; sum += e; }
    l = l * al + sum;
#pragma unroll
    for (int dh = 0; dh < 2; ++dh)
#pragma unroll
        for (int v = 0; v < 16; ++v) o[dh][v] *= al;
}
__device__ __forceinline__ void alibi_cinit(f32x16 (&c)[2], float slope2) {
#pragma unroll
    for (int kh = 0; kh < 2; ++kh)
#pragma unroll
        for (int v = 0; v < 16; ++v) c[kh][v] = slope2 * (float)(32 * kh + (v & 3) + 8 * (v >> 2));
}
__device__ __forceinline__ void qk64c(f32x16 (&s)[2], const LAS unsigned char* Ks, const bf16x8 (&qf)[4], const f32x16 (&cinit)[2], int lane) {
    const LAS unsigned char* kb = Ks + (lane & 31) * KP + (lane >> 5) * 16;
    bf16x8 kf[2][4];
#pragma unroll
    for (int ks = 0; ks < 4; ++ks)
#pragma unroll
        for (int kh = 0; kh < 2; ++kh) kf[kh][ks] = *(const LAS bf16x8*)(kb + kh * 32 * KP + ks * 32);
    __builtin_amdgcn_s_setprio(1);
    f32x16 a0 = MFMA32(kf[0][0], qf[0], cinit[0]), a1 = MFMA32(kf[1][0], qf[0], cinit[1]);
#pragma unroll
    for (int ks = 1; ks < 4; ++ks) { a0 = MFMA32(kf[0][ks], qf[ks], a0); a1 = MFMA32(kf[1][ks], qf[ks], a1); }
    __builtin_amdgcn_s_setprio(0);
    s[0] = a0; s[1] = a1;
}
template <bool MASKED> __device__ __forceinline__ void sm2_tile(f32x16 (&s)[2], float& m, float& l, f32x16 (&o)[2], float off, bool part, int lo, int hi) {
    float mxp = -INFINITY;
#pragma unroll
    for (int kh = 0; kh < 2; ++kh)
#pragma unroll
        for (int v = 0; v < 16; ++v) { const int Kc = 32 * kh + (v & 3) + 8 * (v >> 2); float xp = s[kh][v];
            if (MASKED) { xp = (Kc > lo && Kc <= hi) ? xp : -INFINITY; s[kh][v] = xp; }
            mxp = fmaxf(mxp, xp); }
    float mx = mxp + off; mx = xmax_half(mx);
    const float mn = part ? fmaxf(m, mx) : m, al = fexp2(m - mn); m = mn; l *= al;
#pragma unroll
    for (int dh = 0; dh < 2; ++dh)
#pragma unroll
        for (int v = 0; v < 16; ++v) o[dh][v] *= al;
    const float mb = part ? (mn - off) : INFINITY;
    float sum = 0.f;
#pragma unroll
    for (int kh = 0; kh < 2; ++kh)
#pragma unroll
        for (int v = 0; v < 16; ++v) { const float e = fexp2(s[kh][v] - mb); s[kh][v] = e; sum += e; }
    l += sum;
}
__device__ __forceinline__ void store_row_wide(bf16* rowp, v2u (&grp)[8], int h, bool pred = true) {
#pragma unroll
    for (int g = 0; g < 8; g += 2) { v2u a = grp[g], b = grp[g + 1];
        { auto r = __builtin_amdgcn_permlane32_swap(a.x, b.x, false, false); a.x = r[0]; b.x = r[1]; }
        { auto r = __builtin_amdgcn_permlane32_swap(a.y, b.y, false, false); a.y = r[0]; b.y = r[1]; }
        if (pred) { v4u w; w.x = a.x; w.y = a.y; w.z = b.x; w.w = b.y; *(GAS v4u*)(rowp + 8 * g + 8 * h) = w; } }
}
__device__ __forceinline__ void store_ot(bf16* dst, const f32x16 (&o)[2], float sc, int h) {
    v2u grp[8];
#pragma unroll
    for (int dh = 0; dh < 2; ++dh)
#pragma unroll
        for (int a = 0; a < 4; ++a) { grp[4 * dh + a].x = cvtpk(o[dh][4 * a] * sc, o[dh][4 * a + 1] * sc); grp[4 * dh + a].y = cvtpk(o[dh][4 * a + 2] * sc, o[dh][4 * a + 3] * sc); }
    store_row_wide(dst, grp, h);
}
__device__ __forceinline__ void zero_o(f32x16 (&o)[2]) { for (int dh = 0; dh < 2; ++dh) for (int v = 0; v < 16; ++v) o[dh][v] = 0.f; }

template <bool TO_LDS> __device__ __forceinline__ void l2_wave(const bf16* w2t  , const bf16* hid0, int hstride, const float* kcg  , unsigned char* dst, int dpitch_bytes, int lane) {
    const int r = lane & 31, h = lane >> 5;
    f32x16 acc[2]; zero_o(acc);
    const bf16* hp = hid0 + (size_t)r * hstride + 8 * h;
#pragma unroll
    for (int k0 = 0; k0 < 16; k0 += 8) {
        bf16x8 bfr[8], af[2][8];
#pragma unroll
        for (int k = 0; k < 8; ++k) { bfr[k] = *(const GAS bf16x8*)(hp + 16 * (k0 + k));
#pragma unroll
            for (int dh = 0; dh < 2; ++dh) af[dh][k] = *(const GAS bf16x8*)(w2t + (size_t)(32 * dh + r) * 256 + 16 * (k0 + k) + 8 * h); }
#pragma unroll
        for (int k = 0; k < 8; ++k)
#pragma unroll
            for (int dh = 0; dh < 2; ++dh) acc[dh] = MFMA32(af[dh][k], bfr[k], acc[dh]);
    }
    float sc = 1.f;
    if (kcg) { float ssq = 0.f;
#pragma unroll
        for (int dh = 0; dh < 2; ++dh)
#pragma unroll
            for (int v = 0; v < 16; ++v) ssq += acc[dh][v] * acc[dh][v];
        ssq += __shfl_xor(ssq, 32); sc = 1.f / sqrtf(ssq * (1.f / 64.f) + EPS); }
#pragma unroll
    for (int dh = 0; dh < 2; ++dh)
#pragma unroll
        for (int a = 0; a < 4; ++a) { const int d0 = 32 * dh + 8 * a + 4 * h; f32x4 x = {acc[dh][4 * a], acc[dh][4 * a + 1], acc[dh][4 * a + 2], acc[dh][4 * a + 3]};
            if (kcg) x = x * *(const f32x4*)(kcg + d0) * sc;
            v2u w; w.x = cvtpk(x[0], x[1]); w.y = cvtpk(x[2], x[3]);
            if (TO_LDS) *(LAS v2u*)((LAS unsigned char*)(uintptr_t)dst + r * dpitch_bytes + d0 * 2) = w;
            else *(GAS v2u*)(dst + (size_t)r * dpitch_bytes + d0 * 2) = w; }
}

__device__ __forceinline__ int next_item(gu32* ctr, volatile LAS int* slot) {
    __syncthreads();
    if (threadIdx.x == 0) *slot = (int)__hip_atomic_fetch_add(ctr, 1u, RLX_AGENT);
    __syncthreads();
    return *slot;
}

template <bool MASKED> __device__ __forceinline__ void sb_weights_t(f32x16 (&s)[2], float& P, int kb, int tpos, int h) {
    float gp[8];
#pragma unroll
    for (int kh = 0; kh < 2; ++kh)
#pragma unroll
        for (int aa = 0; aa < 4; ++aa) { float g = 1.f;
#pragma unroll
            for (int j = 3; j >= 0; --j) { const int v = 4 * aa + j; const float z = __builtin_amdgcn_fmed3f(s[kh][v], -80.f, 80.f);
                const float e = fexp2(z * -LOG2E), r = __builtin_amdgcn_rcpf(1.f + e);
                float sg = r, om = e * r;
                if (MASKED) { const bool ok = (kb + kidx_of(kh, v, h)) < tpos; sg = ok ? sg : 0.f; om = ok ? om : 1.f; }
                s[kh][v] = sg * g;
                g *= om; }
            gp[4 * kh + aa] = g; }
    float tot = P, off[8];
#pragma unroll
    for (int ap = 7; ap >= 0; --ap) { const float mine = gp[ap], oth = xhalf(mine, h);
        off[ap] = h == 0 ? tot * oth : tot; tot *= mine * oth; }
#pragma unroll
    for (int kh = 0; kh < 2; ++kh)
#pragma unroll
        for (int v = 0; v < 16; ++v) s[kh][v] *= off[4 * kh + (v >> 2)];
    P = tot;
}
__device__ __forceinline__ void sb_weights(f32x16 (&s)[2], float& P, int kb, int tpos, int h, bool masked) {
    if (masked) sb_weights_t<true>(s, P, kb, tpos, h); else sb_weights_t<false>(s, P, kb, tpos, h);
}
#define SB_PMIN 8.7e-27f
__device__ __forceinline__ void item_l2_sample(const Args& a, int it, int lane, int wave) {
    unsigned char* ws = a.ws; const int sb = it >> 1, g = it & 1, slot = wave & 1;
    const bf16* w2t = (const bf16*)(ws + WS_W2T) + slot * 64 * 256;
    const float* kcg = slot ? nullptr : (const float*)a.in[IN_KCG];
    for (int j = 0; j < 2; ++j) { const int ch = (wave >> 1) + 4 * j;
        const bf16* hid0 = (const bf16*)(ws + WS_HIDS) + ((size_t)slot * 16384 + (size_t)(sb * 256 + 32 * ch) * 2 + g) * 256;
        unsigned char* dst = ws + (slot ? WS_VCS : WS_KCS) + ((size_t)((sb * 2 + g) * 256 + 32 * ch)) * 128;
        l2_wave<false>(w2t, hid0, 512, kcg, dst, 128, lane); }
}
__device__ __forceinline__ void item_sb_prompt(const Args& a, LAS unsigned char* lds, int it, int lane, int wave) {
    unsigned char* ws = a.ws;
    const int qb = 7 - (it >> 6), bh = it & 63, b = bh >> 3, hd = bh & 7;
    const int r = lane & 31, h = lane >> 5, tw = 256 * qb + 32 * wave, tpos = tw + r; const size_t mrow = (size_t)b * TP + tpos;
    const bf16* QA = (const bf16*)(ws + WS_QA); const bf16* KA = (const bf16*)(ws + WS_KA) + hd * 64; const bf16* VA = (const bf16*)(ws + WS_VA) + hd * 64;
    bf16x8 qf[4]; load_qf(qf, QA + mrow * 512 + hd * 64, lane);
    LAS unsigned char* Vs = lds + wave * VT_BYTES;
    f32x16 o[2]; zero_o(o);
    float C = 1.f;
    for (int kb = (tw >> 6) << 6; kb >= 0; kb -= 64) {
        const size_t krow0 = (size_t)b * TP + kb;
        v4u vr[8];
#pragma unroll
        for (int i = 0; i < 8; ++i) vr[i] = *(const GAS v4u*)(VA + (krow0 + 8 * i + (lane >> 3)) * 512 + (lane & 7) * 8);
        f32x16 s[2]; qk64_g(s, KA + krow0 * 512, 512, qf, lane);
#pragma unroll
        for (int i = 0; i < 8; ++i) *(LAS v4u*)(Vs + (8 * i + (lane >> 3)) * VP + (lane & 7) * 16) = vr[i];
        sb_weights(s, C, kb, tpos, h, kb + 64 > tw);
        asm volatile("" ::: "memory");
        pv64(o, Vs, s, lane);
        asm volatile("" ::: "memory");
        if (__all(C < SB_PMIN)) break;
    }
    const bf16* GA = (const bf16*)(ws + WS_GA) + mrow * 512 + hd * 64; bf16* U = (bf16*)(ws + WS_U) + mrow * 1024 + hd * 64;
    v2u grp[8];
#pragma unroll
    for (int dh = 0; dh < 2; ++dh)
#pragma unroll
        for (int aa = 0; aa < 4; ++aa) { const int d0 = 32 * dh + 8 * aa + 4 * h; const v2u gw = *(const GAS v2u*)(GA + d0);
            grp[4 * dh + aa].x = cvtpk(o[dh][4 * aa] * bf_lo(gw.x), o[dh][4 * aa + 1] * bf_hi(gw.x)); grp[4 * dh + aa].y = cvtpk(o[dh][4 * aa + 2] * bf_lo(gw.y), o[dh][4 * aa + 3] * bf_hi(gw.y)); }
    store_row_wide(U, grp, h);
}
__device__ __forceinline__ void item_win_prompt(const Args& a, LAS unsigned char* lds, int it, int tid, int lane, int wave) {
    unsigned char* ws = a.ws;
    const int qp = 15 - (it >> 4), bg = it & 15, b = bg >> 1, g = bg & 1, qA = 2 * qp + 1, qB = 2 * qp;
    const int r = lane & 31, h = lane >> 5, hq = 4 * g + (wave & 3), tA = 64 * qA + 32 * (wave >> 2) + r, tB = tA - 64; const size_t mA = (size_t)b * TP + tA, mB = mA - 64;
    const float slope2 = fexp2(-(float)(hq + 1)) * LOG2E;
    bf16x8 qfA[4], qfB[4]; load_qf(qfA, (const bf16*)(ws + WS_QB) + mA * 512 + hq * 64, lane); load_qf(qfB, (const bf16*)(ws + WS_QB) + mB * 512 + hq * 64, lane);
    const bf16* KW = (const bf16*)(ws + WS_KWIN) + (size_t)b * TP * 128 + g * 64; const bf16* VW = (const bf16*)(ws + WS_VWIN) + (size_t)b * TP * 128 + g * 64;
    f32x16 oA[2], oB[2]; zero_o(oA); zero_o(oB); float mAx = -1e30f, lA = 0.f, mBx = -1e30f, lB = 0.f;
    f32x16 cinit[2]; alibi_cinit(cinit, slope2);
    const int kt_lo = qB >= 8 ? qB - 8 : 0;
    { const v4u k0 = tile_ld(KW + (size_t)(64 * qA) * 128, 128, tid), v0 = tile_ld(VW + (size_t)(64 * qA) * 128, 128, tid);
      tile_st(lds, KP, tid, k0); tile_st(lds + KT_BYTES, VP, tid, v0); }
    v4u kr = {0u, 0u, 0u, 0u}, vr = {0u, 0u, 0u, 0u};
    if (qA - 1 >= kt_lo) { kr = tile_ld(KW + (size_t)(64 * (qA - 1)) * 128, 128, tid); vr = tile_ld(VW + (size_t)(64 * (qA - 1)) * 128, 128, tid); }
    int st = 0;
    for (int kt = qA; kt >= kt_lo; --kt, st ^= 1) {
        __syncthreads();
        LAS unsigned char* Ks = lds + st * (KT_BYTES + VT_BYTES); LAS unsigned char* Vs = Ks + KT_BYTES;
        if (kt - 1 >= kt_lo) { LAS unsigned char* Kn = lds + (st ^ 1) * (KT_BYTES + VT_BYTES); tile_st(Kn, KP, tid, kr); tile_st(Kn + KT_BYTES, VP, tid, vr); }
        if (kt - 2 >= kt_lo) { kr = tile_ld(KW + (size_t)(64 * (kt - 2)) * 128, 128, tid); vr = tile_ld(VW + (size_t)(64 * (kt - 2)) * 128, 128, tid); }
        const int kb = 64 * kt; const float off = slope2 * (float)(kb + 4 * h);
        if (kt >= qA - 8) { f32x16 s[2]; qk64c(s, Ks, qfA, cinit, lane);
            if (kt == qA || kt == qA - 8) sm2_tile<true>(s, mAx, lA, oA, off, true, tA - 512 - kb - 4 * h, tA - kb - 4 * h);
            else sm2_tile<false>(s, mAx, lA, oA, off, true, 0, 0);
            pv64(oA, Vs, s, lane); }
        if (kt <= qB) { f32x16 s[2]; qk64c(s, Ks, qfB, cinit, lane);
            if (kt == qB || kt == qB - 8) sm2_tile<true>(s, mBx, lB, oB, off, true, tB - 512 - kb - 4 * h, tB - kb - 4 * h);
            else sm2_tile<false>(s, mBx, lB, oB, off, true, 0, 0);
            pv64(oB, Vs, s, lane); }
    }
    lA += __shfl_xor(lA, 32); lB += __shfl_xor(lB, 32);
    const float gA = ((const float*)(ws + WS_BR))[mA * 24 + hq * 3 + 2], gB = ((const float*)(ws + WS_BR))[mB * 24 + hq * 3 + 2];
    store_ot((bf16*)(ws + WS_OW) + mA * 512 + hq * 64, oA, gA / lA, h);
    store_ot((bf16*)(ws + WS_OW) + mB * 512 + hq * 64, oB, gB / lB, h);
}

__device__ __forceinline__ void item_sb_sample(const Args& a, LAS unsigned char* lds, int it, int lane, int wave) {
    unsigned char* ws = a.ws; const int pair = it * 8 + wave, sb = pair >> 3, hd = pair & 7;
    const int r = lane & 31, h = lane >> 5, st = r & 7, tpos = 8192 + st; const size_t mrow = (size_t)MP + sb * 8 + st;
    const float* csb = (const float*)a.in[IN_CSB]; const int* pt = (const int*)a.in[IN_PT] + sb * 64;
    bf16x8 qf[4]; load_qf(qf, (const bf16*)(ws + WS_QA) + mrow * 512 + hd * 64, lane);
    LAS unsigned char* Vs = lds + wave * VT_BYTES;
    f32x16 o[2]; zero_o(o); float C = 1.f;
    for (int blk = 128; blk >= 0; --blk) {
        const float* rows = (blk == 128) ? a.out + OFF_SB + (size_t)(MP + sb * 8) * 1024 : csb + ((size_t)pt[blk >> 1] * 128 + (blk & 1) * 64) * 1024;
        const int maxrow = blk == 128 ? 7 : 63;
        const float* kbase = rows + hd * 64; const float* vbase = rows + 512 + hd * 64;
        f32x4 kt[2][4][2];
#pragma unroll
        for (int kh = 0; kh < 2; ++kh) { const float* kp = kbase + (size_t)min(32 * kh + r, maxrow) * 1024 + 8 * h;
#pragma unroll
            for (int ks = 0; ks < 4; ++ks) { kt[kh][ks][0] = *(const GAS f32x4*)(kp + 16 * ks); kt[kh][ks][1] = *(const GAS f32x4*)(kp + 16 * ks + 4); } }
        f32x4 va[4][2], vb[4][2];
#pragma unroll
        for (int i = 0; i < 4; ++i) { const float* vp = vbase + (size_t)min(8 * i + (lane >> 3), maxrow) * 1024 + (lane & 7) * 8; va[i][0] = *(const GAS f32x4*)vp; va[i][1] = *(const GAS f32x4*)(vp + 4); }
        f32x16 s[2];
#pragma unroll
        for (int kh = 0; kh < 2; ++kh) { f32x16 acc; for (int i = 0; i < 16; ++i) acc[i] = 0.f;
#pragma unroll
            for (int ks = 0; ks < 4; ++ks) { const bf16x8 kf8 = pack8(kt[kh][ks][0], kt[kh][ks][1]); __builtin_amdgcn_s_setprio(1); acc = MFMA32(kf8, qf[ks], acc); __builtin_amdgcn_s_setprio(0); }
            s[kh] = acc; }
#pragma unroll
        for (int i = 0; i < 4; ++i) { const float* vp = vbase + (size_t)min(8 * (i + 4) + (lane >> 3), maxrow) * 1024 + (lane & 7) * 8; vb[i][0] = *(const GAS f32x4*)vp; vb[i][1] = *(const GAS f32x4*)(vp + 4); }
#pragma unroll
        for (int i = 0; i < 4; ++i) *(LAS bf16x8*)(Vs + (8 * i + (lane >> 3)) * VP + (lane & 7) * 16) = pack8(va[i][0], va[i][1]);
        sb_weights(s, C, 64 * blk, tpos, h, blk == 128);
#pragma unroll
        for (int i = 0; i < 4; ++i) *(LAS bf16x8*)(Vs + (8 * (i + 4) + (lane >> 3)) * VP + (lane & 7) * 16) = pack8(vb[i][0], vb[i][1]);
        asm volatile("" ::: "memory");
        pv64(o, Vs, s, lane);
        asm volatile("" ::: "memory");
        if (__all(C < SB_PMIN)) break;
    }
    { const bf16* GA = (const bf16*)(ws + WS_GA) + mrow * 512 + hd * 64; bf16* U = (bf16*)(ws + WS_U) + mrow * 1024 + hd * 64;
      v2u grp[8];
#pragma unroll
      for (int dh = 0; dh < 2; ++dh)
#pragma unroll
          for (int aa = 0; aa < 4; ++aa) { const int d0 = 32 * dh + 8 * aa + 4 * h; const v2u gw = *(const GAS v2u*)(GA + d0);
              grp[4 * dh + aa].x = cvtpk(o[dh][4 * aa] * bf_lo(gw.x), o[dh][4 * aa + 1] * bf_hi(gw.x)); grp[4 * dh + aa].y = cvtpk(o[dh][4 * aa + 2] * bf_lo(gw.y), o[dh][4 * aa + 3] * bf_hi(gw.y)); }
      store_row_wide(U, grp, h, r < 8); }
}

#ifndef DBG_DUP
#define DBG_DUP 0
#endif

constexpr size_t WS_KCP = 230 * MiB, WS_VCP = 231 * MiB;
constexpr int P3_KC = 0, P3_VC = KT_BYTES, P3_KS = KT_BYTES + VT_BYTES  , P3_IMPW = P3_KS + 2 * (KT_BYTES + VT_BYTES)  , P3_IMP = P3_IMPW + 8 * 32 * 33 * 4,
              P3_SEL = P3_IMP + 64 * 36 * 4, P3_UM = P3_SEL + 256;
__device__ __forceinline__ void item_nsa_prompt(const Args& a, LAS unsigned char* lds, int it, int tid, int lane, int wave) {
    unsigned char* ws = a.ws;
    const int qblk = 31 - (it >> 4), bg = it & 15, b = bg >> 1, g = bg & 1, cur = qblk;
    const int r = lane & 31, h = lane >> 5, hq = 4 * g + (wave & 3), th = wave >> 2, tpos = 64 * qblk + 32 * th + r; const size_t mrow = (size_t)b * TP + tpos;
    const float slope2 = fexp2(-(float)(hq + 1)) * LOG2E;
    { const bf16* KCP = (const bf16*)(ws + WS_KCP) + (size_t)(b * 2 + g) * 4096; const bf16* VCP = (const bf16*)(ws + WS_VCP) + (size_t)(b * 2 + g) * 4096;
      const v4u k0 = tile_ld(KCP, 64, tid), v0 = tile_ld(VCP, 64, tid); tile_st(lds + P3_KC, KP, tid, k0); tile_st(lds + P3_VC, VP, tid, v0); }
    bf16x8 qf[4]; load_qf(qf, (const bf16*)(ws + WS_QB) + mrow * 512 + hq * 64, lane);
    __syncthreads();
    f32x16 oc[2];
    for (int dupp = 0; dupp < ((DBG_DUP & 128) ? 2 : 1); ++dupp) { if (dupp) __syncthreads();
    zero_o(oc);
    { f32x16 s[2]; qk64(s, lds + P3_KC, qf, lane);
      float mx = -1e30f;
#pragma unroll
      for (int kh = 0; kh < 2; ++kh)
#pragma unroll
          for (int v = 0; v < 16; ++v) { const int ce = 32 * kidx_of(kh, v, h) + 31, dist = tpos - ce; const float x = dist >= 0 ? s[kh][v] - slope2 * (float)dist : -INFINITY; s[kh][v] = x; mx = fmaxf(mx, x); }
      mx = fmaxf(mx, __shfl_xor(mx, 32));
      float sum = 0.f;
#pragma unroll
      for (int kh = 0; kh < 2; ++kh)
#pragma unroll
          for (int v = 0; v < 16; ++v) { const float e = fexp2(s[kh][v] - mx); s[kh][v] = e; sum += e; }
      sum += __shfl_xor(sum, 32);
      const float inv = sum > 0.f ? 1.f / sum : 1.f;
#pragma unroll
      for (int kh = 0; kh < 2; ++kh)
#pragma unroll
          for (int v = 0; v < 16; ++v) s[kh][v] *= inv;
      LAS float* impw = (LAS float*)(lds + P3_IMPW) + (wave * 32 + r) * 33;
#pragma unroll
      for (int kh = 0; kh < 2; ++kh)
#pragma unroll
          for (int aa = 0; aa < 4; ++aa)
#pragma unroll
              for (int b2 = 0; b2 < 2; ++b2) impw[16 * kh + 4 * aa + 2 * h + b2] = s[kh][4 * aa + 2 * b2] + s[kh][4 * aa + 2 * b2 + 1];
      pv64(oc, lds + P3_VC, s, lane);
    }
    __syncthreads();
    { const int tk = tid >> 3, j8 = tid & 7; LAS float* imp = (LAS float*)(lds + P3_IMP) + tk * 36;
      const LAS float* iw = (const LAS float*)(lds + P3_IMPW) + (((tk >> 5) * 4) * 32 + (tk & 31)) * 33;
#pragma unroll
      for (int j = 0; j < 4; ++j) { const int blk = 4 * j8 + j; imp[blk] = (iw[blk] + iw[32 * 33 + blk]) + (iw[2 * 32 * 33 + blk] + iw[3 * 32 * 33 + blk]); }
      __syncthreads();
      unsigned bits = 0u;
      if (cur <= 15) bits = 0xffffffffu;
      else {
          float y[32];
#pragma unroll
          for (int q4 = 0; q4 < 8; ++q4) { const f32x4 v = *(const LAS f32x4*)(imp + 4 * q4); y[4 * q4] = v.x; y[4 * q4 + 1] = v.y; y[4 * q4 + 2] = v.z; y[4 * q4 + 3] = v.w; }
#pragma unroll
          for (int j = 0; j < 4; ++j) { const int blk = 4 * j8 + j;
              if (blk == 0 || blk == cur || blk == cur - 1) bits |= 1u << blk;
              else if (blk < cur - 1) { float x = 0.f;
#pragma unroll
                  for (int o2 = 0; o2 < 32; ++o2) x = (o2 == blk) ? y[o2] : x;
                  int rank = 0;
#pragma unroll
                  for (int o2 = 1; o2 < 30; ++o2) rank += (o2 <= cur - 2 && (y[o2] > x || (y[o2] == x && o2 < blk))) ? 1 : 0;
                  if (rank < 13) bits |= 1u << blk; } } }
      bits |= __shfl_xor(bits, 1); bits |= __shfl_xor(bits, 2); bits |= __shfl_xor(bits, 4);
      if (j8 == 0) ((LAS unsigned*)(lds + P3_SEL))[tk] = bits;
      __syncthreads();
      if (wave == 0) { unsigned um = ((const LAS unsigned*)(lds + P3_SEL))[lane];
#pragma unroll
          for (int o2 = 1; o2 < 64; o2 <<= 1) um |= __shfl_xor(um, o2);
          if (lane == 0) *(LAS unsigned*)(lds + P3_UM) = um; }
      __syncthreads();
    }
    }
    const unsigned selbits = ((const LAS unsigned*)(lds + P3_SEL))[32 * th + r], umask = *(const LAS unsigned*)(lds + P3_UM);
    f32x16 os[2]; zero_o(os); float m = -1e30f, l = 0.f;
    f32x16 cinit[2]; alibi_cinit(cinit, slope2);
    { const bf16* KS = (const bf16*)(ws + WS_KSEL) + (size_t)b * TP * 128 + g * 64; const bf16* VS = (const bf16*)(ws + WS_VSEL) + (size_t)b * TP * 128 + g * 64;
      unsigned todo = umask & (cur >= 31 ? 0xffffffffu : ((2u << cur) - 1u));
      int blk = 31 - __builtin_clz(todo); todo &= ~(1u << blk);
      int nb1 = todo ? 31 - __builtin_clz(todo) : -1; if (nb1 >= 0) todo &= ~(1u << nb1);
      { const v4u k0 = tile_ld(KS + (size_t)(64 * blk) * 128, 128, tid), v0 = tile_ld(VS + (size_t)(64 * blk) * 128, 128, tid);
        tile_st(lds + P3_KS, KP, tid, k0); tile_st(lds + P3_KS + KT_BYTES, VP, tid, v0); }
      v4u kr = {0u, 0u, 0u, 0u}, vr = {0u, 0u, 0u, 0u};
      if (nb1 >= 0) { kr = tile_ld(KS + (size_t)(64 * nb1) * 128, 128, tid); vr = tile_ld(VS + (size_t)(64 * nb1) * 128, 128, tid); }
      int st = 0;
      for (;;) {
          __syncthreads();
          LAS unsigned char* Ks = lds + P3_KS + st * (KT_BYTES + VT_BYTES); LAS unsigned char* Vs = Ks + KT_BYTES;
          if (nb1 >= 0) { LAS unsigned char* Kn = lds + P3_KS + (st ^ 1) * (KT_BYTES + VT_BYTES); tile_st(Kn, KP, tid, kr); tile_st(Kn + KT_BYTES, VP, tid, vr); }
          const int nb2 = todo ? 31 - __builtin_clz(todo) : -1; if (nb2 >= 0) todo &= ~(1u << nb2);
          if (nb2 >= 0) { kr = tile_ld(KS + (size_t)(64 * nb2) * 128, 128, tid); vr = tile_ld(VS + (size_t)(64 * nb2) * 128, 128, tid); }
          const int kb = 64 * blk; const bool mine = (selbits >> blk) & 1u;
          if (__any(mine)) {
              for (int dupc = 0; dupc < ((DBG_DUP & 32) ? 2 : 1); ++dupc) {
              f32x16 s[2]; qk64c(s, Ks, qf, cinit, lane);
              const float off = slope2 * (float)(kb + 4 * h);
              if (blk == cur) sm2_tile<true>(s, m, l, os, off, mine && dupc == 0, -(1 << 30), tpos - kb - 4 * h);
              else sm2_tile<false>(s, m, l, os, off, mine && dupc == 0, 0, 0);
              pv64(os, Vs, s, lane); } }
          if (nb1 < 0) break;
          blk = nb1; nb1 = nb2; st ^= 1;
      } }
    l += __shfl_xor(l, 32);
    { const float* br = (const float*)(ws + WS_BR) + mrow * 24 + hq * 3; const float g0 = br[0], g1 = br[1] / l;
      const bf16* OW = (const bf16*)(ws + WS_OW) + mrow * 512 + hq * 64; const bf16* GB = (const bf16*)(ws + WS_GB) + mrow * 512 + hq * 64; bf16* U = (bf16*)(ws + WS_U) + mrow * 1024 + 512 + hq * 64;
      v2u grp[8];
#pragma unroll
      for (int dh = 0; dh < 2; ++dh)
#pragma unroll
          for (int aa = 0; aa < 4; ++aa) { const int d0 = 32 * dh + 8 * aa + 4 * h; const v2u ow = *(const GAS v2u*)(OW + d0), gb = *(const GAS v2u*)(GB + d0);
              const float x0 = (g0 * oc[dh][4 * aa] + g1 * os[dh][4 * aa] + bf_lo(ow.x)) * bf_lo(gb.x), x1 = (g0 * oc[dh][4 * aa + 1] + g1 * os[dh][4 * aa + 1] + bf_hi(ow.x)) * bf_hi(gb.x);
              const float x2 = (g0 * oc[dh][4 * aa + 2] + g1 * os[dh][4 * aa + 2] + bf_lo(ow.y)) * bf_lo(gb.y), x3 = (g0 * oc[dh][4 * aa + 3] + g1 * os[dh][4 * aa + 3] + bf_hi(ow.y)) * bf_hi(gb.y);
              grp[4 * dh + aa].x = cvtpk(x0, x1); grp[4 * dh + aa].y = cvtpk(x2, x3); }
      store_row_wide(U, grp, h); }
}

constexpr int SM_V = 0, SM_ACC = 8 * VT_BYTES  , SM_ST = SM_ACC + 8192, SM_IMP = SM_ST + 3 * 8 * 32 * 2 * 4  , SM_SELW = SM_IMP + 8 * 128 * 4, SM_END = SM_SELW + 128;
static_assert(SM_END <= RING_BYTES, "sample NSA LDS map");
template <class F> __device__ __forceinline__ void sm_tile_f32(f32x16 (&o)[2], float& m, float& l, const float* kbase, const float* vbase, int stride, int maxrow, LAS unsigned char* Vs, const bf16x8 (&qf)[4], int lane, F&& biasf) {
    const int h = lane >> 5;
    f32x4 kt[2][4][2];
#pragma unroll
    for (int kh = 0; kh < 2; ++kh) { const int row = min(32 * kh + (lane & 31), maxrow); const float* kp = kbase + (size_t)row * stride + 8 * h;
#pragma unroll
        for (int ks = 0; ks < 4; ++ks) { kt[kh][ks][0] = *(const GAS f32x4*)(kp + 16 * ks); kt[kh][ks][1] = *(const GAS f32x4*)(kp + 16 * ks + 4); } }
    f32x4 va[4][2], vb[4][2];
#pragma unroll
    for (int i = 0; i < 4; ++i) { const float* vp = vbase + (size_t)min(8 * i + (lane >> 3), maxrow) * stride + (lane & 7) * 8; va[i][0] = *(const GAS f32x4*)vp; va[i][1] = *(const GAS f32x4*)(vp + 4); }
    f32x16 s[2];
#pragma unroll
    for (int kh = 0; kh < 2; ++kh) { f32x16 acc; for (int i = 0; i < 16; ++i) acc[i] = 0.f;
#pragma unroll
        for (int ks = 0; ks < 4; ++ks) { const bf16x8 kf8 = pack8(kt[kh][ks][0], kt[kh][ks][1]); __builtin_amdgcn_s_setprio(1); acc = MFMA32(kf8, qf[ks], acc); __builtin_amdgcn_s_setprio(0); }
        s[kh] = acc; }
#pragma unroll
    for (int i = 0; i < 4; ++i) { const float* vp = vbase + (size_t)min(8 * (i + 4) + (lane >> 3), maxrow) * stride + (lane & 7) * 8; vb[i][0] = *(const GAS f32x4*)vp; vb[i][1] = *(const GAS f32x4*)(vp + 4); }
#pragma unroll
    for (int i = 0; i < 4; ++i) *(LAS bf16x8*)(Vs + (8 * i + (lane >> 3)) * VP + (lane & 7) * 16) = pack8(va[i][0], va[i][1]);
    softmax_tile(s, m, l, o, h, biasf);
#pragma unroll
    for (int i = 0; i < 4; ++i) *(LAS bf16x8*)(Vs + (8 * (i + 4) + (lane >> 3)) * VP + (lane & 7) * 16) = pack8(vb[i][0], vb[i][1]);
    asm volatile("" ::: "memory");
    pv64(o, Vs, s, lane);
    asm volatile("" ::: "memory");
}
__device__ __forceinline__ void sm_put_stats(LAS float* st, int br, int wave, int lane, float m, float l) { if (lane < 32) { st[((br * 8 + wave) * 32 + lane) * 2] = m; st[((br * 8 + wave) * 32 + lane) * 2 + 1] = l; } }
__device__ __forceinline__ void sm_get_ML(const LAS float* st, int br, int r, float& M, float& L) {
    M = -1e30f;
#pragma unroll
    for (int w = 0; w < 8; ++w) M = fmaxf(M, st[((br * 8 + w) * 32 + r) * 2]);
    L = 0.f;
#pragma unroll
    for (int w = 0; w < 8; ++w) L += st[((br * 8 + w) * 32 + r) * 2 + 1] * fexp2(st[((br * 8 + w) * 32 + r) * 2] - M);
}
__device__ __forceinline__ void sm_put(LAS float* slice, const f32x16 (&o)[2], float f, int lane) {
    const int r = lane & 31, h = lane >> 5;
#pragma unroll
    for (int dh = 0; dh < 2; ++dh)
#pragma unroll
        for (int v = 0; v < 16; ++v) { const int d = 32 * dh + (v & 3) + 8 * (v >> 2) + 4 * h; slice[d * 32 + r] = o[dh][v] * f; }
}
__device__ __forceinline__ void item_nsa_sample(const Args& a, LAS unsigned char* lds, int it, int tid, int lane, int wave) {
    unsigned char* ws = a.ws; const int sb = it >> 1, g = it & 1;
    const int r = lane & 31, h = lane >> 5, st = r >> 2, hh = r & 3, hq = 4 * g + hh, t = 8192 + st; const size_t mrow = (size_t)MP + sb * 8 + st;
    const float* cn = (const float*)a.in[IN_CNSA]; const int* pt = (const int*)a.in[IN_PT] + sb * 64; const float* sw = (const float*)a.in[IN_SWIN];
    LAS unsigned char* Vs = lds + SM_V + wave * VT_BYTES; LAS float* acc = (LAS float*)(lds + SM_ACC); LAS float* stt = (LAS float*)(lds + SM_ST); LAS float* imp = (LAS float*)(lds + SM_IMP);
    LAS unsigned long long* selw = (LAS unsigned long long*)(lds + SM_SELW);
    const float slope2 = fexp2(-(float)(hq + 1)) * LOG2E;
    const float* br = (const float*)(ws + WS_BR) + mrow * 24 + hq * 3; const float g0 = br[0], g1 = br[1], g2 = br[2];
    bf16x8 qf[4]; load_qf(qf, (const bf16*)(ws + WS_QB) + mrow * 512 + hq * 64, lane);
    f32x16 ow[2]; zero_o(ow); float mw = -1e30f, lw = 0.f;
#pragma unroll 1
    for (int pass = 0; pass < 2; ++pass) { if (pass == 1 && wave != 4) break;
        const int j = pass == 0 ? wave : 8, i0 = 64 * j;
        const float* rows = (j < 8) ? sw + ((size_t)(sb * 512 + i0)) * 256 : a.out + OFF_WINS + ((size_t)(sb * 512 + 504)) * 256;
        sm_tile_f32(ow, mw, lw, rows + g * 64, rows + 128 + g * 64, 256, j < 8 ? 63 : 7, Vs, qf, lane, [&](int ki) { const int i = i0 + ki, dist = t - (7680 + i); return (i < 520 && dist >= 0 && dist < 512) ? -slope2 * (float)dist : -INFINITY; }); }
    if (DBG_DUP & 4) { f32x16 o2[2]; zero_o(o2); float m2 = -1e30f, l2 = 0.f;
#pragma unroll 1
        for (int pass = 0; pass < 2; ++pass) { if (pass == 1 && wave != 4) break;
            const int j = pass == 0 ? wave : 8, i0 = 64 * j;
            const float* rows = (j < 8) ? sw + ((size_t)(sb * 512 + i0)) * 256 : a.out + OFF_WINS + ((size_t)(sb * 512 + 504)) * 256;
            sm_tile_f32(o2, m2, l2, rows + g * 64, rows + 128 + g * 64, 256, j < 8 ? 63 : 7, Vs, qf, lane, [&](int ki) { const int i = i0 + ki, dist = t - (7680 + i); return (i < 520 && dist >= 0 && dist < 512) ? -slope2 * (float)dist : -INFINITY; }); }
        if (m2 == 12345.f) ow[0][0] += o2[0][0] + l2; }
    lw += __shfl_xor(lw, 32);
    sm_put_stats(stt, 2, wave, lane, mw, lw);
    f32x16 oc[2]; zero_o(oc); f32x16 ec[2]; float mc = -1e30f, lc = 0.f;
    if (wave < 4) {
        const bf16* KC = (const bf16*)(ws + WS_KCS) + ((size_t)((sb * 2 + g) * 256 + 64 * wave)) * 64; const bf16* VC = (const bf16*)(ws + WS_VCS) + ((size_t)((sb * 2 + g) * 256 + 64 * wave)) * 64;
        v4u vr[8];
#pragma unroll
        for (int i = 0; i < 8; ++i) vr[i] = *(const GAS v4u*)(VC + (size_t)(8 * i + (lane >> 3)) * 64 + (lane & 7) * 8);
        qk64_g(ec, KC, 64, qf, lane);
#pragma unroll
        for (int i = 0; i < 8; ++i) *(LAS v4u*)(Vs + (8 * i + (lane >> 3)) * VP + (lane & 7) * 16) = vr[i];
        const int c0 = 64 * wave;
        softmax_tile(ec, mc, lc, oc, h, [&](int ki) { return -slope2 * (float)(t - (32 * (c0 + ki) + 31)); });
        asm volatile("" ::: "memory");
        pv64(oc, Vs, ec, lane);
        asm volatile("" ::: "memory");
        lc += __shfl_xor(lc, 32);
    }
    sm_put_stats(stt, 0, wave, lane, mc, lc);
    __syncthreads();
    LAS float* mbuf = (LAS float*)(lds + SM_V);
    { float M, L; sm_get_ML(stt, 2, r, M, L); sm_put(mbuf + wave * 2048, ow, (L > 0.f) ? g2 * fexp2(mw - M) / L : 0.f, lane); }
    if (wave < 4) { float M, L; sm_get_ML(stt, 0, r, M, L); const float f = fexp2(mc - M) / L;
        sm_put(mbuf + (8 + wave) * 2048, oc, g0 * f, lane);
#pragma unroll
        for (int kh = 0; kh < 2; ++kh)
#pragma unroll
            for (int aa = 0; aa < 4; ++aa)
#pragma unroll
                for (int b2 = 0; b2 < 2; ++b2) { float v = (ec[kh][4 * aa + 2 * b2] + ec[kh][4 * aa + 2 * b2 + 1]) * f; v += __shfl_xor(v, 1); v += __shfl_xor(v, 2);
                    if (hh == 0) imp[st * 128 + 32 * wave + 16 * kh + 4 * aa + 2 * h + b2] = v; } }
    __syncthreads();
    { f32x4 sum = {0.f, 0.f, 0.f, 0.f};
#pragma unroll
      for (int w = 0; w < 12; ++w) sum += *(const LAS f32x4*)(mbuf + w * 2048 + tid * 4);
      *(LAS f32x4*)(acc + tid * 4) = sum; }
    for (int dup = 0; dup < ((DBG_DUP & 2) ? 2 : 1); ++dup)
    { const LAS float* im = imp + wave * 128; bool s0, s1;
      { const int blk = lane; if (blk == 0) s0 = true; else { const float x = im[blk]; int rank = 0; for (int o2 = 1; o2 <= 126; ++o2) { const float y = im[o2]; rank += (y > x || (y == x && o2 < blk)) ? 1 : 0; } s0 = rank < 13; } }
      { const int blk = lane + 64; if (blk == 127) s1 = true; else { const float x = im[blk]; int rank = 0; for (int o2 = 1; o2 <= 126; ++o2) { const float y = im[o2]; rank += (y > x || (y == x && o2 < blk)) ? 1 : 0; } s1 = rank < 13; } }
      const unsigned long long b0 = __ballot(s0), b1 = __ballot(s1);
      if (lane == 0) { selw[2 * wave] = b0; selw[2 * wave + 1] = b1; } }
    __syncthreads();
    f32x16 os[2]; zero_o(os); float ms = -1e30f, ls = 0.f;
    { unsigned long long u0 = 0ull, u1 = 0ull;
#pragma unroll
      for (int s8 = 0; s8 < 8; ++s8) { u0 |= selw[2 * s8]; u1 |= selw[2 * s8 + 1]; }
      const unsigned long long my0 = selw[2 * st], my1 = selw[2 * st + 1];
      int cnt = 0;
      for (int dup8 = 0; dup8 < ((DBG_DUP & 8) ? 2 : 1); ++dup8)
      for (int half = 0; half < 3; ++half) { unsigned long long bits = half == 0 ? u0 : (half == 1 ? u1 : 1ull);
          while (bits) { const int bi = __builtin_ctzll(bits); bits &= bits - 1; const int blk = 64 * half + bi;
              if ((cnt++ & 7) != wave) continue;
              const float* rows = (blk < 128) ? cn + ((size_t)pt[blk >> 1] * 128 + (blk & 1) * 64) * 512 : a.out + OFF_NSA + ((size_t)(MP + sb * 8)) * 512;
              const bool mine = (dup8 == 0) && (half == 0 ? ((my0 >> bi) & 1ull) : (half == 1 ? ((my1 >> bi) & 1ull) : true));
              const int kb = 64 * blk;
              sm_tile_f32(os, ms, ls, rows + 256 + g * 64, rows + 384 + g * 64, 512, blk < 128 ? 63 : 7, Vs, qf, lane, [&](int ki) { const int dist = t - (kb + ki); return (mine && dist >= 0) ? -slope2 * (float)dist : -INFINITY; }); } } }
    ls += __shfl_xor(ls, 32);
    sm_put_stats(stt, 1, wave, lane, ms, ls);
    __syncthreads();
    { float M, L; sm_get_ML(stt, 1, r, M, L); sm_put(mbuf + wave * 2048, os, (L > 0.f) ? g1 * fexp2(ms - M) / L : 0.f, lane); }
    __syncthreads();
    { f32x4 sum = *(const LAS f32x4*)(acc + tid * 4);
#pragma unroll
      for (int w = 0; w < 8; ++w) sum += *(const LAS f32x4*)(mbuf + w * 2048 + tid * 4);
      *(LAS f32x4*)(acc + tid * 4) = sum; }
    __syncthreads();
    { const int r2 = tid >> 4, d4 = (tid & 15) * 4; const size_t m2 = (size_t)MP + sb * 8 + (r2 >> 2); const int hq2 = 4 * g + (r2 & 3);
      const v2u gb = *(const GAS v2u*)((const bf16*)(ws + WS_GB) + m2 * 512 + hq2 * 64 + d4);
      v2u w; w.x = cvtpk(acc[(d4 + 0) * 32 + r2] * bf_lo(gb.x), acc[(d4 + 1) * 32 + r2] * bf_hi(gb.x)); w.y = cvtpk(acc[(d4 + 2) * 32 + r2] * bf_lo(gb.y), acc[(d4 + 3) * 32 + r2] * bf_hi(gb.y));
      *(GAS v2u*)((bf16*)(ws + WS_U) + m2 * 1024 + 512 + hq2 * 64 + d4) = w; }
}

#ifndef MK_N_LAUNCHES
#define MK_N_LAUNCHES 1
#endif
#ifndef DBG_STAGE
#define DBG_STAGE 0
#endif
constexpr int N_PHASES = 6;
constexpr int N_L2S = 64, N_SBS = 32, N_WINP = 256, N_SBP = 512, N_NP = 512, N_NS = 64;

__global__ void __launch_bounds__(NTHR, 2) mk_fwd(Args a) {
    extern __shared__ __attribute__((aligned(16))) unsigned char lds_raw[];
    LAS unsigned char* lds = (LAS unsigned char*)lds_raw;
    const int tid0 = threadIdx.x;
    const int G = gridDim.x, bx = blockIdx.x, vcu = (G % 8 == 0) ? (bx % 8) * (G / 8) + bx / 8 : bx;
    unsigned char* ws = a.ws; gu32* ctl = (gu32*)(ws + WS_CTL);
    for (int u = tid0; u < (LDS_BYTES - LDSCTL_OFF) / 4; u += NTHR) ((LAS unsigned*)(lds + LDSCTL_OFF))[u] = 0u;
    __syncthreads();
    volatile LAS unsigned* MISC = (volatile LAS unsigned*)(lds + MISC_OFF);
    volatile LAS int* qslot = (volatile LAS int*)(lds + LDSCTL_OFF + 64);
    const int lo = a.ph_lo, hi = a.ph_hi; const bool multi = (hi - lo) > 1;
    XcdBarrier bar; bar.bar = (unsigned*)(ctl + CW_BAR); bar.x = 0; bar.st = nullptr;
    if (multi) bar = xcd_barrier_post((unsigned*)(ctl + CW_BAR), MISC + 8);
#ifdef DBG_PHMASK
#define IN(k) (((DBG_PHMASK >> (k)) & 1) && lo <= (k) && (k) < hi)
#else
#define IN(k) (lo <= (k) && (k) < hi)
#endif
#define SEAM(k) do { if (IN(k) && IN((k) + 1)) xcd_barrier(bar); } while (0)
#ifndef DBG_REP
#define DBG_REP (-1)
#endif
#define NREP(k) ((DBG_REP == (k)) ? 2 : 1)
#define REPSEAM(k) do { if (rep + 1 < NREP(k)) xcd_barrier(bar); } while (0)

    if (IN(0)) _Pragma("unroll") for (int rep = 0; rep < NREP(0); ++rep) { int tid = tid0; asm volatile("" : "+v"(tid)); p0_prologue(a, lds, tid, tid & 63, __builtin_amdgcn_readfirstlane(tid >> 6), vcu, G, rep); REPSEAM(0); }
    SEAM(0);

    if (IN(1)) { _Pragma("unroll") for (int rep = 0; rep < NREP(1); ++rep) {
#ifndef DBG_P1MASK
#define DBG_P1MASK 7
#endif
        const int xcc = (int)xb_xcc_id(); volatile LAS int* gslot = (volatile LAS int*)(lds + LDSCTL_OFF + 128);
#ifndef DBG_P1REPM
#define DBG_P1REPM 7
#endif
#define P1ON(bit) ((DBG_P1MASK & (bit)) && (rep == 0 || (DBG_P1REPM & (bit))))
        const int ngb = G < 128 ? G : 128;
        if (P1ON(1) && bx < ngb) {
#pragma unroll 1
            for (int L = bx; L < 256; L += ngb) {
                pg8::EpiHidB128 E{(bf16*)(ws + WS_HIDS), (const float*)(ws + WS_CTL) + CW_BIAS + (L >> 7) * 256};
                pg8::gemm_unit_gather128(lds, (const float*)a.in[IN_CNSA], (const int*)a.in[IN_PT], (const bf16*)(ws + WS_W1T), L, E); } }
        if (P1ON(4)) { pg8::Gemm g{(const bf16*)(ws + WS_HBF), (const bf16*)(ws + WS_WIN_T), MT, NG1, 1024};
          pg8::HybridOrder S; S.q = (unsigned*)(ctl + CW_Q + 64 * 16 + 4096 * rep); S.slot = gslot; S.nM = MT / 256; S.nN = NG1 / 256; S.nwg = S.nM * S.nN; S.dyn0 = 640;
          if (G != 256) { S.ns = 0; S.l0 = 0; S.lstride = 0; S.dyn0 = 0; }
          else if (bx >= 128) { S.ns = 4; S.l0 = ((bx - 128) & 63) + 256 * ((bx - 128) >> 6); S.lstride = 64; }     else { S.ns = 1; S.l0 = 512 + bx; S.lstride = 0; }
#ifdef DBG_G1STATIC
          if (rep == 1) { S.ns = 4; S.l0 = bx; S.lstride = 256; S.dyn0 = 975; if (bx + 768 >= 975) S.ns = 3; }
#endif
          pg8::EpiG1 E{a.out, (const float*)(ws + WS_RSTD), (bf16*)(ws + WS_QA), (bf16*)(ws + WS_KA), (bf16*)(ws + WS_VA), (bf16*)(ws + WS_GA), (bf16*)(ws + WS_QB), (bf16*)(ws + WS_GB),
                       (bf16*)(ws + WS_KSEL), (bf16*)(ws + WS_VSEL), (bf16*)(ws + WS_KWIN), (bf16*)(ws + WS_VWIN), (bf16*)(ws + WS_ACMP_P),
                       (const float*)a.in[IN_QG], (const float*)a.in[IN_KSG], (const float*)a.in[IN_KWG], (const float*)a.in[IN_PEK], (const float*)a.in[IN_PEV]};
#ifdef DBG_NOEPI
#if DBG_NOEPI == 2
#ifdef DBG_TILECONTIG
          if (rep == 1) { pg8::EpiBf16<0> E0{(bf16*)(ws + WS_ACMP_S), 256, nullptr, 256, (size_t)65 * 65536, 1.f};
#else
          if (rep == 1) { pg8::EpiBf16<0> E0{(bf16*)(ws + WS_ACMP_S), NG1, nullptr, 0, 0, 1.f};
#endif
          pg8::gemm_phase<pg8::EpiBf16<0>, pg8::HybridOrder, PG8_ALIGN, PG8_SP2>(lds, g, S, E0); } else
#else
          if (rep == 1) { pg8::EpiNone E0; pg8::gemm_phase<pg8::EpiNone, pg8::HybridOrder, PG8_ALIGN, PG8_SP2>(lds, g, S, E0); } else
#endif
#endif
          pg8::gemm_phase<pg8::EpiG1, pg8::HybridOrder, PG8_ALIGN, PG8_SP2>(lds, g, S, E); }
#ifndef SEAM1_BARRIER
        { VM_WAIT(); __syncthreads();
          if (tid0 == 0) { __builtin_amdgcn_s_waitcnt(0);
              const unsigned nloc = bar.st[0]; const unsigned old = __hip_atomic_fetch_add(ctl + CW_Q + 64 * (61 + (int)bar.x), 1u, RLX_AGENT);
              if (old + 1u == nloc * (unsigned)(rep + 1)) { __builtin_amdgcn_fence(__ATOMIC_RELEASE, "agent"); VM_WAIT(); (void)__hip_atomic_fetch_add(ctl + CW_Q + 64 * 60, 1u, RLX_AGENT); } } }
#endif
        if (P1ON(2)) { pg8::Gemm g{(const bf16*)(ws + WS_PBF), (const bf16*)(ws + WS_WPLE_T), MT, 1024, 256}; pg8::XcdQueueOrder S; S.init(MT, 1024, (unsigned*)(ctl + CW_Q + 64 * 24 + 4096 * rep), gslot, xcc);
          pg8::EpiBf16<0> E{(bf16*)(ws + WS_T1), 1024, nullptr, 0, 0, 1.f};
          pg8::gemm_phase<pg8::EpiBf16<0>, pg8::XcdQueueOrder, PG8_ALIGN, PG8_SP2, true>(lds, g, S, E); }
        REPSEAM(1); }
#ifdef SEAM1_BARRIER
        SEAM(1);
#else
        if (IN(1) && IN(2)) {
            if (tid0 == 0) { unsigned sp = 0; while (__hip_atomic_load(ctl + CW_Q + 64 * 60, RLX_AGENT) < bar.st[1] * (unsigned)NREP(1)) { __builtin_amdgcn_s_sleep(2); if (++sp > (1u << 22)) break; }
                __builtin_amdgcn_fence(__ATOMIC_ACQUIRE, "agent"); VM_WAIT(); }
            __syncthreads(); }
#endif
    }

    if (IN(2)) { _Pragma("unroll") for (int rep = 0; rep < NREP(2); ++rep) {
#if DBG_STAGE == 1
        { v4u z = {0u, 0u, 0u, 0u}; for (size_t i = (size_t)bx * NTHR + tid0; i < (size_t)MT * 1024 / 8; i += (size_t)G * NTHR) *(GAS v4u*)((bf16*)(ws + WS_U) + i * 8) = z; }
#else
        if (bx < 16) {
            const int slot = bx >> 3, b = bx & 7;
            { pg8::EpiHidB128 E{(bf16*)(ws + WS_HIDP), (const float*)(ws + WS_CTL) + CW_BIAS + 1024  };
              pg8::gemm_unit_bf16_128(lds, (const bf16*)(ws + WS_ACMP_P) + (size_t)bx * 128 * 2048, (const bf16*)(ws + WS_W1T), slot, bx * 128, E); }
            VM_WAIT(); __syncthreads();
            int t2 = tid0; asm volatile("" : "+v"(t2)); const int ln = t2 & 63, wv = __builtin_amdgcn_readfirstlane(t2 >> 6);
            if (wv < 4) { const int g = wv >> 1, chf = wv & 1;
                const bf16* hid0 = (const bf16*)(ws + WS_HIDP) + ((size_t)slot * 1024 + (size_t)(b * 64 + 32 * chf) * 2 + g) * 256;
                unsigned char* dst = ws + (slot ? WS_VCP : WS_KCP) + ((size_t)((b * 2 + g) * 64 + 32 * chf)) * 128;
                l2_wave<false>((const bf16*)(ws + WS_W2T) + slot * 64 * 256, hid0, 512, slot ? nullptr : (const float*)a.in[IN_KCG], dst, 128, ln); } }
        bool arrived = false;
        for (;;) {
            int it = next_item(ctl + CW_Q + 128 * rep, qslot);
            int tid = tid0; asm volatile("" : "+v"(tid)); const int lane = tid & 63, wave = __builtin_amdgcn_readfirstlane(tid >> 6);
            if (!arrived && it >= N_NS + N_SBS + N_WINP) { arrived = true; VM_WAIT(); __syncthreads();
                if (tid == 0) { __builtin_amdgcn_s_waitcnt(0);
                    const unsigned nloc = bar.st[0]; const unsigned old = __hip_atomic_fetch_add(ctl + CW_Q + 64 * (43 + (int)bar.x), 1u, RLX_AGENT);
                    if (old + 1u == nloc * (unsigned)(rep + 1)) { __builtin_amdgcn_fence(__ATOMIC_RELEASE, "agent"); VM_WAIT(); (void)__hip_atomic_fetch_add(ctl + CW_Q + 64 * 42, 1u, RLX_AGENT); } } }
            if (it >= N_NS + N_SBS + N_WINP + N_SBP) break;
#ifndef DBG_IM
#define DBG_IM 63
#endif
#ifndef DBG_REPIM
#define DBG_REPIM 63
#endif
#define IMON(bit) ((DBG_IM & (bit)) && (rep == 0 || (DBG_REPIM & (bit))))
            if (it < N_NS) { if (IMON(32)) { item_l2_sample(a, it, lane, wave); if (DBG_DUP & 1) { VM_WAIT(); item_l2_sample(a, it, lane, wave); } VM_WAIT(); __syncthreads(); item_nsa_sample(a, lds, it, tid, lane, wave); if (DBG_DUP & 16) { __syncthreads(); item_nsa_sample(a, lds, it, tid, lane, wave); } } continue; } it -= N_NS;
            if (it < N_SBS) { if (IMON(2)) item_sb_sample(a, lds, it, lane, wave); continue; } it -= N_SBS;
            if (it < N_WINP) { if (IMON(4)) item_win_prompt(a, lds, it, tid, lane, wave); continue; } it -= N_WINP;
            if (IMON(8)) item_sb_prompt(a, lds, it, lane, wave);
        }
#endif
        REPSEAM(2); }
#ifdef SEAM2_BARRIER
        SEAM(2);
#else
        if (IN(2) && IN(3)) {
            if (tid0 == 0) { unsigned sp = 0; while (__hip_atomic_load(ctl + CW_Q + 64 * 42, RLX_AGENT) < bar.st[1] * (unsigned)NREP(2)) { __builtin_amdgcn_s_sleep(2); if (++sp > (1u << 22)) break; }
                __builtin_amdgcn_fence(__ATOMIC_ACQUIRE, "agent"); VM_WAIT(); }
            __syncthreads(); }
#endif
    }

    if (IN(3)) { _Pragma("unroll") for (int rep = 0; rep < NREP(3); ++rep) {
#if DBG_STAGE != 1
        for (;;) {
            int it = next_item(ctl + CW_Q + 64 + 128 * rep, qslot);
            int tid = tid0; asm volatile("" : "+v"(tid)); const int lane = tid & 63, wave = __builtin_amdgcn_readfirstlane(tid >> 6);
            if (it >= N_NP + 8) break;
            gu32* dep1 = ctl + CW_Q + 64 * 41;
            if (it < 4 || (it >= 300 && it < 304)) {
                const bool second = it >= 300; const int pn = second ? it - 300 : it;
                if (rep == 0) {
                if (!second) { pg8::Gemm g{(const bf16*)(ws + WS_U), (const bf16*)(ws + WS_WOUT_T), MT, 1024, 1024}; pg8::OneUnit S{64, pn};
                    pg8::EpiOut E{(const bf16*)(ws + WS_HBF), (bf16*)(ws + WS_HB2)};
                    pg8::gemm_phase<pg8::EpiOut, pg8::OneUnit, PG8_ALIGN, PG8_SP2>(lds, g, S, E);
                    VM_WAIT(); __syncthreads();
                    if (tid == 0) { __builtin_amdgcn_fence(__ATOMIC_RELEASE, "agent"); VM_WAIT(); (void)__hip_atomic_fetch_add(dep1, 1u, RLX_AGENT); } }
                else {
                    if (tid == 0) { unsigned sp = 0; while (__hip_atomic_load(dep1, RLX_AGENT) < 4u) { __builtin_amdgcn_s_sleep(2); if (++sp > (1u << 22)) break; }
                        __builtin_amdgcn_fence(__ATOMIC_ACQUIRE, "agent"); VM_WAIT(); }
                    __syncthreads();
                    pg8::Gemm g{(const bf16*)(ws + WS_HB2), (const bf16*)(ws + WS_WG_T), MT, 1024, 1024}; pg8::OneUnit S{64, pn};
                    pg8::EpiFinal E{a.out, (const bf16*)(ws + WS_T1), (const bf16*)(ws + WS_HB2)};
                    pg8::gemm_phase<pg8::EpiFinal, pg8::OneUnit, PG8_ALIGN, PG8_SP2>(lds, g, S, E); }
                }
                continue; }
            it -= (it >= 304) ? 8 : 4;
            if (IMON(16)) item_nsa_prompt(a, lds, it, tid, lane, wave);
        }
#endif
        REPSEAM(3); }
#ifdef WINCOPY_P0
        SEAM(3);
#else
        if (IN(3) && IN(4)) { VM_WAIT(); __syncthreads();
            if (tid0 == 0) { __builtin_amdgcn_s_waitcnt(0);
                const unsigned nloc = bar.st[0]; const unsigned old = __hip_atomic_fetch_add(ctl + CW_Q + 64 * (150 + (int)bar.x), 1u, RLX_AGENT);
                if (old + 1u == nloc) { __builtin_amdgcn_fence(__ATOMIC_RELEASE, "agent"); VM_WAIT(); (void)__hip_atomic_fetch_add(ctl + CW_Q + 64 * 149, 1u, RLX_AGENT); } } }
        { const float* sw = (const float*)a.in[IN_SWIN]; float* dst = a.out + OFF_WINS;
          for (;;) { const int c = next_item(ctl + CW_Q + 64 * 78, qslot); if (c >= 252) break;
              int tid = tid0; asm volatile("" : "+v"(tid)); f32x4 v[8];
#pragma unroll
              for (int u = 0; u < 8; ++u) { const int idx = c * 4096 + u * NTHR + tid, q = idx & 63, i = (idx >> 6) % 504, b = (idx >> 6) / 504; v[u] = *(const GAS f32x4*)(sw + ((size_t)(b * 512 + i + 8) * 256) + q * 4); }
#pragma unroll
              for (int u = 0; u < 8; ++u) { const int idx = c * 4096 + u * NTHR + tid, q = idx & 63, i = (idx >> 6) % 504, b = (idx >> 6) / 504; *(GAS f32x4*)(dst + ((size_t)(b * 512 + i) * 256) + q * 4) = v[u]; } } }
        if (IN(3) && IN(4)) {
            if (tid0 == 0) { unsigned sp = 0; while (__hip_atomic_load(ctl + CW_Q + 64 * 149, RLX_AGENT) < bar.st[1]) { __builtin_amdgcn_s_sleep(2); if (++sp > (1u << 22)) break; }
                __builtin_amdgcn_fence(__ATOMIC_ACQUIRE, "agent"); VM_WAIT(); }
            __syncthreads(); }
#endif
    }

    if (IN(4)) { _Pragma("unroll") for (int rep = 0; rep < NREP(4); ++rep) {
        pg8::Gemm g{(const bf16*)(ws + WS_U), (const bf16*)(ws + WS_WOUT_T), MP, 1024, 1024}; pg8::StaticOrder S; S.init(MP, 1024, G, bx);
        pg8::EpiOut E{(const bf16*)(ws + WS_HBF), (bf16*)(ws + WS_HB2)};
        pg8::gemm_phase<pg8::EpiOut, pg8::StaticOrder, PG8_ALIGN, PG8_SP2>(lds, g, S, E);
        REPSEAM(4); }
        SEAM(4);
    }
    if (IN(5)) {
        pg8::Gemm g{(const bf16*)(ws + WS_HB2), (const bf16*)(ws + WS_WG_T), MP, 1024, 1024}; pg8::StaticOrder S; S.init(MP, 1024, G, bx);
        pg8::EpiFinal E{a.out, (const bf16*)(ws + WS_T1), (const bf16*)(ws + WS_HB2)};
        pg8::gemm_phase<pg8::EpiFinal, pg8::StaticOrder, PG8_ALIGN, PG8_SP2>(lds, g, S, E);
    }
#undef IN
#undef SEAM
}

extern "C" void kernel_launch(void* const* d_in, const int* in_sizes, int n_in, void* d_out, int out_size, void* d_ws, size_t ws_size, hipStream_t stream) {
    static int grid = 0;
    if (grid == 0) {
        if (n_in != N_INPUTS || (size_t)out_size != OUT_TOTAL || ws_size < WS_END) { fprintf(stderr, "kernel_launch: unexpected shapes (n_in %d, out %d, ws %zu); nothing launched\n", n_in, out_size, ws_size); grid = -1; return; }
        int dev = 0, cus = 0;
        if (hipGetDevice(&dev) != hipSuccess || hipDeviceGetAttribute(&cus, hipDeviceAttributeMultiprocessorCount, dev) != hipSuccess) { grid = -1; return; }
        if (hipFuncSetAttribute((const void*)mk_fwd, hipFuncAttributeMaxDynamicSharedMemorySize, LDS_BYTES) != hipSuccess) { fprintf(stderr, "kernel_launch: hipFuncSetAttribute failed\n"); grid = -1; return; }
        int per_cu = 0;
        if (hipOccupancyMaxActiveBlocksPerMultiprocessor(&per_cu, (const void*)mk_fwd, NTHR, LDS_BYTES) != hipSuccess || per_cu < 1) { fprintf(stderr, "kernel_launch: occupancy query says %d\n", per_cu); per_cu = 1; }
        (void)hipGetLastError();
        grid = cus;
    }
    if (grid < 0) return;
    if (hipMemsetAsync((char*)d_ws + WS_CTL, 0, CTL_ZERO_BYTES, stream) != hipSuccess) { fprintf(stderr, "kernel_launch: memset failed\n"); return; }
    Args a{};
    for (int i = 0; i < N_INPUTS; ++i) a.in[i] = d_in[i];
    a.out = (float*)d_out; a.ws = (unsigned char*)d_ws;
#if MK_N_LAUNCHES == 1
    a.ph_lo = 0; a.ph_hi = N_PHASES;
    hipLaunchKernelGGL(mk_fwd, dim3(grid), dim3(NTHR), LDS_BYTES, stream, a);
#else
    for (int p = 0; p < N_PHASES; ++p) { a.ph_lo = p; a.ph_hi = p + 1; hipLaunchKernelGGL(mk_fwd, dim3(grid), dim3(NTHR), LDS_BYTES, stream, a); }
#endif
    const hipError_t le = hipPeekAtLastError();
    if (le != hipSuccess) fprintf(stderr, "kernel_launch: launch failed: %s\n", hipGetErrorName(le));
}
```
